# Optimizing an MI355X kernel written in HIP

```python
import math
import jax, jax.numpy as jnp
from jax import lax
import numpy as np

D_MODEL = 4096
BATCH = 1
SEQ = 8192
DEPTH = 1

GRID_W = 64
CTX_LEN = 256
MLA_HEADS = 16
QK_NOPE = 128
QK_ROPE = 64
V_HEAD = 128
Q_LORA = 768
KV_LORA = 512
ROPE_THETA = 10000.0
Q_BLOCK = 128
SOFTMAX_SCALE = 1.0 / math.sqrt(QK_NOPE + QK_ROPE)
CONV_CH = 2048
CONV_GROUPS = 16
CONV_K = 3
PEER_HEADS = 8
N_KEYS = 128
N_EXPERTS = N_KEYS * N_KEYS
PEER_TOPK = 16
PEER_DK = 256
PEER_BLOCK = 32
MLA_WIDTH = MLA_HEADS * V_HEAD
MIX_WIDTH = MLA_WIDTH + CONV_CH
O_CQ = 0
O_CKV = Q_LORA
O_KR = Q_LORA + KV_LORA
O_CONV = O_KR + QK_ROPE
IN_COLS = O_CONV + 3 * CONV_CH
N_MOD = 6
EPS = 1e-6

kernel_name = "hybrid_mla_shortconv_peer_dit"


def rmsnorm(x, g):
    xf = x.astype(jnp.float32)
    y = xf * lax.rsqrt(jnp.mean(xf * xf, axis=-1, keepdims=True) + EPS)
    return (y * g.astype(jnp.float32)).astype(x.dtype)


def adaln(cond, w, b):
    m = jax.nn.silu(cond) @ w + b
    return m.reshape(*cond.shape[:-1], N_MOD, D_MODEL)


def modulate(h, shift, scale):
    return h * (1 + scale) + shift


def axial_tables(T, dtype):
    rows = T // GRID_W
    row = jnp.repeat(jnp.arange(rows), GRID_W).astype(jnp.float32)
    col = jnp.tile(jnp.arange(GRID_W), rows).astype(jnp.float32)
    half = QK_ROPE // 2
    freqs = ROPE_THETA ** (-jnp.arange(0, half, 2, dtype=jnp.float32) / half)
    ang_r = row[:, None] * freqs
    ang_c = col[:, None] * freqs
    return tuple(t.astype(dtype) for t in (jnp.cos(ang_r), jnp.sin(ang_r), jnp.cos(ang_c), jnp.sin(ang_c)))


def rotate(x, cos, sin):
    x1, x2 = jnp.split(x, 2, axis=-1)
    return jnp.concatenate([x1 * cos - x2 * sin, x2 * cos + x1 * sin], axis=-1)


def axial_rope(x, tabs):
    cr, sr, cc, sc = tabs
    xr, xc = jnp.split(x, 2, axis=-1)
    return jnp.concatenate([rotate(xr, cr, sr), rotate(xc, cc, sc)], axis=-1)


def mla_queries(cq, q_norm_g, w_uq):
    B, S, _ = cq.shape
    q = (rmsnorm(cq, q_norm_g) @ w_uq).reshape(B, S, MLA_HEADS, QK_NOPE + QK_ROPE)
    return q[..., :QK_NOPE], q[..., QK_NOPE:]


def mla_keys(ckv, kv_norm_g, w_ukv):
    B, S, _ = ckv.shape
    kv = (rmsnorm(ckv, kv_norm_g) @ w_ukv).reshape(B, S, MLA_HEADS, QK_NOPE + V_HEAD)
    return kv[..., :QK_NOPE], kv[..., QK_NOPE:]


def attend(q_nope, q_rope, k_nope, k_rope, v):
    B, S, H, _ = q_nope.shape
    nb = S // Q_BLOCK
    qn = q_nope.reshape(B, nb, Q_BLOCK, H, QK_NOPE).transpose(1, 0, 2, 3, 4)
    qr = q_rope.reshape(B, nb, Q_BLOCK, H, QK_ROPE).transpose(1, 0, 2, 3, 4)

    def block(args):
        qn_b, qr_b = args
        s = (jnp.einsum('bqhd,bkhd->bhqk', qn_b, k_nope)
             + jnp.einsum('bqhr,bkr->bhqk', qr_b, k_rope)).astype(jnp.float32) * SOFTMAX_SCALE
        p = jax.nn.softmax(s, axis=-1).astype(v.dtype)
        return jnp.einsum('bhqk,bkhd->bqhd', p, v)

    o = lax.map(block, (qn, qr))
    return o.transpose(1, 0, 2, 3, 4).reshape(B, S, H * V_HEAD)


def short_conv(pconv, w, b):
    xin, gb, gc = jnp.split(pconv, 3, axis=-1)
    u = jnp.pad(gc * xin, ((0, 0), (1, 1), (0, 0)))
    y = u[:, :-2] * w[0] + u[:, 1:-1] * w[1] + u[:, 2:] * w[2] + b
    return gb * y


def peer(h, w_q, keys, u, v):
    B, S, D = h.shape
    q = (h @ w_q).reshape(B, S, PEER_HEADS, 2, PEER_DK // 2)
    s = jnp.einsum('bshpd,hpkd->bshpk', q, keys)
    s1, i1 = lax.top_k(s[..., 0, :], PEER_TOPK)
    s2, i2 = lax.top_k(s[..., 1, :], PEER_TOPK)
    cand = (s1[..., :, None] + s2[..., None, :]).reshape(B, S, PEER_HEADS, PEER_TOPK * PEER_TOPK)
    top, flat = lax.top_k(cand, PEER_TOPK)
    e = (jnp.take_along_axis(i1, flat // PEER_TOPK, axis=-1) * N_KEYS
         + jnp.take_along_axis(i2, flat % PEER_TOPK, axis=-1))
    g = jax.nn.softmax(top.astype(jnp.float32), axis=-1).astype(h.dtype)
    nb = (B * S) // PEER_BLOCK
    hb = h.reshape(nb, PEER_BLOCK, D)
    eb = e.reshape(nb, PEER_BLOCK, PEER_HEADS * PEER_TOPK)
    gb = g.reshape(nb, PEER_BLOCK, PEER_HEADS * PEER_TOPK)

    def block(args):
        h_b, e_b, g_b = args
        act = jnp.einsum('td,tkd->tk', h_b, u[e_b])
        wgt = g_b * jax.nn.gelu(act, approximate=False)
        return jnp.einsum('tk,tkd->td', wgt, v[e_b])

    return lax.map(block, (hb, eb, gb)).reshape(B, S, D)


def setup_inputs(seed: int = 0) -> dict:
    key = jax.random.key(seed)
    ks = jax.random.split(key, 21)
    f32 = jnp.float32

    def nrm(k, shape, s):
        return jax.random.normal(k, shape, f32) * s

    D = D_MODEL
    return {
        "x": nrm(ks[0], (BATCH, SEQ, D), 1.0),
        "c": nrm(ks[1], (BATCH, D), 1.0),
        "ctx": nrm(ks[2], (BATCH, CTX_LEN, D), 1.0),
        "c_ctx": nrm(ks[3], (D,), 1.0),
        "w_ada": nrm(ks[4], (DEPTH, D, N_MOD * D), D ** -0.5),
        "b_ada": nrm(ks[5], (DEPTH, N_MOD * D), 0.01),
        "norm1_g": 1.0 + nrm(ks[6], (DEPTH, D), 0.02),
        "w_in": nrm(ks[7], (DEPTH, D, IN_COLS), D ** -0.5),
        "q_norm_g": 1.0 + nrm(ks[8], (DEPTH, Q_LORA), 0.02),
        "w_uq": nrm(ks[9], (DEPTH, Q_LORA, MLA_HEADS * (QK_NOPE + QK_ROPE)), Q_LORA ** -0.5),
        "kv_norm_g": 1.0 + nrm(ks[10], (DEPTH, KV_LORA), 0.02),
        "w_ukv": nrm(ks[11], (DEPTH, KV_LORA, MLA_HEADS * (QK_NOPE + V_HEAD)), KV_LORA ** -0.5),
        "conv_w": nrm(ks[12], (DEPTH, CONV_K, CONV_CH), CONV_K ** -0.5),
        "conv_b": nrm(ks[13], (DEPTH, CONV_CH), 0.01),
        "w_o": nrm(ks[14], (DEPTH, MIX_WIDTH, D), MIX_WIDTH ** -0.5),
        "norm2_g": 1.0 + nrm(ks[15], (DEPTH, D), 0.02),
        "peer_wq": nrm(ks[16], (DEPTH, D, PEER_HEADS * PEER_DK), D ** -0.5),
        "peer_keys": nrm(ks[17], (DEPTH, PEER_HEADS, 2, N_KEYS, PEER_DK // 2), (PEER_DK // 2) ** -0.5),
        "peer_u": nrm(ks[18], (DEPTH, N_EXPERTS, D), D ** -0.5),
        "peer_v": nrm(ks[19], (DEPTH, N_EXPERTS, D), PEER_HEADS ** -0.5),
        "final_norm_g": 1.0 + nrm(ks[20], (D,), 0.02),
    }


def reference(x, c, ctx, c_ctx, w_ada, b_ada, norm1_g, w_in, q_norm_g, w_uq, kv_norm_g,
              w_ukv, conv_w, conv_b, w_o, norm2_g, peer_wq, peer_keys, peer_u, peer_v,
              final_norm_g):
    T = x.shape[1]
    tabs_k = axial_tables(T, x.dtype)
    tabs_q = tuple(t[:, None, :] for t in tabs_k)
    xc = ctx
    for i in range(DEPTH):
        last = i == DEPTH - 1
        m_x = adaln(c, w_ada[i], b_ada[i])[:, None]
        m_c = adaln(c_ctx, w_ada[i], b_ada[i])

        hx = modulate(rmsnorm(x, norm1_g[i]), m_x[..., 0, :], m_x[..., 1, :])
        hc = modulate(rmsnorm(xc, norm1_g[i]), m_c[0], m_c[1])
        px = hx @ w_in[i]
        if last:
            pc = hc @ w_in[i][:, O_CKV:O_CONV]
            ckv_c, kr_c = pc[..., :KV_LORA], pc[..., KV_LORA:]
        else:
            pc = hc @ w_in[i]
            ckv_c, kr_c = pc[..., O_CKV:O_KR], pc[..., O_KR:O_CONV]

        kn_c, v_c = mla_keys(ckv_c, kv_norm_g[i], w_ukv[i])
        kn_x, v_x = mla_keys(px[..., O_CKV:O_KR], kv_norm_g[i], w_ukv[i])
        kr_x = axial_rope(px[..., O_KR:O_CONV], tabs_k)
        qn_x, qr_x = mla_queries(px[..., O_CQ:O_CKV], q_norm_g[i], w_uq[i])
        qr_x = axial_rope(qr_x, tabs_q)
        att_x = attend(qn_x, qr_x,
                       jnp.concatenate([kn_x, kn_c], axis=1),
                       jnp.concatenate([kr_x, kr_c], axis=1),
                       jnp.concatenate([v_x, v_c], axis=1))
        conv_x = short_conv(px[..., O_CONV:], conv_w[i], conv_b[i])
        x = x + m_x[..., 2, :] * (jnp.concatenate([att_x, conv_x], axis=-1) @ w_o[i])

        h2 = modulate(rmsnorm(x, norm2_g[i]), m_x[..., 3, :], m_x[..., 4, :])
        x = x + m_x[..., 5, :] * peer(h2, peer_wq[i], peer_keys[i], peer_u[i], peer_v[i])

        if not last:
            qn_c, qr_c = mla_queries(pc[..., O_CQ:O_CKV], q_norm_g[i], w_uq[i])
            att_c = attend(qn_c, qr_c, kn_c, kr_c, v_c)
            conv_c = short_conv(pc[..., O_CONV:], conv_w[i], conv_b[i])
            xc = xc + m_c[2] * (jnp.concatenate([att_c, conv_c], axis=-1) @ w_o[i])
            h2c = modulate(rmsnorm(xc, norm2_g[i]), m_c[3], m_c[4])
            xc = xc + m_c[5] * peer(h2c, peer_wq[i], peer_keys[i], peer_u[i], peer_v[i])
    return rmsnorm(x, final_norm_g)
```

```cpp
#include <hip/hip_runtime.h>
#include <cstdio>
#include <cstdint>
#include <cmath>
namespace pg8 {
#define PG8_LAS __attribute__((address_space(3)))
typedef unsigned short bf16_t;
typedef short bf16x8 __attribute__((ext_vector_type(8)));
typedef float f32x4 __attribute__((ext_vector_type(4)));
typedef unsigned u32x4 __attribute__((ext_vector_type(4)));
constexpr int BM = 256, BK = 64, HALF = 128, HTB = HALF * BK * 2  , STAGE_BYTES = 8 * HTB, NXCD = 8, WGM = 8;

__host__ __device__ __forceinline__ int lds_byte(int r, int c) { const int st = (r >> 4) * 2 + (c >> 5), rr = r & 15, cc = c & 31, ob = rr * 64 + cc * 2; return st * 1024 + (ob ^ (((ob >> 9) & 1) << 5)); }
__host__ __device__ __forceinline__ void stage_rc(int b, int& R, int& C) { const int st = b / 1024, sb = b % 1024, swz = sb ^ (((sb >> 9) & 1) << 5); R = (st >> 1) * 16 + swz / 64; C = (st & 1) * 32 + (swz % 64) / 2; }
__host__ __device__ __forceinline__ int perm32(int rho) { const int n = rho >> 4, i = rho & 15; return 8 * (i >> 2) + 4 * n + (i & 3); }

struct Unit { int pm, pn; };
struct Gemm { const bf16_t* A; const bf16_t* Bt; int M, N, K; size_t a_pn; size_t b_pm; };

struct StaticOrder {
    int nM, nN, nwg, G, c;
    __host__ __device__ void init(int M, int N, int G_, int c_) { nM = M / BM; nN = N / BM; nwg = nM * nN; G = G_; c = c_; }
    __host__ __device__ bool next(int i, Unit& u) const {
        const long L = (long)i * G + c; if (L >= nwg) return false;
        int wgid = (int)L; { const int q = nwg / NXCD, r = nwg % NXCD, xcd = wgid % NXCD, off = wgid / NXCD; wgid = (xcd < r ? xcd * (q + 1) : r * (q + 1) + (xcd - r) * q) + off; }
        const int nig = WGM * nN, gid = wgid / nig, fm = gid * WGM, gsz = (nM - fm) < WGM ? (nM - fm) : WGM;
        u.pm = fm + ((wgid % nig) % gsz); u.pn = (wgid % nig) / gsz; return true;
    }
    __device__ __forceinline__ void a_ready(const Unit&) const {}
    __device__ __forceinline__ void done(const Unit&) const {}
};

__device__ __forceinline__ unsigned cvt_pk_bf16(float lo, float hi) { unsigned r; asm volatile("v_cvt_pk_bf16_f32 %0, %1, %2" : "=v"(r) : "v"(lo), "v"(hi)); return r; }
typedef float f32x2 __attribute__((ext_vector_type(2)));
__device__ __forceinline__ f32x2 gelu_pk(f32x2 v) {
    const f32x2 av = __builtin_elementwise_abs(v), d = av * 0.2316418882f + 1.0f;
    f32x2 t; t.x = __builtin_amdgcn_rcpf(d.x); t.y = __builtin_amdgcn_rcpf(d.y);
    f32x2 q = t * 0.5307027145f + (-0.7265760135f); q = q * t + 0.7107068705f; q = q * t + (-0.142248368f); q = q * t + 0.127414796f; q = q * t;
    const f32x2 s = (v * v) * (-0.72134752044f);
    f32x2 e; e.x = __builtin_amdgcn_exp2f(s.x); e.y = __builtin_amdgcn_exp2f(s.y);
    const f32x2 m = v * (q * e), r = v - m;
    f32x2 o; o.x = v.x < 0.f ? m.x : r.x; o.y = v.y < 0.f ? m.y : r.y; return o;
}


__device__ __forceinline__ u32x4 pack8(f32x4 v0, f32x4 v1) { u32x4 w; w.x = cvt_pk_bf16(v0[0], v0[1]); w.y = cvt_pk_bf16(v0[2], v0[3]); w.z = cvt_pk_bf16(v1[0], v1[1]); w.w = cvt_pk_bf16(v1[2], v1[3]); return w; }
__device__ __forceinline__ float quad_row_sum(float s) { s += __shfl_xor(s, 16); s += __shfl_xor(s, 32); return s; }

__device__ __forceinline__ f32x4 rope4(f32x4 v, const float* tab, int i) {
    const f32x4 cs = *(const f32x4*)(tab + 2 * i);
    f32x4 o; o[0] = v[0] * cs[0] - v[1] * cs[1]; o[1] = v[1] * cs[0] + v[0] * cs[1]; o[2] = v[2] * cs[2] - v[3] * cs[3]; o[3] = v[3] * cs[2] + v[2] * cs[3]; return o;
}

struct EpiIn {
    static constexpr bool PERM = true, AFTER_DRAIN = false;
    bf16_t* cq; bf16_t* ckv; bf16_t* kr; bf16_t* ub; bf16_t* gb; float* ssq_cq; float* ssq_ckv; const float* rope;
    __device__ __forceinline__ void operator()(const f32x4 (&acc)[2][2][4][2], const Unit& u, int wr, int wc, int fr, int fq) const {
        const int pn = u.pn, row0 = u.pm * BM + wr * 64 + fr, cw = wc * 32 + 8 * fq;
        if (pn < 5) {
            bf16_t* dst = pn < 3 ? cq : ckv; const int ld = pn < 3 ? 768 : 512, pl = pn < 3 ? pn : pn - 3, coff = pl * 256 + cw, nsl = pn < 3 ? 12 : 8; float* ssq = pn < 3 ? ssq_cq : ssq_ckv;
#pragma unroll
            for (int ai = 0; ai < 2; ++ai)
#pragma unroll
                for (int m = 0; m < 4; ++m) { const int row = row0 + ai * HALF + m * 16; float s = 0.f;
#pragma unroll
                    for (int bj = 0; bj < 2; ++bj) { const f32x4 v0 = acc[ai][bj][m][0], v1 = acc[ai][bj][m][1];
                        s += (v0[0] * v0[0] + v0[1] * v0[1]) + (v0[2] * v0[2] + v0[3] * v0[3]) + (v1[0] * v1[0] + v1[1] * v1[1]) + (v1[2] * v1[2] + v1[3] * v1[3]);
                        *(u32x4*)(dst + (size_t)row * ld + coff + bj * HALF) = pack8(v0, v1); }
                    s = quad_row_sum(s); if (fq == 0) ssq[(size_t)row * nsl + pl * 4 + wc] = s; }
        } else if (pn == 5) {
            if (wc < 2) {
#pragma unroll
                for (int ai = 0; ai < 2; ++ai)
#pragma unroll
                    for (int m = 0; m < 4; ++m) { const int row = row0 + ai * HALF + m * 16; f32x4 v0 = acc[ai][0][m][0], v1 = acc[ai][0][m][1];
                        if (row < 8192) { const int pos = wc == 0 ? (row >> 6) : 128 + (row & 63); const float* tab = rope + pos * 32; v0 = rope4(v0, tab, 4 * fq); v1 = rope4(v1, tab, 4 * fq + 2); }
                        *(u32x4*)(kr + (size_t)row * 64 + cw) = pack8(v0, v1); }
            }
        } else if (pn < 22) {
            const int j = pn - 6;
#pragma unroll
            for (int ai = 0; ai < 2; ++ai)
#pragma unroll
                for (int m = 0; m < 4; ++m) { const int row = row0 + ai * HALF + m * 16;
                    *(u32x4*)(ub + (size_t)row * 2048 + j * 128 + cw) = pack8(acc[ai][0][m][0] * acc[ai][1][m][0], acc[ai][0][m][1] * acc[ai][1][m][1]); }
        } else {
            const int j = pn - 22;
#pragma unroll
            for (int ai = 0; ai < 2; ++ai)
#pragma unroll
                for (int m = 0; m < 4; ++m) { const int row = row0 + ai * HALF + m * 16;
#pragma unroll
                    for (int bj = 0; bj < 2; ++bj) *(u32x4*)(gb + (size_t)row * 2048 + j * 256 + bj * HALF + cw) = pack8(acc[ai][bj][m][0], acc[ai][bj][m][1]); }
        }
    }
};

struct EpiQ {
    static constexpr bool PERM = true, AFTER_DRAIN = false;
    bf16_t* q; const float* ssq_cq; const float* rope; float c2;
    __device__ __forceinline__ void operator()(const f32x4 (&acc)[2][2][4][2], const Unit& u, int wr, int wc, int fr, int fq) const {
        const int row0 = u.pm * BM + wr * 64 + fr, cw = wc * 32 + 8 * fq;
#pragma unroll
        for (int ai = 0; ai < 2; ++ai)
#pragma unroll
            for (int m = 0; m < 4; ++m) { const int row = row0 + ai * HALF + m * 16; const f32x4 q0 = *(const f32x4*)(ssq_cq + (size_t)row * 12), q1 = *(const f32x4*)(ssq_cq + (size_t)row * 12 + 4), q2 = *(const f32x4*)(ssq_cq + (size_t)row * 12 + 8);
                const float ssum = (((q0[0] + q0[1]) + (q0[2] + q0[3])) + ((q1[0] + q1[1]) + (q1[2] + q1[3]))) + ((q2[0] + q2[1]) + (q2[2] + q2[3])); const float sc = c2 / sqrtf(ssum * (1.f / 768.f) + 1e-6f);
#pragma unroll
                for (int bj = 0; bj < 2; ++bj) { const int col = u.pn * BM + bj * HALF + cw, d = col % 192; f32x4 v0 = acc[ai][bj][m][0] * sc, v1 = acc[ai][bj][m][1] * sc;
                    if (d >= 128) { const int p = d - 128, ax = p >> 5, i = (p & 31) >> 1; const int pos = ax == 0 ? (row >> 6) : 128 + (row & 63); const float* tab = rope + pos * 32;
                        v0 = rope4(v0, tab, i); v1 = rope4(v1, tab, i + 2); }
                    *(u32x4*)(q + (size_t)row * 3072 + col) = pack8(v0, v1); } }
    }
};

struct EpiKV {
    static constexpr bool PERM = true, AFTER_DRAIN = false;
    bf16_t* kn; bf16_t* v; const float* ssq_ckv;
    __device__ __forceinline__ void operator()(const f32x4 (&acc)[2][2][4][2], const Unit& u, int wr, int wc, int fr, int fq) const {
        const int row0 = u.pm * BM + wr * 64 + fr, cw = u.pn * 128 + wc * 32 + 8 * fq;
#pragma unroll
        for (int ai = 0; ai < 2; ++ai)
#pragma unroll
            for (int m = 0; m < 4; ++m) { const int row = row0 + ai * HALF + m * 16; const f32x4 q0 = *(const f32x4*)(ssq_ckv + (size_t)row * 8), q1 = *(const f32x4*)(ssq_ckv + (size_t)row * 8 + 4);
                const float ssum = ((q0[0] + q0[1]) + (q0[2] + q0[3])) + ((q1[0] + q1[1]) + (q1[2] + q1[3])); const float sc = 1.f / sqrtf(ssum * (1.f / 512.f) + 1e-6f);
                *(u32x4*)(kn + (size_t)row * 2048 + cw) = pack8(acc[ai][0][m][0] * sc, acc[ai][0][m][1] * sc);
                *(u32x4*)(v + (size_t)row * 2048 + cw) = pack8(acc[ai][1][m][0] * sc, acc[ai][1][m][1] * sc); }
    }
};

struct EpiO {
    static constexpr bool PERM = true, AFTER_DRAIN = false;
    const float* gate; bf16_t* dlt;
    __device__ __forceinline__ void operator()(const f32x4 (&acc)[2][2][4][2], const Unit& u, int wr, int wc, int fr, int fq) const {
        const int row0 = u.pm * BM + wr * 64 + fr, c0 = u.pn * BM + wc * 32 + 8 * fq;
        f32x4 g[2][2];
#pragma unroll
        for (int bj = 0; bj < 2; ++bj)
#pragma unroll
            for (int n = 0; n < 2; ++n) g[bj][n] = *(const f32x4*)(gate + c0 + bj * HALF + 4 * n);
#pragma unroll
        for (int ai = 0; ai < 2; ++ai)
#pragma unroll
            for (int m = 0; m < 4; ++m) { const int row = row0 + ai * HALF + m * 16;
#pragma unroll
                for (int bj = 0; bj < 2; ++bj) *(u32x4*)(dlt + (size_t)row * 4096 + c0 + bj * HALF) = pack8(g[bj][0] * acc[ai][bj][m][0], g[bj][1] * acc[ai][bj][m][1]); }
    }
};

struct EpiPQ {
    static constexpr bool PERM = true, AFTER_DRAIN = false;
    bf16_t* qp;
    __device__ __forceinline__ void operator()(const f32x4 (&acc)[2][2][4][2], const Unit& u, int wr, int wc, int fr, int fq) const {
        const int row0 = u.pm * BM + wr * 64 + fr, cw = wc * 32 + 8 * fq; bf16_t* base = qp + (size_t)u.pn * 8192 * 256;
#pragma unroll
        for (int ai = 0; ai < 2; ++ai)
#pragma unroll
            for (int m = 0; m < 4; ++m) { const int row = row0 + ai * HALF + m * 16;
#pragma unroll
                for (int bj = 0; bj < 2; ++bj) *(u32x4*)(base + (size_t)row * 256 + bj * HALF + cw) = pack8(acc[ai][bj][m][0], acc[ai][bj][m][1]); }
    }
};

struct EpiB16 {
    static constexpr bool PERM = true, AFTER_DRAIN = false;
    bf16_t* o; int ldc;
    __device__ __forceinline__ void operator()(const f32x4 (&acc)[2][2][4][2], const Unit& u, int wr, int wc, int fr, int fq) const {
        const int row0 = u.pm * BM + wr * 64 + fr, c0 = u.pn * BM + wc * 32 + 8 * fq;
#pragma unroll
        for (int ai = 0; ai < 2; ++ai)
#pragma unroll
            for (int m = 0; m < 4; ++m) { const int row = row0 + ai * HALF + m * 16;
#pragma unroll
                for (int bj = 0; bj < 2; ++bj) *(u32x4*)(o + (size_t)row * ldc + c0 + bj * HALF) = pack8(acc[ai][bj][m][0], acc[ai][bj][m][1]); }
    }
};

struct EpiF32 {
    static constexpr bool PERM = true, AFTER_DRAIN = false;
    float* o; int ldc;
    __device__ __forceinline__ void operator()(const f32x4 (&acc)[2][2][4][2], const Unit& u, int wr, int wc, int fr, int fq) const {
        const int row0 = u.pm * BM + wr * 64 + fr, c0 = u.pn * BM + wc * 32 + 8 * fq;
#pragma unroll
        for (int ai = 0; ai < 2; ++ai)
#pragma unroll
            for (int m = 0; m < 4; ++m) { const int row = row0 + ai * HALF + m * 16;
#pragma unroll
                for (int bj = 0; bj < 2; ++bj)
#pragma unroll
                    for (int n = 0; n < 2; ++n) *(f32x4*)(o + (size_t)row * ldc + c0 + bj * HALF + 4 * n) = acc[ai][bj][m][n]; }
    }
};

struct OrderIn : StaticOrder {
    __device__ bool next(int i, Unit& u) const {
        const long L = (long)i * G + c;
        if (L < nwg) return StaticOrder::next(i, u);
        if (L < nwg + 3) { u.pm = 32; u.pn = 3 + (int)(L - nwg); return true; }
        return false;
    }
};

struct RunOrder {
    int base, cnt, nN;
    __device__ bool next(int i, Unit& u) const { if (i >= cnt) return false; const int idx = base + i; u.pm = idx / nN; u.pn = idx % nN; return true; }
    __device__ __forceinline__ void a_ready(const Unit&) const {}
    __device__ __forceinline__ void done(const Unit&) const {}
};
template <class Epi, class Sched, bool ALIGN_EPI = false, bool SP2 = false>
__device__ __forceinline__ void gemm_phase(PG8_LAS unsigned char* lds, const Gemm g, const Sched& S, const Epi& E) {
    const int tid = threadIdx.x, wid = __builtin_amdgcn_readfirstlane(tid >> 6), lane = tid & 63, wr = wid >> 2, wc = wid & 3, fr = lane & 15, fq = lane >> 4;
    const int K = g.K, nt = K / BK;
    unsigned voffA[2], voffB[2];
#pragma unroll
    for (int i = 0; i < 2; ++i) { int R, C; stage_rc(tid * 16 + i * 8192, R, C); const int Rb = Epi::PERM ? ((R & ~31) + perm32(R & 31)) : R;
        voffA[i] = (unsigned)(R * K + C) * 2u; voffB[i] = (unsigned)(Rb * K + C) * 2u; }
    const size_t kstep = (size_t)(BK * 2);
    const size_t hstep = (size_t)HALF * K * 2;
    const size_t tstep = 2 * hstep;
    const unsigned ldsw = (unsigned)wid * 1024u;
    const int aoff = lds_byte(wr * 64 + fr, fq * 8), boff = lds_byte(wc * 32 + fr, fq * 8);
#define PG8_SA(b, h) (((b) * 2 + (h)) * HTB)
#define PG8_SB(b, h) ((4 + (b) * 2 + (h)) * HTB)
#define PG8_STAGE(bufoff, gbase, voff) do { _Pragma("unroll") for (int _i = 0; _i < 2; ++_i) \
        __builtin_amdgcn_global_load_lds((const unsigned*)((const char*)(gbase) + (voff)[_i]), (PG8_LAS unsigned*)(lds + (bufoff) + ldsw + _i * 8192), 16, 0, 0); } while (0)
#define PG8_LDA(dst, b, h) do { _Pragma("unroll") for (int m = 0; m < 4; ++m) _Pragma("unroll") for (int k = 0; k < 2; ++k) dst[m][k] = *(const PG8_LAS bf16x8*)(lds + PG8_SA(b, h) + aoff + m * 2048 + k * 1024); } while (0)
#define PG8_LDB(dst, b, h) do { _Pragma("unroll") for (int n = 0; n < 2; ++n) _Pragma("unroll") for (int k = 0; k < 2; ++k) dst[n][k] = *(const PG8_LAS bf16x8*)(lds + PG8_SB(b, h) + boff + n * 2048 + k * 1024); } while (0)
#define PG8_MMA(ai, bj, At, Bt) do { __builtin_amdgcn_s_setprio(1); _Pragma("unroll") for (int m = 0; m < 4; ++m) _Pragma("unroll") for (int n = 0; n < 2; ++n) _Pragma("unroll") for (int k = 0; k < 2; ++k) \
        acc[ai][bj][m][n] = __builtin_amdgcn_mfma_f32_16x16x32_bf16(Bt[n][k], At[m][k], acc[ai][bj][m][n], 0, 0, 0); __builtin_amdgcn_s_setprio(0); } while (0)
#define PG8_WAIT_V(n) asm volatile("s_waitcnt vmcnt(" #n ")" ::: "memory")
#define PG8_WAIT_L(n) asm volatile("s_waitcnt lgkmcnt(" #n ")" ::: "memory")
#define PG8_BAR __builtin_amdgcn_s_barrier()
#define PG8_SCHED __builtin_amdgcn_sched_barrier(0)
    Unit cur, nxt; int ui = 0;
    if (!S.next(0, cur)) return;
    f32x4 acc[2][2][4][2];
#pragma unroll
    for (int a = 0; a < 2; ++a)
#pragma unroll
        for (int b = 0; b < 2; ++b)
#pragma unroll
            for (int m = 0; m < 4; ++m)
#pragma unroll
                for (int n = 0; n < 2; ++n) acc[a][b][m][n] = (f32x4){0.f, 0.f, 0.f, 0.f};
    bf16x8 At[4][2], B0[2][2], B1[2][2];
    const char* cA = (const char*)g.A + (size_t)cur.pm * tstep + (size_t)cur.pn * g.a_pn; const char* cB = (const char*)g.Bt + (size_t)cur.pn * tstep + (size_t)cur.pm * g.b_pm;
    S.a_ready(cur);
    if constexpr (SP2) {
        PG8_STAGE(PG8_SB(0, 0), cB, voffB); PG8_STAGE(PG8_SB(0, 1), cB + hstep, voffB); PG8_STAGE(PG8_SA(0, 0), cA, voffA); PG8_STAGE(PG8_SA(0, 1), cA + hstep, voffA);
        if (wr == 1) PG8_BAR;
        PG8_WAIT_V(2); PG8_BAR;
        PG8_STAGE(PG8_SB(1, 0), cB + kstep, voffB); PG8_STAGE(PG8_SA(1, 0), cA + kstep, voffA); PG8_STAGE(PG8_SB(1, 1), cB + hstep + kstep, voffB);
        PG8_WAIT_V(6); PG8_BAR;
    } else {
        PG8_STAGE(PG8_SB(0, 0), cB, voffB); PG8_STAGE(PG8_SA(0, 0), cA, voffA); PG8_STAGE(PG8_SB(0, 1), cB + hstep, voffB); PG8_STAGE(PG8_SA(0, 1), cA + hstep, voffA);
        if (wr == 1) PG8_BAR;
        PG8_WAIT_V(4); PG8_BAR;
        PG8_STAGE(PG8_SB(1, 0), cB + kstep, voffB); PG8_STAGE(PG8_SA(1, 0), cA + kstep, voffA); PG8_STAGE(PG8_SB(1, 1), cB + hstep + kstep, voffB);
        PG8_WAIT_V(6); PG8_BAR;
    }
    for (;;) {
        const bool has_next = S.next(ui + 1, nxt);
        const char* nA = has_next ? (const char*)g.A + (size_t)nxt.pm * tstep + (size_t)nxt.pn * g.a_pn : cA; const char* nB = has_next ? (const char*)g.Bt + (size_t)nxt.pn * tstep + (size_t)nxt.pm * g.b_pm : cB;
        for (int t = 0; t < nt; t += 2) {
            const bool last = (t == nt - 2);
            const char* a1 = cA + (size_t)(t + 1) * kstep;
            const char* a2 = last ? nA : cA + (size_t)(t + 2) * kstep; const char* b2 = last ? nB : cB + (size_t)(t + 2) * kstep;
            const char* a3 = a2 + kstep; const char* b3 = b2 + kstep;
            if (last && has_next) S.a_ready(nxt);
            if constexpr (SP2) {
            PG8_LDB(B0, 0, 0); PG8_LDB(B1, 0, 1); PG8_SCHED; PG8_LDA(At, 0, 0); PG8_STAGE(PG8_SA(1, 1), a1 + hstep, voffA);
            PG8_WAIT_V(8); PG8_WAIT_L(0); PG8_BAR; PG8_MMA(0, 0, At, B0); PG8_MMA(0, 1, At, B1); PG8_BAR; PG8_SCHED;
            PG8_LDA(At, 0, 1); PG8_STAGE(PG8_SB(0, 0), b2, voffB); PG8_STAGE(PG8_SB(0, 1), b2 + hstep, voffB); PG8_STAGE(PG8_SA(0, 0), a2, voffA);
            PG8_WAIT_V(8); PG8_WAIT_L(0); PG8_BAR; PG8_MMA(1, 0, At, B0); PG8_MMA(1, 1, At, B1); PG8_BAR; PG8_SCHED;
            PG8_LDB(B0, 1, 0); PG8_LDB(B1, 1, 1); PG8_SCHED; PG8_LDA(At, 1, 0); PG8_STAGE(PG8_SA(0, 1), a2 + hstep, voffA);
            PG8_WAIT_V(8); PG8_WAIT_L(0); PG8_BAR; PG8_MMA(0, 0, At, B0); PG8_MMA(0, 1, At, B1); PG8_BAR; PG8_SCHED;
            PG8_LDA(At, 1, 1); PG8_STAGE(PG8_SB(1, 0), b3, voffB); PG8_STAGE(PG8_SB(1, 1), b3 + hstep, voffB); PG8_STAGE(PG8_SA(1, 0), a3, voffA);
            PG8_WAIT_V(8); PG8_WAIT_L(0); PG8_BAR; PG8_MMA(1, 0, At, B0); PG8_MMA(1, 1, At, B1); PG8_BAR; PG8_SCHED;
            } else {
            PG8_LDB(B0, 0, 0); PG8_SCHED; PG8_LDA(At, 0, 0); PG8_STAGE(PG8_SA(1, 1), a1 + hstep, voffA);
            PG8_WAIT_L(8); PG8_BAR; PG8_WAIT_L(0); PG8_MMA(0, 0, At, B0); PG8_BAR; PG8_SCHED;
            PG8_LDB(B1, 0, 1); PG8_STAGE(PG8_SB(0, 0), b2, voffB);
            PG8_BAR; PG8_WAIT_L(0); PG8_MMA(0, 1, At, B1); PG8_BAR;
            PG8_LDA(At, 0, 1); PG8_STAGE(PG8_SA(0, 0), a2, voffA);
            PG8_BAR; PG8_WAIT_L(0); PG8_MMA(1, 0, At, B0); PG8_BAR; PG8_SCHED;
            PG8_STAGE(PG8_SB(0, 1), b2 + hstep, voffB);
            PG8_WAIT_V(6); PG8_BAR; PG8_MMA(1, 1, At, B1); PG8_BAR;
            PG8_LDB(B0, 1, 0); PG8_SCHED; PG8_LDA(At, 1, 0); PG8_STAGE(PG8_SA(0, 1), a2 + hstep, voffA);
            PG8_WAIT_L(8); PG8_BAR; PG8_WAIT_L(0); PG8_MMA(0, 0, At, B0); PG8_BAR; PG8_SCHED;
            PG8_LDB(B1, 1, 1); PG8_STAGE(PG8_SB(1, 0), b3, voffB);
            PG8_BAR; PG8_WAIT_L(0); PG8_MMA(0, 1, At, B1); PG8_BAR;
            PG8_LDA(At, 1, 1); PG8_STAGE(PG8_SA(1, 0), a3, voffA);
            PG8_BAR; PG8_WAIT_L(0); PG8_MMA(1, 0, At, B0); PG8_BAR; PG8_SCHED;
            PG8_STAGE(PG8_SB(1, 1), b3 + hstep, voffB);
            PG8_WAIT_V(6); PG8_BAR; PG8_MMA(1, 1, At, B1); PG8_BAR;
            }
        }
        if constexpr (ALIGN_EPI) { if (wr == 0) PG8_BAR; }
        if constexpr (!Epi::AFTER_DRAIN) { E(acc, cur, wr, wc, fr, fq); S.done(cur); }
        if (!has_next) break;
#pragma unroll
        for (int a = 0; a < 2; ++a)
#pragma unroll
            for (int b = 0; b < 2; ++b)
#pragma unroll
                for (int m = 0; m < 4; ++m)
#pragma unroll
                    for (int n = 0; n < 2; ++n) acc[a][b][m][n] = (f32x4){0.f, 0.f, 0.f, 0.f};
        cur = nxt; cA = nA; cB = nB; ++ui;
        if constexpr (ALIGN_EPI) { if (wr == 1) PG8_BAR; }
    }
    PG8_WAIT_V(0);
    if constexpr (!ALIGN_EPI) { if (wr == 0) PG8_BAR; }
    PG8_BAR;
    if constexpr (Epi::AFTER_DRAIN) { E.fused(acc, cur, wr, wc, fr, fq, lds, wid, lane); S.done(cur); }
#undef PG8_SA
#undef PG8_SB
#undef PG8_STAGE
#undef PG8_LDA
#undef PG8_LDB
#undef PG8_MMA
#undef PG8_WAIT_V
#undef PG8_WAIT_L
#undef PG8_BAR
#undef PG8_SCHED
}
}

namespace att {
using bf16x8 = __attribute__((ext_vector_type(8))) short;
using s16x4  = __attribute__((ext_vector_type(4))) short;
using f32x16 = __attribute__((ext_vector_type(16))) float;
using u32x4  = __attribute__((ext_vector_type(4))) unsigned;
typedef unsigned short bf16;
constexpr int NW = 8, QBLK = 32, KVBLK = 64;
#ifndef ATT_SDEPTH
#define ATT_SDEPTH 1
#endif
constexpr int SDEPTH = ATT_SDEPTH;
#ifndef QKT_GRP
#define QKT_GRP 4
#endif
constexpr int LDQ = 3072, LDKV = 2048, LDKR = 64, LDO = 4096;
constexpr int SHM_V = 16384, SHM_KN = 16384, SHM_KR = 8192;
constexpr int NSLOT = 3, OFF_V = 0, OFF_KN = NSLOT * SHM_V, OFF_KR = OFF_KN + NSLOT * SHM_KN, OFF_WS = OFF_KR + NSLOT * SHM_KR, SHM_ATTN = OFF_WS + NW * 64 * 4;
#define ALDS __attribute__((address_space(3)))
constexpr float THRL = 8.f * 1.4426950408889634f;
#define KSWZ(row, colB) ((row) * 256 + ((colB) ^ (((row) & 15) << 4)))
#define RSWZ(row, colB) ((row) * 128 + ((colB) ^ ((((row) >> 1) & 7) << 4)))
#define SBAR() __builtin_amdgcn_sched_barrier(0)
__device__ __forceinline__ int crow(int r, int hi) { return (r & 3) + 8 * (r >> 2) + 4 * hi; }
__device__ __forceinline__ unsigned cvtpk(float lo, float hi) { unsigned r; asm volatile("v_cvt_pk_bf16_f32 %0, %1, %2" : "=v"(r) : "v"(lo), "v"(hi)); return r; }

__device__ __forceinline__ void partialSM(f32x16& p0, f32x16& p1, float& m_reg, float& mn, float& alpha) {
  float pmax = p0[0];
#pragma unroll
  for (int r = 1; r < 16; ++r) pmax = fmaxf(pmax, p0[r]);
#pragma unroll
  for (int r = 0; r < 16; ++r) pmax = fmaxf(pmax, p1[r]);
  { auto rr = __builtin_amdgcn_permlane32_swap(__float_as_uint(pmax), __float_as_uint(pmax), false, false);
    pmax = fmaxf(__uint_as_float(rr[0]), __uint_as_float(rr[1])); }
  if (__builtin_expect(__all(pmax - m_reg <= THRL), 1)) { mn = m_reg; alpha = 1.f; }
  else { mn = fmaxf(m_reg, pmax); alpha = __builtin_amdgcn_exp2f(m_reg - mn); m_reg = mn; }
#pragma unroll
  for (int r = 0; r < 16; ++r) p0[r] = p0[r] - mn;
#pragma unroll
  for (int r = 0; r < 16; ++r) p1[r] = p1[r] - mn;
#pragma unroll
  for (int r = 0; r < 16; ++r) p0[r] = __builtin_amdgcn_exp2f(p0[r]);
}
__device__ __forceinline__ void finishSM(f32x16& p0, f32x16& p1, float alpha, float& l_reg, bf16x8& pa0, bf16x8& pa1, bf16x8& pa2, bf16x8& pa3) {
#pragma unroll
  for (int r = 0; r < 16; ++r) p1[r] = __builtin_amdgcn_exp2f(p1[r]);
  float ps = 0;
#pragma unroll
  for (int r = 0; r < 16; ++r) ps += p0[r];
#pragma unroll
  for (int r = 0; r < 16; ++r) ps += p1[r];
  { auto rr = __builtin_amdgcn_permlane32_swap(__float_as_uint(ps), __float_as_uint(ps), false, false);
    ps = __uint_as_float(rr[0]) + __uint_as_float(rr[1]); }
  l_reg = l_reg * alpha + ps;
#define PK4(P, BASE, OUT) do { unsigned a0 = cvtpk(P[BASE + 0], P[BASE + 1]), a1 = cvtpk(P[BASE + 2], P[BASE + 3]);   \
    unsigned b0 = cvtpk(P[BASE + 4], P[BASE + 5]), b1 = cvtpk(P[BASE + 6], P[BASE + 7]);                              \
    auto r0 = __builtin_amdgcn_permlane32_swap(a0, b0, false, false); auto r1 = __builtin_amdgcn_permlane32_swap(a1, b1, false, false); \
    u32x4 w = {r0[0], r1[0], r0[1], r1[1]}; OUT = *reinterpret_cast<bf16x8*>(&w); } while (0)
  PK4(p0, 0, pa0); PK4(p0, 8, pa1); PK4(p1, 0, pa2); PK4(p1, 8, pa3);
#undef PK4
}
#ifndef QKT_PF
#define QKT_PF 0
#endif
#if QKT_PF == 0
__device__ __forceinline__ void qkt(f32x16& p0, f32x16& p1, const char* Kn, const char* Kr, const bf16x8* qr, const char* Qr, int r32, int hi) {
  p0 = f32x16{}; p1 = f32x16{};
#pragma unroll
  for (int d0 = 0; d0 < 8; ++d0) { const int cb = (d0 * 16 + hi * 8) * 2;
    bf16x8 b0 = *reinterpret_cast<const bf16x8*>(Kn + KSWZ(r32, cb));
    bf16x8 b1 = *reinterpret_cast<const bf16x8*>(Kn + KSWZ(32 + r32, cb));
    p0 = __builtin_amdgcn_mfma_f32_32x32x16_bf16(b0, qr[d0], p0, 0, 0, 0);
    p1 = __builtin_amdgcn_mfma_f32_32x32x16_bf16(b1, qr[d0], p1, 0, 0, 0);
    if ((d0 & (QKT_GRP - 1)) == QKT_GRP - 1) SBAR(); }
#pragma unroll
  for (int d0 = 0; d0 < 4; ++d0) { const int cb = (d0 * 16 + hi * 8) * 2;
    bf16x8 b0 = *reinterpret_cast<const bf16x8*>(Kr + RSWZ(r32, cb));
    bf16x8 b1 = *reinterpret_cast<const bf16x8*>(Kr + RSWZ(32 + r32, cb));
    const bf16x8 qf = qr[8 + d0];
    p0 = __builtin_amdgcn_mfma_f32_32x32x16_bf16(b0, qf, p0, 0, 0, 0);
    p1 = __builtin_amdgcn_mfma_f32_32x32x16_bf16(b1, qf, p1, 0, 0, 0);
    if ((d0 & (QKT_GRP - 1)) == QKT_GRP - 1) SBAR(); }
}
#else
__device__ __forceinline__ void qkt(f32x16& p0, f32x16& p1, const char* Kn, const char* Kr, const bf16x8* qr, const char* Qr, int r32, int hi) {
  p0 = f32x16{}; p1 = f32x16{};
  constexpr int NB = QKT_PF + 1;
  bf16x8 kb0[NB], kb1[NB], qf[NB];
#define KLD(S) do { constexpr int s_ = (S), i_ = s_ % NB; if constexpr (s_ < 8) { const int cb = (s_ * 16 + hi * 8) * 2; kb0[i_] = *reinterpret_cast<const bf16x8*>(Kn + KSWZ(r32, cb)); kb1[i_] = *reinterpret_cast<const bf16x8*>(Kn + KSWZ(32 + r32, cb)); } \
    else { const int cb = ((s_ - 8) * 16 + hi * 8) * 2; kb0[i_] = *reinterpret_cast<const bf16x8*>(Kr + RSWZ(r32, cb)); kb1[i_] = *reinterpret_cast<const bf16x8*>(Kr + RSWZ(32 + r32, cb)); qf[i_] = *reinterpret_cast<const bf16x8*>(Qr + (s_ - 8) * 1024); } } while (0)
#define KSTEP(S) do { constexpr int s_ = (S), i_ = s_ % NB; if constexpr (s_ + QKT_PF < 12) KLD(S + QKT_PF); const bf16x8 q_ = s_ < 8 ? qr[s_ < 8 ? s_ : 0] : qf[i_]; \
    p0 = __builtin_amdgcn_mfma_f32_32x32x16_bf16(kb0[i_], q_, p0, 0, 0, 0); p1 = __builtin_amdgcn_mfma_f32_32x32x16_bf16(kb1[i_], q_, p1, 0, 0, 0); } while (0)
  KLD(0); if constexpr (QKT_PF >= 2) KLD(1);
  KSTEP(0); KSTEP(1); KSTEP(2); KSTEP(3); KSTEP(4); KSTEP(5); KSTEP(6); KSTEP(7); KSTEP(8); KSTEP(9); KSTEP(10); KSTEP(11);
#undef KLD
#undef KSTEP
}
#endif
__device__ __forceinline__ int v_st(int k, int c) { const int kk = (k & ~0xC) | ((k & 4) << 1) | ((k & 8) >> 1); return ((kk >> 3) * 4 + (c >> 5)) * 512 + ((kk & 7) * 32 + (c & 31)) * 2; }
__device__ __forceinline__ int v_rd_base(int lane) { return ((lane & 3) << 3) | (((lane >> 2) & 3) << 6) | (((lane >> 4) & 1) << 5) | (((lane >> 5) & 1) << 8); }
constexpr int v_rd_off(int d0, int ks, int half) { return d0 * 512 + ks * 4096 + half * 2048; }
template <int OFF> __device__ __forceinline__ s16x4 tr_read(int vb) {
  s16x4 r; asm volatile("ds_read_b64_tr_b16 %0, %1 offset:%2" : "=&v"(r) : "v"(vb), "i"(OFF) : "memory"); return r;
}
template <int D0> __device__ __forceinline__ void pv_one(f32x16& od, int vb, bf16x8 pa0, bf16x8 pa1, bf16x8 pa2, bf16x8 pa3) {
  const s16x4 l0 = tr_read<v_rd_off(D0, 0, 0)>(vb), h0 = tr_read<v_rd_off(D0, 0, 1)>(vb), l1 = tr_read<v_rd_off(D0, 1, 0)>(vb), h1 = tr_read<v_rd_off(D0, 1, 1)>(vb);
  const s16x4 l2 = tr_read<v_rd_off(D0, 2, 0)>(vb), h2 = tr_read<v_rd_off(D0, 2, 1)>(vb), l3 = tr_read<v_rd_off(D0, 3, 0)>(vb), h3 = tr_read<v_rd_off(D0, 3, 1)>(vb);
  asm volatile("s_waitcnt lgkmcnt(0)" ::: "memory"); SBAR();
#define PK(L, H) (bf16x8){L[0], L[1], L[2], L[3], H[0], H[1], H[2], H[3]}
  od = __builtin_amdgcn_mfma_f32_32x32x16_bf16(pa0, PK(l0, h0), od, 0, 0, 0);
  od = __builtin_amdgcn_mfma_f32_32x32x16_bf16(pa1, PK(l1, h1), od, 0, 0, 0);
  od = __builtin_amdgcn_mfma_f32_32x32x16_bf16(pa2, PK(l2, h2), od, 0, 0, 0);
  od = __builtin_amdgcn_mfma_f32_32x32x16_bf16(pa3, PK(l3, h3), od, 0, 0, 0);
#undef PK
}
__device__ __forceinline__ void pv_d0(f32x16* o, int vb, bf16x8 pa0, bf16x8 pa1, bf16x8 pa2, bf16x8 pa3) {
  pv_one<0>(o[0], vb, pa0, pa1, pa2, pa3); pv_one<1>(o[1], vb, pa0, pa1, pa2, pa3); pv_one<2>(o[2], vb, pa0, pa1, pa2, pa3); pv_one<3>(o[3], vb, pa0, pa1, pa2, pa3);
}

typedef short v4i16_t __attribute__((ext_vector_type(4)));
#define PKF(L_, H_) (bf16x8){L_[0], L_[1], L_[2], L_[3], H_[0], H_[1], H_[2], H_[3]}
#define LDSR128(dst, base, OFF) asm volatile("ds_read_b128 %0, %1 offset:%2" : "=v"(dst) : "v"((unsigned)(uintptr_t)(base)), "i"(OFF) : "memory")
#define LDSRTR(dst, base, OFF) asm volatile("ds_read_b64_tr_b16 %0, %1 offset:%2" : "=v"(dst) : "v"((unsigned)(uintptr_t)(base)), "i"(OFF) : "memory")
#define WAITK(N, A, B) asm volatile("s_waitcnt lgkmcnt(" #N ")" : "+v"(A), "+v"(B) :: "memory")
#define WAITV(N, VL_, VH_) asm volatile("s_waitcnt lgkmcnt(" #N ")" : "+v"(VL_[0]), "+v"(VL_[1]), "+v"(VL_[2]), "+v"(VL_[3]), "+v"(VH_[0]), "+v"(VH_[1]), "+v"(VH_[2]), "+v"(VH_[3]) :: "memory")
template <bool DO_QK, bool DO_PV, class IssueF>
__device__ __forceinline__ void mat_segment(const IssueF& issue, f32x16& p0, f32x16& p1, f32x16* o, const ALDS char* Kn, const ALDS char* Kr, const ALDS char* Vb, const bf16x8* qr, bf16x8 pa0, bf16x8 pa1, bf16x8 pa2, bf16x8 pa3, int r32, int hi, const int probe) {
  bf16x8 kf[4][2]; s16x4 vl[2][4], vh[2][4];
  const int kbase = r32 * 256, ksw = (r32 & 15) << 4, rbase = r32 * 128, rsw = ((r32 >> 1) & 7) << 4, hb = hi * 16;
  asm volatile("s_waitcnt lgkmcnt(0)" ::: "memory");
  if constexpr (DO_QK && DO_PV) {
  p0 = f32x16{}; p1 = f32x16{};
  { const int a_ = kbase + (((0 * 32) + hb) ^ ksw); LDSR128(kf[0][0], Kn + a_, 0); LDSR128(kf[0][1], Kn + a_, 8192); }
  { const int a_ = kbase + (((1 * 32) + hb) ^ ksw); LDSR128(kf[1][0], Kn + a_, 0); LDSR128(kf[1][1], Kn + a_, 8192); }
  { const int a_ = kbase + (((2 * 32) + hb) ^ ksw); LDSR128(kf[2][0], Kn + a_, 0); LDSR128(kf[2][1], Kn + a_, 8192); }
  { const int a_ = kbase + (((3 * 32) + hb) ^ ksw); LDSR128(kf[3][0], Kn + a_, 0); LDSR128(kf[3][1], Kn + a_, 8192); }
  WAITK(6, kf[0][0], kf[0][1]);
  p0 = __builtin_amdgcn_mfma_f32_32x32x16_bf16(kf[0][0], qr[0], p0, 0, 0, 0); p1 = __builtin_amdgcn_mfma_f32_32x32x16_bf16(kf[0][1], qr[0], p1, 0, 0, 0);
  issue(0);
  { const int a_ = kbase + (((4 * 32) + hb) ^ ksw); LDSR128(kf[0][0], Kn + a_, 0); LDSR128(kf[0][1], Kn + a_, 8192); }
  WAITK(6, kf[1][0], kf[1][1]);
  p0 = __builtin_amdgcn_mfma_f32_32x32x16_bf16(kf[1][0], qr[1], p0, 0, 0, 0); p1 = __builtin_amdgcn_mfma_f32_32x32x16_bf16(kf[1][1], qr[1], p1, 0, 0, 0);
  issue(1);
  { const int a_ = kbase + (((5 * 32) + hb) ^ ksw); LDSR128(kf[1][0], Kn + a_, 0); LDSR128(kf[1][1], Kn + a_, 8192); }
  WAITK(6, kf[2][0], kf[2][1]);
  p0 = __builtin_amdgcn_mfma_f32_32x32x16_bf16(kf[2][0], qr[2], p0, 0, 0, 0); p1 = __builtin_amdgcn_mfma_f32_32x32x16_bf16(kf[2][1], qr[2], p1, 0, 0, 0);
  issue(2);
  { const int a_ = kbase + (((6 * 32) + hb) ^ ksw); LDSR128(kf[2][0], Kn + a_, 0); LDSR128(kf[2][1], Kn + a_, 8192); }
  WAITK(6, kf[3][0], kf[3][1]);
  p0 = __builtin_amdgcn_mfma_f32_32x32x16_bf16(kf[3][0], qr[3], p0, 0, 0, 0); p1 = __builtin_amdgcn_mfma_f32_32x32x16_bf16(kf[3][1], qr[3], p1, 0, 0, 0);
  issue(3);
  { const int a_ = kbase + (((7 * 32) + hb) ^ ksw); LDSR128(kf[3][0], Kn + a_, 0); LDSR128(kf[3][1], Kn + a_, 8192); }
  WAITK(6, kf[0][0], kf[0][1]);
  p0 = __builtin_amdgcn_mfma_f32_32x32x16_bf16(kf[0][0], qr[4], p0, 0, 0, 0); p1 = __builtin_amdgcn_mfma_f32_32x32x16_bf16(kf[0][1], qr[4], p1, 0, 0, 0);
  issue(4);
  { const int a_ = rbase + (((0 * 32) + hb) ^ rsw); LDSR128(kf[0][0], Kr + a_, 0); LDSR128(kf[0][1], Kr + a_, 4096); }
  WAITK(6, kf[1][0], kf[1][1]);
  p0 = __builtin_amdgcn_mfma_f32_32x32x16_bf16(kf[1][0], qr[5], p0, 0, 0, 0); p1 = __builtin_amdgcn_mfma_f32_32x32x16_bf16(kf[1][1], qr[5], p1, 0, 0, 0);
  { const int a_ = rbase + (((1 * 32) + hb) ^ rsw); LDSR128(kf[1][0], Kr + a_, 0); LDSR128(kf[1][1], Kr + a_, 4096); }
  WAITK(6, kf[2][0], kf[2][1]);
  p0 = __builtin_amdgcn_mfma_f32_32x32x16_bf16(kf[2][0], qr[6], p0, 0, 0, 0); p1 = __builtin_amdgcn_mfma_f32_32x32x16_bf16(kf[2][1], qr[6], p1, 0, 0, 0);
  { const int a_ = rbase + (((2 * 32) + hb) ^ rsw); LDSR128(kf[2][0], Kr + a_, 0); LDSR128(kf[2][1], Kr + a_, 4096); }
  WAITK(6, kf[3][0], kf[3][1]);
  p0 = __builtin_amdgcn_mfma_f32_32x32x16_bf16(kf[3][0], qr[7], p0, 0, 0, 0); p1 = __builtin_amdgcn_mfma_f32_32x32x16_bf16(kf[3][1], qr[7], p1, 0, 0, 0);
  { const int a_ = rbase + (((3 * 32) + hb) ^ rsw); LDSR128(kf[3][0], Kr + a_, 0); LDSR128(kf[3][1], Kr + a_, 4096); }
  WAITK(6, kf[0][0], kf[0][1]);
  p0 = __builtin_amdgcn_mfma_f32_32x32x16_bf16(kf[0][0], qr[8], p0, 0, 0, 0); p1 = __builtin_amdgcn_mfma_f32_32x32x16_bf16(kf[0][1], qr[8], p1, 0, 0, 0);
  LDSRTR(vl[0][0], Vb, 0); LDSRTR(vh[0][0], Vb, 2048);
  LDSRTR(vl[0][1], Vb, 4096); LDSRTR(vh[0][1], Vb, 6144);
  LDSRTR(vl[0][2], Vb, 8192); LDSRTR(vh[0][2], Vb, 10240);
  LDSRTR(vl[0][3], Vb, 12288); LDSRTR(vh[0][3], Vb, 14336);
  WAITK(12, kf[1][0], kf[1][1]);
  p0 = __builtin_amdgcn_mfma_f32_32x32x16_bf16(kf[1][0], qr[9], p0, 0, 0, 0); p1 = __builtin_amdgcn_mfma_f32_32x32x16_bf16(kf[1][1], qr[9], p1, 0, 0, 0);
  WAITK(10, kf[2][0], kf[2][1]);
  p0 = __builtin_amdgcn_mfma_f32_32x32x16_bf16(kf[2][0], qr[10], p0, 0, 0, 0); p1 = __builtin_amdgcn_mfma_f32_32x32x16_bf16(kf[2][1], qr[10], p1, 0, 0, 0);
  LDSRTR(vl[1][0], Vb, 512); LDSRTR(vh[1][0], Vb, 2560);
  LDSRTR(vl[1][1], Vb, 4608); LDSRTR(vh[1][1], Vb, 6656);
  LDSRTR(vl[1][2], Vb, 8704); LDSRTR(vh[1][2], Vb, 10752);
  LDSRTR(vl[1][3], Vb, 12800); LDSRTR(vh[1][3], Vb, 14848);
  WAITK(15, kf[3][0], kf[3][1]);
  p0 = __builtin_amdgcn_mfma_f32_32x32x16_bf16(kf[3][0], qr[11], p0, 0, 0, 0); p1 = __builtin_amdgcn_mfma_f32_32x32x16_bf16(kf[3][1], qr[11], p1, 0, 0, 0);
  WAITV(8, vl[0], vh[0]);
  o[0] = __builtin_amdgcn_mfma_f32_32x32x16_bf16(pa0, PKF(vl[0][0], vh[0][0]), o[0], 0, 0, 0); o[0] = __builtin_amdgcn_mfma_f32_32x32x16_bf16(pa1, PKF(vl[0][1], vh[0][1]), o[0], 0, 0, 0);
  o[0] = __builtin_amdgcn_mfma_f32_32x32x16_bf16(pa2, PKF(vl[0][2], vh[0][2]), o[0], 0, 0, 0); o[0] = __builtin_amdgcn_mfma_f32_32x32x16_bf16(pa3, PKF(vl[0][3], vh[0][3]), o[0], 0, 0, 0);
  LDSRTR(vl[0][0], Vb, 1024); LDSRTR(vh[0][0], Vb, 3072);
  LDSRTR(vl[0][1], Vb, 5120); LDSRTR(vh[0][1], Vb, 7168);
  LDSRTR(vl[0][2], Vb, 9216); LDSRTR(vh[0][2], Vb, 11264);
  LDSRTR(vl[0][3], Vb, 13312); LDSRTR(vh[0][3], Vb, 15360);
  WAITV(8, vl[1], vh[1]);
  o[1] = __builtin_amdgcn_mfma_f32_32x32x16_bf16(pa0, PKF(vl[1][0], vh[1][0]), o[1], 0, 0, 0); o[1] = __builtin_amdgcn_mfma_f32_32x32x16_bf16(pa1, PKF(vl[1][1], vh[1][1]), o[1], 0, 0, 0);
  o[1] = __builtin_amdgcn_mfma_f32_32x32x16_bf16(pa2, PKF(vl[1][2], vh[1][2]), o[1], 0, 0, 0); o[1] = __builtin_amdgcn_mfma_f32_32x32x16_bf16(pa3, PKF(vl[1][3], vh[1][3]), o[1], 0, 0, 0);
  LDSRTR(vl[1][0], Vb, 1536); LDSRTR(vh[1][0], Vb, 3584);
  LDSRTR(vl[1][1], Vb, 5632); LDSRTR(vh[1][1], Vb, 7680);
  LDSRTR(vl[1][2], Vb, 9728); LDSRTR(vh[1][2], Vb, 11776);
  LDSRTR(vl[1][3], Vb, 13824); LDSRTR(vh[1][3], Vb, 15872);
  WAITV(8, vl[0], vh[0]);
  o[2] = __builtin_amdgcn_mfma_f32_32x32x16_bf16(pa0, PKF(vl[0][0], vh[0][0]), o[2], 0, 0, 0); o[2] = __builtin_amdgcn_mfma_f32_32x32x16_bf16(pa1, PKF(vl[0][1], vh[0][1]), o[2], 0, 0, 0);
  o[2] = __builtin_amdgcn_mfma_f32_32x32x16_bf16(pa2, PKF(vl[0][2], vh[0][2]), o[2], 0, 0, 0); o[2] = __builtin_amdgcn_mfma_f32_32x32x16_bf16(pa3, PKF(vl[0][3], vh[0][3]), o[2], 0, 0, 0);
  WAITV(0, vl[1], vh[1]);
  o[3] = __builtin_amdgcn_mfma_f32_32x32x16_bf16(pa0, PKF(vl[1][0], vh[1][0]), o[3], 0, 0, 0); o[3] = __builtin_amdgcn_mfma_f32_32x32x16_bf16(pa1, PKF(vl[1][1], vh[1][1]), o[3], 0, 0, 0);
  o[3] = __builtin_amdgcn_mfma_f32_32x32x16_bf16(pa2, PKF(vl[1][2], vh[1][2]), o[3], 0, 0, 0); o[3] = __builtin_amdgcn_mfma_f32_32x32x16_bf16(pa3, PKF(vl[1][3], vh[1][3]), o[3], 0, 0, 0);
  } else if constexpr (DO_QK) {
  p0 = f32x16{}; p1 = f32x16{};
  { const int a_ = kbase + (((0 * 32) + hb) ^ ksw); LDSR128(kf[0][0], Kn + a_, 0); LDSR128(kf[0][1], Kn + a_, 8192); }
  { const int a_ = kbase + (((1 * 32) + hb) ^ ksw); LDSR128(kf[1][0], Kn + a_, 0); LDSR128(kf[1][1], Kn + a_, 8192); }
  { const int a_ = kbase + (((2 * 32) + hb) ^ ksw); LDSR128(kf[2][0], Kn + a_, 0); LDSR128(kf[2][1], Kn + a_, 8192); }
  { const int a_ = kbase + (((3 * 32) + hb) ^ ksw); LDSR128(kf[3][0], Kn + a_, 0); LDSR128(kf[3][1], Kn + a_, 8192); }
  WAITK(6, kf[0][0], kf[0][1]);
  p0 = __builtin_amdgcn_mfma_f32_32x32x16_bf16(kf[0][0], qr[0], p0, 0, 0, 0); p1 = __builtin_amdgcn_mfma_f32_32x32x16_bf16(kf[0][1], qr[0], p1, 0, 0, 0);
  issue(0);
  { const int a_ = kbase + (((4 * 32) + hb) ^ ksw); LDSR128(kf[0][0], Kn + a_, 0); LDSR128(kf[0][1], Kn + a_, 8192); }
  WAITK(6, kf[1][0], kf[1][1]);
  p0 = __builtin_amdgcn_mfma_f32_32x32x16_bf16(kf[1][0], qr[1], p0, 0, 0, 0); p1 = __builtin_amdgcn_mfma_f32_32x32x16_bf16(kf[1][1], qr[1], p1, 0, 0, 0);
  issue(1);
  { const int a_ = kbase + (((5 * 32) + hb) ^ ksw); LDSR128(kf[1][0], Kn + a_, 0); LDSR128(kf[1][1], Kn + a_, 8192); }
  WAITK(6, kf[2][0], kf[2][1]);
  p0 = __builtin_amdgcn_mfma_f32_32x32x16_bf16(kf[2][0], qr[2], p0, 0, 0, 0); p1 = __builtin_amdgcn_mfma_f32_32x32x16_bf16(kf[2][1], qr[2], p1, 0, 0, 0);
  issue(2);
  { const int a_ = kbase + (((6 * 32) + hb) ^ ksw); LDSR128(kf[2][0], Kn + a_, 0); LDSR128(kf[2][1], Kn + a_, 8192); }
  WAITK(6, kf[3][0], kf[3][1]);
  p0 = __builtin_amdgcn_mfma_f32_32x32x16_bf16(kf[3][0], qr[3], p0, 0, 0, 0); p1 = __builtin_amdgcn_mfma_f32_32x32x16_bf16(kf[3][1], qr[3], p1, 0, 0, 0);
  issue(3);
  { const int a_ = kbase + (((7 * 32) + hb) ^ ksw); LDSR128(kf[3][0], Kn + a_, 0); LDSR128(kf[3][1], Kn + a_, 8192); }
  WAITK(6, kf[0][0], kf[0][1]);
  p0 = __builtin_amdgcn_mfma_f32_32x32x16_bf16(kf[0][0], qr[4], p0, 0, 0, 0); p1 = __builtin_amdgcn_mfma_f32_32x32x16_bf16(kf[0][1], qr[4], p1, 0, 0, 0);
  issue(4);
  { const int a_ = rbase + (((0 * 32) + hb) ^ rsw); LDSR128(kf[0][0], Kr + a_, 0); LDSR128(kf[0][1], Kr + a_, 4096); }
  WAITK(6, kf[1][0], kf[1][1]);
  p0 = __builtin_amdgcn_mfma_f32_32x32x16_bf16(kf[1][0], qr[5], p0, 0, 0, 0); p1 = __builtin_amdgcn_mfma_f32_32x32x16_bf16(kf[1][1], qr[5], p1, 0, 0, 0);
  { const int a_ = rbase + (((1 * 32) + hb) ^ rsw); LDSR128(kf[1][0], Kr + a_, 0); LDSR128(kf[1][1], Kr + a_, 4096); }
  WAITK(6, kf[2][0], kf[2][1]);
  p0 = __builtin_amdgcn_mfma_f32_32x32x16_bf16(kf[2][0], qr[6], p0, 0, 0, 0); p1 = __builtin_amdgcn_mfma_f32_32x32x16_bf16(kf[2][1], qr[6], p1, 0, 0, 0);
  { const int a_ = rbase + (((2 * 32) + hb) ^ rsw); LDSR128(kf[2][0], Kr + a_, 0); LDSR128(kf[2][1], Kr + a_, 4096); }
  WAITK(6, kf[3][0], kf[3][1]);
  p0 = __builtin_amdgcn_mfma_f32_32x32x16_bf16(kf[3][0], qr[7], p0, 0, 0, 0); p1 = __builtin_amdgcn_mfma_f32_32x32x16_bf16(kf[3][1], qr[7], p1, 0, 0, 0);
  { const int a_ = rbase + (((3 * 32) + hb) ^ rsw); LDSR128(kf[3][0], Kr + a_, 0); LDSR128(kf[3][1], Kr + a_, 4096); }
  WAITK(6, kf[0][0], kf[0][1]);
  p0 = __builtin_amdgcn_mfma_f32_32x32x16_bf16(kf[0][0], qr[8], p0, 0, 0, 0); p1 = __builtin_amdgcn_mfma_f32_32x32x16_bf16(kf[0][1], qr[8], p1, 0, 0, 0);
  WAITK(4, kf[1][0], kf[1][1]);
  p0 = __builtin_amdgcn_mfma_f32_32x32x16_bf16(kf[1][0], qr[9], p0, 0, 0, 0); p1 = __builtin_amdgcn_mfma_f32_32x32x16_bf16(kf[1][1], qr[9], p1, 0, 0, 0);
  WAITK(2, kf[2][0], kf[2][1]);
  p0 = __builtin_amdgcn_mfma_f32_32x32x16_bf16(kf[2][0], qr[10], p0, 0, 0, 0); p1 = __builtin_amdgcn_mfma_f32_32x32x16_bf16(kf[2][1], qr[10], p1, 0, 0, 0);
  WAITK(0, kf[3][0], kf[3][1]);
  p0 = __builtin_amdgcn_mfma_f32_32x32x16_bf16(kf[3][0], qr[11], p0, 0, 0, 0); p1 = __builtin_amdgcn_mfma_f32_32x32x16_bf16(kf[3][1], qr[11], p1, 0, 0, 0);
  } else {
  LDSRTR(vl[0][0], Vb, 0); LDSRTR(vh[0][0], Vb, 2048);
  LDSRTR(vl[0][1], Vb, 4096); LDSRTR(vh[0][1], Vb, 6144);
  LDSRTR(vl[0][2], Vb, 8192); LDSRTR(vh[0][2], Vb, 10240);
  LDSRTR(vl[0][3], Vb, 12288); LDSRTR(vh[0][3], Vb, 14336);
  LDSRTR(vl[1][0], Vb, 512); LDSRTR(vh[1][0], Vb, 2560);
  LDSRTR(vl[1][1], Vb, 4608); LDSRTR(vh[1][1], Vb, 6656);
  LDSRTR(vl[1][2], Vb, 8704); LDSRTR(vh[1][2], Vb, 10752);
  LDSRTR(vl[1][3], Vb, 12800); LDSRTR(vh[1][3], Vb, 14848);
  WAITV(8, vl[0], vh[0]);
  o[0] = __builtin_amdgcn_mfma_f32_32x32x16_bf16(pa0, PKF(vl[0][0], vh[0][0]), o[0], 0, 0, 0); o[0] = __builtin_amdgcn_mfma_f32_32x32x16_bf16(pa1, PKF(vl[0][1], vh[0][1]), o[0], 0, 0, 0);
  o[0] = __builtin_amdgcn_mfma_f32_32x32x16_bf16(pa2, PKF(vl[0][2], vh[0][2]), o[0], 0, 0, 0); o[0] = __builtin_amdgcn_mfma_f32_32x32x16_bf16(pa3, PKF(vl[0][3], vh[0][3]), o[0], 0, 0, 0);
  LDSRTR(vl[0][0], Vb, 1024); LDSRTR(vh[0][0], Vb, 3072);
  LDSRTR(vl[0][1], Vb, 5120); LDSRTR(vh[0][1], Vb, 7168);
  LDSRTR(vl[0][2], Vb, 9216); LDSRTR(vh[0][2], Vb, 11264);
  LDSRTR(vl[0][3], Vb, 13312); LDSRTR(vh[0][3], Vb, 15360);
  WAITV(8, vl[1], vh[1]);
  o[1] = __builtin_amdgcn_mfma_f32_32x32x16_bf16(pa0, PKF(vl[1][0], vh[1][0]), o[1], 0, 0, 0); o[1] = __builtin_amdgcn_mfma_f32_32x32x16_bf16(pa1, PKF(vl[1][1], vh[1][1]), o[1], 0, 0, 0);
  o[1] = __builtin_amdgcn_mfma_f32_32x32x16_bf16(pa2, PKF(vl[1][2], vh[1][2]), o[1], 0, 0, 0); o[1] = __builtin_amdgcn_mfma_f32_32x32x16_bf16(pa3, PKF(vl[1][3], vh[1][3]), o[1], 0, 0, 0);
  LDSRTR(vl[1][0], Vb, 1536); LDSRTR(vh[1][0], Vb, 3584);
  LDSRTR(vl[1][1], Vb, 5632); LDSRTR(vh[1][1], Vb, 7680);
  LDSRTR(vl[1][2], Vb, 9728); LDSRTR(vh[1][2], Vb, 11776);
  LDSRTR(vl[1][3], Vb, 13824); LDSRTR(vh[1][3], Vb, 15872);
  WAITV(8, vl[0], vh[0]);
  o[2] = __builtin_amdgcn_mfma_f32_32x32x16_bf16(pa0, PKF(vl[0][0], vh[0][0]), o[2], 0, 0, 0); o[2] = __builtin_amdgcn_mfma_f32_32x32x16_bf16(pa1, PKF(vl[0][1], vh[0][1]), o[2], 0, 0, 0);
  o[2] = __builtin_amdgcn_mfma_f32_32x32x16_bf16(pa2, PKF(vl[0][2], vh[0][2]), o[2], 0, 0, 0); o[2] = __builtin_amdgcn_mfma_f32_32x32x16_bf16(pa3, PKF(vl[0][3], vh[0][3]), o[2], 0, 0, 0);
  WAITV(0, vl[1], vh[1]);
  o[3] = __builtin_amdgcn_mfma_f32_32x32x16_bf16(pa0, PKF(vl[1][0], vh[1][0]), o[3], 0, 0, 0); o[3] = __builtin_amdgcn_mfma_f32_32x32x16_bf16(pa1, PKF(vl[1][1], vh[1][1]), o[3], 0, 0, 0);
  o[3] = __builtin_amdgcn_mfma_f32_32x32x16_bf16(pa2, PKF(vl[1][2], vh[1][2]), o[3], 0, 0, 0); o[3] = __builtin_amdgcn_mfma_f32_32x32x16_bf16(pa3, PKF(vl[1][3], vh[1][3]), o[3], 0, 0, 0);
  }
}

#define ATT_BAR() do { asm volatile("" ::: "memory"); __builtin_amdgcn_s_barrier(); asm volatile("" ::: "memory"); } while (0)
#define ATT_VM(N) asm volatile("s_waitcnt vmcnt(" #N ")" ::: "memory")
__device__ __forceinline__ void glds16(const bf16* g, ALDS unsigned char* l) { __builtin_amdgcn_global_load_lds((const unsigned*)g, (ALDS unsigned*)l, 16, 0, 0); }
__device__ __forceinline__ void attn_unit(const bf16* __restrict__ Qb, const bf16* __restrict__ Knh, const bf16* __restrict__ Vh, const bf16* __restrict__ Krb,
                                          bf16* __restrict__ Ob, int seq, char* lds, ALDS unsigned char* L, const int probe) {
  int tid_ = threadIdx.x; asm volatile("" : "+v"(tid_));
  const int tid = tid_, wid = __builtin_amdgcn_readfirstlane(tid >> 6), lane = tid & 63, r32 = lane & 31, hi = lane >> 5;
  const bool trail = wid >= 4;
  float* ws = (float*)(lds + OFF_WS) + wid * 64; float* li_l = ws; float* al_l = ws + 32;
  float m_reg = -1e30f, l_reg = 0; f32x16 o[4] = {}; bf16x8 qr[12];
  const bf16* Qw = Qb + (long)(wid * QBLK + r32) * LDQ + hi * 8;
#pragma unroll
  for (int d0 = 0; d0 < 12; ++d0) qr[d0] = *reinterpret_cast<const bf16x8*>(Qw + d0 * 16);
#define VOFF(i) ([&]() { const int st = 2 * (2 * wid + (i)) + (lane >> 5), kk = (st >> 2) * 8 + ((lane & 31) >> 2), k = (kk & ~0xC) | ((kk & 4) << 1) | ((kk & 8) >> 1), c = (st & 3) * 32 + (lane & 3) * 8; return k * LDKV + c; }())
#define KOFF(i) ([&]() { const int row = (2 * wid + (i)) * 4 + (lane >> 4), colB = ((lane & 15) * 16) ^ ((row & 15) << 4); return row * LDKV + (colB >> 1); }())
#define ROFF() ([&]() { const int row = wid * 8 + (lane >> 3), colB = ((lane & 7) * 16) ^ (((row >> 1) & 7) << 4); return row * LDKR + (colB >> 1); }())
  const ALDS char* KL = (const ALDS char*)L + OFF_KN; const ALDS char* RL = (const ALDS char*)L + OFF_KR; const ALDS char* VL = (const ALDS char*)L + OFF_V + v_rd_base(lane);
#define ISSUE_K(t, s) do { const long kb_ = (long)(t) * KVBLK; const int s_ = (s); \
    glds16(Knh + kb_ * LDKV + KOFF(0), L + OFF_KN + s_ * SHM_KN + (2 * wid) * 1024); glds16(Knh + kb_ * LDKV + KOFF(1), L + OFF_KN + s_ * SHM_KN + (2 * wid + 1) * 1024); \
    glds16(Krb + kb_ * LDKR + ROFF(), L + OFF_KR + s_ * SHM_KR + wid * 1024); } while (0)
#define ISSUE_V(t, s) do { const long kb_ = (long)(t) * KVBLK; const int s_ = (s); \
    glds16(Vh + kb_ * LDKV + VOFF(0), L + OFF_V + s_ * SHM_V + (2 * wid) * 1024); glds16(Vh + kb_ * LDKV + VOFF(1), L + OFF_V + s_ * SHM_V + (2 * wid + 1) * 1024); } while (0)
#define ISSUE_NEXT(j) do { if ((j) + 2 < NT) ISSUE_K((j) + 2, sp); if ((j) + 1 < NT) ISSUE_V((j) + 1, sn); } while (0)
#define ROT() do { const int t_ = sc; sc = sn; sn = sp; sp = t_; } while (0)
#define RESC(a) do { if (__any((a) < 1.f)) { if (hi == 0) al_l[r32] = (a); asm volatile("s_waitcnt lgkmcnt(0)" ::: "memory"); \
    _Pragma("unroll") for (int d = 0; d < 4; ++d) _Pragma("unroll") for (int r = 0; r < 16; ++r) o[d][r] *= al_l[crow(r, hi)]; } } while (0)
  f32x16 p0, p1; float mn, al; bf16x8 pa0 = {}, pa1 = {}, pa2 = {}, pa3 = {}; const int NT = seq / KVBLK;
  int sc = 0, sn = 1, sp = 2;
  ISSUE_K(0, 0); ISSUE_K(1, 1); ISSUE_V(0, 0);
  ATT_VM(5); ATT_BAR();
  int jj = 0;
  const auto issue = [&](int step) {
    const long kb2 = (long)(jj + 2) * KVBLK, kb1 = (long)(jj + 1) * KVBLK;
    if (jj + 2 < NT) { if (step == 0) glds16(Knh + kb2 * LDKV + KOFF(0), L + OFF_KN + sp * SHM_KN + (2 * wid) * 1024); if (step == 1) glds16(Knh + kb2 * LDKV + KOFF(1), L + OFF_KN + sp * SHM_KN + (2 * wid + 1) * 1024);
                       if (step == 2) glds16(Krb + kb2 * LDKR + ROFF(), L + OFF_KR + sp * SHM_KR + wid * 1024); }
    if (jj + 1 < NT) { if (step == 3) glds16(Vh + kb1 * LDKV + VOFF(0), L + OFF_V + sn * SHM_V + (2 * wid) * 1024); if (step == 4) glds16(Vh + kb1 * LDKV + VOFF(1), L + OFF_V + sn * SHM_V + (2 * wid + 1) * 1024); } };
  const auto noissue = [](int) {};
  mat_segment<true, false>(issue, p0, p1, o, KL, RL, VL, qr, pa0, pa1, pa2, pa3, r32, hi, probe);
  if (trail) { ATT_VM(5); ATT_BAR(); }
  partialSM(p0, p1, m_reg, mn, al); finishSM(p0, p1, al, l_reg, pa0, pa1, pa2, pa3);
  ROT();
  for (int j = 1; j < NT; ++j) {
    if (!trail) { if (j + 1 < NT) ATT_VM(5); else ATT_VM(0); ATT_BAR(); }
    jj = j;
    mat_segment<true, true>(issue, p0, p1, o, KL + sc * SHM_KN, RL + sc * SHM_KR, VL + sp * SHM_V, qr, pa0, pa1, pa2, pa3, r32, hi, probe);
    if (trail) { if (j + 2 < NT) ATT_VM(5); else ATT_VM(0); ATT_BAR(); }
    partialSM(p0, p1, m_reg, mn, al); RESC(al); finishSM(p0, p1, al, l_reg, pa0, pa1, pa2, pa3);
    ROT();
  }
  if (!trail) { ATT_VM(0); ATT_BAR(); }
  mat_segment<false, true>(noissue, p0, p1, o, KL, RL, VL + sp * SHM_V, qr, pa0, pa1, pa2, pa3, r32, hi, probe);
  if (hi == 0) li_l[r32] = l_reg; asm volatile("s_waitcnt lgkmcnt(0)" ::: "memory");
  float rli[16];
#pragma unroll
  for (int r = 0; r < 16; ++r) rli[r] = __builtin_amdgcn_rcpf(li_l[crow(r, hi)]);
  int lane_e = lane; asm volatile("" : "+v"(lane_e));
  bf16* Ow = Ob + (long)(wid * QBLK + 4 * (lane_e >> 5)) * LDO + (lane_e & 31);
#pragma unroll
  for (int r = 0; r < 16; ++r) { const int orow = (r & 3) + 8 * (r >> 2);
#pragma unroll
    for (int d0 = 0; d0 < 4; ++d0) { const float val = o[d0][r] * rli[r]; Ow[orow * LDO + d0 * 32] = (bf16)(cvtpk(val, val) & 0xffffu); } }
  ATT_VM(0);
  ATT_BAR();
#undef VOFF
#undef KOFF
#undef ROFF
#undef ISSUE_K
#undef ISSUE_V
#undef ISSUE_NEXT
#undef ROT
#undef RESC
}
#undef KSWZ
#undef RSWZ
}

constexpr int DM = 4096, SEQ = 8192, CTXL = 256, MR = SEQ + CTXL;
constexpr int NH = 16, QL = 768, KVL = 512, NIN = 7680, NMODC = 6 * DM;
constexpr int NEXP = 16384;
constexpr float EPS = 1e-6f;
constexpr float C2 = 0.072168783648703220f * 1.4426950408889634f;

#ifndef MK_ONE_LAUNCH
#define MK_ONE_LAUNCH 1
#endif
constexpr int NPHASE = 10;
constexpr int NWAVES = 8, NTHR = NWAVES * 64;

constexpr size_t MiB = 1u << 20;
constexpr size_t a256(size_t x) { return (x + 255) & ~(size_t)255; }
constexpr size_t WS_CTL = 0, CTL_ZERO_BYTES = 1 * MiB;
constexpr int CW_BAR = 4096;
constexpr int CW_END = CW_BAR + 3456;
static_assert((size_t)CW_END * 4 <= CTL_ZERO_BYTES, "CTL words inside the memset region");
constexpr size_t WS_MODF = 1 * MiB;
constexpr size_t WS_ROPE = WS_MODF + a256((size_t)(NMODC + 2 * DM) * 4);
constexpr size_t WS_WIN  = 2 * MiB;
constexpr size_t WS_WUQ  = WS_WIN + (size_t)NIN * DM * 2;
constexpr size_t WS_WUKV = WS_WUQ + (size_t)3072 * 768 * 2;
constexpr size_t WS_WO   = WS_WUKV + (size_t)4096 * 512 * 2;
constexpr size_t WS_WPQ  = WS_WO + (size_t)DM * DM * 2;
constexpr size_t WS_KBD  = WS_WPQ + (size_t)2048 * DM * 2;
constexpr int ROWB = 3072;
constexpr size_t WS_KB2  = WS_KBD + (size_t)2048 * DM * 2;
constexpr size_t WS_UB   = WS_KB2 + (size_t)8 * 256 * 256 * 2;
constexpr size_t WS_VB   = WS_UB + (size_t)NEXP * ROWB;
constexpr size_t WS_SU   = WS_VB + (size_t)NEXP * ROWB;
constexpr size_t WS_HX   = WS_SU + (size_t)2 * NEXP * 4;
constexpr size_t WS_CQ   = WS_HX + (size_t)MR * DM * 2;
constexpr size_t WS_CKV  = WS_CQ + (size_t)SEQ * QL * 2;
constexpr size_t WS_KR   = WS_CKV + (size_t)MR * KVL * 2;
constexpr size_t WS_U    = WS_KR + (size_t)MR * 64 * 2;
constexpr size_t WS_GB   = WS_U + (size_t)SEQ * 2048 * 2;
constexpr size_t WS_Q    = WS_GB + (size_t)SEQ * 2048 * 2;
constexpr size_t WS_KN   = WS_Q + (size_t)SEQ * 3072 * 2;
constexpr size_t WS_V    = WS_KN + (size_t)MR * 2048 * 2;
constexpr size_t WS_ACAT = WS_V + (size_t)MR * 2048 * 2;
constexpr size_t WS_X1   = WS_ACAT + (size_t)SEQ * DM * 2;
constexpr size_t WS_H2   = WS_X1 + (size_t)SEQ * DM * 4;
constexpr size_t WS_QP   = WS_H2 + (size_t)SEQ * DM * 2;
constexpr size_t WS_SC   = WS_QP + (size_t)SEQ * 2048 * 2;
constexpr size_t WS_MODP = WS_SC + (size_t)SEQ * 2048 * 4;
constexpr size_t WS_SQ1  = WS_MODP + (size_t)64 * 32768 * 4;
constexpr size_t WS_SQ2  = WS_SQ1 + (size_t)SEQ * 12 * 4;
constexpr size_t WS_SQ3  = WS_SQ2 + (size_t)MR * 8 * 4;
constexpr size_t WS_END  = WS_SQ3 + (size_t)SEQ * 64 * 4;
static_assert(WS_ROPE + 192 * 32 * 4 <= WS_WIN, "rope table below the weights");

constexpr int RING_BYTES = 158720;
constexpr int MISC_OFF = RING_BYTES + 320;
constexpr int LDS_BYTES = 163840;
static_assert(att::SHM_ATTN <= RING_BYTES && MISC_OFF + 128 <= LDS_BYTES, "LDS map");

#define GAS __attribute__((address_space(1)))
#define LAS __attribute__((address_space(3)))
typedef unsigned short bf16;
typedef unsigned v4u __attribute__((ext_vector_type(4)));
typedef float f32x4 __attribute__((ext_vector_type(4)));
typedef __bf16 bf16x2_t __attribute__((ext_vector_type(2)));
typedef float f32x2 __attribute__((ext_vector_type(2)));
typedef float f32x16v __attribute__((ext_vector_type(16)));
typedef float f32x32v __attribute__((ext_vector_type(32)));
typedef unsigned u32x6v __attribute__((ext_vector_type(6)));
typedef _Float16 h16x2 __attribute__((ext_vector_type(2)));
typedef _Float16 h16x32 __attribute__((ext_vector_type(32)));
#ifndef FP6_INTERLEAVED
#define FP6_INTERLEAVED 1
#endif
#define LDS_WAIT() asm volatile("s_waitcnt lgkmcnt(0)" ::: "memory")
__device__ __forceinline__ unsigned f2bf(float f) { unsigned u = __builtin_bit_cast(unsigned, f); return (u + 0x7fffu + ((u >> 16) & 1u)) >> 16; }
__device__ __forceinline__ unsigned pk2(float lo, float hi) { return f2bf(lo) | (f2bf(hi) << 16); }
__device__ __forceinline__ float bflo(unsigned w) { return __builtin_bit_cast(float, w << 16); }
__device__ __forceinline__ float bfhi(unsigned w) { return __builtin_bit_cast(float, w & 0xffff0000u); }
__device__ __forceinline__ float dot2bf(unsigned a, unsigned b, float c) { return __builtin_amdgcn_fdot2_f32_bf16(__builtin_bit_cast(bf16x2_t, a), __builtin_bit_cast(bf16x2_t, b), c, false); }
#define DPP_F(v, CTRL) __builtin_bit_cast(float, __builtin_amdgcn_update_dpp(0, __builtin_bit_cast(int, (v)), (CTRL), 0xf, 0xf, true))
__device__ __forceinline__ float row16_sum(float v) { v += DPP_F(v, 0xB1); v += DPP_F(v, 0x4E); v += DPP_F(v, 0x141); v += DPP_F(v, 0x140); return v; }
__device__ __forceinline__ float row16_max(float v) { v = fmaxf(v, DPP_F(v, 0xB1)); v = fmaxf(v, DPP_F(v, 0x4E)); v = fmaxf(v, DPP_F(v, 0x141)); v = fmaxf(v, DPP_F(v, 0x140)); return v; }
__device__ __forceinline__ float rl_f(float v, int l) { return __builtin_bit_cast(float, __builtin_amdgcn_readlane(__builtin_bit_cast(int, v), l)); }
__device__ __forceinline__ float wave_sum(float v) { v = row16_sum(v); return (rl_f(v, 0) + rl_f(v, 16)) + (rl_f(v, 32) + rl_f(v, 48)); }
__device__ __forceinline__ float wave_max(float v) { v = row16_max(v); return fmaxf(fmaxf(rl_f(v, 0), rl_f(v, 16)), fmaxf(rl_f(v, 32), rl_f(v, 48))); }

#define XB_TMO      128
#define XB_XCNT(j)  (256  + 64 * (j))
#define XB_XSUB(j)  (1280 + 64 * (j))
#define XB_XGEN(j)  (2304 + 64 * (j))
#define XB_TOP      3328
#define XB_TOPGEN   3392
#define XCD_BAR_WORDS 3456
#define XB_SPIN_CAP (1u << 18)
__device__ __forceinline__ unsigned xb_ld(unsigned* p)              { return __hip_atomic_load(p, __ATOMIC_RELAXED, __HIP_MEMORY_SCOPE_AGENT); }
__device__ __forceinline__ unsigned xb_add(unsigned* p, unsigned v) { return __hip_atomic_fetch_add(p, v, __ATOMIC_RELAXED, __HIP_MEMORY_SCOPE_AGENT); }
__device__ __forceinline__ unsigned xb_xcc_id() { return (unsigned)__builtin_amdgcn_s_getreg((3 << 11) | 20) & 0xFu; }
#define XB_SPIN(cond, bar) do { unsigned _sp = 0; while (cond) { __builtin_amdgcn_s_sleep(1); \
    if ((++_sp & 255u) == 0u) { if (xb_ld(&(bar)[XB_TMO])) break; if (_sp > XB_SPIN_CAP) { atomicAdd(&(bar)[XB_TMO], 1u); break; } } } } while (0)
struct XcdBarrier { unsigned* bar; unsigned x; volatile LAS unsigned* st; };
__device__ __forceinline__ XcdBarrier xcd_barrier_post(unsigned* bar, volatile LAS unsigned* st) {
    XcdBarrier b; b.bar = bar; b.x = xb_xcc_id(); b.st = st;
    if (threadIdx.x == 0) (void)xb_add(&bar[XB_XCNT(b.x)], 1u);
    return b;
}
__device__ __forceinline__ void xcd_barrier_complete(unsigned* bar, unsigned x, unsigned& nloc, unsigned& nx) {
    const unsigned G = gridDim.x * gridDim.y * gridDim.z;
    unsigned sum, cnt, mine, sp = 0u;
    for (;;) {
        sum = 0u; cnt = 0u; mine = 0u;
#pragma unroll
        for (unsigned j = 0; j < 16; ++j) { const unsigned c = xb_ld(&bar[XB_XCNT(j)]); sum += c; cnt += (c > 0u) ? 1u : 0u; mine = (j == x) ? c : mine; }
        if (sum == G) break;
        __builtin_amdgcn_s_sleep(1);
        if ((++sp & 255u) == 0u) { if (xb_ld(&bar[XB_TMO])) break; if (sp > XB_SPIN_CAP) { atomicAdd(&bar[XB_TMO], 1u); break; } }
    }
    nloc = mine > 0u ? mine : 1u; nx = cnt > 0u ? cnt : 1u;
}
__device__ __forceinline__ void xcd_barrier(const XcdBarrier& b) {
    asm volatile("s_waitcnt vmcnt(0)" ::: "memory");
    __syncthreads();
    if (threadIdx.x == 0) {
        unsigned* bar = b.bar;
        __builtin_amdgcn_s_waitcnt(0);
        unsigned nloc = b.st[0], nx = b.st[1];
        if (nloc == 0u) { xcd_barrier_complete(bar, b.x, nloc, nx); b.st[0] = nloc; b.st[1] = nx; }
        const unsigned old = xb_add(&bar[XB_XSUB(b.x)], 1u);
        const unsigned gen = old / nloc;
        if (old + 1u == (gen + 1u) * nloc) {
            __builtin_amdgcn_fence(__ATOMIC_RELEASE, "agent");
            asm volatile("s_waitcnt vmcnt(0)" ::: "memory");
            const unsigned og = xb_add(&bar[XB_TOP], 1u);
            const unsigned tg = og / nx;
            if (og + 1u == (tg + 1u) * nx) xb_add(&bar[XB_TOPGEN], 1u);
            else XB_SPIN(xb_ld(&bar[XB_TOPGEN]) == tg, bar);
            __builtin_amdgcn_fence(__ATOMIC_ACQUIRE, "agent");
            xb_add(&bar[XB_XGEN(b.x)], 1u);
            asm volatile("s_waitcnt vmcnt(0)" ::: "memory");
        } else {
            XB_SPIN(xb_ld(&bar[XB_XGEN(b.x)]) == gen, bar);
            __builtin_amdgcn_fence(__ATOMIC_ACQUIRE, "agent");
            asm volatile("s_waitcnt vmcnt(0)" ::: "memory");
        }
    }
    __syncthreads();
}

__device__ __forceinline__ int pi32(int o) { return 2 * (o & 15) + (o >> 4); }
__device__ __forceinline__ void tr_item(const float* __restrict__ W, int N, int k0, int n0, bf16* __restrict__ WT, int ldk, int drow0, bool perm, const float* __restrict__ gsc, LAS float* scr, int lane) {
    f32x4 w[8]; const int c4 = (lane & 7) * 4, rsub = lane >> 3;
#pragma unroll
    for (int i = 0; i < 8; ++i) w[i] = *(const f32x4*)(W + (size_t)(k0 + 8 * i + rsub) * N + n0 + c4);
#pragma unroll
    for (int i = 0; i < 8; ++i) { const int kk = 8 * i + rsub; const float g = gsc ? gsc[k0 + kk] : 1.f;
        scr[kk * 33 + c4] = w[i][0] * g; scr[kk * 33 + c4 + 1] = w[i][1] * g; scr[kk * 33 + c4 + 2] = w[i][2] * g; scr[kk * 33 + c4 + 3] = w[i][3] * g; }
    LDS_WAIT(); asm volatile("" ::: "memory");
    const int c = lane & 7;
#pragma unroll
    for (int j = 0; j < 4; ++j) { const int n = (lane >> 3) + 8 * j; const LAS float* s = scr + (8 * c) * 33 + n;
        v4u o; o.x = pk2(s[0 * 33], s[1 * 33]); o.y = pk2(s[2 * 33], s[3 * 33]); o.z = pk2(s[4 * 33], s[5 * 33]); o.w = pk2(s[6 * 33], s[7 * 33]);
        const int dn = perm ? pi32(n) : n;
        *(v4u*)(WT + (size_t)(drow0 + dn) * ldk + k0 + 8 * c) = o; }
    LDS_WAIT(); asm volatile("" ::: "memory");
}
__device__ __forceinline__ float silu_f(float v) { return v / (1.f + expf(-v)); }
__device__ __forceinline__ float gelu_erf(float v) { return 0.5f * v * (1.f + erff(v * 0.70710678118654752f)); }
__device__ __forceinline__ unsigned fkey(float f) { const unsigned u = __builtin_bit_cast(unsigned, f); return (u & 0x80000000u) ? ~u : (u | 0x80000000u); }

template <int NV> __device__ __forceinline__ unsigned kth16(const unsigned (&k)[NV]) {
    unsigned T = 0u;
    for (int bit = 31; bit >= 0; --bit) { const unsigned c = T | (1u << bit); int cnt = 0;
#pragma unroll
        for (int v = 0; v < NV; ++v) cnt += __popcll(__ballot(k[v] >= c));
        if (cnt >= 16) T = c; }
    return T;
}
template <int NC, int NV> __device__ __forceinline__ void kth16_multi(const unsigned (&k)[NC][NV], unsigned (&T)[NC]) {
#pragma unroll
    for (int c = 0; c < NC; ++c) T[c] = 0u;
    for (int bit = 31; bit >= 0; --bit) {
#pragma unroll
        for (int c = 0; c < NC; ++c) { const unsigned cd = T[c] | (1u << bit); int cnt = 0;
#pragma unroll
            for (int v = 0; v < NV; ++v) cnt += __popcll(__ballot(k[c][v] >= cd));
            if (cnt >= 16) T[c] = cd; } }
}
template <int NV> __device__ __forceinline__ void compact16(const unsigned (&k)[NV], const unsigned (&val)[NV], const unsigned (&pay)[NV], unsigned T, LAS unsigned* oval, LAS unsigned* opay, int lane) {
    const unsigned long long lt = (1ull << lane) - 1ull; int pos = 0;
#pragma unroll
    for (int v = 0; v < NV; ++v) { const bool s = k[v] > T; const unsigned long long m = __ballot(s); const int slot = pos + __popcll(m & lt); if (s) { oval[slot] = val[v]; opay[slot] = pay[v]; } pos += __popcll(m); }
#pragma unroll
    for (int v = 0; v < NV; ++v) { const bool s = k[v] == T; const unsigned long long m = __ballot(s); const int slot = pos + __popcll(m & lt); if (s && slot < 16) { oval[slot] = val[v]; opay[slot] = pay[v]; } pos += __popcll(m); }
}

struct Args { const float* in[21]; float* out; unsigned char* ws; int ph_lo, ph_hi, probe, pad; };
static_assert(sizeof(Args) == 23 * 8 + 16, "Args has no padding");

__global__ void __launch_bounds__(NTHR, 2) fwd(Args a) {
    extern __shared__ __attribute__((aligned(16))) unsigned char lds[];
    LAS unsigned char* L = (LAS unsigned char*)lds;
    const int wave = __builtin_amdgcn_readfirstlane((int)threadIdx.x >> 6);
    const int G = gridDim.x, bx = blockIdx.x;
    const int gw = bx * NWAVES + wave, NGW = G * NWAVES;
    const size_t NT = (size_t)G * NTHR;
#define PH_IDS() int tid_ph_ = threadIdx.x; asm volatile("" : "+v"(tid_ph_)); const int tid = tid_ph_, lane = tid & 63; const size_t gt = (size_t)bx * NTHR + tid; (void)lane; (void)gt
    unsigned char* ws = a.ws;
    float* ctlf = (float*)(ws + WS_CTL);
    const float* x = a.in[0]; const float* cvec = a.in[1]; const float* ctx = a.in[2]; const float* cctx = a.in[3]; const float* w_ada = a.in[4]; const float* b_ada = a.in[5];
    const float* norm1_g = a.in[6]; const float* w_in = a.in[7]; const float* q_norm_g = a.in[8]; const float* w_uq = a.in[9]; const float* kv_norm_g = a.in[10]; const float* w_ukv = a.in[11];
    const float* conv_w = a.in[12]; const float* conv_b = a.in[13]; const float* w_o = a.in[14]; const float* norm2_g = a.in[15]; const float* peer_wq = a.in[16]; const float* peer_keys = a.in[17];
    const float* peer_u = a.in[18]; const float* peer_v = a.in[19]; const float* final_g = a.in[20];
    float* modp = (float*)(ws + WS_MODP); float* ssq_cq = (float*)(ws + WS_SQ1); float* ssq_ckv = (float*)(ws + WS_SQ2); float* ssq_x1 = (float*)(ws + WS_SQ3);
    float* modf = (float*)(ws + WS_MODF); float* rope = (float*)(ws + WS_ROPE);
    bf16* WIN = (bf16*)(ws + WS_WIN); bf16* WUQ = (bf16*)(ws + WS_WUQ); bf16* WUKV = (bf16*)(ws + WS_WUKV); bf16* WO = (bf16*)(ws + WS_WO); bf16* WPQ = (bf16*)(ws + WS_WPQ); bf16* KBD = (bf16*)(ws + WS_KBD); bf16* KB2 = (bf16*)(ws + WS_KB2);
    unsigned char* UB = ws + WS_UB; unsigned char* VB = ws + WS_VB; float* SUV = (float*)(ws + WS_SU); bf16* HX = (bf16*)(ws + WS_HX); bf16* CQ = (bf16*)(ws + WS_CQ); bf16* CKV = (bf16*)(ws + WS_CKV); bf16* KR = (bf16*)(ws + WS_KR);
    bf16* UCV = (bf16*)(ws + WS_U); bf16* GBV = (bf16*)(ws + WS_GB); bf16* Q = (bf16*)(ws + WS_Q); bf16* KN = (bf16*)(ws + WS_KN); bf16* V = (bf16*)(ws + WS_V); bf16* ACAT = (bf16*)(ws + WS_ACAT);
    bf16* DLT = (bf16*)(ws + WS_X1); bf16* H2 = (bf16*)(ws + WS_H2); float* SC = (float*)(ws + WS_SC);

    for (int u = threadIdx.x; u < (LDS_BYTES - RING_BYTES) / 4; u += NTHR) ((LAS unsigned*)(L + RING_BYTES))[u] = 0u;
    __syncthreads();
    const int lo = a.ph_lo, hi = a.ph_hi;
    XcdBarrier bar; bar.bar = (unsigned*)ctlf + CW_BAR; bar.x = 0; bar.st = (volatile LAS unsigned*)(L + MISC_OFF);
    if (hi - lo > 1) bar = xcd_barrier_post((unsigned*)ctlf + CW_BAR, (volatile LAS unsigned*)(L + MISC_OFF));
#define IN(k) (lo <= (k) && (k) < hi)
#ifndef PHASE_MASK
#define PHASE_MASK 0x3ff
#endif
#define PH_ON(k) (((PHASE_MASK) >> (k)) & 1)
#ifndef REPEAT_MASK
#define REPEAT_MASK 0
#endif
#define NREP(k) (1 + (((REPEAT_MASK) >> (k)) & 1))
#define GRID_BAR(k) do { if (IN(k) && IN((k) + 1)) xcd_barrier(bar); } while (0)

    if (PH_ON(0) && IN(0)) for (int rep_ = 0; rep_ < NREP(0); ++rep_) {
        PH_IDS();
        const int psel = a.probe ? a.probe : 7;
        if (psel & 1)
        for (int it = gw; it < 64 * 96; it += NGW) {
            const int kb = it / 96, cb = it % 96, col = cb * 256 + lane * 4;
            const float* wp = w_ada + (size_t)(kb * 64) * NMODC + col;
            f32x4 ax = {0.f, 0.f, 0.f, 0.f}, ac = {0.f, 0.f, 0.f, 0.f}; const bool cc = cb < 32;
            const float sxv = silu_f(cvec[kb * 64 + lane]), scv = silu_f(cctx[kb * 64 + lane]);
#pragma unroll 16
            for (int i = 0; i < 64; ++i) { const f32x4 w = __builtin_nontemporal_load((const f32x4*)(wp + (size_t)i * NMODC));
                ax += w * rl_f(sxv, i); ac += w * (cc ? rl_f(scv, i) : 0.f); }
            *(f32x4*)(modp + (size_t)kb * 32768 + col) = ax; if (cc) *(f32x4*)(modp + (size_t)kb * 32768 + NMODC + col) = ac;
        }
        if (psel & 2) {
            LAS float* scr = (LAS float*)(L + wave * 8448);
            constexpr int I_IN = 64 * 234, I_UQ = 12 * 96, I_UKV = 8 * 128, I_O = 64 * 128, NIT = I_IN + I_UQ + I_UKV + I_O;
            for (int it = gw; it < NIT; it += NGW) { int r = it;
                if (r < I_IN) { const int kb = r / 234, n0 = (r % 234) * 32; int drow0; bool perm = false;
                    if (n0 < 1280) drow0 = n0; else if (n0 < 1344) { drow0 = n0; perm = true; }
                    else { const int c0 = n0 - 1344; if (c0 < 2048) drow0 = 1536 + (c0 >> 7) * 256 + (c0 & 127); else if (c0 < 4096) drow0 = 5632 + (c0 - 2048); else { const int c1 = c0 - 4096; drow0 = 1536 + (c1 >> 7) * 256 + 128 + (c1 & 127); } }
                    tr_item(w_in, 7488, kb * 64, n0, WIN, 4096, drow0, perm, nullptr, scr, lane); continue; } r -= I_IN;
                if (r < I_UQ) { const int kb = r / 96, n0 = (r % 96) * 32; tr_item(w_uq, 3072, kb * 64, n0, WUQ, 768, n0, (n0 % 192) >= 128, q_norm_g, scr, lane); continue; } r -= I_UQ;
                if (r < I_UKV) { const int kb = r / 128, n0 = (r % 128) * 32; tr_item(w_ukv, 4096, kb * 64, n0, WUKV, 512, n0, false, kv_norm_g, scr, lane); continue; } r -= I_UKV;
                { const int kb = r / 128, n0 = (r % 128) * 32; tr_item(w_o, 4096, kb * 64, n0, WO, 4096, n0, false, nullptr, scr, lane); }
            }
        }
        for (size_t i = gt; i < (size_t)192 * 512; i += NT) { const v4u z = {0u, 0u, 0u, 0u}; *(v4u*)(WIN + (size_t)1344 * 4096 + i * 8) = z; }
        for (size_t i = gt; i < (size_t)DM * 2048 / 8; i += NT) {
            const int d = (int)(i >> 8), c8 = (int)(i & 255) * 8, h = c8 >> 8, j = c8 & 255; const float* sp_ = peer_wq + (size_t)d * 2048 + c8; const f32x4 a0 = *(const f32x4*)sp_, a1 = *(const f32x4*)(sp_ + 4);
            v4u o; o.x = pk2(a0[0], a0[1]); o.y = pk2(a0[2], a0[3]); o.z = pk2(a1[0], a1[1]); o.w = pk2(a1[2], a1[3]); *(v4u*)(WPQ + ((size_t)h * DM + d) * 256 + j) = o; }
        for (size_t i = gt; i < (size_t)8 * 256 * 32; i += NT) {
            const int d8 = (int)(i & 31) * 8, rr = (int)(i >> 5) & 255, h = (int)(i >> 13), p = rr >> 7, k = rr & 127; v4u o = {0u, 0u, 0u, 0u};
            if ((d8 >> 7) == p) { const float* s_ = peer_keys + ((size_t)((h * 2 + p) * 128 + k)) * 128 + (d8 & 127); const f32x4 a0 = *(const f32x4*)s_, a1 = *(const f32x4*)(s_ + 4);
                o.x = pk2(a0[0], a0[1]); o.y = pk2(a0[2], a0[3]); o.z = pk2(a1[0], a1[1]); o.w = pk2(a1[2], a1[3]); }
            *(v4u*)(KB2 + i * 8) = o; }
        for (size_t i = gt; i < (size_t)192 * 16; i += NT) {
            const int pi = (int)(i >> 4), fi = (int)(i & 15); const int pos = pi < 128 ? pi : pi - 128;
            const float fr = __builtin_amdgcn_exp2f(-(float)fi * 0.83048202372184059f);
            const float turns = (float)pos * fr * 0.15915494309189535f, fx = turns - floorf(turns);
            rope[pi * 32 + 2 * fi] = __builtin_amdgcn_cosf(fx); rope[pi * 32 + 2 * fi + 1] = __builtin_amdgcn_sinf(fx); }
        if (psel & 4)
        for (int r = gw; r < 2 * NEXP; r += NGW) { const bool isv = r >= NEXP; const int e = isv ? r - NEXP : r; const float* src = (isv ? peer_v : peer_u) + (size_t)e * DM + lane * 4;
            f32x4 v[2][8]; float am = 0.f;
#pragma unroll
            for (int b = 0; b < 2; ++b)
#pragma unroll
                for (int q = 0; q < 8; ++q) { v[b][q] = __builtin_nontemporal_load((const f32x4*)(src + b * 2048 + q * 256)); am = fmaxf(am, fmaxf(fmaxf(fabsf(v[b][q][0]), fabsf(v[b][q][1])), fmaxf(fabsf(v[b][q][2]), fabsf(v[b][q][3])))); }
            am = wave_max(am);
            const float sc = am > 0.f ? exp2f(floorf(log2f(7.5f / am))) : 1.f;
            unsigned d[12];
#pragma unroll
            for (int b = 0; b < 2; ++b) { f32x16v s0, s1;
#pragma unroll
                for (int i = 0; i < 16; ++i) { const int i0 = FP6_INTERLEAVED ? 2 * i : i, i1 = FP6_INTERLEAVED ? 2 * i + 1 : 16 + i; s0[i] = v[b][i0 >> 2][i0 & 3] * sc; s1[i] = v[b][i1 >> 2][i1 & 3] * sc; }
                const u32x6v w = __builtin_amdgcn_cvt_scalef32_2xpk16_fp6_f32(s0, s1, 1.0f);
#pragma unroll
                for (int i = 0; i < 6; ++i) d[6 * b + i] = w[i]; }
            unsigned char* dst = (isv ? VB : UB) + (size_t)e * ROWB + lane * 16;
#pragma unroll
            for (int p = 0; p < 3; ++p) { const v4u o = {d[4 * p], d[4 * p + 1], d[4 * p + 2], d[4 * p + 3]}; *(v4u*)(dst + p * 1024) = o; }
            if (lane == 0) SUV[r] = 1.f / sc;
        }
    }
    GRID_BAR(0);

    if (PH_ON(1) && IN(1)) for (int rep_ = 0; rep_ < NREP(1); ++rep_) {
        PH_IDS();
        for (size_t j = gt; j < (size_t)(NMODC + 2 * DM); j += NT) { float sacc = 0.f;
#pragma unroll 8
            for (int kb = 0; kb < 64; ++kb) sacc += modp[(size_t)kb * 32768 + j];
            modf[j] = sacc + b_ada[j < (size_t)NMODC ? j : j - NMODC]; }
        { pg8::Gemm g{KB2, WPQ, 2048, DM, 256, 0, (size_t)DM * 256 * 2}; pg8::StaticOrder S; S.init(2048, DM, G, bx); pg8::EpiB16 E{KBD, DM};
          pg8::gemm_phase<pg8::EpiB16, pg8::StaticOrder, true, true>(L, g, S, E); }
    }
    GRID_BAR(1);

    if (PH_ON(2) && IN(2)) for (int rep_ = 0; rep_ < NREP(2); ++rep_) {
        PH_IDS();
        for (int row = gw; row < MR; row += NGW) {
            const bool lat = row < SEQ; const float* xr = lat ? x + (size_t)row * DM : ctx + (size_t)(row - SEQ) * DM; const float* md = lat ? modf : modf + NMODC;
            f32x4 v[16]; float ss = 0.f;
#pragma unroll
            for (int j = 0; j < 16; ++j) { v[j] = *(const f32x4*)(xr + 4 * (lane + 64 * j)); ss += (v[j][0] * v[j][0] + v[j][1] * v[j][1]) + (v[j][2] * v[j][2] + v[j][3] * v[j][3]); }
            ss = wave_sum(ss); const float rstd = 1.f / sqrtf(ss * (1.f / DM) + EPS);
#pragma unroll
            for (int j = 0; j < 16; ++j) { const int idx = 4 * (lane + 64 * j);
                const f32x4 g = *(const f32x4*)(norm1_g + idx), sh = *(const f32x4*)(md + idx), sc = *(const f32x4*)(md + DM + idx);
                const f32x4 hh = (v[j] * rstd * g) * (sc + 1.f) + sh;
                *(unsigned long long*)(HX + (size_t)row * DM + idx) = (unsigned long long)pk2(hh[0], hh[1]) | ((unsigned long long)pk2(hh[2], hh[3]) << 32); }
        }
    }
    GRID_BAR(2);

    if (PH_ON(3) && IN(3)) for (int rep_ = 0; rep_ < NREP(3); ++rep_) {
        pg8::Gemm g{HX, WIN, MR, NIN, DM, 0, 0}; pg8::OrderIn S; S.init(SEQ, NIN, G, bx);
        pg8::EpiIn E{CQ, CKV, KR, UCV, GBV, ssq_cq, ssq_ckv, rope};
        pg8::gemm_phase<pg8::EpiIn, pg8::OrderIn, true, true>(L, g, S, E);
    }
    GRID_BAR(3);

    if (PH_ON(4) && IN(4)) for (int rep_ = 0; rep_ < NREP(4); ++rep_) {
        PH_IDS();
        if (G == 256) {
            const int nq = bx < 144 ? 1 : bx < 240 ? 2 : 3, qb0 = bx < 144 ? bx : bx < 240 ? 144 + 2 * (bx - 144) : 336 + 3 * (bx - 240);
            const int nkv = bx < 144 ? 3 : bx < 240 ? 1 : 0, kb0 = bx < 144 ? 3 * bx : 432 + (bx - 144);
            { pg8::Gemm g{CQ, WUQ, SEQ, 3072, QL, 0, 0}; pg8::RunOrder S{qb0, nq, 12}; pg8::EpiQ E{Q, ssq_cq, rope, C2};
              pg8::gemm_phase<pg8::EpiQ, pg8::RunOrder, true, true>(L, g, S, E); }
            { pg8::Gemm g{CKV, WUKV, MR, 4096, KVL, 0, 0}; pg8::RunOrder S{kb0, nkv, 16}; pg8::EpiKV E{KN, V, ssq_ckv};
              pg8::gemm_phase<pg8::EpiKV, pg8::RunOrder, true, true>(L, g, S, E); }
        } else {
            { pg8::Gemm g{CQ, WUQ, SEQ, 3072, QL, 0, 0}; pg8::RunOrder S{(int)(((long)384 * bx) / G), (int)(((long)384 * (bx + 1)) / G - ((long)384 * bx) / G), 12}; pg8::EpiQ E{Q, ssq_cq, rope, C2};
              pg8::gemm_phase<pg8::EpiQ, pg8::RunOrder, true, true>(L, g, S, E); }
            { pg8::Gemm g{CKV, WUKV, MR, 4096, KVL, 0, 0}; pg8::RunOrder S{(int)(((long)528 * bx) / G), (int)(((long)528 * (bx + 1)) / G - ((long)528 * bx) / G), 16}; pg8::EpiKV E{KN, V, ssq_ckv};
              pg8::gemm_phase<pg8::EpiKV, pg8::RunOrder, true, true>(L, g, S, E); }
        }
        for (size_t it = gt; it < (size_t)SEQ * 256; it += NT) {
            const int t = (int)(it >> 8), c8 = (int)(it & 255) * 8; const v4u z = {0u, 0u, 0u, 0u};
            const v4u um = t > 0 ? *(const v4u*)(UCV + (size_t)(t - 1) * 2048 + c8) : z, u0 = *(const v4u*)(UCV + (size_t)t * 2048 + c8), up = t < SEQ - 1 ? *(const v4u*)(UCV + (size_t)(t + 1) * 2048 + c8) : z;
            const v4u gv = *(const v4u*)(GBV + (size_t)t * 2048 + c8); v4u o;
            float w0[8], w1[8], w2[8], wb[8];
#pragma unroll
            for (int q = 0; q < 2; ++q) { const f32x4 a0 = *(const f32x4*)(conv_w + c8 + 4 * q), a1 = *(const f32x4*)(conv_w + 2048 + c8 + 4 * q), a2 = *(const f32x4*)(conv_w + 4096 + c8 + 4 * q), a3 = *(const f32x4*)(conv_b + c8 + 4 * q);
#pragma unroll
                for (int j = 0; j < 4; ++j) { w0[4 * q + j] = a0[j]; w1[4 * q + j] = a1[j]; w2[4 * q + j] = a2[j]; wb[4 * q + j] = a3[j]; } }
#pragma unroll
            for (int j = 0; j < 4; ++j) {
                const float y0 = w0[2 * j] * bflo(um[j]) + w1[2 * j] * bflo(u0[j]) + w2[2 * j] * bflo(up[j]) + wb[2 * j];
                const float y1 = w0[2 * j + 1] * bfhi(um[j]) + w1[2 * j + 1] * bfhi(u0[j]) + w2[2 * j + 1] * bfhi(up[j]) + wb[2 * j + 1];
                o[j] = pk2(bflo(gv[j]) * y0, bfhi(gv[j]) * y1); }
            *(v4u*)(ACAT + (size_t)t * DM + 2048 + c8) = o; }
    }
    GRID_BAR(4);

    if (PH_ON(5) && IN(5)) for (int rep_ = 0; rep_ < NREP(5); ++rep_) {
        for (int i = 0;; ++i) { int h, qb;
            if (G == 256) { if (i >= 2) break; h = 2 * (bx & 7) + i; qb = bx >> 3; } else { const int Lu = i * G + bx; if (Lu >= 512) break; h = Lu >> 5; qb = Lu & 31; }
            att::attn_unit(Q + (size_t)(qb * 256) * 3072 + h * 192, KN + h * 128, V + h * 128, KR, ACAT + (size_t)(qb * 256) * DM + h * 128, MR, (char*)lds, L, a.probe); }
    }
    GRID_BAR(5);

    if (PH_ON(6) && IN(6)) for (int rep_ = 0; rep_ < NREP(6); ++rep_) {
        pg8::Gemm g{ACAT, WO, SEQ, DM, DM, 0, 0}; pg8::StaticOrder S; S.init(SEQ, DM, G, bx); pg8::EpiO E{modf + 2 * DM, DLT};
        pg8::gemm_phase<pg8::EpiO, pg8::StaticOrder, true, true>(L, g, S, E);
    }
    GRID_BAR(6);

    if (PH_ON(7) && IN(7)) for (int rep_ = 0; rep_ < NREP(7); ++rep_) {
        PH_IDS();
        for (int row = gw; row < SEQ; row += NGW) {
            f32x4 v[16]; float ssq[4] = {0.f, 0.f, 0.f, 0.f};
#pragma unroll
            for (int j = 0; j < 16; ++j) { const int idx = 4 * (lane + 64 * j); const unsigned long long d8 = *(const unsigned long long*)(DLT + (size_t)row * DM + idx); const f32x4 xv = *(const f32x4*)(x + (size_t)row * DM + idx);
                v[j][0] = xv[0] + bflo((unsigned)d8); v[j][1] = xv[1] + bfhi((unsigned)d8); v[j][2] = xv[2] + bflo((unsigned)(d8 >> 32)); v[j][3] = xv[3] + bfhi((unsigned)(d8 >> 32));
#pragma unroll
                for (int c = 0; c < 4; ++c) ssq[c] = fmaf(v[j][c], v[j][c], ssq[c]); }
            const float rstd = 1.f / sqrtf(wave_sum((ssq[0] + ssq[1]) + (ssq[2] + ssq[3])) * (1.f / DM) + EPS);
#pragma unroll
            for (int j = 0; j < 16; ++j) { const int idx = 4 * (lane + 64 * j);
                const f32x4 g = *(const f32x4*)(norm2_g + idx), sh = *(const f32x4*)(modf + 3 * DM + idx), sc = *(const f32x4*)(modf + 4 * DM + idx);
                const f32x4 hh = (v[j] * rstd * g) * (sc + 1.f) + sh;
                *(unsigned long long*)(H2 + (size_t)row * DM + idx) = (unsigned long long)pk2(hh[0], hh[1]) | ((unsigned long long)pk2(hh[2], hh[3]) << 32); }
        }
    }
    GRID_BAR(7);

    if (PH_ON(8) && IN(8)) for (int rep_ = 0; rep_ < NREP(8); ++rep_) {
        pg8::Gemm g{H2, KBD, SEQ, 2048, DM, 0, 0}; pg8::StaticOrder S; S.init(SEQ, 2048, G, bx); pg8::EpiF32 E{SC, 2048};
        pg8::gemm_phase<pg8::EpiF32, pg8::StaticOrder, true, true>(L, g, S, E);
    }
    GRID_BAR(8);

    if (PH_ON(9) && IN(9)) for (int rep_ = 0; rep_ < NREP(9); ++rep_) {
        int lane0_ = threadIdx.x; asm volatile("" : "+v"(lane0_)); lane0_ &= 63;
        LAS unsigned* wl = (LAS unsigned*)(L + wave * 8192);
        LAS unsigned* sSel = wl;
        LAS unsigned* eL = wl + 256; LAS float* gL = (LAS float*)(wl + 256 + 512);
        const float* gate2 = modf + 5 * DM; const int emask_ = a.probe ? 63 : 0xffff; float* outp_ = a.probe ? (float*)(ws + WS_HX) : a.out;
        for (int tb = gw * 4; tb < SEQ; tb += NGW * 4) {
            for (int ti = 0; ti < 4; ++ti) { const int t = tb + ti; int lane = lane0_; asm volatile("" : "+v"(lane));
                for (int hp = 0; hp < 4; ++hp) {
                    const float* sp = SC + (size_t)t * 2048 + hp * 512;
                    { unsigned k[4][2], vb[4][2]; unsigned T[4]; const unsigned pl[2] = {(unsigned)lane, (unsigned)(64 + lane)};
#pragma unroll
                      for (int c = 0; c < 4; ++c) { const float s0 = sp[c * 128 + lane], s1 = sp[c * 128 + 64 + lane]; k[c][0] = fkey(s0); k[c][1] = fkey(s1); vb[c][0] = __builtin_bit_cast(unsigned, s0); vb[c][1] = __builtin_bit_cast(unsigned, s1); }
                      kth16_multi<4, 2>(k, T);
#pragma unroll
                      for (int c = 0; c < 4; ++c) compact16<2>(k[c], vb[c], pl, T[c], sSel + c * 32, sSel + c * 32 + 16, lane); }
                    LDS_WAIT();
                    { unsigned k[2][4], vb[2][4], pl[2][4]; unsigned T[2];
#pragma unroll
                      for (int c = 0; c < 2; ++c) { const float s2b = __builtin_bit_cast(float, sSel[c * 64 + 32 + (lane & 15)]); const unsigned i2b = sSel[c * 64 + 48 + (lane & 15)];
#pragma unroll
                          for (int r = 0; r < 4; ++r) { const int aa = (lane >> 4) + 4 * r; const float cv = __builtin_bit_cast(float, sSel[c * 64 + aa]) + s2b; k[c][r] = fkey(cv); vb[c][r] = __builtin_bit_cast(unsigned, cv); pl[c][r] = sSel[c * 64 + 16 + aa] * 128u + i2b; } }
                      kth16_multi<2, 4>(k, T);
#pragma unroll
                      for (int c = 0; c < 2; ++c) compact16<4>(k[c], vb[c], pl[c], T[c], sSel + 128 + c * 32, sSel + 128 + c * 32 + 16, lane); }
                    LDS_WAIT();
#pragma unroll
                    for (int c = 0; c < 2; ++c) { const float tv = __builtin_bit_cast(float, sSel[128 + c * 32 + (lane & 15)]); const float mx = row16_max(tv);
                      const float ex = expf(tv - mx); const float sm = row16_sum(ex);
                      if (lane < 16) { eL[ti * 128 + (2 * hp + c) * 16 + lane] = sSel[128 + c * 32 + 16 + lane]; gL[ti * 128 + (2 * hp + c) * 16 + lane] = ex / sm; } }
                    LDS_WAIT();
                }
                { const unsigned e0 = eL[ti * 128 + lane], e1 = eL[ti * 128 + 64 + lane]; const float g0 = gL[ti * 128 + lane], g1 = gL[ti * 128 + 64 + lane];
                  const unsigned k0 = (e0 << 7) | (unsigned)lane, k1 = (e1 << 7) | (unsigned)(64 + lane); int r0 = 0, r1 = 0;
#pragma unroll 8
                  for (int m = 0; m < 128; ++m) { const unsigned km = (eL[ti * 128 + m] << 7) | (unsigned)m; r0 += km < k0 ? 1 : 0; r1 += km < k1 ? 1 : 0; }
                  LDS_WAIT();
                  eL[ti * 128 + r0] = e0; gL[ti * 128 + r0] = g0; eL[ti * 128 + r1] = e1; gL[ti * 128 + r1] = g1;
                  LDS_WAIT(); }
                h16x2 hh[2][16];
#pragma unroll
                for (int b = 0; b < 2; ++b)
#pragma unroll
                    for (int q = 0; q < 8; ++q) { const unsigned long long a0 = *(const unsigned long long*)(H2 + (size_t)t * DM + b * 2048 + q * 256 + lane * 4);
                        hh[b][2 * q] = (h16x2){(_Float16)bflo((unsigned)a0), (_Float16)bfhi((unsigned)a0)}; hh[b][2 * q + 1] = (h16x2){(_Float16)bflo((unsigned)(a0 >> 32)), (_Float16)bfhi((unsigned)(a0 >> 32))}; }
                v4u rr[6][3]; float rs[6];
#define LDROW(j, TAB, e, SOFF) do { const unsigned char* rp_ = (TAB) + (size_t)(e) * ROWB + lane * 16; _Pragma("unroll") for (int p = 0; p < 3; ++p) rr[j][p] = *(const v4u*)(rp_ + p * 1024); rs[j] = SUV[(SOFF) + (e)]; } while (0)
#define EIDX(k) (__builtin_amdgcn_readfirstlane((int)eL[ti * 128 + (k)]) & emask_)
#define UNPKH(j, b) __builtin_amdgcn_cvt_scalef32_pk32_f16_fp6((b) == 0 ? (u32x6v){rr[j][0][0], rr[j][0][1], rr[j][0][2], rr[j][0][3], rr[j][1][0], rr[j][1][1]} : (u32x6v){rr[j][1][2], rr[j][1][3], rr[j][2][0], rr[j][2][1], rr[j][2][2], rr[j][2][3]}, 1.0f)
#define DOTROW(out, j) do { float a0 = 0.f, a1 = 0.f, a2 = 0.f, a3 = 0.f; _Pragma("unroll") for (int b = 0; b < 2; ++b) { const h16x32 x_ = UNPKH(j, b); \
                    _Pragma("unroll") for (int i = 0; i < 16; i += 4) { a0 = __builtin_amdgcn_fdot2((h16x2){x_[2 * i], x_[2 * i + 1]}, hh[b][i], a0, false); a1 = __builtin_amdgcn_fdot2((h16x2){x_[2 * i + 2], x_[2 * i + 3]}, hh[b][i + 1], a1, false); \
                        a2 = __builtin_amdgcn_fdot2((h16x2){x_[2 * i + 4], x_[2 * i + 5]}, hh[b][i + 2], a2, false); a3 = __builtin_amdgcn_fdot2((h16x2){x_[2 * i + 6], x_[2 * i + 7]}, hh[b][i + 3], a3, false); } } \
                    out = (a0 + a1) + (a2 + a3); } while (0)
                int ei[6];
#pragma unroll
                for (int j = 0; j < 6; ++j) { ei[j] = EIDX(j); LDROW(j, UB, ei[j], 0); }
                for (int k0 = 0; k0 < 126; k0 += 6) {
                    float dsum[6];
#pragma unroll
                    for (int j = 0; j < 6; ++j) { float part; DOTROW(part, j); const float sc_ = rs[j];
                        if (k0 + 6 + j < 128) { ei[j] = EIDX(k0 + 6 + j); LDROW(j, UB, ei[j], 0); }
                        dsum[j] = wave_sum(part) * sc_; }
                    if (lane < 6) { float d = dsum[0];
#pragma unroll
                        for (int j = 1; j < 6; ++j) d = lane == j ? dsum[j] : d;
                        gL[ti * 128 + k0 + lane] = gL[ti * 128 + k0 + lane] * gelu_erf(d); }
                }
                { float dsum[2];
#pragma unroll
                  for (int j = 0; j < 2; ++j) { float part; DOTROW(part, j); dsum[j] = wave_sum(part) * rs[j]; }
                  if (lane < 2) { const float d = lane == 0 ? dsum[0] : dsum[1]; gL[ti * 128 + 126 + lane] = gL[ti * 128 + 126 + lane] * gelu_erf(d); } }
                LDS_WAIT();
            }
            for (int ti = 0; ti < 4; ++ti) { const int t = tb + ti; int lane = lane0_; asm volatile("" : "+v"(lane));
                h16x2 ah[2][16];
#pragma unroll
                for (int b = 0; b < 2; ++b)
#pragma unroll
                    for (int i = 0; i < 16; ++i) ah[b][i] = (h16x2){(_Float16)0.f, (_Float16)0.f};
                v4u rr[6][3]; float rs[6];
#define FMAROW(j, WW) do { const _Float16 wh_ = (_Float16)(WW); const h16x2 w2_ = {wh_, wh_}; _Pragma("unroll") for (int b = 0; b < 2; ++b) { const h16x32 x_ = UNPKH(j, b); \
                    _Pragma("unroll") for (int i = 0; i < 16; ++i) ah[b][i] = __builtin_elementwise_fma(w2_, (h16x2){x_[2 * i], x_[2 * i + 1]}, ah[b][i]); } } while (0)
                int ei[6];
#pragma unroll
                for (int j = 0; j < 6; ++j) { ei[j] = EIDX(j); LDROW(j, VB, ei[j], NEXP); }
                for (int k0 = 0; k0 < 126; k0 += 6) {
#pragma unroll
                    for (int j = 0; j < 6; ++j) { FMAROW(j, gL[ti * 128 + k0 + j] * rs[j]);
                        if (k0 + 6 + j < 128) { ei[j] = EIDX(k0 + 6 + j); LDROW(j, VB, ei[j], NEXP); } }
                }
#pragma unroll
                for (int j = 0; j < 2; ++j) FMAROW(j, gL[ti * 128 + 126 + j] * rs[j]);
                float acc[2][32];
#pragma unroll
                for (int b = 0; b < 2; ++b)
#pragma unroll
                    for (int i = 0; i < 16; ++i) { acc[b][2 * i] = (float)ah[b][i][0]; acc[b][2 * i + 1] = (float)ah[b][i][1]; }
                float ssp[4] = {0.f, 0.f, 0.f, 0.f}; int lane_f = lane; asm volatile("" : "+v"(lane_f));
#pragma unroll
                for (int b = 0; b < 2; ++b)
#pragma unroll
                    for (int q = 0; q < 8; ++q) { unsigned o = (unsigned)(b * 2048 + q * 256 + lane_f * 4); asm volatile("" : "+v"(o)); const unsigned long long d8 = *(const unsigned long long*)(DLT + (size_t)t * DM + o); f32x4 xa = *(const f32x4*)(x + (size_t)t * DM + o); const f32x4 ga = *(const f32x4*)(gate2 + o);
                        xa[0] += bflo((unsigned)d8); xa[1] += bfhi((unsigned)d8); xa[2] += bflo((unsigned)(d8 >> 32)); xa[3] += bfhi((unsigned)(d8 >> 32));
#pragma unroll
                        for (int j = 0; j < 4; ++j) { acc[b][4 * q + j] = fmaf(ga[j], acc[b][4 * q + j], xa[j]); ssp[j] = fmaf(acc[b][4 * q + j], acc[b][4 * q + j], ssp[j]); }
                        if ((q & 1) == 1) asm volatile("" ::: "memory"); }
                const float ss = wave_sum((ssp[0] + ssp[1]) + (ssp[2] + ssp[3])); const float rstd = 1.f / sqrtf(ss * (1.f / DM) + EPS);
#pragma unroll
                for (int b = 0; b < 2; ++b)
#pragma unroll
                    for (int q = 0; q < 8; ++q) { unsigned o = (unsigned)(b * 2048 + q * 256 + lane_f * 4); asm volatile("" : "+v"(o)); const f32x4 fa = *(const f32x4*)(final_g + o); f32x4 oa;
#pragma unroll
                        for (int j = 0; j < 4; ++j) oa[j] = acc[b][4 * q + j] * rstd * fa[j];
                        *(f32x4*)(outp_ + (size_t)t * DM + o) = oa; if ((q & 1) == 1) asm volatile("" ::: "memory"); }
            }
            LDS_WAIT();
#undef LDROW
#undef EIDX
#undef DOTROW
#undef FMAROW
#undef UNPKH
        }
    }
#undef IN
#undef GRID_BAR
}

extern "C" void kernel_launch(void* const* d_in, const int* in_sizes, int n_in, void* d_out, int out_size, void* d_ws, size_t ws_size, hipStream_t stream) {
    static int grid = 0;
    if (grid == 0) {
        if (n_in != 21 || in_sizes[0] != SEQ * DM || out_size != SEQ * DM || ws_size < WS_END) {
            fprintf(stderr, "kernel_launch: built for 21 inputs, x/out of %d floats, >= %zu bytes of workspace; got n_in %d, in0 %d, out %d, ws %zu; nothing launched\n", SEQ * DM, (size_t)WS_END, n_in, n_in > 0 ? in_sizes[0] : -1, out_size, ws_size); grid = -1; return; }
        int dev = 0, cus = 0, per_cu = 0;
        if (hipGetDevice(&dev) != hipSuccess || hipDeviceGetAttribute(&cus, hipDeviceAttributeMultiprocessorCount, dev) != hipSuccess) { fprintf(stderr, "kernel_launch: device query failed\n"); grid = -1; return; }
        if (hipFuncSetAttribute((const void*)fwd, hipFuncAttributeMaxDynamicSharedMemorySize, LDS_BYTES) != hipSuccess) { fprintf(stderr, "kernel_launch: hipFuncSetAttribute failed\n"); grid = -1; return; }
        if (hipOccupancyMaxActiveBlocksPerMultiprocessor(&per_cu, (const void*)fwd, NTHR, LDS_BYTES) != hipSuccess || per_cu < 1) fprintf(stderr, "kernel_launch: note: occupancy query reports %d workgroups per CU\n", per_cu);
        (void)hipGetLastError();
        grid = cus;
    }
    if (grid < 0) return;
    if (hipMemsetAsync((char*)d_ws + WS_CTL, 0, CTL_ZERO_BYTES, stream) != hipSuccess) { fprintf(stderr, "kernel_launch: memset failed\n"); return; }
    Args a{};
    for (int i = 0; i < 21; ++i) a.in[i] = (const float*)d_in[i];
    a.out = (float*)d_out; a.ws = (unsigned char*)d_ws;
#if MK_ONE_LAUNCH
    a.ph_lo = 0; a.ph_hi = NPHASE;
    hipLaunchKernelGGL(fwd, dim3(grid), dim3(NTHR), LDS_BYTES, stream, a);
#ifndef PROBE_MODE
#define PROBE_MODE 0
#endif
#ifdef PROBE_PHASES
    for (int p = 0; p < NPHASE; ++p) if ((PROBE_PHASES >> p) & 1) { a.ph_lo = p; a.ph_hi = p + 1; a.probe = PROBE_MODE; hipLaunchKernelGGL(fwd, dim3(grid), dim3(NTHR), LDS_BYTES, stream, a); }
#endif
#else
    for (int p = 0; p < NPHASE; ++p) { a.ph_lo = p; a.ph_hi = p + 1; hipLaunchKernelGGL(fwd, dim3(grid), dim3(NTHR), LDS_BYTES, stream, a); }
#endif
    const hipError_t le = hipPeekAtLastError();
    if (le != hipSuccess) fprintf(stderr, "kernel_launch: launch failed: %s\n", hipGetErrorName(le));
}
```

```cpp
#include <hip/hip_runtime.h>
#include <cstdio>
#include <cstdint>
#include <cmath>
namespace pg8 {
#define PG8_LAS __attribute__((address_space(3)))
typedef unsigned short bf16_t;
typedef short bf16x8 __attribute__((ext_vector_type(8)));
typedef float f32x4 __attribute__((ext_vector_type(4)));
typedef unsigned u32x4 __attribute__((ext_vector_type(4)));
constexpr int BM = 256, BK = 64, HALF = 128, HTB = HALF * BK * 2  , STAGE_BYTES = 8 * HTB, NXCD = 8, WGM = 8;

__host__ __device__ __forceinline__ int lds_byte(int r, int c) { const int st = (r >> 4) * 2 + (c >> 5), rr = r & 15, cc = c & 31, ob = rr * 64 + cc * 2; return st * 1024 + (ob ^ (((ob >> 9) & 1) << 5)); }
__host__ __device__ __forceinline__ void stage_rc(int b, int& R, int& C) { const int st = b / 1024, sb = b % 1024, swz = sb ^ (((sb >> 9) & 1) << 5); R = (st >> 1) * 16 + swz / 64; C = (st & 1) * 32 + (swz % 64) / 2; }
__host__ __device__ __forceinline__ int perm32(int rho) { const int n = rho >> 4, i = rho & 15; return 8 * (i >> 2) + 4 * n + (i & 3); }

struct Unit { int pm, pn; };
struct Gemm { const bf16_t* A; const bf16_t* Bt; int M, N, K; size_t a_pn; size_t b_pm; };

struct StaticOrder {
    int nM, nN, nwg, G, c;
    __host__ __device__ void init(int M, int N, int G_, int c_) { nM = M / BM; nN = N / BM; nwg = nM * nN; G = G_; c = c_; }
    __host__ __device__ bool next(int i, Unit& u) const {
        const long L = (long)i * G + c; if (L >= nwg) return false;
        int wgid = (int)L; { const int q = nwg / NXCD, r = nwg % NXCD, xcd = wgid % NXCD, off = wgid / NXCD; wgid = (xcd < r ? xcd * (q + 1) : r * (q + 1) + (xcd - r) * q) + off; }
        const int nig = WGM * nN, gid = wgid / nig, fm = gid * WGM, gsz = (nM - fm) < WGM ? (nM - fm) : WGM;
        u.pm = fm + ((wgid % nig) % gsz); u.pn = (wgid % nig) / gsz; return true;
    }
    __device__ __forceinline__ void a_ready(const Unit&) const {}
    __device__ __forceinline__ void done(const Unit&) const {}
};

__device__ __forceinline__ unsigned cvt_pk_bf16(float lo, float hi) { unsigned r; asm volatile("v_cvt_pk_bf16_f32 %0, %1, %2" : "=v"(r) : "v"(lo), "v"(hi)); return r; }
typedef float f32x2 __attribute__((ext_vector_type(2)));
__device__ __forceinline__ f32x2 gelu_pk(f32x2 v) {
    const f32x2 av = __builtin_elementwise_abs(v), d = av * 0.2316418882f + 1.0f;
    f32x2 t; t.x = __builtin_amdgcn_rcpf(d.x); t.y = __builtin_amdgcn_rcpf(d.y);
    f32x2 q = t * 0.5307027145f + (-0.7265760135f); q = q * t + 0.7107068705f; q = q * t + (-0.142248368f); q = q * t + 0.127414796f; q = q * t;
    const f32x2 s = (v * v) * (-0.72134752044f);
    f32x2 e; e.x = __builtin_amdgcn_exp2f(s.x); e.y = __builtin_amdgcn_exp2f(s.y);
    const f32x2 m = v * (q * e), r = v - m;
    f32x2 o; o.x = v.x < 0.f ? m.x : r.x; o.y = v.y < 0.f ? m.y : r.y; return o;
}


__device__ __forceinline__ u32x4 pack8(f32x4 v0, f32x4 v1) { u32x4 w; w.x = cvt_pk_bf16(v0[0], v0[1]); w.y = cvt_pk_bf16(v0[2], v0[3]); w.z = cvt_pk_bf16(v1[0], v1[1]); w.w = cvt_pk_bf16(v1[2], v1[3]); return w; }
__device__ __forceinline__ float quad_row_sum(float s) { s += __shfl_xor(s, 16); s += __shfl_xor(s, 32); return s; }

__device__ __forceinline__ f32x4 rope4(f32x4 v, const float* tab, int i) {
    const f32x4 cs = *(const f32x4*)(tab + 2 * i);
    f32x4 o; o[0] = v[0] * cs[0] - v[1] * cs[1]; o[1] = v[1] * cs[0] + v[0] * cs[1]; o[2] = v[2] * cs[2] - v[3] * cs[3]; o[3] = v[3] * cs[2] + v[2] * cs[3]; return o;
}

struct EpiIn {
    static constexpr bool PERM = true, AFTER_DRAIN = false;
    bf16_t* cq; bf16_t* ckv; bf16_t* kr; bf16_t* ub; bf16_t* gb; float* ssq_cq; float* ssq_ckv; const float* rope;
    __device__ __forceinline__ void operator()(const f32x4 (&acc)[2][2][4][2], const Unit& u, int wr, int wc, int fr, int fq) const {
        const int pn = u.pn, row0 = u.pm * BM + wr * 64 + fr, cw = wc * 32 + 8 * fq;
        if (pn < 5) {
            bf16_t* dst = pn < 3 ? cq : ckv; const int ld = pn < 3 ? 768 : 512, pl = pn < 3 ? pn : pn - 3, coff = pl * 256 + cw, nsl = pn < 3 ? 12 : 8; float* ssq = pn < 3 ? ssq_cq : ssq_ckv;
#pragma unroll
            for (int ai = 0; ai < 2; ++ai)
#pragma unroll
                for (int m = 0; m < 4; ++m) { const int row = row0 + ai * HALF + m * 16; float s = 0.f;
#pragma unroll
                    for (int bj = 0; bj < 2; ++bj) { const f32x4 v0 = acc[ai][bj][m][0], v1 = acc[ai][bj][m][1];
                        s += (v0[0] * v0[0] + v0[1] * v0[1]) + (v0[2] * v0[2] + v0[3] * v0[3]) + (v1[0] * v1[0] + v1[1] * v1[1]) + (v1[2] * v1[2] + v1[3] * v1[3]);
                        *(u32x4*)(dst + (size_t)row * ld + coff + bj * HALF) = pack8(v0, v1); }
                    s = quad_row_sum(s); if (fq == 0) ssq[(size_t)row * nsl + pl * 4 + wc] = s; }
        } else if (pn == 5) {
            if (wc < 2) {
#pragma unroll
                for (int ai = 0; ai < 2; ++ai)
#pragma unroll
                    for (int m = 0; m < 4; ++m) { const int row = row0 + ai * HALF + m * 16; f32x4 v0 = acc[ai][0][m][0], v1 = acc[ai][0][m][1];
                        if (row < 8192) { const int pos = wc == 0 ? (row >> 6) : 128 + (row & 63); const float* tab = rope + pos * 32; v0 = rope4(v0, tab, 4 * fq); v1 = rope4(v1, tab, 4 * fq + 2); }
                        *(u32x4*)(kr + (size_t)row * 64 + cw) = pack8(v0, v1); }
            }
        } else if (pn < 22) {
            const int j = pn - 6;
#pragma unroll
            for (int ai = 0; ai < 2; ++ai)
#pragma unroll
                for (int m = 0; m < 4; ++m) { const int row = row0 + ai * HALF + m * 16;
                    *(u32x4*)(ub + (size_t)row * 2048 + j * 128 + cw) = pack8(acc[ai][0][m][0] * acc[ai][1][m][0], acc[ai][0][m][1] * acc[ai][1][m][1]); }
        } else {
            const int j = pn - 22;
#pragma unroll
            for (int ai = 0; ai < 2; ++ai)
#pragma unroll
                for (int m = 0; m < 4; ++m) { const int row = row0 + ai * HALF + m * 16;
#pragma unroll
                    for (int bj = 0; bj < 2; ++bj) *(u32x4*)(gb + (size_t)row * 2048 + j * 256 + bj * HALF + cw) = pack8(acc[ai][bj][m][0], acc[ai][bj][m][1]); }
        }
    }
};

struct EpiQ {
    static constexpr bool PERM = true, AFTER_DRAIN = false;
    bf16_t* q; const float* ssq_cq; const float* rope; float c2;
    __device__ __forceinline__ void operator()(const f32x4 (&acc)[2][2][4][2], const Unit& u, int wr, int wc, int fr, int fq) const {
        const int row0 = u.pm * BM + wr * 64 + fr, cw = wc * 32 + 8 * fq;
#pragma unroll
        for (int ai = 0; ai < 2; ++ai)
#pragma unroll
            for (int m = 0; m < 4; ++m) { const int row = row0 + ai * HALF + m * 16; const f32x4 q0 = *(const f32x4*)(ssq_cq + (size_t)row * 12), q1 = *(const f32x4*)(ssq_cq + (size_t)row * 12 + 4), q2 = *(const f32x4*)(ssq_cq + (size_t)row * 12 + 8);
                const float ssum = (((q0[0] + q0[1]) + (q0[2] + q0[3])) + ((q1[0] + q1[1]) + (q1[2] + q1[3]))) + ((q2[0] + q2[1]) + (q2[2] + q2[3])); const float sc = c2 / sqrtf(ssum * (1.f / 768.f) + 1e-6f);
#pragma unroll
                for (int bj = 0; bj < 2; ++bj) { const int col = u.pn * BM + bj * HALF + cw, d = col % 192; f32x4 v0 = acc[ai][bj][m][0] * sc, v1 = acc[ai][bj][m][1] * sc;
                    if (d >= 128) { const int p = d - 128, ax = p >> 5, i = (p & 31) >> 1; const int pos = ax == 0 ? (row >> 6) : 128 + (row & 63); const float* tab = rope + pos * 32;
                        v0 = rope4(v0, tab, i); v1 = rope4(v1, tab, i + 2); }
                    *(u32x4*)(q + (size_t)row * 3072 + col) = pack8(v0, v1); } }
    }
};

struct EpiKV {
    static constexpr bool PERM = true, AFTER_DRAIN = false;
    bf16_t* kn; bf16_t* v; const float* ssq_ckv;
    __device__ __forceinline__ void operator()(const f32x4 (&acc)[2][2][4][2], const Unit& u, int wr, int wc, int fr, int fq) const {
        const int row0 = u.pm * BM + wr * 64 + fr, cw = u.pn * 128 + wc * 32 + 8 * fq;
#pragma unroll
        for (int ai = 0; ai < 2; ++ai)
#pragma unroll
            for (int m = 0; m < 4; ++m) { const int row = row0 + ai * HALF + m * 16; const f32x4 q0 = *(const f32x4*)(ssq_ckv + (size_t)row * 8), q1 = *(const f32x4*)(ssq_ckv + (size_t)row * 8 + 4);
                const float ssum = ((q0[0] + q0[1]) + (q0[2] + q0[3])) + ((q1[0] + q1[1]) + (q1[2] + q1[3])); const float sc = 1.f / sqrtf(ssum * (1.f / 512.f) + 1e-6f);
                *(u32x4*)(kn + (size_t)row * 2048 + cw) = pack8(acc[ai][0][m][0] * sc, acc[ai][0][m][1] * sc);
                *(u32x4*)(v + (size_t)row * 2048 + cw) = pack8(acc[ai][1][m][0] * sc, acc[ai][1][m][1] * sc); }
    }
};

struct EpiO {
    static constexpr bool PERM = true, AFTER_DRAIN = false;
    const float* gate; bf16_t* dlt;
    __device__ __forceinline__ void operator()(const f32x4 (&acc)[2][2][4][2], const Unit& u, int wr, int wc, int fr, int fq) const {
        const int row0 = u.pm * BM + wr * 64 + fr, c0 = u.pn * BM + wc * 32 + 8 * fq;
        f32x4 g[2][2];
#pragma unroll
        for (int bj = 0; bj < 2; ++bj)
#pragma unroll
            for (int n = 0; n < 2; ++n) g[bj][n] = *(const f32x4*)(gate + c0 + bj * HALF + 4 * n);
#pragma unroll
        for (int ai = 0; ai < 2; ++ai)
#pragma unroll
            for (int m = 0; m < 4; ++m) { const int row = row0 + ai * HALF + m * 16;
#pragma unroll
                for (int bj = 0; bj < 2; ++bj) *(u32x4*)(dlt + (size_t)row * 4096 + c0 + bj * HALF) = pack8(g[bj][0] * acc[ai][bj][m][0], g[bj][1] * acc[ai][bj][m][1]); }
    }
};

struct EpiPQ {
    static constexpr bool PERM = true, AFTER_DRAIN = false;
    bf16_t* qp;
    __device__ __forceinline__ void operator()(const f32x4 (&acc)[2][2][4][2], const Unit& u, int wr, int wc, int fr, int fq) const {
        const int row0 = u.pm * BM + wr * 64 + fr, cw = wc * 32 + 8 * fq; bf16_t* base = qp + (size_t)u.pn * 8192 * 256;
#pragma unroll
        for (int ai = 0; ai < 2; ++ai)
#pragma unroll
            for (int m = 0; m < 4; ++m) { const int row = row0 + ai * HALF + m * 16;
#pragma unroll
                for (int bj = 0; bj < 2; ++bj) *(u32x4*)(base + (size_t)row * 256 + bj * HALF + cw) = pack8(acc[ai][bj][m][0], acc[ai][bj][m][1]); }
    }
};

struct EpiB16 {
    static constexpr bool PERM = true, AFTER_DRAIN = false;
    bf16_t* o; int ldc;
    __device__ __forceinline__ void operator()(const f32x4 (&acc)[2][2][4][2], const Unit& u, int wr, int wc, int fr, int fq) const {
        const int row0 = u.pm * BM + wr * 64 + fr, c0 = u.pn * BM + wc * 32 + 8 * fq;
#pragma unroll
        for (int ai = 0; ai < 2; ++ai)
#pragma unroll
            for (int m = 0; m < 4; ++m) { const int row = row0 + ai * HALF + m * 16;
#pragma unroll
                for (int bj = 0; bj < 2; ++bj) *(u32x4*)(o + (size_t)row * ldc + c0 + bj * HALF) = pack8(acc[ai][bj][m][0], acc[ai][bj][m][1]); }
    }
};

struct EpiF32 {
    static constexpr bool PERM = true, AFTER_DRAIN = false;
    float* o; int ldc;
    __device__ __forceinline__ void operator()(const f32x4 (&acc)[2][2][4][2], const Unit& u, int wr, int wc, int fr, int fq) const {
        const int row0 = u.pm * BM + wr * 64 + fr, c0 = u.pn * BM + wc * 32 + 8 * fq;
#pragma unroll
        for (int ai = 0; ai < 2; ++ai)
#pragma unroll
            for (int m = 0; m < 4; ++m) { const int row = row0 + ai * HALF + m * 16;
#pragma unroll
                for (int bj = 0; bj < 2; ++bj)
#pragma unroll
                    for (int n = 0; n < 2; ++n) *(f32x4*)(o + (size_t)row * ldc + c0 + bj * HALF + 4 * n) = acc[ai][bj][m][n]; }
    }
};

struct OrderIn : StaticOrder {
    __device__ bool next(int i, Unit& u) const {
        const long L = (long)i * G + c;
        if (L < nwg) return StaticOrder::next(i, u);
        if (L < nwg + 3) { u.pm = 32; u.pn = 3 + (int)(L - nwg); return true; }
        return false;
    }
};

struct RunOrder {
    int base, cnt, nN;
    __device__ bool next(int i, Unit& u) const { if (i >= cnt) return false; const int idx = base + i; u.pm = idx / nN; u.pn = idx % nN; return true; }
    __device__ __forceinline__ void a_ready(const Unit&) const {}
    __device__ __forceinline__ void done(const Unit&) const {}
};
template <class Epi, class Sched, bool ALIGN_EPI = false, bool SP2 = false>
__device__ __forceinline__ void gemm_phase(PG8_LAS unsigned char* lds, const Gemm g, const Sched& S, const Epi& E) {
    const int tid = threadIdx.x, wid = __builtin_amdgcn_readfirstlane(tid >> 6), lane = tid & 63, wr = wid >> 2, wc = wid & 3, fr = lane & 15, fq = lane >> 4;
    const int K = g.K, nt = K / BK;
    unsigned voffA[2], voffB[2];
#pragma unroll
    for (int i = 0; i < 2; ++i) { int R, C; stage_rc(tid * 16 + i * 8192, R, C); const int Rb = Epi::PERM ? ((R & ~31) + perm32(R & 31)) : R;
        voffA[i] = (unsigned)(R * K + C) * 2u; voffB[i] = (unsigned)(Rb * K + C) * 2u; }
    const size_t kstep = (size_t)(BK * 2);
    const size_t hstep = (size_t)HALF * K * 2;
    const size_t tstep = 2 * hstep;
    const unsigned ldsw = (unsigned)wid * 1024u;
    const int aoff = lds_byte(wr * 64 + fr, fq * 8), boff = lds_byte(wc * 32 + fr, fq * 8);
#define PG8_SA(b, h) (((b) * 2 + (h)) * HTB)
#define PG8_SB(b, h) ((4 + (b) * 2 + (h)) * HTB)
#define PG8_STAGE(bufoff, gbase, voff) do { _Pragma("unroll") for (int _i = 0; _i < 2; ++_i) \
        __builtin_amdgcn_global_load_lds((const unsigned*)((const char*)(gbase) + (voff)[_i]), (PG8_LAS unsigned*)(lds + (bufoff) + ldsw + _i * 8192), 16, 0, 0); } while (0)
#define PG8_LDA(dst, b, h) do { _Pragma("unroll") for (int m = 0; m < 4; ++m) _Pragma("unroll") for (int k = 0; k < 2; ++k) dst[m][k] = *(const PG8_LAS bf16x8*)(lds + PG8_SA(b, h) + aoff + m * 2048 + k * 1024); } while (0)
#define PG8_LDB(dst, b, h) do { _Pragma("unroll") for (int n = 0; n < 2; ++n) _Pragma("unroll") for (int k = 0; k < 2; ++k) dst[n][k] = *(const PG8_LAS bf16x8*)(lds + PG8_SB(b, h) + boff + n * 2048 + k * 1024); } while (0)
#define PG8_MMA(ai, bj, At, Bt) do { __builtin_amdgcn_s_setprio(1); _Pragma("unroll") for (int m = 0; m < 4; ++m) _Pragma("unroll") for (int n = 0; n < 2; ++n) _Pragma("unroll") for (int k = 0; k < 2; ++k) \
        acc[ai][bj][m][n] = __builtin_amdgcn_mfma_f32_16x16x32_bf16(Bt[n][k], At[m][k], acc[ai][bj][m][n], 0, 0, 0); __builtin_amdgcn_s_setprio(0); } while (0)
#define PG8_WAIT_V(n) asm volatile("s_waitcnt vmcnt(" #n ")" ::: "memory")
#define PG8_WAIT_L(n) asm volatile("s_waitcnt lgkmcnt(" #n ")" ::: "memory")
#define PG8_BAR __builtin_amdgcn_s_barrier()
#define PG8_SCHED __builtin_amdgcn_sched_barrier(0)
    Unit cur, nxt; int ui = 0;
    if (!S.next(0, cur)) return;
    f32x4 acc[2][2][4][2];
#pragma unroll
    for (int a = 0; a < 2; ++a)
#pragma unroll
        for (int b = 0; b < 2; ++b)
#pragma unroll
            for (int m = 0; m < 4; ++m)
#pragma unroll
                for (int n = 0; n < 2; ++n) acc[a][b][m][n] = (f32x4){0.f, 0.f, 0.f, 0.f};
    bf16x8 At[4][2], B0[2][2], B1[2][2];
    const char* cA = (const char*)g.A + (size_t)cur.pm * tstep + (size_t)cur.pn * g.a_pn; const char* cB = (const char*)g.Bt + (size_t)cur.pn * tstep + (size_t)cur.pm * g.b_pm;
    S.a_ready(cur);
    if constexpr (SP2) {
        PG8_STAGE(PG8_SB(0, 0), cB, voffB); PG8_STAGE(PG8_SB(0, 1), cB + hstep, voffB); PG8_STAGE(PG8_SA(0, 0), cA, voffA); PG8_STAGE(PG8_SA(0, 1), cA + hstep, voffA);
        if (wr == 1) PG8_BAR;
        PG8_WAIT_V(2); PG8_BAR;
        PG8_STAGE(PG8_SB(1, 0), cB + kstep, voffB); PG8_STAGE(PG8_SA(1, 0), cA + kstep, voffA); PG8_STAGE(PG8_SB(1, 1), cB + hstep + kstep, voffB);
        PG8_WAIT_V(6); PG8_BAR;
    } else {
        PG8_STAGE(PG8_SB(0, 0), cB, voffB); PG8_STAGE(PG8_SA(0, 0), cA, voffA); PG8_STAGE(PG8_SB(0, 1), cB + hstep, voffB); PG8_STAGE(PG8_SA(0, 1), cA + hstep, voffA);
        if (wr == 1) PG8_BAR;
        PG8_WAIT_V(4); PG8_BAR;
        PG8_STAGE(PG8_SB(1, 0), cB + kstep, voffB); PG8_STAGE(PG8_SA(1, 0), cA + kstep, voffA); PG8_STAGE(PG8_SB(1, 1), cB + hstep + kstep, voffB);
        PG8_WAIT_V(6); PG8_BAR;
    }
    for (;;) {
        const bool has_next = S.next(ui + 1, nxt);
        const char* nA = has_next ? (const char*)g.A + (size_t)nxt.pm * tstep + (size_t)nxt.pn * g.a_pn : cA; const char* nB = has_next ? (const char*)g.Bt + (size_t)nxt.pn * tstep + (size_t)nxt.pm * g.b_pm : cB;
        for (int t = 0; t < nt; t += 2) {
            const bool last = (t == nt - 2);
            const char* a1 = cA + (size_t)(t + 1) * kstep;
            const char* a2 = last ? nA : cA + (size_t)(t + 2) * kstep; const char* b2 = last ? nB : cB + (size_t)(t + 2) * kstep;
            const char* a3 = a2 + kstep; const char* b3 = b2 + kstep;
            if (last && has_next) S.a_ready(nxt);
            if constexpr (SP2) {
            PG8_LDB(B0, 0, 0); PG8_LDB(B1, 0, 1); PG8_SCHED; PG8_LDA(At, 0, 0); PG8_STAGE(PG8_SA(1, 1), a1 + hstep, voffA);
            PG8_WAIT_V(8); PG8_WAIT_L(0); PG8_BAR; PG8_MMA(0, 0, At, B0); PG8_MMA(0, 1, At, B1); PG8_BAR; PG8_SCHED;
            PG8_LDA(At, 0, 1); PG8_STAGE(PG8_SB(0, 0), b2, voffB); PG8_STAGE(PG8_SB(0, 1), b2 + hstep, voffB); PG8_STAGE(PG8_SA(0, 0), a2, voffA);
            PG8_WAIT_V(8); PG8_WAIT_L(0); PG8_BAR; PG8_MMA(1, 0, At, B0); PG8_MMA(1, 1, At, B1); PG8_BAR; PG8_SCHED;
            PG8_LDB(B0, 1, 0); PG8_LDB(B1, 1, 1); PG8_SCHED; PG8_LDA(At, 1, 0); PG8_STAGE(PG8_SA(0, 1), a2 + hstep, voffA);
            PG8_WAIT_V(8); PG8_WAIT_L(0); PG8_BAR; PG8_MMA(0, 0, At, B0); PG8_MMA(0, 1, At, B1); PG8_BAR; PG8_SCHED;
            PG8_LDA(At, 1, 1); PG8_STAGE(PG8_SB(1, 0), b3, voffB); PG8_STAGE(PG8_SB(1, 1), b3 + hstep, voffB); PG8_STAGE(PG8_SA(1, 0), a3, voffA);
            PG8_WAIT_V(8); PG8_WAIT_L(0); PG8_BAR; PG8_MMA(1, 0, At, B0); PG8_MMA(1, 1, At, B1); PG8_BAR; PG8_SCHED;
            } else {
            PG8_LDB(B0, 0, 0); PG8_SCHED; PG8_LDA(At, 0, 0); PG8_STAGE(PG8_SA(1, 1), a1 + hstep, voffA);
            PG8_WAIT_L(8); PG8_BAR; PG8_WAIT_L(0); PG8_MMA(0, 0, At, B0); PG8_BAR; PG8_SCHED;
            PG8_LDB(B1, 0, 1); PG8_STAGE(PG8_SB(0, 0), b2, voffB);
            PG8_BAR; PG8_WAIT_L(0); PG8_MMA(0, 1, At, B1); PG8_BAR;
            PG8_LDA(At, 0, 1); PG8_STAGE(PG8_SA(0, 0), a2, voffA);
            PG8_BAR; PG8_WAIT_L(0); PG8_MMA(1, 0, At, B0); PG8_BAR; PG8_SCHED;
            PG8_STAGE(PG8_SB(0, 1), b2 + hstep, voffB);
            PG8_WAIT_V(6); PG8_BAR; PG8_MMA(1, 1, At, B1); PG8_BAR;
            PG8_LDB(B0, 1, 0); PG8_SCHED; PG8_LDA(At, 1, 0); PG8_STAGE(PG8_SA(0, 1), a2 + hstep, voffA);
            PG8_WAIT_L(8); PG8_BAR; PG8_WAIT_L(0); PG8_MMA(0, 0, At, B0); PG8_BAR; PG8_SCHED;
            PG8_LDB(B1, 1, 1); PG8_STAGE(PG8_SB(1, 0), b3, voffB);
            PG8_BAR; PG8_WAIT_L(0); PG8_MMA(0, 1, At, B1); PG8_BAR;
            PG8_LDA(At, 1, 1); PG8_STAGE(PG8_SA(1, 0), a3, voffA);
            PG8_BAR; PG8_WAIT_L(0); PG8_MMA(1, 0, At, B0); PG8_BAR; PG8_SCHED;
            PG8_STAGE(PG8_SB(1, 1), b3 + hstep, voffB);
            PG8_WAIT_V(6); PG8_BAR; PG8_MMA(1, 1, At, B1); PG8_BAR;
            }
        }
        if constexpr (ALIGN_EPI) { if (wr == 0) PG8_BAR; }
        if constexpr (!Epi::AFTER_DRAIN) { E(acc, cur, wr, wc, fr, fq); S.done(cur); }
        if (!has_next) break;
#pragma unroll
        for (int a = 0; a < 2; ++a)
#pragma unroll
            for (int b = 0; b < 2; ++b)
#pragma unroll
                for (int m = 0; m < 4; ++m)
#pragma unroll
                    for (int n = 0; n < 2; ++n) acc[a][b][m][n] = (f32x4){0.f, 0.f, 0.f, 0.f};
        cur = nxt; cA = nA; cB = nB; ++ui;
        if constexpr (ALIGN_EPI) { if (wr == 1) PG8_BAR; }
    }
    PG8_WAIT_V(0);
    if constexpr (!ALIGN_EPI) { if (wr == 0) PG8_BAR; }
    PG8_BAR;
    if constexpr (Epi::AFTER_DRAIN) { E.fused(acc, cur, wr, wc, fr, fq, lds, wid, lane); S.done(cur); }
#undef PG8_SA
#undef PG8_SB
#undef PG8_STAGE
#undef PG8_LDA
#undef PG8_LDB
#undef PG8_MMA
#undef PG8_WAIT_V
#undef PG8_WAIT_L
#undef PG8_BAR
#undef PG8_SCHED
}
}

namespace att {
using bf16x8 = __attribute__((ext_vector_type(8))) short;
using s16x4  = __attribute__((ext_vector_type(4))) short;
using f32x16 = __attribute__((ext_vector_type(16))) float;
using u32x4  = __attribute__((ext_vector_type(4))) unsigned;
typedef unsigned short bf16;
constexpr int NW = 8, QBLK = 32, KVBLK = 64;
#ifndef ATT_SDEPTH
#define ATT_SDEPTH 1
#endif
constexpr int SDEPTH = ATT_SDEPTH;
#ifndef QKT_GRP
#define QKT_GRP 4
#endif
constexpr int LDQ = 3072, LDKV = 2048, LDKR = 64, LDO = 4096;
constexpr int SHM_V = 16384, SHM_KN = 16384, SHM_KR = 8192;
constexpr int NSLOT = 3, OFF_V = 0, OFF_KN = NSLOT * SHM_V, OFF_KR = OFF_KN + NSLOT * SHM_KN, OFF_WS = OFF_KR + NSLOT * SHM_KR, SHM_ATTN = OFF_WS + NW * 64 * 4;
#define ALDS __attribute__((address_space(3)))
constexpr float THRL = 8.f * 1.4426950408889634f;
#define KSWZ(row, colB) ((row) * 256 + ((colB) ^ (((row) & 15) << 4)))
#define RSWZ(row, colB) ((row) * 128 + ((colB) ^ ((((row) >> 1) & 7) << 4)))
#define SBAR() __builtin_amdgcn_sched_barrier(0)
__device__ __forceinline__ int crow(int r, int hi) { return (r & 3) + 8 * (r >> 2) + 4 * hi; }
__device__ __forceinline__ unsigned cvtpk(float lo, float hi) { unsigned r; asm volatile("v_cvt_pk_bf16_f32 %0, %1, %2" : "=v"(r) : "v"(lo), "v"(hi)); return r; }

__device__ __forceinline__ void partialSM(f32x16& p0, f32x16& p1, float& m_reg, float& mn, float& alpha) {
  float pmax = p0[0];
#pragma unroll
  for (int r = 1; r < 16; ++r) pmax = fmaxf(pmax, p0[r]);
#pragma unroll
  for (int r = 0; r < 16; ++r) pmax = fmaxf(pmax, p1[r]);
  { auto rr = __builtin_amdgcn_permlane32_swap(__float_as_uint(pmax), __float_as_uint(pmax), false, false);
    pmax = fmaxf(__uint_as_float(rr[0]), __uint_as_float(rr[1])); }
  if (__builtin_expect(__all(pmax - m_reg <= THRL), 1)) { mn = m_reg; alpha = 1.f; }
  else { mn = fmaxf(m_reg, pmax); alpha = __builtin_amdgcn_exp2f(m_reg - mn); m_reg = mn; }
#pragma unroll
  for (int r = 0; r < 16; ++r) p0[r] = p0[r] - mn;
#pragma unroll
  for (int r = 0; r < 16; ++r) p1[r] = p1[r] - mn;
#pragma unroll
  for (int r = 0; r < 16; ++r) p0[r] = __builtin_amdgcn_exp2f(p0[r]);
}
__device__ __forceinline__ void finishSM(f32x16& p0, f32x16& p1, float alpha, float& l_reg, bf16x8& pa0, bf16x8& pa1, bf16x8& pa2, bf16x8& pa3) {
#pragma unroll
  for (int r = 0; r < 16; ++r) p1[r] = __builtin_amdgcn_exp2f(p1[r]);
  float ps = 0;
#pragma unroll
  for (int r = 0; r < 16; ++r) ps += p0[r];
#pragma unroll
  for (int r = 0; r < 16; ++r) ps += p1[r];
  { auto rr = __builtin_amdgcn_permlane32_swap(__float_as_uint(ps), __float_as_uint(ps), false, false);
    ps = __uint_as_float(rr[0]) + __uint_as_float(rr[1]); }
  l_reg = l_reg * alpha + ps;
#define PK4(P, BASE, OUT) do { unsigned a0 = cvtpk(P[BASE + 0], P[BASE + 1]), a1 = cvtpk(P[BASE + 2], P[BASE + 3]);   \
    unsigned b0 = cvtpk(P[BASE + 4], P[BASE + 5]), b1 = cvtpk(P[BASE + 6], P[BASE + 7]);                              \
    auto r0 = __builtin_amdgcn_permlane32_swap(a0, b0, false, false); auto r1 = __builtin_amdgcn_permlane32_swap(a1, b1, false, false); \
    u32x4 w = {r0[0], r1[0], r0[1], r1[1]}; OUT = *reinterpret_cast<bf16x8*>(&w); } while (0)
  PK4(p0, 0, pa0); PK4(p0, 8, pa1); PK4(p1, 0, pa2); PK4(p1, 8, pa3);
#undef PK4
}
#ifndef QKT_PF
#define QKT_PF 0
#endif
#if QKT_PF == 0
__device__ __forceinline__ void qkt(f32x16& p0, f32x16& p1, const char* Kn, const char* Kr, const bf16x8* qr, const char* Qr, int r32, int hi) {
  p0 = f32x16{}; p1 = f32x16{};
#pragma unroll
  for (int d0 = 0; d0 < 8; ++d0) { const int cb = (d0 * 16 + hi * 8) * 2;
    bf16x8 b0 = *reinterpret_cast<const bf16x8*>(Kn + KSWZ(r32, cb));
    bf16x8 b1 = *reinterpret_cast<const bf16x8*>(Kn + KSWZ(32 + r32, cb));
    p0 = __builtin_amdgcn_mfma_f32_32x32x16_bf16(b0, qr[d0], p0, 0, 0, 0);
    p1 = __builtin_amdgcn_mfma_f32_32x32x16_bf16(b1, qr[d0], p1, 0, 0, 0);
    if ((d0 & (QKT_GRP - 1)) == QKT_GRP - 1) SBAR(); }
#pragma unroll
  for (int d0 = 0; d0 < 4; ++d0) { const int cb = (d0 * 16 + hi * 8) * 2;
    bf16x8 b0 = *reinterpret_cast<const bf16x8*>(Kr + RSWZ(r32, cb));
    bf16x8 b1 = *reinterpret_cast<const bf16x8*>(Kr + RSWZ(32 + r32, cb));
    const bf16x8 qf = qr[8 + d0];
    p0 = __builtin_amdgcn_mfma_f32_32x32x16_bf16(b0, qf, p0, 0, 0, 0);
    p1 = __builtin_amdgcn_mfma_f32_32x32x16_bf16(b1, qf, p1, 0, 0, 0);
    if ((d0 & (QKT_GRP - 1)) == QKT_GRP - 1) SBAR(); }
}
#else
__device__ __forceinline__ void qkt(f32x16& p0, f32x16& p1, const char* Kn, const char* Kr, const bf16x8* qr, const char* Qr, int r32, int hi) {
  p0 = f32x16{}; p1 = f32x16{};
  constexpr int NB = QKT_PF + 1;
  bf16x8 kb0[NB], kb1[NB], qf[NB];
#define KLD(S) do { constexpr int s_ = (S), i_ = s_ % NB; if constexpr (s_ < 8) { const int cb = (s_ * 16 + hi * 8) * 2; kb0[i_] = *reinterpret_cast<const bf16x8*>(Kn + KSWZ(r32, cb)); kb1[i_] = *reinterpret_cast<const bf16x8*>(Kn + KSWZ(32 + r32, cb)); } \
    else { const int cb = ((s_ - 8) * 16 + hi * 8) * 2; kb0[i_] = *reinterpret_cast<const bf16x8*>(Kr + RSWZ(r32, cb)); kb1[i_] = *reinterpret_cast<const bf16x8*>(Kr + RSWZ(32 + r32, cb)); qf[i_] = *reinterpret_cast<const bf16x8*>(Qr + (s_ - 8) * 1024); } } while (0)
#define KSTEP(S) do { constexpr int s_ = (S), i_ = s_ % NB; if constexpr (s_ + QKT_PF < 12) KLD(S + QKT_PF); const bf16x8 q_ = s_ < 8 ? qr[s_ < 8 ? s_ : 0] : qf[i_]; \
    p0 = __builtin_amdgcn_mfma_f32_32x32x16_bf16(kb0[i_], q_, p0, 0, 0, 0); p1 = __builtin_amdgcn_mfma_f32_32x32x16_bf16(kb1[i_], q_, p1, 0, 0, 0); } while (0)
  KLD(0); if constexpr (QKT_PF >= 2) KLD(1);
  KSTEP(0); KSTEP(1); KSTEP(2); KSTEP(3); KSTEP(4); KSTEP(5); KSTEP(6); KSTEP(7); KSTEP(8); KSTEP(9); KSTEP(10); KSTEP(11);
#undef KLD
#undef KSTEP
}
#endif
__device__ __forceinline__ int v_st(int k, int c) { const int kk = (k & ~0xC) | ((k & 4) << 1) | ((k & 8) >> 1); return ((kk >> 3) * 4 + (c >> 5)) * 512 + ((kk & 7) * 32 + (c & 31)) * 2; }
__device__ __forceinline__ int v_rd_base(int lane) { return ((lane & 3) << 3) | (((lane >> 2) & 3) << 6) | (((lane >> 4) & 1) << 5) | (((lane >> 5) & 1) << 8); }
constexpr int v_rd_off(int d0, int ks, int half) { return d0 * 512 + ks * 4096 + half * 2048; }
template <int OFF> __device__ __forceinline__ s16x4 tr_read(int vb) {
  s16x4 r; asm volatile("ds_read_b64_tr_b16 %0, %1 offset:%2" : "=&v"(r) : "v"(vb), "i"(OFF) : "memory"); return r;
}
template <int D0> __device__ __forceinline__ void pv_one(f32x16& od, int vb, bf16x8 pa0, bf16x8 pa1, bf16x8 pa2, bf16x8 pa3) {
  const s16x4 l0 = tr_read<v_rd_off(D0, 0, 0)>(vb), h0 = tr_read<v_rd_off(D0, 0, 1)>(vb), l1 = tr_read<v_rd_off(D0, 1, 0)>(vb), h1 = tr_read<v_rd_off(D0, 1, 1)>(vb);
  const s16x4 l2 = tr_read<v_rd_off(D0, 2, 0)>(vb), h2 = tr_read<v_rd_off(D0, 2, 1)>(vb), l3 = tr_read<v_rd_off(D0, 3, 0)>(vb), h3 = tr_read<v_rd_off(D0, 3, 1)>(vb);
  asm volatile("s_waitcnt lgkmcnt(0)" ::: "memory"); SBAR();
#define PK(L, H) (bf16x8){L[0], L[1], L[2], L[3], H[0], H[1], H[2], H[3]}
  od = __builtin_amdgcn_mfma_f32_32x32x16_bf16(pa0, PK(l0, h0), od, 0, 0, 0);
  od = __builtin_amdgcn_mfma_f32_32x32x16_bf16(pa1, PK(l1, h1), od, 0, 0, 0);
  od = __builtin_amdgcn_mfma_f32_32x32x16_bf16(pa2, PK(l2, h2), od, 0, 0, 0);
  od = __builtin_amdgcn_mfma_f32_32x32x16_bf16(pa3, PK(l3, h3), od, 0, 0, 0);
#undef PK
}
__device__ __forceinline__ void pv_d0(f32x16* o, int vb, bf16x8 pa0, bf16x8 pa1, bf16x8 pa2, bf16x8 pa3) {
  pv_one<0>(o[0], vb, pa0, pa1, pa2, pa3); pv_one<1>(o[1], vb, pa0, pa1, pa2, pa3); pv_one<2>(o[2], vb, pa0, pa1, pa2, pa3); pv_one<3>(o[3], vb, pa0, pa1, pa2, pa3);
}

typedef short v4i16_t __attribute__((ext_vector_type(4)));
#define PKF(L_, H_) (bf16x8){L_[0], L_[1], L_[2], L_[3], H_[0], H_[1], H_[2], H_[3]}
#define LDSR128(dst, base, OFF) asm volatile("ds_read_b128 %0, %1 offset:%2" : "=v"(dst) : "v"((unsigned)(uintptr_t)(base)), "i"(OFF) : "memory")
#define LDSRTR(dst, base, OFF) asm volatile("ds_read_b64_tr_b16 %0, %1 offset:%2" : "=v"(dst) : "v"((unsigned)(uintptr_t)(base)), "i"(OFF) : "memory")
#define WAITK(N, A, B) asm volatile("s_waitcnt lgkmcnt(" #N ")" : "+v"(A), "+v"(B) :: "memory")
#define WAITV(N, VL_, VH_) asm volatile("s_waitcnt lgkmcnt(" #N ")" : "+v"(VL_[0]), "+v"(VL_[1]), "+v"(VL_[2]), "+v"(VL_[3]), "+v"(VH_[0]), "+v"(VH_[1]), "+v"(VH_[2]), "+v"(VH_[3]) :: "memory")
template <bool DO_QK, bool DO_PV, class IssueF>
__device__ __forceinline__ void mat_segment(const IssueF& issue, f32x16& p0, f32x16& p1, f32x16* o, const ALDS char* Kn, const ALDS char* Kr, const ALDS char* Vb, const bf16x8* qr, bf16x8 pa0, bf16x8 pa1, bf16x8 pa2, bf16x8 pa3, int r32, int hi, const int probe) {
  bf16x8 kf[4][2]; s16x4 vl[2][4], vh[2][4];
  const int kbase = r32 * 256, ksw = (r32 & 15) << 4, rbase = r32 * 128, rsw = ((r32 >> 1) & 7) << 4, hb = hi * 16;
  asm volatile("s_waitcnt lgkmcnt(0)" ::: "memory");
  if constexpr (DO_QK && DO_PV) {
  p0 = f32x16{}; p1 = f32x16{};
  { const int a_ = kbase + (((0 * 32) + hb) ^ ksw); LDSR128(kf[0][0], Kn + a_, 0); LDSR128(kf[0][1], Kn + a_, 8192); }
  { const int a_ = kbase + (((1 * 32) + hb) ^ ksw); LDSR128(kf[1][0], Kn + a_, 0); LDSR128(kf[1][1], Kn + a_, 8192); }
  { const int a_ = kbase + (((2 * 32) + hb) ^ ksw); LDSR128(kf[2][0], Kn + a_, 0); LDSR128(kf[2][1], Kn + a_, 8192); }
  { const int a_ = kbase + (((3 * 32) + hb) ^ ksw); LDSR128(kf[3][0], Kn + a_, 0); LDSR128(kf[3][1], Kn + a_, 8192); }
  WAITK(6, kf[0][0], kf[0][1]);
  p0 = __builtin_amdgcn_mfma_f32_32x32x16_bf16(kf[0][0], qr[0], p0, 0, 0, 0); p1 = __builtin_amdgcn_mfma_f32_32x32x16_bf16(kf[0][1], qr[0], p1, 0, 0, 0);
  issue(0);
  { const int a_ = kbase + (((4 * 32) + hb) ^ ksw); LDSR128(kf[0][0], Kn + a_, 0); LDSR128(kf[0][1], Kn + a_, 8192); }
  WAITK(6, kf[1][0], kf[1][1]);
  p0 = __builtin_amdgcn_mfma_f32_32x32x16_bf16(kf[1][0], qr[1], p0, 0, 0, 0); p1 = __builtin_amdgcn_mfma_f32_32x32x16_bf16(kf[1][1], qr[1], p1, 0, 0, 0);
  issue(1);
  { const int a_ = kbase + (((5 * 32) + hb) ^ ksw); LDSR128(kf[1][0], Kn + a_, 0); LDSR128(kf[1][1], Kn + a_, 8192); }
  WAITK(6, kf[2][0], kf[2][1]);
  p0 = __builtin_amdgcn_mfma_f32_32x32x16_bf16(kf[2][0], qr[2], p0, 0, 0, 0); p1 = __builtin_amdgcn_mfma_f32_32x32x16_bf16(kf[2][1], qr[2], p1, 0, 0, 0);
  issue(2);
  { const int a_ = kbase + (((6 * 32) + hb) ^ ksw); LDSR128(kf[2][0], Kn + a_, 0); LDSR128(kf[2][1], Kn + a_, 8192); }
  WAITK(6, kf[3][0], kf[3][1]);
  p0 = __builtin_amdgcn_mfma_f32_32x32x16_bf16(kf[3][0], qr[3], p0, 0, 0, 0); p1 = __builtin_amdgcn_mfma_f32_32x32x16_bf16(kf[3][1], qr[3], p1, 0, 0, 0);
  issue(3);
  { const int a_ = kbase + (((7 * 32) + hb) ^ ksw); LDSR128(kf[3][0], Kn + a_, 0); LDSR128(kf[3][1], Kn + a_, 8192); }
  WAITK(6, kf[0][0], kf[0][1]);
  p0 = __builtin_amdgcn_mfma_f32_32x32x16_bf16(kf[0][0], qr[4], p0, 0, 0, 0); p1 = __builtin_amdgcn_mfma_f32_32x32x16_bf16(kf[0][1], qr[4], p1, 0, 0, 0);
  issue(4);
  { const int a_ = rbase + (((0 * 32) + hb) ^ rsw); LDSR128(kf[0][0], Kr + a_, 0); LDSR128(kf[0][1], Kr + a_, 4096); }
  WAITK(6, kf[1][0], kf[1][1]);
  p0 = __builtin_amdgcn_mfma_f32_32x32x16_bf16(kf[1][0], qr[5], p0, 0, 0, 0); p1 = __builtin_amdgcn_mfma_f32_32x32x16_bf16(kf[1][1], qr[5], p1, 0, 0, 0);
  { const int a_ = rbase + (((1 * 32) + hb) ^ rsw); LDSR128(kf[1][0], Kr + a_, 0); LDSR128(kf[1][1], Kr + a_, 4096); }
  WAITK(6, kf[2][0], kf[2][1]);
  p0 = __builtin_amdgcn_mfma_f32_32x32x16_bf16(kf[2][0], qr[6], p0, 0, 0, 0); p1 = __builtin_amdgcn_mfma_f32_32x32x16_bf16(kf[2][1], qr[6], p1, 0, 0, 0);
  { const int a_ = rbase + (((2 * 32) + hb) ^ rsw); LDSR128(kf[2][0], Kr + a_, 0); LDSR128(kf[2][1], Kr + a_, 4096); }
  WAITK(6, kf[3][0], kf[3][1]);
  p0 = __builtin_amdgcn_mfma_f32_32x32x16_bf16(kf[3][0], qr[7], p0, 0, 0, 0); p1 = __builtin_amdgcn_mfma_f32_32x32x16_bf16(kf[3][1], qr[7], p1, 0, 0, 0);
  { const int a_ = rbase + (((3 * 32) + hb) ^ rsw); LDSR128(kf[3][0], Kr + a_, 0); LDSR128(kf[3][1], Kr + a_, 4096); }
  WAITK(6, kf[0][0], kf[0][1]);
  p0 = __builtin_amdgcn_mfma_f32_32x32x16_bf16(kf[0][0], qr[8], p0, 0, 0, 0); p1 = __builtin_amdgcn_mfma_f32_32x32x16_bf16(kf[0][1], qr[8], p1, 0, 0, 0);
  LDSRTR(vl[0][0], Vb, 0); LDSRTR(vh[0][0], Vb, 2048);
  LDSRTR(vl[0][1], Vb, 4096); LDSRTR(vh[0][1], Vb, 6144);
  LDSRTR(vl[0][2], Vb, 8192); LDSRTR(vh[0][2], Vb, 10240);
  LDSRTR(vl[0][3], Vb, 12288); LDSRTR(vh[0][3], Vb, 14336);
  WAITK(12, kf[1][0], kf[1][1]);
  p0 = __builtin_amdgcn_mfma_f32_32x32x16_bf16(kf[1][0], qr[9], p0, 0, 0, 0); p1 = __builtin_amdgcn_mfma_f32_32x32x16_bf16(kf[1][1], qr[9], p1, 0, 0, 0);
  WAITK(10, kf[2][0], kf[2][1]);
  p0 = __builtin_amdgcn_mfma_f32_32x32x16_bf16(kf[2][0], qr[10], p0, 0, 0, 0); p1 = __builtin_amdgcn_mfma_f32_32x32x16_bf16(kf[2][1], qr[10], p1, 0, 0, 0);
  LDSRTR(vl[1][0], Vb, 512); LDSRTR(vh[1][0], Vb, 2560);
  LDSRTR(vl[1][1], Vb, 4608); LDSRTR(vh[1][1], Vb, 6656);
  LDSRTR(vl[1][2], Vb, 8704); LDSRTR(vh[1][2], Vb, 10752);
  LDSRTR(vl[1][3], Vb, 12800); LDSRTR(vh[1][3], Vb, 14848);
  WAITK(15, kf[3][0], kf[3][1]);
  p0 = __builtin_amdgcn_mfma_f32_32x32x16_bf16(kf[3][0], qr[11], p0, 0, 0, 0); p1 = __builtin_amdgcn_mfma_f32_32x32x16_bf16(kf[3][1], qr[11], p1, 0, 0, 0);
  WAITV(8, vl[0], vh[0]);
  o[0] = __builtin_amdgcn_mfma_f32_32x32x16_bf16(pa0, PKF(vl[0][0], vh[0][0]), o[0], 0, 0, 0); o[0] = __builtin_amdgcn_mfma_f32_32x32x16_bf16(pa1, PKF(vl[0][1], vh[0][1]), o[0], 0, 0, 0);
  o[0] = __builtin_amdgcn_mfma_f32_32x32x16_bf16(pa2, PKF(vl[0][2], vh[0][2]), o[0], 0, 0, 0); o[0] = __builtin_amdgcn_mfma_f32_32x32x16_bf16(pa3, PKF(vl[0][3], vh[0][3]), o[0], 0, 0, 0);
  LDSRTR(vl[0][0], Vb, 1024); LDSRTR(vh[0][0], Vb, 3072);
  LDSRTR(vl[0][1], Vb, 5120); LDSRTR(vh[0][1], Vb, 7168);
  LDSRTR(vl[0][2], Vb, 9216); LDSRTR(vh[0][2], Vb, 11264);
  LDSRTR(vl[0][3], Vb, 13312); LDSRTR(vh[0][3], Vb, 15360);
  WAITV(8, vl[1], vh[1]);
  o[1] = __builtin_amdgcn_mfma_f32_32x32x16_bf16(pa0, PKF(vl[1][0], vh[1][0]), o[1], 0, 0, 0); o[1] = __builtin_amdgcn_mfma_f32_32x32x16_bf16(pa1, PKF(vl[1][1], vh[1][1]), o[1], 0, 0, 0);
  o[1] = __builtin_amdgcn_mfma_f32_32x32x16_bf16(pa2, PKF(vl[1][2], vh[1][2]), o[1], 0, 0, 0); o[1] = __builtin_amdgcn_mfma_f32_32x32x16_bf16(pa3, PKF(vl[1][3], vh[1][3]), o[1], 0, 0, 0);
  LDSRTR(vl[1][0], Vb, 1536); LDSRTR(vh[1][0], Vb, 3584);
  LDSRTR(vl[1][1], Vb, 5632); LDSRTR(vh[1][1], Vb, 7680);
  LDSRTR(vl[1][2], Vb, 9728); LDSRTR(vh[1][2], Vb, 11776);
  LDSRTR(vl[1][3], Vb, 13824); LDSRTR(vh[1][3], Vb, 15872);
  WAITV(8, vl[0], vh[0]);
  o[2] = __builtin_amdgcn_mfma_f32_32x32x16_bf16(pa0, PKF(vl[0][0], vh[0][0]), o[2], 0, 0, 0); o[2] = __builtin_amdgcn_mfma_f32_32x32x16_bf16(pa1, PKF(vl[0][1], vh[0][1]), o[2], 0, 0, 0);
  o[2] = __builtin_amdgcn_mfma_f32_32x32x16_bf16(pa2, PKF(vl[0][2], vh[0][2]), o[2], 0, 0, 0); o[2] = __builtin_amdgcn_mfma_f32_32x32x16_bf16(pa3, PKF(vl[0][3], vh[0][3]), o[2], 0, 0, 0);
  WAITV(0, vl[1], vh[1]);
  o[3] = __builtin_amdgcn_mfma_f32_32x32x16_bf16(pa0, PKF(vl[1][0], vh[1][0]), o[3], 0, 0, 0); o[3] = __builtin_amdgcn_mfma_f32_32x32x16_bf16(pa1, PKF(vl[1][1], vh[1][1]), o[3], 0, 0, 0);
  o[3] = __builtin_amdgcn_mfma_f32_32x32x16_bf16(pa2, PKF(vl[1][2], vh[1][2]), o[3], 0, 0, 0); o[3] = __builtin_amdgcn_mfma_f32_32x32x16_bf16(pa3, PKF(vl[1][3], vh[1][3]), o[3], 0, 0, 0);
  } else if constexpr (DO_QK) {
  p0 = f32x16{}; p1 = f32x16{};
  { const int a_ = kbase + (((0 * 32) + hb) ^ ksw); LDSR128(kf[0][0], Kn + a_, 0); LDSR128(kf[0][1], Kn + a_, 8192); }
  { const int a_ = kbase + (((1 * 32) + hb) ^ ksw); LDSR128(kf[1][0], Kn + a_, 0); LDSR128(kf[1][1], Kn + a_, 8192); }
  { const int a_ = kbase + (((2 * 32) + hb) ^ ksw); LDSR128(kf[2][0], Kn + a_, 0); LDSR128(kf[2][1], Kn + a_, 8192); }
  { const int a_ = kbase + (((3 * 32) + hb) ^ ksw); LDSR128(kf[3][0], Kn + a_, 0); LDSR128(kf[3][1], Kn + a_, 8192); }
  WAITK(6, kf[0][0], kf[0][1]);
  p0 = __builtin_amdgcn_mfma_f32_32x32x16_bf16(kf[0][0], qr[0], p0, 0, 0, 0); p1 = __builtin_amdgcn_mfma_f32_32x32x16_bf16(kf[0][1], qr[0], p1, 0, 0, 0);
  issue(0);
  { const int a_ = kbase + (((4 * 32) + hb) ^ ksw); LDSR128(kf[0][0], Kn + a_, 0); LDSR128(kf[0][1], Kn + a_, 8192); }
  WAITK(6, kf[1][0], kf[1][1]);
  p0 = __builtin_amdgcn_mfma_f32_32x32x16_bf16(kf[1][0], qr[1], p0, 0, 0, 0); p1 = __builtin_amdgcn_mfma_f32_32x32x16_bf16(kf[1][1], qr[1], p1, 0, 0, 0);
  issue(1);
  { const int a_ = kbase + (((5 * 32) + hb) ^ ksw); LDSR128(kf[1][0], Kn + a_, 0); LDSR128(kf[1][1], Kn + a_, 8192); }
  WAITK(6, kf[2][0], kf[2][1]);
  p0 = __builtin_amdgcn_mfma_f32_32x32x16_bf16(kf[2][0], qr[2], p0, 0, 0, 0); p1 = __builtin_amdgcn_mfma_f32_32x32x16_bf16(kf[2][1], qr[2], p1, 0, 0, 0);
  issue(2);
  { const int a_ = kbase + (((6 * 32) + hb) ^ ksw); LDSR128(kf[2][0], Kn + a_, 0); LDSR128(kf[2][1], Kn + a_, 8192); }
  WAITK(6, kf[3][0], kf[3][1]);
  p0 = __builtin_amdgcn_mfma_f32_32x32x16_bf16(kf[3][0], qr[3], p0, 0, 0, 0); p1 = __builtin_amdgcn_mfma_f32_32x32x16_bf16(kf[3][1], qr[3], p1, 0, 0, 0);
  issue(3);
  { const int a_ = kbase + (((7 * 32) + hb) ^ ksw); LDSR128(kf[3][0], Kn + a_, 0); LDSR128(kf[3][1], Kn + a_, 8192); }
  WAITK(6, kf[0][0], kf[0][1]);
  p0 = __builtin_amdgcn_mfma_f32_32x32x16_bf16(kf[0][0], qr[4], p0, 0, 0, 0); p1 = __builtin_amdgcn_mfma_f32_32x32x16_bf16(kf[0][1], qr[4], p1, 0, 0, 0);
  issue(4);
  { const int a_ = rbase + (((0 * 32) + hb) ^ rsw); LDSR128(kf[0][0], Kr + a_, 0); LDSR128(kf[0][1], Kr + a_, 4096); }
  WAITK(6, kf[1][0], kf[1][1]);
  p0 = __builtin_amdgcn_mfma_f32_32x32x16_bf16(kf[1][0], qr[5], p0, 0, 0, 0); p1 = __builtin_amdgcn_mfma_f32_32x32x16_bf16(kf[1][1], qr[5], p1, 0, 0, 0);
  { const int a_ = rbase + (((1 * 32) + hb) ^ rsw); LDSR128(kf[1][0], Kr + a_, 0); LDSR128(kf[1][1], Kr + a_, 4096); }
  WAITK(6, kf[2][0], kf[2][1]);
  p0 = __builtin_amdgcn_mfma_f32_32x32x16_bf16(kf[2][0], qr[6], p0, 0, 0, 0); p1 = __builtin_amdgcn_mfma_f32_32x32x16_bf16(kf[2][1], qr[6], p1, 0, 0, 0);
  { const int a_ = rbase + (((2 * 32) + hb) ^ rsw); LDSR128(kf[2][0], Kr + a_, 0); LDSR128(kf[2][1], Kr + a_, 4096); }
  WAITK(6, kf[3][0], kf[3][1]);
  p0 = __builtin_amdgcn_mfma_f32_32x32x16_bf16(kf[3][0], qr[7], p0, 0, 0, 0); p1 = __builtin_amdgcn_mfma_f32_32x32x16_bf16(kf[3][1], qr[7], p1, 0, 0, 0);
  { const int a_ = rbase + (((3 * 32) + hb) ^ rsw); LDSR128(kf[3][0], Kr + a_, 0); LDSR128(kf[3][1], Kr + a_, 4096); }
  WAITK(6, kf[0][0], kf[0][1]);
  p0 = __builtin_amdgcn_mfma_f32_32x32x16_bf16(kf[0][0], qr[8], p0, 0, 0, 0); p1 = __builtin_amdgcn_mfma_f32_32x32x16_bf16(kf[0][1], qr[8], p1, 0, 0, 0);
  WAITK(4, kf[1][0], kf[1][1]);
  p0 = __builtin_amdgcn_mfma_f32_32x32x16_bf16(kf[1][0], qr[9], p0, 0, 0, 0); p1 = __builtin_amdgcn_mfma_f32_32x32x16_bf16(kf[1][1], qr[9], p1, 0, 0, 0);
  WAITK(2, kf[2][0], kf[2][1]);
  p0 = __builtin_amdgcn_mfma_f32_32x32x16_bf16(kf[2][0], qr[10], p0, 0, 0, 0); p1 = __builtin_amdgcn_mfma_f32_32x32x16_bf16(kf[2][1], qr[10], p1, 0, 0, 0);
  WAITK(0, kf[3][0], kf[3][1]);
  p0 = __builtin_amdgcn_mfma_f32_32x32x16_bf16(kf[3][0], qr[11], p0, 0, 0, 0); p1 = __builtin_amdgcn_mfma_f32_32x32x16_bf16(kf[3][1], qr[11], p1, 0, 0, 0);
  } else {
  LDSRTR(vl[0][0], Vb, 0); LDSRTR(vh[0][0], Vb, 2048);
  LDSRTR(vl[0][1], Vb, 4096); LDSRTR(vh[0][1], Vb, 6144);
  LDSRTR(vl[0][2], Vb, 8192); LDSRTR(vh[0][2], Vb, 10240);
  LDSRTR(vl[0][3], Vb, 12288); LDSRTR(vh[0][3], Vb, 14336);
  LDSRTR(vl[1][0], Vb, 512); LDSRTR(vh[1][0], Vb, 2560);
  LDSRTR(vl[1][1], Vb, 4608); LDSRTR(vh[1][1], Vb, 6656);
  LDSRTR(vl[1][2], Vb, 8704); LDSRTR(vh[1][2], Vb, 10752);
  LDSRTR(vl[1][3], Vb, 12800); LDSRTR(vh[1][3], Vb, 14848);
  WAITV(8, vl[0], vh[0]);
  o[0] = __builtin_amdgcn_mfma_f32_32x32x16_bf16(pa0, PKF(vl[0][0], vh[0][0]), o[0], 0, 0, 0); o[0] = __builtin_amdgcn_mfma_f32_32x32x16_bf16(pa1, PKF(vl[0][1], vh[0][1]), o[0], 0, 0, 0);
  o[0] = __builtin_amdgcn_mfma_f32_32x32x16_bf16(pa2, PKF(vl[0][2], vh[0][2]), o[0], 0, 0, 0); o[0] = __builtin_amdgcn_mfma_f32_32x32x16_bf16(pa3, PKF(vl[0][3], vh[0][3]), o[0], 0, 0, 0);
  LDSRTR(vl[0][0], Vb, 1024); LDSRTR(vh[0][0], Vb, 3072);
  LDSRTR(vl[0][1], Vb, 5120); LDSRTR(vh[0][1], Vb, 7168);
  LDSRTR(vl[0][2], Vb, 9216); LDSRTR(vh[0][2], Vb, 11264);
  LDSRTR(vl[0][3], Vb, 13312); LDSRTR(vh[0][3], Vb, 15360);
  WAITV(8, vl[1], vh[1]);
  o[1] = __builtin_amdgcn_mfma_f32_32x32x16_bf16(pa0, PKF(vl[1][0], vh[1][0]), o[1], 0, 0, 0); o[1] = __builtin_amdgcn_mfma_f32_32x32x16_bf16(pa1, PKF(vl[1][1], vh[1][1]), o[1], 0, 0, 0);
  o[1] = __builtin_amdgcn_mfma_f32_32x32x16_bf16(pa2, PKF(vl[1][2], vh[1][2]), o[1], 0, 0, 0); o[1] = __builtin_amdgcn_mfma_f32_32x32x16_bf16(pa3, PKF(vl[1][3], vh[1][3]), o[1], 0, 0, 0);
  LDSRTR(vl[1][0], Vb, 1536); LDSRTR(vh[1][0], Vb, 3584);
  LDSRTR(vl[1][1], Vb, 5632); LDSRTR(vh[1][1], Vb, 7680);
  LDSRTR(vl[1][2], Vb, 9728); LDSRTR(vh[1][2], Vb, 11776);
  LDSRTR(vl[1][3], Vb, 13824); LDSRTR(vh[1][3], Vb, 15872);
  WAITV(8, vl[0], vh[0]);
  o[2] = __builtin_amdgcn_mfma_f32_32x32x16_bf16(pa0, PKF(vl[0][0], vh[0][0]), o[2], 0, 0, 0); o[2] = __builtin_amdgcn_mfma_f32_32x32x16_bf16(pa1, PKF(vl[0][1], vh[0][1]), o[2], 0, 0, 0);
  o[2] = __builtin_amdgcn_mfma_f32_32x32x16_bf16(pa2, PKF(vl[0][2], vh[0][2]), o[2], 0, 0, 0); o[2] = __builtin_amdgcn_mfma_f32_32x32x16_bf16(pa3, PKF(vl[0][3], vh[0][3]), o[2], 0, 0, 0);
  WAITV(0, vl[1], vh[1]);
  o[3] = __builtin_amdgcn_mfma_f32_32x32x16_bf16(pa0, PKF(vl[1][0], vh[1][0]), o[3], 0, 0, 0); o[3] = __builtin_amdgcn_mfma_f32_32x32x16_bf16(pa1, PKF(vl[1][1], vh[1][1]), o[3], 0, 0, 0);
  o[3] = __builtin_amdgcn_mfma_f32_32x32x16_bf16(pa2, PKF(vl[1][2], vh[1][2]), o[3], 0, 0, 0); o[3] = __builtin_amdgcn_mfma_f32_32x32x16_bf16(pa3, PKF(vl[1][3], vh[1][3]), o[3], 0, 0, 0);
  }
}

#define ATT_BAR() do { asm volatile("" ::: "memory"); __builtin_amdgcn_s_barrier(); asm volatile("" ::: "memory"); } while (0)
#define ATT_VM(N) asm volatile("s_waitcnt vmcnt(" #N ")" ::: "memory")
__device__ __forceinline__ void glds16(const bf16* g, ALDS unsigned char* l) { __builtin_amdgcn_global_load_lds((const unsigned*)g, (ALDS unsigned*)l, 16, 0, 0); }
__device__ __forceinline__ void attn_unit(const bf16* __restrict__ Qb, const bf16* __restrict__ Knh, const bf16* __restrict__ Vh, const bf16* __restrict__ Krb,
                                          bf16* __restrict__ Ob, int seq, char* lds, ALDS unsigned char* L, const int probe) {
  int tid_ = threadIdx.x; asm volatile("" : "+v"(tid_));
  const int tid = tid_, wid = __builtin_amdgcn_readfirstlane(tid >> 6), lane = tid & 63, r32 = lane & 31, hi = lane >> 5;
  const bool trail = wid >= 4;
  float* ws = (float*)(lds + OFF_WS) + wid * 64; float* li_l = ws; float* al_l = ws + 32;
  float m_reg = -1e30f, l_reg = 0; f32x16 o[4] = {}; bf16x8 qr[12];
  const bf16* Qw = Qb + (long)(wid * QBLK + r32) * LDQ + hi * 8;
#pragma unroll
  for (int d0 = 0; d0 < 12; ++d0) qr[d0] = *reinterpret_cast<const bf16x8*>(Qw + d0 * 16);
#define VOFF(i) ([&]() { const int st = 2 * (2 * wid + (i)) + (lane >> 5), kk = (st >> 2) * 8 + ((lane & 31) >> 2), k = (kk & ~0xC) | ((kk & 4) << 1) | ((kk & 8) >> 1), c = (st & 3) * 32 + (lane & 3) * 8; return k * LDKV + c; }())
#define KOFF(i) ([&]() { const int row = (2 * wid + (i)) * 4 + (lane >> 4), colB = ((lane & 15) * 16) ^ ((row & 15) << 4); return row * LDKV + (colB >> 1); }())
#define ROFF() ([&]() { const int row = wid * 8 + (lane >> 3), colB = ((lane & 7) * 16) ^ (((row >> 1) & 7) << 4); return row * LDKR + (colB >> 1); }())
  const ALDS char* KL = (const ALDS char*)L + OFF_KN; const ALDS char* RL = (const ALDS char*)L + OFF_KR; const ALDS char* VL = (const ALDS char*)L + OFF_V + v_rd_base(lane);
#define ISSUE_K(t, s) do { const long kb_ = (long)(t) * KVBLK; const int s_ = (s); \
    glds16(Knh + kb_ * LDKV + KOFF(0), L + OFF_KN + s_ * SHM_KN + (2 * wid) * 1024); glds16(Knh + kb_ * LDKV + KOFF(1), L + OFF_KN + s_ * SHM_KN + (2 * wid + 1) * 1024); \
    glds16(Krb + kb_ * LDKR + ROFF(), L + OFF_KR + s_ * SHM_KR + wid * 1024); } while (0)
#define ISSUE_V(t, s) do { const long kb_ = (long)(t) * KVBLK; const int s_ = (s); \
    glds16(Vh + kb_ * LDKV + VOFF(0), L + OFF_V + s_ * SHM_V + (2 * wid) * 1024); glds16(Vh + kb_ * LDKV + VOFF(1), L + OFF_V + s_ * SHM_V + (2 * wid + 1) * 1024); } while (0)
#define ISSUE_NEXT(j) do { if ((j) + 2 < NT) ISSUE_K((j) + 2, sp); if ((j) + 1 < NT) ISSUE_V((j) + 1, sn); } while (0)
#define ROT() do { const int t_ = sc; sc = sn; sn = sp; sp = t_; } while (0)
#define RESC(a) do { if (__any((a) < 1.f)) { if (hi == 0) al_l[r32] = (a); asm volatile("s_waitcnt lgkmcnt(0)" ::: "memory"); \
    _Pragma("unroll") for (int d = 0; d < 4; ++d) _Pragma("unroll") for (int r = 0; r < 16; ++r) o[d][r] *= al_l[crow(r, hi)]; } } while (0)
  f32x16 p0, p1; float mn, al; bf16x8 pa0 = {}, pa1 = {}, pa2 = {}, pa3 = {}; const int NT = seq / KVBLK;
  int sc = 0, sn = 1, sp = 2;
  ISSUE_K(0, 0); ISSUE_K(1, 1); ISSUE_V(0, 0);
  ATT_VM(5); ATT_BAR();
  int jj = 0;
  const auto issue = [&](int step) {
    const long kb2 = (long)(jj + 2) * KVBLK, kb1 = (long)(jj + 1) * KVBLK;
    if (jj + 2 < NT) { if (step == 0) glds16(Knh + kb2 * LDKV + KOFF(0), L + OFF_KN + sp * SHM_KN + (2 * wid) * 1024); if (step == 1) glds16(Knh + kb2 * LDKV + KOFF(1), L + OFF_KN + sp * SHM_KN + (2 * wid + 1) * 1024);
                       if (step == 2) glds16(Krb + kb2 * LDKR + ROFF(), L + OFF_KR + sp * SHM_KR + wid * 1024); }
    if (jj + 1 < NT) { if (step == 3) glds16(Vh + kb1 * LDKV + VOFF(0), L + OFF_V + sn * SHM_V + (2 * wid) * 1024); if (step == 4) glds16(Vh + kb1 * LDKV + VOFF(1), L + OFF_V + sn * SHM_V + (2 * wid + 1) * 1024); } };
  const auto noissue = [](int) {};
  mat_segment<true, false>(issue, p0, p1, o, KL, RL, VL, qr, pa0, pa1, pa2, pa3, r32, hi, probe);
  if (trail) { ATT_VM(5); ATT_BAR(); }
  partialSM(p0, p1, m_reg, mn, al); finishSM(p0, p1, al, l_reg, pa0, pa1, pa2, pa3);
  ROT();
  for (int j = 1; j < NT; ++j) {
    if (!trail) { if (j + 1 < NT) ATT_VM(5); else ATT_VM(0); ATT_BAR(); }
    jj = j;
    mat_segment<true, true>(issue, p0, p1, o, KL + sc * SHM_KN, RL + sc * SHM_KR, VL + sp * SHM_V, qr, pa0, pa1, pa2, pa3, r32, hi, probe);
    if (trail) { if (j + 2 < NT) ATT_VM(5); else ATT_VM(0); ATT_BAR(); }
    partialSM(p0, p1, m_reg, mn, al); RESC(al); finishSM(p0, p1, al, l_reg, pa0, pa1, pa2, pa3);
    ROT();
  }
  if (!trail) { ATT_VM(0); ATT_BAR(); }
  mat_segment<false, true>(noissue, p0, p1, o, KL, RL, VL + sp * SHM_V, qr, pa0, pa1, pa2, pa3, r32, hi, probe);
  if (hi == 0) li_l[r32] = l_reg; asm volatile("s_waitcnt lgkmcnt(0)" ::: "memory");
  float rli[16];
#pragma unroll
  for (int r = 0; r < 16; ++r) rli[r] = __builtin_amdgcn_rcpf(li_l[crow(r, hi)]);
  int lane_e = lane; asm volatile("" : "+v"(lane_e));
  bf16* Ow = Ob + (long)(wid * QBLK + 4 * (lane_e >> 5)) * LDO + (lane_e & 31);
#pragma unroll
  for (int r = 0; r < 16; ++r) { const int orow = (r & 3) + 8 * (r >> 2);
#pragma unroll
    for (int d0 = 0; d0 < 4; ++d0) { const float val = o[d0][r] * rli[r]; Ow[orow * LDO + d0 * 32] = (bf16)(cvtpk(val, val) & 0xffffu); } }
  ATT_VM(0);
  ATT_BAR();
#undef VOFF
#undef KOFF
#undef ROFF
#undef ISSUE_K
#undef ISSUE_V
#undef ISSUE_NEXT
#undef ROT
#undef RESC
}
#undef KSWZ
#undef RSWZ
}

constexpr int DM = 4096, SEQ = 8192, CTXL = 256, MR = SEQ + CTXL;
constexpr int NH = 16, QL = 768, KVL = 512, NIN = 7680, NMODC = 6 * DM;
constexpr int NEXP = 16384;
constexpr float EPS = 1e-6f;
constexpr float C2 = 0.072168783648703220f * 1.4426950408889634f;

#ifndef MK_ONE_LAUNCH
#define MK_ONE_LAUNCH 1
#endif
constexpr int NPHASE = 10;
constexpr int NWAVES = 8, NTHR = NWAVES * 64;

constexpr size_t MiB = 1u << 20;
constexpr size_t a256(size_t x) { return (x + 255) & ~(size_t)255; }
constexpr size_t WS_CTL = 0, CTL_ZERO_BYTES = 1 * MiB;
constexpr int CW_BAR = 4096;
constexpr int CW_END = CW_BAR + 3456;
static_assert((size_t)CW_END * 4 <= CTL_ZERO_BYTES, "CTL words inside the memset region");
constexpr size_t WS_MODF = 1 * MiB;
constexpr size_t WS_ROPE = WS_MODF + a256((size_t)(NMODC + 2 * DM) * 4);
constexpr size_t WS_WIN  = 2 * MiB;
constexpr size_t WS_WUQ  = WS_WIN + (size_t)NIN * DM * 2;
constexpr size_t WS_WUKV = WS_WUQ + (size_t)3072 * 768 * 2;
constexpr size_t WS_WO   = WS_WUKV + (size_t)4096 * 512 * 2;
constexpr size_t WS_WPQ  = WS_WO + (size_t)DM * DM * 2;
constexpr size_t WS_KBD  = WS_WPQ + (size_t)2048 * DM * 2;
constexpr int ROWB = 3072;
constexpr size_t WS_KB2  = WS_KBD + (size_t)2048 * DM * 2;
constexpr size_t WS_UB   = WS_KB2 + (size_t)8 * 256 * 256 * 2;
constexpr size_t WS_VB   = WS_UB + (size_t)NEXP * ROWB;
constexpr size_t WS_SU   = WS_VB + (size_t)NEXP * ROWB;
constexpr size_t WS_HX   = WS_SU + (size_t)2 * NEXP * 4;
constexpr size_t WS_CQ   = WS_HX + (size_t)MR * DM * 2;
constexpr size_t WS_CKV  = WS_CQ + (size_t)SEQ * QL * 2;
constexpr size_t WS_KR   = WS_CKV + (size_t)MR * KVL * 2;
constexpr size_t WS_U    = WS_KR + (size_t)MR * 64 * 2;
constexpr size_t WS_GB   = WS_U + (size_t)SEQ * 2048 * 2;
constexpr size_t WS_Q    = WS_GB + (size_t)SEQ * 2048 * 2;
constexpr size_t WS_KN   = WS_Q + (size_t)SEQ * 3072 * 2;
constexpr size_t WS_V    = WS_KN + (size_t)MR * 2048 * 2;
constexpr size_t WS_ACAT = WS_V + (size_t)MR * 2048 * 2;
constexpr size_t WS_X1   = WS_ACAT + (size_t)SEQ * DM * 2;
constexpr size_t WS_H2   = WS_X1 + (size_t)SEQ * DM * 4;
constexpr size_t WS_QP   = WS_H2 + (size_t)SEQ * DM * 2;
constexpr size_t WS_SC   = WS_QP + (size_t)SEQ * 2048 * 2;
constexpr size_t WS_MODP = WS_SC + (size_t)SEQ * 2048 * 4;
constexpr size_t WS_SQ1  = WS_MODP + (size_t)64 * 32768 * 4;
constexpr size_t WS_SQ2  = WS_SQ1 + (size_t)SEQ * 12 * 4;
constexpr size_t WS_SQ3  = WS_SQ2 + (size_t)MR * 8 * 4;
constexpr size_t WS_END  = WS_SQ3 + (size_t)SEQ * 64 * 4;
static_assert(WS_ROPE + 192 * 32 * 4 <= WS_WIN, "rope table below the weights");

constexpr int RING_BYTES = 158720;
constexpr int MISC_OFF = RING_BYTES + 320;
constexpr int LDS_BYTES = 163840;
static_assert(att::SHM_ATTN <= RING_BYTES && MISC_OFF + 128 <= LDS_BYTES, "LDS map");

#define GAS __attribute__((address_space(1)))
#define LAS __attribute__((address_space(3)))
typedef unsigned short bf16;
typedef unsigned v4u __attribute__((ext_vector_type(4)));
typedef float f32x4 __attribute__((ext_vector_type(4)));
typedef __bf16 bf16x2_t __attribute__((ext_vector_type(2)));
typedef float f32x2 __attribute__((ext_vector_type(2)));
typedef float f32x16v __attribute__((ext_vector_type(16)));
typedef float f32x32v __attribute__((ext_vector_type(32)));
typedef unsigned u32x6v __attribute__((ext_vector_type(6)));
typedef _Float16 h16x2 __attribute__((ext_vector_type(2)));
typedef _Float16 h16x32 __attribute__((ext_vector_type(32)));
#ifndef FP6_INTERLEAVED
#define FP6_INTERLEAVED 1
#endif
#define LDS_WAIT() asm volatile("s_waitcnt lgkmcnt(0)" ::: "memory")
__device__ __forceinline__ unsigned f2bf(float f) { unsigned u = __builtin_bit_cast(unsigned, f); return (u + 0x7fffu + ((u >> 16) & 1u)) >> 16; }
__device__ __forceinline__ unsigned pk2(float lo, float hi) { return f2bf(lo) | (f2bf(hi) << 16); }
__device__ __forceinline__ float bflo(unsigned w) { return __builtin_bit_cast(float, w << 16); }
__device__ __forceinline__ float bfhi(unsigned w) { return __builtin_bit_cast(float, w & 0xffff0000u); }
__device__ __forceinline__ float dot2bf(unsigned a, unsigned b, float c) { return __builtin_amdgcn_fdot2_f32_bf16(__builtin_bit_cast(bf16x2_t, a), __builtin_bit_cast(bf16x2_t, b), c, false); }
#define DPP_F(v, CTRL) __builtin_bit_cast(float, __builtin_amdgcn_update_dpp(0, __builtin_bit_cast(int, (v)), (CTRL), 0xf, 0xf, true))
__device__ __forceinline__ float row16_sum(float v) { v += DPP_F(v, 0xB1); v += DPP_F(v, 0x4E); v += DPP_F(v, 0x141); v += DPP_F(v, 0x140); return v; }
__device__ __forceinline__ float row16_max(float v) { v = fmaxf(v, DPP_F(v, 0xB1)); v = fmaxf(v, DPP_F(v, 0x4E)); v = fmaxf(v, DPP_F(v, 0x141)); v = fmaxf(v, DPP_F(v, 0x140)); return v; }
__device__ __forceinline__ float rl_f(float v, int l) { return __builtin_bit_cast(float, __builtin_amdgcn_readlane(__builtin_bit_cast(int, v), l)); }
__device__ __forceinline__ float wave_sum(float v) { v = row16_sum(v); return (rl_f(v, 0) + rl_f(v, 16)) + (rl_f(v, 32) + rl_f(v, 48)); }
__device__ __forceinline__ float wave_max(float v) { v = row16_max(v); return fmaxf(fmaxf(rl_f(v, 0), rl_f(v, 16)), fmaxf(rl_f(v, 32), rl_f(v, 48))); }

#define XB_TMO      128
#define XB_XCNT(j)  (256  + 64 * (j))
#define XB_XSUB(j)  (1280 + 64 * (j))
#define XB_XGEN(j)  (2304 + 64 * (j))
#define XB_TOP      3328
#define XB_TOPGEN   3392
#define XCD_BAR_WORDS 3456
#define XB_SPIN_CAP (1u << 18)
__device__ __forceinline__ unsigned xb_ld(unsigned* p)              { return __hip_atomic_load(p, __ATOMIC_RELAXED, __HIP_MEMORY_SCOPE_AGENT); }
__device__ __forceinline__ unsigned xb_add(unsigned* p, unsigned v) { return __hip_atomic_fetch_add(p, v, __ATOMIC_RELAXED, __HIP_MEMORY_SCOPE_AGENT); }
__device__ __forceinline__ unsigned xb_xcc_id() { return (unsigned)__builtin_amdgcn_s_getreg((3 << 11) | 20) & 0xFu; }
#define XB_SPIN(cond, bar) do { unsigned _sp = 0; while (cond) { __builtin_amdgcn_s_sleep(1); \
    if ((++_sp & 255u) == 0u) { if (xb_ld(&(bar)[XB_TMO])) break; if (_sp > XB_SPIN_CAP) { atomicAdd(&(bar)[XB_TMO], 1u); break; } } } } while (0)
struct XcdBarrier { unsigned* bar; unsigned x; volatile LAS unsigned* st; };
__device__ __forceinline__ XcdBarrier xcd_barrier_post(unsigned* bar, volatile LAS unsigned* st) {
    XcdBarrier b; b.bar = bar; b.x = xb_xcc_id(); b.st = st;
    if (threadIdx.x == 0) (void)xb_add(&bar[XB_XCNT(b.x)], 1u);
    return b;
}
__device__ __forceinline__ void xcd_barrier_complete(unsigned* bar, unsigned x, unsigned& nloc, unsigned& nx) {
    const unsigned G = gridDim.x * gridDim.y * gridDim.z;
    unsigned sum, cnt, mine, sp = 0u;
    for (;;) {
        sum = 0u; cnt = 0u; mine = 0u;
#pragma unroll
        for (unsigned j = 0; j < 16; ++j) { const unsigned c = xb_ld(&bar[XB_XCNT(j)]); sum += c; cnt += (c > 0u) ? 1u : 0u; mine = (j == x) ? c : mine; }
        if (sum == G) break;
        __builtin_amdgcn_s_sleep(1);
        if ((++sp & 255u) == 0u) { if (xb_ld(&bar[XB_TMO])) break; if (sp > XB_SPIN_CAP) { atomicAdd(&bar[XB_TMO], 1u); break; } }
    }
    nloc = mine > 0u ? mine : 1u; nx = cnt > 0u ? cnt : 1u;
}
__device__ __forceinline__ void xcd_barrier(const XcdBarrier& b) {
    asm volatile("s_waitcnt vmcnt(0)" ::: "memory");
    __syncthreads();
    if (threadIdx.x == 0) {
        unsigned* bar = b.bar;
        __builtin_amdgcn_s_waitcnt(0);
        unsigned nloc = b.st[0], nx = b.st[1];
        if (nloc == 0u) { xcd_barrier_complete(bar, b.x, nloc, nx); b.st[0] = nloc; b.st[1] = nx; }
        const unsigned old = xb_add(&bar[XB_XSUB(b.x)], 1u);
        const unsigned gen = old / nloc;
        if (old + 1u == (gen + 1u) * nloc) {
            __builtin_amdgcn_fence(__ATOMIC_RELEASE, "agent");
            asm volatile("s_waitcnt vmcnt(0)" ::: "memory");
            const unsigned og = xb_add(&bar[XB_TOP], 1u);
            const unsigned tg = og / nx;
            if (og + 1u == (tg + 1u) * nx) xb_add(&bar[XB_TOPGEN], 1u);
            else XB_SPIN(xb_ld(&bar[XB_TOPGEN]) == tg, bar);
            __builtin_amdgcn_fence(__ATOMIC_ACQUIRE, "agent");
            xb_add(&bar[XB_XGEN(b.x)], 1u);
            asm volatile("s_waitcnt vmcnt(0)" ::: "memory");
        } else {
            XB_SPIN(xb_ld(&bar[XB_XGEN(b.x)]) == gen, bar);
            __builtin_amdgcn_fence(__ATOMIC_ACQUIRE, "agent");
            asm volatile("s_waitcnt vmcnt(0)" ::: "memory");
        }
    }
    __syncthreads();
}

__device__ __forceinline__ int pi32(int o) { return 2 * (o & 15) + (o >> 4); }
__device__ __forceinline__ void tr_item(const float* __restrict__ W, int N, int k0, int n0, bf16* __restrict__ WT, int ldk, int drow0, bool perm, const float* __restrict__ gsc, LAS float* scr, int lane) {
    f32x4 w[8]; const int c4 = (lane & 7) * 4, rsub = lane >> 3;
#pragma unroll
    for (int i = 0; i < 8; ++i) w[i] = *(const f32x4*)(W + (size_t)(k0 + 8 * i + rsub) * N + n0 + c4);
#pragma unroll
    for (int i = 0; i < 8; ++i) { const int kk = 8 * i + rsub; const float g = gsc ? gsc[k0 + kk] : 1.f;
        scr[kk * 33 + c4] = w[i][0] * g; scr[kk * 33 + c4 + 1] = w[i][1] * g; scr[kk * 33 + c4 + 2] = w[i][2] * g; scr[kk * 33 + c4 + 3] = w[i][3] * g; }
    LDS_WAIT(); asm volatile("" ::: "memory");
    const int c = lane & 7;
#pragma unroll
    for (int j = 0; j < 4; ++j) { const int n = (lane >> 3) + 8 * j; const LAS float* s = scr + (8 * c) * 33 + n;
        v4u o; o.x = pk2(s[0 * 33], s[1 * 33]); o.y = pk2(s[2 * 33], s[3 * 33]); o.z = pk2(s[4 * 33], s[5 * 33]); o.w = pk2(s[6 * 33], s[7 * 33]);
        const int dn = perm ? pi32(n) : n;
        *(v4u*)(WT + (size_t)(drow0 + dn) * ldk + k0 + 8 * c) = o; }
    LDS_WAIT(); asm volatile("" ::: "memory");
}
__device__ __forceinline__ float silu_f(float v) { return v / (1.f + expf(-v)); }
__device__ __forceinline__ float gelu_erf(float v) { return 0.5f * v * (1.f + erff(v * 0.70710678118654752f)); }
__device__ __forceinline__ unsigned fkey(float f) { const unsigned u = __builtin_bit_cast(unsigned, f); return (u & 0x80000000u) ? ~u : (u | 0x80000000u); }

template <int NV> __device__ __forceinline__ unsigned kth16(const unsigned (&k)[NV]) {
    unsigned T = 0u;
    for (int bit = 31; bit >= 0; --bit) { const unsigned c = T | (1u << bit); int cnt = 0;
#pragma unroll
        for (int v = 0; v < NV; ++v) cnt += __popcll(__ballot(k[v] >= c));
        if (cnt >= 16) T = c; }
    return T;
}
template <int NV> __device__ __forceinline__ void compact16(const unsigned (&k)[NV], const unsigned (&val)[NV], const unsigned (&pay)[NV], unsigned T, LAS unsigned* oval, LAS unsigned* opay, int lane) {
    const unsigned long long lt = (1ull << lane) - 1ull; int pos = 0;
#pragma unroll
    for (int v = 0; v < NV; ++v) { const bool s = k[v] > T; const unsigned long long m = __ballot(s); const int slot = pos + __popcll(m & lt); if (s) { oval[slot] = val[v]; opay[slot] = pay[v]; } pos += __popcll(m); }
#pragma unroll
    for (int v = 0; v < NV; ++v) { const bool s = k[v] == T; const unsigned long long m = __ballot(s); const int slot = pos + __popcll(m & lt); if (s && slot < 16) { oval[slot] = val[v]; opay[slot] = pay[v]; } pos += __popcll(m); }
}

struct Args { const float* in[21]; float* out; unsigned char* ws; int ph_lo, ph_hi, probe, pad; };
static_assert(sizeof(Args) == 23 * 8 + 16, "Args has no padding");

__global__ void __launch_bounds__(NTHR, 2) fwd(Args a) {
    extern __shared__ __attribute__((aligned(16))) unsigned char lds[];
    LAS unsigned char* L = (LAS unsigned char*)lds;
    const int wave = __builtin_amdgcn_readfirstlane((int)threadIdx.x >> 6);
    const int G = gridDim.x, bx = blockIdx.x;
    const int gw = bx * NWAVES + wave, NGW = G * NWAVES;
    const size_t NT = (size_t)G * NTHR;
#define PH_IDS() int tid_ph_ = threadIdx.x; asm volatile("" : "+v"(tid_ph_)); const int tid = tid_ph_, lane = tid & 63; const size_t gt = (size_t)bx * NTHR + tid; (void)lane; (void)gt
    unsigned char* ws = a.ws;
    float* ctlf = (float*)(ws + WS_CTL);
    const float* x = a.in[0]; const float* cvec = a.in[1]; const float* ctx = a.in[2]; const float* cctx = a.in[3]; const float* w_ada = a.in[4]; const float* b_ada = a.in[5];
    const float* norm1_g = a.in[6]; const float* w_in = a.in[7]; const float* q_norm_g = a.in[8]; const float* w_uq = a.in[9]; const float* kv_norm_g = a.in[10]; const float* w_ukv = a.in[11];
    const float* conv_w = a.in[12]; const float* conv_b = a.in[13]; const float* w_o = a.in[14]; const float* norm2_g = a.in[15]; const float* peer_wq = a.in[16]; const float* peer_keys = a.in[17];
    const float* peer_u = a.in[18]; const float* peer_v = a.in[19]; const float* final_g = a.in[20];
    float* modp = (float*)(ws + WS_MODP); float* ssq_cq = (float*)(ws + WS_SQ1); float* ssq_ckv = (float*)(ws + WS_SQ2); float* ssq_x1 = (float*)(ws + WS_SQ3);
    float* modf = (float*)(ws + WS_MODF); float* rope = (float*)(ws + WS_ROPE);
    bf16* WIN = (bf16*)(ws + WS_WIN); bf16* WUQ = (bf16*)(ws + WS_WUQ); bf16* WUKV = (bf16*)(ws + WS_WUKV); bf16* WO = (bf16*)(ws + WS_WO); bf16* WPQ = (bf16*)(ws + WS_WPQ); bf16* KBD = (bf16*)(ws + WS_KBD); bf16* KB2 = (bf16*)(ws + WS_KB2);
    unsigned char* UB = ws + WS_UB; unsigned char* VB = ws + WS_VB; float* SUV = (float*)(ws + WS_SU); bf16* HX = (bf16*)(ws + WS_HX); bf16* CQ = (bf16*)(ws + WS_CQ); bf16* CKV = (bf16*)(ws + WS_CKV); bf16* KR = (bf16*)(ws + WS_KR);
    bf16* UCV = (bf16*)(ws + WS_U); bf16* GBV = (bf16*)(ws + WS_GB); bf16* Q = (bf16*)(ws + WS_Q); bf16* KN = (bf16*)(ws + WS_KN); bf16* V = (bf16*)(ws + WS_V); bf16* ACAT = (bf16*)(ws + WS_ACAT);
    bf16* DLT = (bf16*)(ws + WS_X1); bf16* H2 = (bf16*)(ws + WS_H2); float* SC = (float*)(ws + WS_SC);

    for (int u = threadIdx.x; u < (LDS_BYTES - RING_BYTES) / 4; u += NTHR) ((LAS unsigned*)(L + RING_BYTES))[u] = 0u;
    __syncthreads();
    const int lo = a.ph_lo, hi = a.ph_hi;
    XcdBarrier bar; bar.bar = (unsigned*)ctlf + CW_BAR; bar.x = 0; bar.st = (volatile LAS unsigned*)(L + MISC_OFF);
    if (hi - lo > 1) bar = xcd_barrier_post((unsigned*)ctlf + CW_BAR, (volatile LAS unsigned*)(L + MISC_OFF));
#define IN(k) (lo <= (k) && (k) < hi)
#ifndef PHASE_MASK
#define PHASE_MASK 0x3ff
#endif
#define PH_ON(k) (((PHASE_MASK) >> (k)) & 1)
#ifndef REPEAT_MASK
#define REPEAT_MASK 0
#endif
#define NREP(k) (1 + (((REPEAT_MASK) >> (k)) & 1))
#define GRID_BAR(k) do { if (IN(k) && IN((k) + 1)) xcd_barrier(bar); } while (0)

    if (PH_ON(0) && IN(0)) for (int rep_ = 0; rep_ < NREP(0); ++rep_) {
        PH_IDS();
        const int psel = a.probe ? a.probe : 7;
        if (psel & 1)
        for (int it = gw; it < 64 * 96; it += NGW) {
            const int kb = it / 96, cb = it % 96, col = cb * 256 + lane * 4;
            const float* wp = w_ada + (size_t)(kb * 64) * NMODC + col;
            f32x4 ax = {0.f, 0.f, 0.f, 0.f}, ac = {0.f, 0.f, 0.f, 0.f}; const bool cc = cb < 32;
            const float sxv = silu_f(cvec[kb * 64 + lane]), scv = silu_f(cctx[kb * 64 + lane]);
#pragma unroll 16
            for (int i = 0; i < 64; ++i) { const f32x4 w = __builtin_nontemporal_load((const f32x4*)(wp + (size_t)i * NMODC));
                ax += w * rl_f(sxv, i); ac += w * (cc ? rl_f(scv, i) : 0.f); }
            *(f32x4*)(modp + (size_t)kb * 32768 + col) = ax; if (cc) *(f32x4*)(modp + (size_t)kb * 32768 + NMODC + col) = ac;
        }
        if (psel & 2) {
            LAS float* scr = (LAS float*)(L + wave * 8448);
            constexpr int I_IN = 64 * 234, I_UQ = 12 * 96, I_UKV = 8 * 128, I_O = 64 * 128, NIT = I_IN + I_UQ + I_UKV + I_O;
            for (int it = gw; it < NIT; it += NGW) { int r = it;
                if (r < I_IN) { const int kb = r / 234, n0 = (r % 234) * 32; int drow0; bool perm = false;
                    if (n0 < 1280) drow0 = n0; else if (n0 < 1344) { drow0 = n0; perm = true; }
                    else { const int c0 = n0 - 1344; if (c0 < 2048) drow0 = 1536 + (c0 >> 7) * 256 + (c0 & 127); else if (c0 < 4096) drow0 = 5632 + (c0 - 2048); else { const int c1 = c0 - 4096; drow0 = 1536 + (c1 >> 7) * 256 + 128 + (c1 & 127); } }
                    tr_item(w_in, 7488, kb * 64, n0, WIN, 4096, drow0, perm, nullptr, scr, lane); continue; } r -= I_IN;
                if (r < I_UQ) { const int kb = r / 96, n0 = (r % 96) * 32; tr_item(w_uq, 3072, kb * 64, n0, WUQ, 768, n0, (n0 % 192) >= 128, q_norm_g, scr, lane); continue; } r -= I_UQ;
                if (r < I_UKV) { const int kb = r / 128, n0 = (r % 128) * 32; tr_item(w_ukv, 4096, kb * 64, n0, WUKV, 512, n0, false, kv_norm_g, scr, lane); continue; } r -= I_UKV;
                { const int kb = r / 128, n0 = (r % 128) * 32; tr_item(w_o, 4096, kb * 64, n0, WO, 4096, n0, false, nullptr, scr, lane); }
            }
        }
        for (size_t i = gt; i < (size_t)192 * 512; i += NT) { const v4u z = {0u, 0u, 0u, 0u}; *(v4u*)(WIN + (size_t)1344 * 4096 + i * 8) = z; }
        for (size_t i = gt; i < (size_t)DM * 2048 / 8; i += NT) {
            const int d = (int)(i >> 8), c8 = (int)(i & 255) * 8, h = c8 >> 8, j = c8 & 255; const float* sp_ = peer_wq + (size_t)d * 2048 + c8; const f32x4 a0 = *(const f32x4*)sp_, a1 = *(const f32x4*)(sp_ + 4);
            v4u o; o.x = pk2(a0[0], a0[1]); o.y = pk2(a0[2], a0[3]); o.z = pk2(a1[0], a1[1]); o.w = pk2(a1[2], a1[3]); *(v4u*)(WPQ + ((size_t)h * DM + d) * 256 + j) = o; }
        for (size_t i = gt; i < (size_t)8 * 256 * 32; i += NT) {
            const int d8 = (int)(i & 31) * 8, rr = (int)(i >> 5) & 255, h = (int)(i >> 13), p = rr >> 7, k = rr & 127; v4u o = {0u, 0u, 0u, 0u};
            if ((d8 >> 7) == p) { const float* s_ = peer_keys + ((size_t)((h * 2 + p) * 128 + k)) * 128 + (d8 & 127); const f32x4 a0 = *(const f32x4*)s_, a1 = *(const f32x4*)(s_ + 4);
                o.x = pk2(a0[0], a0[1]); o.y = pk2(a0[2], a0[3]); o.z = pk2(a1[0], a1[1]); o.w = pk2(a1[2], a1[3]); }
            *(v4u*)(KB2 + i * 8) = o; }
        for (size_t i = gt; i < (size_t)192 * 16; i += NT) {
            const int pi = (int)(i >> 4), fi = (int)(i & 15); const int pos = pi < 128 ? pi : pi - 128;
            const float fr = __builtin_amdgcn_exp2f(-(float)fi * 0.83048202372184059f);
            const float turns = (float)pos * fr * 0.15915494309189535f, fx = turns - floorf(turns);
            rope[pi * 32 + 2 * fi] = __builtin_amdgcn_cosf(fx); rope[pi * 32 + 2 * fi + 1] = __builtin_amdgcn_sinf(fx); }
        if (psel & 4)
        for (int r = gw; r < 2 * NEXP; r += NGW) { const bool isv = r >= NEXP; const int e = isv ? r - NEXP : r; const float* src = (isv ? peer_v : peer_u) + (size_t)e * DM + lane * 4;
            f32x4 v[2][8]; float am = 0.f;
#pragma unroll
            for (int b = 0; b < 2; ++b)
#pragma unroll
                for (int q = 0; q < 8; ++q) { v[b][q] = __builtin_nontemporal_load((const f32x4*)(src + b * 2048 + q * 256)); am = fmaxf(am, fmaxf(fmaxf(fabsf(v[b][q][0]), fabsf(v[b][q][1])), fmaxf(fabsf(v[b][q][2]), fabsf(v[b][q][3])))); }
            am = wave_max(am);
            const float sc = am > 0.f ? exp2f(floorf(log2f(7.5f / am))) : 1.f;
            unsigned d[12];
#pragma unroll
            for (int b = 0; b < 2; ++b) { f32x16v s0, s1;
#pragma unroll
                for (int i = 0; i < 16; ++i) { const int i0 = FP6_INTERLEAVED ? 2 * i : i, i1 = FP6_INTERLEAVED ? 2 * i + 1 : 16 + i; s0[i] = v[b][i0 >> 2][i0 & 3] * sc; s1[i] = v[b][i1 >> 2][i1 & 3] * sc; }
                const u32x6v w = __builtin_amdgcn_cvt_scalef32_2xpk16_fp6_f32(s0, s1, 1.0f);
#pragma unroll
                for (int i = 0; i < 6; ++i) d[6 * b + i] = w[i]; }
            unsigned char* dst = (isv ? VB : UB) + (size_t)e * ROWB + lane * 16;
#pragma unroll
            for (int p = 0; p < 3; ++p) { const v4u o = {d[4 * p], d[4 * p + 1], d[4 * p + 2], d[4 * p + 3]}; *(v4u*)(dst + p * 1024) = o; }
            if (lane == 0) SUV[r] = 1.f / sc;
        }
    }
    GRID_BAR(0);

    if (PH_ON(1) && IN(1)) for (int rep_ = 0; rep_ < NREP(1); ++rep_) {
        PH_IDS();
        for (size_t j = gt; j < (size_t)(NMODC + 2 * DM); j += NT) { float sacc = 0.f;
#pragma unroll 8
            for (int kb = 0; kb < 64; ++kb) sacc += modp[(size_t)kb * 32768 + j];
            modf[j] = sacc + b_ada[j < (size_t)NMODC ? j : j - NMODC]; }
        { pg8::Gemm g{KB2, WPQ, 2048, DM, 256, 0, (size_t)DM * 256 * 2}; pg8::StaticOrder S; S.init(2048, DM, G, bx); pg8::EpiB16 E{KBD, DM};
          pg8::gemm_phase<pg8::EpiB16, pg8::StaticOrder, true, true>(L, g, S, E); }
    }
    GRID_BAR(1);

    if (PH_ON(2) && IN(2)) for (int rep_ = 0; rep_ < NREP(2); ++rep_) {
        PH_IDS();
        for (int row = gw; row < MR; row += NGW) {
            const bool lat = row < SEQ; const float* xr = lat ? x + (size_t)row * DM : ctx + (size_t)(row - SEQ) * DM; const float* md = lat ? modf : modf + NMODC;
            f32x4 v[16]; float ss = 0.f;
#pragma unroll
            for (int j = 0; j < 16; ++j) { v[j] = *(const f32x4*)(xr + 4 * (lane + 64 * j)); ss += (v[j][0] * v[j][0] + v[j][1] * v[j][1]) + (v[j][2] * v[j][2] + v[j][3] * v[j][3]); }
            ss = wave_sum(ss); const float rstd = 1.f / sqrtf(ss * (1.f / DM) + EPS);
#pragma unroll
            for (int j = 0; j < 16; ++j) { const int idx = 4 * (lane + 64 * j);
                const f32x4 g = *(const f32x4*)(norm1_g + idx), sh = *(const f32x4*)(md + idx), sc = *(const f32x4*)(md + DM + idx);
                const f32x4 hh = (v[j] * rstd * g) * (sc + 1.f) + sh;
                *(unsigned long long*)(HX + (size_t)row * DM + idx) = (unsigned long long)pk2(hh[0], hh[1]) | ((unsigned long long)pk2(hh[2], hh[3]) << 32); }
        }
    }
    GRID_BAR(2);

    if (PH_ON(3) && IN(3)) for (int rep_ = 0; rep_ < NREP(3); ++rep_) {
        pg8::Gemm g{HX, WIN, MR, NIN, DM, 0, 0}; pg8::OrderIn S; S.init(SEQ, NIN, G, bx);
        pg8::EpiIn E{CQ, CKV, KR, UCV, GBV, ssq_cq, ssq_ckv, rope};
        pg8::gemm_phase<pg8::EpiIn, pg8::OrderIn, true, true>(L, g, S, E);
    }
    GRID_BAR(3);

    if (PH_ON(4) && IN(4)) for (int rep_ = 0; rep_ < NREP(4); ++rep_) {
        PH_IDS();
        if (G == 256) {
            const int nq = bx < 144 ? 1 : bx < 240 ? 2 : 3, qb0 = bx < 144 ? bx : bx < 240 ? 144 + 2 * (bx - 144) : 336 + 3 * (bx - 240);
            const int nkv = bx < 144 ? 3 : bx < 240 ? 1 : 0, kb0 = bx < 144 ? 3 * bx : 432 + (bx - 144);
            { pg8::Gemm g{CQ, WUQ, SEQ, 3072, QL, 0, 0}; pg8::RunOrder S{qb0, nq, 12}; pg8::EpiQ E{Q, ssq_cq, rope, C2};
              pg8::gemm_phase<pg8::EpiQ, pg8::RunOrder, true, true>(L, g, S, E); }
            { pg8::Gemm g{CKV, WUKV, MR, 4096, KVL, 0, 0}; pg8::RunOrder S{kb0, nkv, 16}; pg8::EpiKV E{KN, V, ssq_ckv};
              pg8::gemm_phase<pg8::EpiKV, pg8::RunOrder, true, true>(L, g, S, E); }
        } else {
            { pg8::Gemm g{CQ, WUQ, SEQ, 3072, QL, 0, 0}; pg8::RunOrder S{(int)(((long)384 * bx) / G), (int)(((long)384 * (bx + 1)) / G - ((long)384 * bx) / G), 12}; pg8::EpiQ E{Q, ssq_cq, rope, C2};
              pg8::gemm_phase<pg8::EpiQ, pg8::RunOrder, true, true>(L, g, S, E); }
            { pg8::Gemm g{CKV, WUKV, MR, 4096, KVL, 0, 0}; pg8::RunOrder S{(int)(((long)528 * bx) / G), (int)(((long)528 * (bx + 1)) / G - ((long)528 * bx) / G), 16}; pg8::EpiKV E{KN, V, ssq_ckv};
              pg8::gemm_phase<pg8::EpiKV, pg8::RunOrder, true, true>(L, g, S, E); }
        }
        for (size_t it = gt; it < (size_t)SEQ * 256; it += NT) {
            const int t = (int)(it >> 8), c8 = (int)(it & 255) * 8; const v4u z = {0u, 0u, 0u, 0u};
            const v4u um = t > 0 ? *(const v4u*)(UCV + (size_t)(t - 1) * 2048 + c8) : z, u0 = *(const v4u*)(UCV + (size_t)t * 2048 + c8), up = t < SEQ - 1 ? *(const v4u*)(UCV + (size_t)(t + 1) * 2048 + c8) : z;
            const v4u gv = *(const v4u*)(GBV + (size_t)t * 2048 + c8); v4u o;
            float w0[8], w1[8], w2[8], wb[8];
#pragma unroll
            for (int q = 0; q < 2; ++q) { const f32x4 a0 = *(const f32x4*)(conv_w + c8 + 4 * q), a1 = *(const f32x4*)(conv_w + 2048 + c8 + 4 * q), a2 = *(const f32x4*)(conv_w + 4096 + c8 + 4 * q), a3 = *(const f32x4*)(conv_b + c8 + 4 * q);
#pragma unroll
                for (int j = 0; j < 4; ++j) { w0[4 * q + j] = a0[j]; w1[4 * q + j] = a1[j]; w2[4 * q + j] = a2[j]; wb[4 * q + j] = a3[j]; } }
#pragma unroll
            for (int j = 0; j < 4; ++j) {
                const float y0 = w0[2 * j] * bflo(um[j]) + w1[2 * j] * bflo(u0[j]) + w2[2 * j] * bflo(up[j]) + wb[2 * j];
                const float y1 = w0[2 * j + 1] * bfhi(um[j]) + w1[2 * j + 1] * bfhi(u0[j]) + w2[2 * j + 1] * bfhi(up[j]) + wb[2 * j + 1];
                o[j] = pk2(bflo(gv[j]) * y0, bfhi(gv[j]) * y1); }
            *(v4u*)(ACAT + (size_t)t * DM + 2048 + c8) = o; }
    }
    GRID_BAR(4);

    if (PH_ON(5) && IN(5)) for (int rep_ = 0; rep_ < NREP(5); ++rep_) {
        for (int i = 0;; ++i) { int h, qb;
            if (G == 256) { if (i >= 2) break; h = 2 * (bx & 7) + i; qb = bx >> 3; } else { const int Lu = i * G + bx; if (Lu >= 512) break; h = Lu >> 5; qb = Lu & 31; }
            att::attn_unit(Q + (size_t)(qb * 256) * 3072 + h * 192, KN + h * 128, V + h * 128, KR, ACAT + (size_t)(qb * 256) * DM + h * 128, MR, (char*)lds, L, a.probe); }
    }
    GRID_BAR(5);

    if (PH_ON(6) && IN(6)) for (int rep_ = 0; rep_ < NREP(6); ++rep_) {
        pg8::Gemm g{ACAT, WO, SEQ, DM, DM, 0, 0}; pg8::StaticOrder S; S.init(SEQ, DM, G, bx); pg8::EpiO E{modf + 2 * DM, DLT};
        pg8::gemm_phase<pg8::EpiO, pg8::StaticOrder, true, true>(L, g, S, E);
    }
    GRID_BAR(6);

    if (PH_ON(7) && IN(7)) for (int rep_ = 0; rep_ < NREP(7); ++rep_) {
        PH_IDS();
        for (int row = gw; row < SEQ; row += NGW) {
            f32x4 v[16]; float ssq[4] = {0.f, 0.f, 0.f, 0.f};
#pragma unroll
            for (int j = 0; j < 16; ++j) { const int idx = 4 * (lane + 64 * j); const unsigned long long d8 = *(const unsigned long long*)(DLT + (size_t)row * DM + idx); const f32x4 xv = *(const f32x4*)(x + (size_t)row * DM + idx);
                v[j][0] = xv[0] + bflo((unsigned)d8); v[j][1] = xv[1] + bfhi((unsigned)d8); v[j][2] = xv[2] + bflo((unsigned)(d8 >> 32)); v[j][3] = xv[3] + bfhi((unsigned)(d8 >> 32));
#pragma unroll
                for (int c = 0; c < 4; ++c) ssq[c] = fmaf(v[j][c], v[j][c], ssq[c]); }
            const float rstd = 1.f / sqrtf(wave_sum((ssq[0] + ssq[1]) + (ssq[2] + ssq[3])) * (1.f / DM) + EPS);
#pragma unroll
            for (int j = 0; j < 16; ++j) { const int idx = 4 * (lane + 64 * j);
                const f32x4 g = *(const f32x4*)(norm2_g + idx), sh = *(const f32x4*)(modf + 3 * DM + idx), sc = *(const f32x4*)(modf + 4 * DM + idx);
                const f32x4 hh = (v[j] * rstd * g) * (sc + 1.f) + sh;
                *(unsigned long long*)(H2 + (size_t)row * DM + idx) = (unsigned long long)pk2(hh[0], hh[1]) | ((unsigned long long)pk2(hh[2], hh[3]) << 32); }
        }
    }
    GRID_BAR(7);

    if (PH_ON(8) && IN(8)) for (int rep_ = 0; rep_ < NREP(8); ++rep_) {
        pg8::Gemm g{H2, KBD, SEQ, 2048, DM, 0, 0}; pg8::StaticOrder S; S.init(SEQ, 2048, G, bx); pg8::EpiF32 E{SC, 2048};
        pg8::gemm_phase<pg8::EpiF32, pg8::StaticOrder, true, true>(L, g, S, E);
    }
    GRID_BAR(8);

    if (PH_ON(9) && IN(9)) for (int rep_ = 0; rep_ < NREP(9); ++rep_) {
        int lane0_ = threadIdx.x; asm volatile("" : "+v"(lane0_)); lane0_ &= 63;
        LAS unsigned* wl = (LAS unsigned*)(L + wave * 8192);
        LAS unsigned* sV1 = wl, *sI1 = wl + 16, *sV2 = wl + 32, *sI2 = wl + 48, *sVc = wl + 64, *sEc = wl + 80;
        LAS unsigned* eL = wl + 128; LAS float* gL = (LAS float*)(wl + 128 + 512);
        const float* gate2 = modf + 5 * DM; const int emask_ = a.probe ? 63 : 0xffff; float* outp_ = a.probe ? (float*)(ws + WS_HX) : a.out;
        for (int tb = gw * 4; tb < SEQ; tb += NGW * 4) {
            for (int ti = 0; ti < 4; ++ti) { const int t = tb + ti; int lane = lane0_; asm volatile("" : "+v"(lane));
                for (int h = 0; h < 8; ++h) { const float* sp = SC + (size_t)t * 2048 + h * 256;
                    { const float s0 = sp[lane], s1 = sp[64 + lane]; const unsigned k[2] = {fkey(s0), fkey(s1)}, vb[2] = {__builtin_bit_cast(unsigned, s0), __builtin_bit_cast(unsigned, s1)}, pl[2] = {(unsigned)lane, (unsigned)(64 + lane)};
                      const unsigned T = kth16<2>(k); compact16<2>(k, vb, pl, T, sV1, sI1, lane); }
                    { const float s0 = sp[128 + lane], s1 = sp[192 + lane]; const unsigned k[2] = {fkey(s0), fkey(s1)}, vb[2] = {__builtin_bit_cast(unsigned, s0), __builtin_bit_cast(unsigned, s1)}, pl[2] = {(unsigned)lane, (unsigned)(64 + lane)};
                      const unsigned T = kth16<2>(k); compact16<2>(k, vb, pl, T, sV2, sI2, lane); }
                    LDS_WAIT();
                    { const float s2b = __builtin_bit_cast(float, sV2[lane & 15]); const unsigned i2b = sI2[lane & 15]; unsigned k[4], vb[4], pl[4];
#pragma unroll
                      for (int r = 0; r < 4; ++r) { const int aa = (lane >> 4) + 4 * r; const float cv = __builtin_bit_cast(float, sV1[aa]) + s2b; k[r] = fkey(cv); vb[r] = __builtin_bit_cast(unsigned, cv); pl[r] = sI1[aa] * 128u + i2b; }
                      const unsigned T = kth16<4>(k); compact16<4>(k, vb, pl, T, sVc, sEc, lane); }
                    LDS_WAIT();
                    { const float tv = __builtin_bit_cast(float, sVc[lane & 15]); const float mx = row16_max(tv);
                      const float ex = expf(tv - mx); const float sm = row16_sum(ex);
                      if (lane < 16) { eL[ti * 128 + h * 16 + lane] = sEc[lane]; gL[ti * 128 + h * 16 + lane] = ex / sm; } }
                    LDS_WAIT();
                }
                { const unsigned e0 = eL[ti * 128 + lane], e1 = eL[ti * 128 + 64 + lane]; const float g0 = gL[ti * 128 + lane], g1 = gL[ti * 128 + 64 + lane];
                  const unsigned k0 = (e0 << 7) | (unsigned)lane, k1 = (e1 << 7) | (unsigned)(64 + lane); int r0 = 0, r1 = 0;
#pragma unroll 8
                  for (int m = 0; m < 128; ++m) { const unsigned km = (eL[ti * 128 + m] << 7) | (unsigned)m; r0 += km < k0 ? 1 : 0; r1 += km < k1 ? 1 : 0; }
                  LDS_WAIT();
                  eL[ti * 128 + r0] = e0; gL[ti * 128 + r0] = g0; eL[ti * 128 + r1] = e1; gL[ti * 128 + r1] = g1;
                  LDS_WAIT(); }
                h16x2 hh[2][16];
#pragma unroll
                for (int b = 0; b < 2; ++b)
#pragma unroll
                    for (int q = 0; q < 8; ++q) { const unsigned long long a0 = *(const unsigned long long*)(H2 + (size_t)t * DM + b * 2048 + q * 256 + lane * 4);
                        hh[b][2 * q] = (h16x2){(_Float16)bflo((unsigned)a0), (_Float16)bfhi((unsigned)a0)}; hh[b][2 * q + 1] = (h16x2){(_Float16)bflo((unsigned)(a0 >> 32)), (_Float16)bfhi((unsigned)(a0 >> 32))}; }
                v4u rr[6][3]; float rs[6];
#define LDROW(j, TAB, e, SOFF) do { const unsigned char* rp_ = (TAB) + (size_t)(e) * ROWB + lane * 16; _Pragma("unroll") for (int p = 0; p < 3; ++p) rr[j][p] = *(const v4u*)(rp_ + p * 1024); rs[j] = SUV[(SOFF) + (e)]; } while (0)
#define EIDX(k) (__builtin_amdgcn_readfirstlane((int)eL[ti * 128 + (k)]) & emask_)
#define UNPKH(j, b) __builtin_amdgcn_cvt_scalef32_pk32_f16_fp6((b) == 0 ? (u32x6v){rr[j][0][0], rr[j][0][1], rr[j][0][2], rr[j][0][3], rr[j][1][0], rr[j][1][1]} : (u32x6v){rr[j][1][2], rr[j][1][3], rr[j][2][0], rr[j][2][1], rr[j][2][2], rr[j][2][3]}, 1.0f)
#define DOTROW(out, j) do { float a0 = 0.f, a1 = 0.f, a2 = 0.f, a3 = 0.f; _Pragma("unroll") for (int b = 0; b < 2; ++b) { const h16x32 x_ = UNPKH(j, b); \
                    _Pragma("unroll") for (int i = 0; i < 16; i += 4) { a0 = __builtin_amdgcn_fdot2((h16x2){x_[2 * i], x_[2 * i + 1]}, hh[b][i], a0, false); a1 = __builtin_amdgcn_fdot2((h16x2){x_[2 * i + 2], x_[2 * i + 3]}, hh[b][i + 1], a1, false); \
                        a2 = __builtin_amdgcn_fdot2((h16x2){x_[2 * i + 4], x_[2 * i + 5]}, hh[b][i + 2], a2, false); a3 = __builtin_amdgcn_fdot2((h16x2){x_[2 * i + 6], x_[2 * i + 7]}, hh[b][i + 3], a3, false); } } \
                    out = (a0 + a1) + (a2 + a3); } while (0)
                int ei[6];
#pragma unroll
                for (int j = 0; j < 6; ++j) { ei[j] = EIDX(j); LDROW(j, UB, ei[j], 0); }
                for (int k0 = 0; k0 < 126; k0 += 6) {
                    float dsum[6];
#pragma unroll
                    for (int j = 0; j < 6; ++j) { float part; DOTROW(part, j); const float sc_ = rs[j];
                        if (k0 + 6 + j < 128) { ei[j] = EIDX(k0 + 6 + j); LDROW(j, UB, ei[j], 0); }
                        dsum[j] = wave_sum(part) * sc_; }
                    if (lane < 6) { float d = dsum[0];
#pragma unroll
                        for (int j = 1; j < 6; ++j) d = lane == j ? dsum[j] : d;
                        gL[ti * 128 + k0 + lane] = gL[ti * 128 + k0 + lane] * gelu_erf(d); }
                }
                { float dsum[2];
#pragma unroll
                  for (int j = 0; j < 2; ++j) { float part; DOTROW(part, j); dsum[j] = wave_sum(part) * rs[j]; }
                  if (lane < 2) { const float d = lane == 0 ? dsum[0] : dsum[1]; gL[ti * 128 + 126 + lane] = gL[ti * 128 + 126 + lane] * gelu_erf(d); } }
                LDS_WAIT();
            }
            for (int ti = 0; ti < 4; ++ti) { const int t = tb + ti; int lane = lane0_; asm volatile("" : "+v"(lane));
                h16x2 ah[2][16];
#pragma unroll
                for (int b = 0; b < 2; ++b)
#pragma unroll
                    for (int i = 0; i < 16; ++i) ah[b][i] = (h16x2){(_Float16)0.f, (_Float16)0.f};
                v4u rr[6][3]; float rs[6];
#define FMAROW(j, WW) do { const _Float16 wh_ = (_Float16)(WW); const h16x2 w2_ = {wh_, wh_}; _Pragma("unroll") for (int b = 0; b < 2; ++b) { const h16x32 x_ = UNPKH(j, b); \
                    _Pragma("unroll") for (int i = 0; i < 16; ++i) ah[b][i] = __builtin_elementwise_fma(w2_, (h16x2){x_[2 * i], x_[2 * i + 1]}, ah[b][i]); } } while (0)
                int ei[6];
#pragma unroll
                for (int j = 0; j < 6; ++j) { ei[j] = EIDX(j); LDROW(j, VB, ei[j], NEXP); }
                for (int k0 = 0; k0 < 126; k0 += 6) {
#pragma unroll
                    for (int j = 0; j < 6; ++j) { FMAROW(j, gL[ti * 128 + k0 + j] * rs[j]);
                        if (k0 + 6 + j < 128) { ei[j] = EIDX(k0 + 6 + j); LDROW(j, VB, ei[j], NEXP); } }
                }
#pragma unroll
                for (int j = 0; j < 2; ++j) FMAROW(j, gL[ti * 128 + 126 + j] * rs[j]);
                float acc[2][32];
#pragma unroll
                for (int b = 0; b < 2; ++b)
#pragma unroll
                    for (int i = 0; i < 16; ++i) { acc[b][2 * i] = (float)ah[b][i][0]; acc[b][2 * i + 1] = (float)ah[b][i][1]; }
                float ssp[4] = {0.f, 0.f, 0.f, 0.f}; int lane_f = lane; asm volatile("" : "+v"(lane_f));
#pragma unroll
                for (int b = 0; b < 2; ++b)
#pragma unroll
                    for (int q = 0; q < 8; ++q) { unsigned o = (unsigned)(b * 2048 + q * 256 + lane_f * 4); asm volatile("" : "+v"(o)); const unsigned long long d8 = *(const unsigned long long*)(DLT + (size_t)t * DM + o); f32x4 xa = *(const f32x4*)(x + (size_t)t * DM + o); const f32x4 ga = *(const f32x4*)(gate2 + o);
                        xa[0] += bflo((unsigned)d8); xa[1] += bfhi((unsigned)d8); xa[2] += bflo((unsigned)(d8 >> 32)); xa[3] += bfhi((unsigned)(d8 >> 32));
#pragma unroll
                        for (int j = 0; j < 4; ++j) { acc[b][4 * q + j] = fmaf(ga[j], acc[b][4 * q + j], xa[j]); ssp[j] = fmaf(acc[b][4 * q + j], acc[b][4 * q + j], ssp[j]); }
                        if ((q & 1) == 1) asm volatile("" ::: "memory"); }
                const float ss = wave_sum((ssp[0] + ssp[1]) + (ssp[2] + ssp[3])); const float rstd = 1.f / sqrtf(ss * (1.f / DM) + EPS);
#pragma unroll
                for (int b = 0; b < 2; ++b)
#pragma unroll
                    for (int q = 0; q < 8; ++q) { unsigned o = (unsigned)(b * 2048 + q * 256 + lane_f * 4); asm volatile("" : "+v"(o)); const f32x4 fa = *(const f32x4*)(final_g + o); f32x4 oa;
#pragma unroll
                        for (int j = 0; j < 4; ++j) oa[j] = acc[b][4 * q + j] * rstd * fa[j];
                        *(f32x4*)(outp_ + (size_t)t * DM + o) = oa; if ((q & 1) == 1) asm volatile("" ::: "memory"); }
            }
            LDS_WAIT();
#undef LDROW
#undef EIDX
#undef DOTROW
#undef FMAROW
#undef UNPKH
        }
    }
#undef IN
#undef GRID_BAR
}

extern "C" void kernel_launch(void* const* d_in, const int* in_sizes, int n_in, void* d_out, int out_size, void* d_ws, size_t ws_size, hipStream_t stream) {
    static int grid = 0;
    if (grid == 0) {
        if (n_in != 21 || in_sizes[0] != SEQ * DM || out_size != SEQ * DM || ws_size < WS_END) {
            fprintf(stderr, "kernel_launch: built for 21 inputs, x/out of %d floats, >= %zu bytes of workspace; got n_in %d, in0 %d, out %d, ws %zu; nothing launched\n", SEQ * DM, (size_t)WS_END, n_in, n_in > 0 ? in_sizes[0] : -1, out_size, ws_size); grid = -1; return; }
        int dev = 0, cus = 0, per_cu = 0;
        if (hipGetDevice(&dev) != hipSuccess || hipDeviceGetAttribute(&cus, hipDeviceAttributeMultiprocessorCount, dev) != hipSuccess) { fprintf(stderr, "kernel_launch: device query failed\n"); grid = -1; return; }
        if (hipFuncSetAttribute((const void*)fwd, hipFuncAttributeMaxDynamicSharedMemorySize, LDS_BYTES) != hipSuccess) { fprintf(stderr, "kernel_launch: hipFuncSetAttribute failed\n"); grid = -1; return; }
        if (hipOccupancyMaxActiveBlocksPerMultiprocessor(&per_cu, (const void*)fwd, NTHR, LDS_BYTES) != hipSuccess || per_cu < 1) fprintf(stderr, "kernel_launch: note: occupancy query reports %d workgroups per CU\n", per_cu);
        (void)hipGetLastError();
        grid = cus;
    }
    if (grid < 0) return;
    if (hipMemsetAsync((char*)d_ws + WS_CTL, 0, CTL_ZERO_BYTES, stream) != hipSuccess) { fprintf(stderr, "kernel_launch: memset failed\n"); return; }
    Args a{};
    for (int i = 0; i < 21; ++i) a.in[i] = (const float*)d_in[i];
    a.out = (float*)d_out; a.ws = (unsigned char*)d_ws;
#if MK_ONE_LAUNCH
    a.ph_lo = 0; a.ph_hi = NPHASE;
    hipLaunchKernelGGL(fwd, dim3(grid), dim3(NTHR), LDS_BYTES, stream, a);
#ifndef PROBE_MODE
#define PROBE_MODE 0
#endif
#ifdef PROBE_PHASES
    for (int p = 0; p < NPHASE; ++p) if ((PROBE_PHASES >> p) & 1) { a.ph_lo = p; a.ph_hi = p + 1; a.probe = PROBE_MODE; hipLaunchKernelGGL(fwd, dim3(grid), dim3(NTHR), LDS_BYTES, stream, a); }
#endif
#else
    for (int p = 0; p < NPHASE; ++p) { a.ph_lo = p; a.ph_hi = p + 1; hipLaunchKernelGGL(fwd, dim3(grid), dim3(NTHR), LDS_BYTES, stream, a); }
#endif
    const hipError_t le = hipPeekAtLastError();
    if (le != hipSuccess) fprintf(stderr, "kernel_launch: launch failed: %s\n", hipGetErrorName(le));
}
```

```cpp
#include <hip/hip_runtime.h>
#include <cstdio>
#include <cstdint>
#include <cmath>
namespace pg8 {
#define PG8_LAS __attribute__((address_space(3)))
typedef unsigned short bf16_t;
typedef short bf16x8 __attribute__((ext_vector_type(8)));
typedef float f32x4 __attribute__((ext_vector_type(4)));
typedef unsigned u32x4 __attribute__((ext_vector_type(4)));
constexpr int BM = 256, BK = 64, HALF = 128, HTB = HALF * BK * 2  , STAGE_BYTES = 8 * HTB, NXCD = 8, WGM = 8;

__host__ __device__ __forceinline__ int lds_byte(int r, int c) { const int st = (r >> 4) * 2 + (c >> 5), rr = r & 15, cc = c & 31, ob = rr * 64 + cc * 2; return st * 1024 + (ob ^ (((ob >> 9) & 1) << 5)); }
__host__ __device__ __forceinline__ void stage_rc(int b, int& R, int& C) { const int st = b / 1024, sb = b % 1024, swz = sb ^ (((sb >> 9) & 1) << 5); R = (st >> 1) * 16 + swz / 64; C = (st & 1) * 32 + (swz % 64) / 2; }
__host__ __device__ __forceinline__ int perm32(int rho) { const int n = rho >> 4, i = rho & 15; return 8 * (i >> 2) + 4 * n + (i & 3); }

struct Unit { int pm, pn; };
struct Gemm { const bf16_t* A; const bf16_t* Bt; int M, N, K; size_t a_pn; size_t b_pm; };

struct StaticOrder {
    int nM, nN, nwg, G, c;
    __host__ __device__ void init(int M, int N, int G_, int c_) { nM = M / BM; nN = N / BM; nwg = nM * nN; G = G_; c = c_; }
    __host__ __device__ bool next(int i, Unit& u) const {
        const long L = (long)i * G + c; if (L >= nwg) return false;
        int wgid = (int)L; { const int q = nwg / NXCD, r = nwg % NXCD, xcd = wgid % NXCD, off = wgid / NXCD; wgid = (xcd < r ? xcd * (q + 1) : r * (q + 1) + (xcd - r) * q) + off; }
        const int nig = WGM * nN, gid = wgid / nig, fm = gid * WGM, gsz = (nM - fm) < WGM ? (nM - fm) : WGM;
        u.pm = fm + ((wgid % nig) % gsz); u.pn = (wgid % nig) / gsz; return true;
    }
    __device__ __forceinline__ void a_ready(const Unit&) const {}
    __device__ __forceinline__ void done(const Unit&) const {}
};

__device__ __forceinline__ unsigned cvt_pk_bf16(float lo, float hi) { unsigned r; asm volatile("v_cvt_pk_bf16_f32 %0, %1, %2" : "=v"(r) : "v"(lo), "v"(hi)); return r; }
typedef float f32x2 __attribute__((ext_vector_type(2)));
__device__ __forceinline__ f32x2 gelu_pk(f32x2 v) {
    const f32x2 av = __builtin_elementwise_abs(v), d = av * 0.2316418882f + 1.0f;
    f32x2 t; t.x = __builtin_amdgcn_rcpf(d.x); t.y = __builtin_amdgcn_rcpf(d.y);
    f32x2 q = t * 0.5307027145f + (-0.7265760135f); q = q * t + 0.7107068705f; q = q * t + (-0.142248368f); q = q * t + 0.127414796f; q = q * t;
    const f32x2 s = (v * v) * (-0.72134752044f);
    f32x2 e; e.x = __builtin_amdgcn_exp2f(s.x); e.y = __builtin_amdgcn_exp2f(s.y);
    const f32x2 m = v * (q * e), r = v - m;
    f32x2 o; o.x = v.x < 0.f ? m.x : r.x; o.y = v.y < 0.f ? m.y : r.y; return o;
}


__device__ __forceinline__ u32x4 pack8(f32x4 v0, f32x4 v1) { u32x4 w; w.x = cvt_pk_bf16(v0[0], v0[1]); w.y = cvt_pk_bf16(v0[2], v0[3]); w.z = cvt_pk_bf16(v1[0], v1[1]); w.w = cvt_pk_bf16(v1[2], v1[3]); return w; }
__device__ __forceinline__ unsigned long long pack8_fp8(f32x4 v0, f32x4 v1) { int lo = __builtin_amdgcn_cvt_pk_fp8_f32(v0[0], v0[1], 0, false); lo = __builtin_amdgcn_cvt_pk_fp8_f32(v0[2], v0[3], lo, true);
    int hi = __builtin_amdgcn_cvt_pk_fp8_f32(v1[0], v1[1], 0, false); hi = __builtin_amdgcn_cvt_pk_fp8_f32(v1[2], v1[3], hi, true); return (unsigned long long)(unsigned)lo | ((unsigned long long)(unsigned)hi << 32); }
__device__ __forceinline__ float quad_row_sum(float s) { s += __shfl_xor(s, 16); s += __shfl_xor(s, 32); return s; }

__device__ __forceinline__ f32x4 rope4(f32x4 v, const float* tab, int i) {
    const f32x4 cs = *(const f32x4*)(tab + 2 * i);
    f32x4 o; o[0] = v[0] * cs[0] - v[1] * cs[1]; o[1] = v[1] * cs[0] + v[0] * cs[1]; o[2] = v[2] * cs[2] - v[3] * cs[3]; o[3] = v[3] * cs[2] + v[2] * cs[3]; return o;
}

struct EpiIn {
    static constexpr bool PERM = true, AFTER_DRAIN = false;
    bf16_t* cq; bf16_t* ckv; unsigned char* kr; bf16_t* ub; bf16_t* gb; float* ssq_cq; float* ssq_ckv; const float* rope;
    __device__ __forceinline__ void operator()(const f32x4 (&acc)[2][2][4][2], const Unit& u, int wr, int wc, int fr, int fq) const {
        const int pn = u.pn, row0 = u.pm * BM + wr * 64 + fr, cw = wc * 32 + 8 * fq;
        if (pn < 5) {
            bf16_t* dst = pn < 3 ? cq : ckv; const int ld = pn < 3 ? 768 : 512, pl = pn < 3 ? pn : pn - 3, coff = pl * 256 + cw, nsl = pn < 3 ? 12 : 8; float* ssq = pn < 3 ? ssq_cq : ssq_ckv;
#pragma unroll
            for (int ai = 0; ai < 2; ++ai)
#pragma unroll
                for (int m = 0; m < 4; ++m) { const int row = row0 + ai * HALF + m * 16; float s = 0.f;
#pragma unroll
                    for (int bj = 0; bj < 2; ++bj) { const f32x4 v0 = acc[ai][bj][m][0], v1 = acc[ai][bj][m][1];
                        s += (v0[0] * v0[0] + v0[1] * v0[1]) + (v0[2] * v0[2] + v0[3] * v0[3]) + (v1[0] * v1[0] + v1[1] * v1[1]) + (v1[2] * v1[2] + v1[3] * v1[3]);
                        *(u32x4*)(dst + (size_t)row * ld + coff + bj * HALF) = pack8(v0, v1); }
                    s = quad_row_sum(s); if (fq == 0) ssq[(size_t)row * nsl + pl * 4 + wc] = s; }
        } else if (pn == 5) {
            if (wc < 2) {
#pragma unroll
                for (int ai = 0; ai < 2; ++ai)
#pragma unroll
                    for (int m = 0; m < 4; ++m) { const int row = row0 + ai * HALF + m * 16; f32x4 v0 = acc[ai][0][m][0], v1 = acc[ai][0][m][1];
                        if (row < 8192) { const int pos = wc == 0 ? (row >> 6) : 128 + (row & 63); const float* tab = rope + pos * 32; v0 = rope4(v0, tab, 4 * fq); v1 = rope4(v1, tab, 4 * fq + 2); }
                        *(unsigned long long*)(kr + (size_t)row * 64 + cw) = pack8_fp8(v0, v1); }
            }
        } else if (pn < 22) {
            const int j = pn - 6;
#pragma unroll
            for (int ai = 0; ai < 2; ++ai)
#pragma unroll
                for (int m = 0; m < 4; ++m) { const int row = row0 + ai * HALF + m * 16;
                    *(u32x4*)(ub + (size_t)row * 2048 + j * 128 + cw) = pack8(acc[ai][0][m][0] * acc[ai][1][m][0], acc[ai][0][m][1] * acc[ai][1][m][1]); }
        } else {
            const int j = pn - 22;
#pragma unroll
            for (int ai = 0; ai < 2; ++ai)
#pragma unroll
                for (int m = 0; m < 4; ++m) { const int row = row0 + ai * HALF + m * 16;
#pragma unroll
                    for (int bj = 0; bj < 2; ++bj) *(u32x4*)(gb + (size_t)row * 2048 + j * 256 + bj * HALF + cw) = pack8(acc[ai][bj][m][0], acc[ai][bj][m][1]); }
        }
    }
};

struct EpiQ {
    static constexpr bool PERM = true, AFTER_DRAIN = false;
    unsigned char* q; const float* ssq_cq; const float* rope; float c2;
    __device__ __forceinline__ void operator()(const f32x4 (&acc)[2][2][4][2], const Unit& u, int wr, int wc, int fr, int fq) const {
        const int row0 = u.pm * BM + wr * 64 + fr, cw = wc * 32 + 8 * fq;
#pragma unroll
        for (int ai = 0; ai < 2; ++ai)
#pragma unroll
            for (int m = 0; m < 4; ++m) { const int row = row0 + ai * HALF + m * 16; const f32x4 q0 = *(const f32x4*)(ssq_cq + (size_t)row * 12), q1 = *(const f32x4*)(ssq_cq + (size_t)row * 12 + 4), q2 = *(const f32x4*)(ssq_cq + (size_t)row * 12 + 8);
                const float ssum = (((q0[0] + q0[1]) + (q0[2] + q0[3])) + ((q1[0] + q1[1]) + (q1[2] + q1[3]))) + ((q2[0] + q2[1]) + (q2[2] + q2[3])); const float sc = c2 / sqrtf(ssum * (1.f / 768.f) + 1e-6f);
#pragma unroll
                for (int bj = 0; bj < 2; ++bj) { const int col = u.pn * BM + bj * HALF + cw, d = col % 192; f32x4 v0 = acc[ai][bj][m][0] * sc, v1 = acc[ai][bj][m][1] * sc;
                    if (d >= 128) { const int p = d - 128, ax = p >> 5, i = (p & 31) >> 1; const int pos = ax == 0 ? (row >> 6) : 128 + (row & 63); const float* tab = rope + pos * 32;
                        v0 = rope4(v0, tab, i); v1 = rope4(v1, tab, i + 2); }
                    *(unsigned long long*)(q + (size_t)row * 3072 + col) = pack8_fp8(v0, v1); } }
    }
};

struct EpiKV {
    static constexpr bool PERM = true, AFTER_DRAIN = false;
    unsigned char* kn; bf16_t* v; const float* ssq_ckv;
    __device__ __forceinline__ void operator()(const f32x4 (&acc)[2][2][4][2], const Unit& u, int wr, int wc, int fr, int fq) const {
        const int row0 = u.pm * BM + wr * 64 + fr, cw = u.pn * 128 + wc * 32 + 8 * fq;
#pragma unroll
        for (int ai = 0; ai < 2; ++ai)
#pragma unroll
            for (int m = 0; m < 4; ++m) { const int row = row0 + ai * HALF + m * 16; const f32x4 q0 = *(const f32x4*)(ssq_ckv + (size_t)row * 8), q1 = *(const f32x4*)(ssq_ckv + (size_t)row * 8 + 4);
                const float ssum = ((q0[0] + q0[1]) + (q0[2] + q0[3])) + ((q1[0] + q1[1]) + (q1[2] + q1[3])); const float sc = 1.f / sqrtf(ssum * (1.f / 512.f) + 1e-6f);
                *(unsigned long long*)(kn + (size_t)row * 2048 + cw) = pack8_fp8(acc[ai][0][m][0] * sc, acc[ai][0][m][1] * sc);
                *(u32x4*)(v + (size_t)row * 2048 + cw) = pack8(acc[ai][1][m][0] * sc, acc[ai][1][m][1] * sc); }
    }
};

struct EpiO {
    static constexpr bool PERM = true, AFTER_DRAIN = false;
    const float* gate; bf16_t* dlt;
    __device__ __forceinline__ void operator()(const f32x4 (&acc)[2][2][4][2], const Unit& u, int wr, int wc, int fr, int fq) const {
        const int row0 = u.pm * BM + wr * 64 + fr, c0 = u.pn * BM + wc * 32 + 8 * fq;
        f32x4 g[2][2];
#pragma unroll
        for (int bj = 0; bj < 2; ++bj)
#pragma unroll
            for (int n = 0; n < 2; ++n) g[bj][n] = *(const f32x4*)(gate + c0 + bj * HALF + 4 * n);
#pragma unroll
        for (int ai = 0; ai < 2; ++ai)
#pragma unroll
            for (int m = 0; m < 4; ++m) { const int row = row0 + ai * HALF + m * 16;
#pragma unroll
                for (int bj = 0; bj < 2; ++bj) *(u32x4*)(dlt + (size_t)row * 4096 + c0 + bj * HALF) = pack8(g[bj][0] * acc[ai][bj][m][0], g[bj][1] * acc[ai][bj][m][1]); }
    }
};

struct EpiPQ {
    static constexpr bool PERM = true, AFTER_DRAIN = false;
    bf16_t* qp;
    __device__ __forceinline__ void operator()(const f32x4 (&acc)[2][2][4][2], const Unit& u, int wr, int wc, int fr, int fq) const {
        const int row0 = u.pm * BM + wr * 64 + fr, cw = wc * 32 + 8 * fq; bf16_t* base = qp + (size_t)u.pn * 8192 * 256;
#pragma unroll
        for (int ai = 0; ai < 2; ++ai)
#pragma unroll
            for (int m = 0; m < 4; ++m) { const int row = row0 + ai * HALF + m * 16;
#pragma unroll
                for (int bj = 0; bj < 2; ++bj) *(u32x4*)(base + (size_t)row * 256 + bj * HALF + cw) = pack8(acc[ai][bj][m][0], acc[ai][bj][m][1]); }
    }
};

struct EpiB16 {
    static constexpr bool PERM = true, AFTER_DRAIN = false;
    bf16_t* o; int ldc;
    __device__ __forceinline__ void operator()(const f32x4 (&acc)[2][2][4][2], const Unit& u, int wr, int wc, int fr, int fq) const {
        const int row0 = u.pm * BM + wr * 64 + fr, c0 = u.pn * BM + wc * 32 + 8 * fq;
#pragma unroll
        for (int ai = 0; ai < 2; ++ai)
#pragma unroll
            for (int m = 0; m < 4; ++m) { const int row = row0 + ai * HALF + m * 16;
#pragma unroll
                for (int bj = 0; bj < 2; ++bj) *(u32x4*)(o + (size_t)row * ldc + c0 + bj * HALF) = pack8(acc[ai][bj][m][0], acc[ai][bj][m][1]); }
    }
};

struct EpiF32 {
    static constexpr bool PERM = true, AFTER_DRAIN = false;
    float* o; int ldc;
    __device__ __forceinline__ void operator()(const f32x4 (&acc)[2][2][4][2], const Unit& u, int wr, int wc, int fr, int fq) const {
        const int row0 = u.pm * BM + wr * 64 + fr, c0 = u.pn * BM + wc * 32 + 8 * fq;
#pragma unroll
        for (int ai = 0; ai < 2; ++ai)
#pragma unroll
            for (int m = 0; m < 4; ++m) { const int row = row0 + ai * HALF + m * 16;
#pragma unroll
                for (int bj = 0; bj < 2; ++bj)
#pragma unroll
                    for (int n = 0; n < 2; ++n) *(f32x4*)(o + (size_t)row * ldc + c0 + bj * HALF + 4 * n) = acc[ai][bj][m][n]; }
    }
};

struct OrderIn : StaticOrder {
    __device__ bool next(int i, Unit& u) const {
        const long L = (long)i * G + c;
        if (L < nwg) return StaticOrder::next(i, u);
        if (L < nwg + 3) { u.pm = 32; u.pn = 3 + (int)(L - nwg); return true; }
        return false;
    }
};

struct RunOrder {
    int base, cnt, nN;
    __device__ bool next(int i, Unit& u) const { if (i >= cnt) return false; const int idx = base + i; u.pm = idx / nN; u.pn = idx % nN; return true; }
    __device__ __forceinline__ void a_ready(const Unit&) const {}
    __device__ __forceinline__ void done(const Unit&) const {}
};
template <class Epi, class Sched, bool ALIGN_EPI = false, bool SP2 = false>
__device__ __forceinline__ void gemm_phase(PG8_LAS unsigned char* lds, const Gemm g, const Sched& S, const Epi& E) {
    const int tid = threadIdx.x, wid = __builtin_amdgcn_readfirstlane(tid >> 6), lane = tid & 63, wr = wid >> 2, wc = wid & 3, fr = lane & 15, fq = lane >> 4;
    const int K = g.K, nt = K / BK;
    unsigned voffA[2], voffB[2];
#pragma unroll
    for (int i = 0; i < 2; ++i) { int R, C; stage_rc(tid * 16 + i * 8192, R, C); const int Rb = Epi::PERM ? ((R & ~31) + perm32(R & 31)) : R;
        voffA[i] = (unsigned)(R * K + C) * 2u; voffB[i] = (unsigned)(Rb * K + C) * 2u; }
    const size_t kstep = (size_t)(BK * 2);
    const size_t hstep = (size_t)HALF * K * 2;
    const size_t tstep = 2 * hstep;
    const unsigned ldsw = (unsigned)wid * 1024u;
    const int aoff = lds_byte(wr * 64 + fr, fq * 8), boff = lds_byte(wc * 32 + fr, fq * 8);
#define PG8_SA(b, h) (((b) * 2 + (h)) * HTB)
#define PG8_SB(b, h) ((4 + (b) * 2 + (h)) * HTB)
#define PG8_STAGE(bufoff, gbase, voff) do { _Pragma("unroll") for (int _i = 0; _i < 2; ++_i) \
        __builtin_amdgcn_global_load_lds((const unsigned*)((const char*)(gbase) + (voff)[_i]), (PG8_LAS unsigned*)(lds + (bufoff) + ldsw + _i * 8192), 16, 0, 0); } while (0)
#define PG8_LDA(dst, b, h) do { _Pragma("unroll") for (int m = 0; m < 4; ++m) _Pragma("unroll") for (int k = 0; k < 2; ++k) dst[m][k] = *(const PG8_LAS bf16x8*)(lds + PG8_SA(b, h) + aoff + m * 2048 + k * 1024); } while (0)
#define PG8_LDB(dst, b, h) do { _Pragma("unroll") for (int n = 0; n < 2; ++n) _Pragma("unroll") for (int k = 0; k < 2; ++k) dst[n][k] = *(const PG8_LAS bf16x8*)(lds + PG8_SB(b, h) + boff + n * 2048 + k * 1024); } while (0)
#define PG8_MMA(ai, bj, At, Bt) do { __builtin_amdgcn_s_setprio(1); _Pragma("unroll") for (int m = 0; m < 4; ++m) _Pragma("unroll") for (int n = 0; n < 2; ++n) _Pragma("unroll") for (int k = 0; k < 2; ++k) \
        acc[ai][bj][m][n] = __builtin_amdgcn_mfma_f32_16x16x32_bf16(Bt[n][k], At[m][k], acc[ai][bj][m][n], 0, 0, 0); __builtin_amdgcn_s_setprio(0); } while (0)
#define PG8_WAIT_V(n) asm volatile("s_waitcnt vmcnt(" #n ")" ::: "memory")
#define PG8_WAIT_L(n) asm volatile("s_waitcnt lgkmcnt(" #n ")" ::: "memory")
#define PG8_BAR __builtin_amdgcn_s_barrier()
#define PG8_SCHED __builtin_amdgcn_sched_barrier(0)
    Unit cur, nxt; int ui = 0;
    if (!S.next(0, cur)) return;
    f32x4 acc[2][2][4][2];
#pragma unroll
    for (int a = 0; a < 2; ++a)
#pragma unroll
        for (int b = 0; b < 2; ++b)
#pragma unroll
            for (int m = 0; m < 4; ++m)
#pragma unroll
                for (int n = 0; n < 2; ++n) acc[a][b][m][n] = (f32x4){0.f, 0.f, 0.f, 0.f};
    bf16x8 At[4][2], B0[2][2], B1[2][2];
    const char* cA = (const char*)g.A + (size_t)cur.pm * tstep + (size_t)cur.pn * g.a_pn; const char* cB = (const char*)g.Bt + (size_t)cur.pn * tstep + (size_t)cur.pm * g.b_pm;
    S.a_ready(cur);
    if constexpr (SP2) {
        PG8_STAGE(PG8_SB(0, 0), cB, voffB); PG8_STAGE(PG8_SB(0, 1), cB + hstep, voffB); PG8_STAGE(PG8_SA(0, 0), cA, voffA); PG8_STAGE(PG8_SA(0, 1), cA + hstep, voffA);
        if (wr == 1) PG8_BAR;
        PG8_WAIT_V(2); PG8_BAR;
        PG8_STAGE(PG8_SB(1, 0), cB + kstep, voffB); PG8_STAGE(PG8_SA(1, 0), cA + kstep, voffA); PG8_STAGE(PG8_SB(1, 1), cB + hstep + kstep, voffB);
        PG8_WAIT_V(6); PG8_BAR;
    } else {
        PG8_STAGE(PG8_SB(0, 0), cB, voffB); PG8_STAGE(PG8_SA(0, 0), cA, voffA); PG8_STAGE(PG8_SB(0, 1), cB + hstep, voffB); PG8_STAGE(PG8_SA(0, 1), cA + hstep, voffA);
        if (wr == 1) PG8_BAR;
        PG8_WAIT_V(4); PG8_BAR;
        PG8_STAGE(PG8_SB(1, 0), cB + kstep, voffB); PG8_STAGE(PG8_SA(1, 0), cA + kstep, voffA); PG8_STAGE(PG8_SB(1, 1), cB + hstep + kstep, voffB);
        PG8_WAIT_V(6); PG8_BAR;
    }
    for (;;) {
        const bool has_next = S.next(ui + 1, nxt);
        const char* nA = has_next ? (const char*)g.A + (size_t)nxt.pm * tstep + (size_t)nxt.pn * g.a_pn : cA; const char* nB = has_next ? (const char*)g.Bt + (size_t)nxt.pn * tstep + (size_t)nxt.pm * g.b_pm : cB;
        for (int t = 0; t < nt; t += 2) {
            const bool last = (t == nt - 2);
            const char* a1 = cA + (size_t)(t + 1) * kstep;
            const char* a2 = last ? nA : cA + (size_t)(t + 2) * kstep; const char* b2 = last ? nB : cB + (size_t)(t + 2) * kstep;
            const char* a3 = a2 + kstep; const char* b3 = b2 + kstep;
            if (last && has_next) S.a_ready(nxt);
            if constexpr (SP2) {
            PG8_LDB(B0, 0, 0); PG8_LDB(B1, 0, 1); PG8_SCHED; PG8_LDA(At, 0, 0); PG8_STAGE(PG8_SA(1, 1), a1 + hstep, voffA);
            PG8_WAIT_V(8); PG8_WAIT_L(0); PG8_BAR; PG8_MMA(0, 0, At, B0); PG8_MMA(0, 1, At, B1); PG8_BAR; PG8_SCHED;
            PG8_LDA(At, 0, 1); PG8_STAGE(PG8_SB(0, 0), b2, voffB); PG8_STAGE(PG8_SB(0, 1), b2 + hstep, voffB); PG8_STAGE(PG8_SA(0, 0), a2, voffA);
            PG8_WAIT_V(8); PG8_WAIT_L(0); PG8_BAR; PG8_MMA(1, 0, At, B0); PG8_MMA(1, 1, At, B1); PG8_BAR; PG8_SCHED;
            PG8_LDB(B0, 1, 0); PG8_LDB(B1, 1, 1); PG8_SCHED; PG8_LDA(At, 1, 0); PG8_STAGE(PG8_SA(0, 1), a2 + hstep, voffA);
            PG8_WAIT_V(8); PG8_WAIT_L(0); PG8_BAR; PG8_MMA(0, 0, At, B0); PG8_MMA(0, 1, At, B1); PG8_BAR; PG8_SCHED;
            PG8_LDA(At, 1, 1); PG8_STAGE(PG8_SB(1, 0), b3, voffB); PG8_STAGE(PG8_SB(1, 1), b3 + hstep, voffB); PG8_STAGE(PG8_SA(1, 0), a3, voffA);
            PG8_WAIT_V(8); PG8_WAIT_L(0); PG8_BAR; PG8_MMA(1, 0, At, B0); PG8_MMA(1, 1, At, B1); PG8_BAR; PG8_SCHED;
            } else {
            PG8_LDB(B0, 0, 0); PG8_SCHED; PG8_LDA(At, 0, 0); PG8_STAGE(PG8_SA(1, 1), a1 + hstep, voffA);
            PG8_WAIT_L(8); PG8_BAR; PG8_WAIT_L(0); PG8_MMA(0, 0, At, B0); PG8_BAR; PG8_SCHED;
            PG8_LDB(B1, 0, 1); PG8_STAGE(PG8_SB(0, 0), b2, voffB);
            PG8_BAR; PG8_WAIT_L(0); PG8_MMA(0, 1, At, B1); PG8_BAR;
            PG8_LDA(At, 0, 1); PG8_STAGE(PG8_SA(0, 0), a2, voffA);
            PG8_BAR; PG8_WAIT_L(0); PG8_MMA(1, 0, At, B0); PG8_BAR; PG8_SCHED;
            PG8_STAGE(PG8_SB(0, 1), b2 + hstep, voffB);
            PG8_WAIT_V(6); PG8_BAR; PG8_MMA(1, 1, At, B1); PG8_BAR;
            PG8_LDB(B0, 1, 0); PG8_SCHED; PG8_LDA(At, 1, 0); PG8_STAGE(PG8_SA(0, 1), a2 + hstep, voffA);
            PG8_WAIT_L(8); PG8_BAR; PG8_WAIT_L(0); PG8_MMA(0, 0, At, B0); PG8_BAR; PG8_SCHED;
            PG8_LDB(B1, 1, 1); PG8_STAGE(PG8_SB(1, 0), b3, voffB);
            PG8_BAR; PG8_WAIT_L(0); PG8_MMA(0, 1, At, B1); PG8_BAR;
            PG8_LDA(At, 1, 1); PG8_STAGE(PG8_SA(1, 0), a3, voffA);
            PG8_BAR; PG8_WAIT_L(0); PG8_MMA(1, 0, At, B0); PG8_BAR; PG8_SCHED;
            PG8_STAGE(PG8_SB(1, 1), b3 + hstep, voffB);
            PG8_WAIT_V(6); PG8_BAR; PG8_MMA(1, 1, At, B1); PG8_BAR;
            }
        }
        if constexpr (ALIGN_EPI) { if (wr == 0) PG8_BAR; }
        if constexpr (!Epi::AFTER_DRAIN) { E(acc, cur, wr, wc, fr, fq); S.done(cur); }
        if (!has_next) break;
#pragma unroll
        for (int a = 0; a < 2; ++a)
#pragma unroll
            for (int b = 0; b < 2; ++b)
#pragma unroll
                for (int m = 0; m < 4; ++m)
#pragma unroll
                    for (int n = 0; n < 2; ++n) acc[a][b][m][n] = (f32x4){0.f, 0.f, 0.f, 0.f};
        cur = nxt; cA = nA; cB = nB; ++ui;
        if constexpr (ALIGN_EPI) { if (wr == 1) PG8_BAR; }
    }
    PG8_WAIT_V(0);
    if constexpr (!ALIGN_EPI) { if (wr == 0) PG8_BAR; }
    PG8_BAR;
    if constexpr (Epi::AFTER_DRAIN) { E.fused(acc, cur, wr, wc, fr, fq, lds, wid, lane); S.done(cur); }
#undef PG8_SA
#undef PG8_SB
#undef PG8_STAGE
#undef PG8_LDA
#undef PG8_LDB
#undef PG8_MMA
#undef PG8_WAIT_V
#undef PG8_WAIT_L
#undef PG8_BAR
#undef PG8_SCHED
}
}

namespace att {
using bf16x8 = __attribute__((ext_vector_type(8))) short;
using s16x4  = __attribute__((ext_vector_type(4))) short;
using f32x16 = __attribute__((ext_vector_type(16))) float;
using u32x4  = __attribute__((ext_vector_type(4))) unsigned;
typedef unsigned short bf16;
constexpr int NW = 8, QBLK = 32, KVBLK = 64;
#ifndef ATT_SDEPTH
#define ATT_SDEPTH 1
#endif
constexpr int SDEPTH = ATT_SDEPTH;
#ifndef QKT_GRP
#define QKT_GRP 4
#endif
constexpr int LDQ = 3072, LDKV = 2048, LDKR = 64, LDO = 4096;
constexpr int SHM_V = 16384, SHM_KN = 8192, SHM_KR = 4096;
constexpr float QSC = 64.f, QSI = 1.f / 64.f;
constexpr int NSLOT = 3, OFF_V = 0, OFF_KN = NSLOT * SHM_V, OFF_KR = OFF_KN + NSLOT * SHM_KN, OFF_WS = OFF_KR + NSLOT * SHM_KR, SHM_ATTN = OFF_WS + NW * 64 * 4;
#define ALDS __attribute__((address_space(3)))
constexpr float THRL = 8.f * 1.4426950408889634f * 64.f;
#define KSWZ(row, colB) ((row) * 256 + ((colB) ^ (((row) & 15) << 4)))
#define RSWZ(row, colB) ((row) * 128 + ((colB) ^ ((((row) >> 1) & 7) << 4)))
#define SBAR() __builtin_amdgcn_sched_barrier(0)
__device__ __forceinline__ int crow(int r, int hi) { return (r & 3) + 8 * (r >> 2) + 4 * hi; }
__device__ __forceinline__ unsigned cvtpk(float lo, float hi) { unsigned r; asm volatile("v_cvt_pk_bf16_f32 %0, %1, %2" : "=v"(r) : "v"(lo), "v"(hi)); return r; }

__device__ __forceinline__ void partialSM(f32x16& p0, f32x16& p1, float& m_reg, float& mn, float& alpha) {
  float pmax = p0[0];
#pragma unroll
  for (int r = 1; r < 16; ++r) pmax = fmaxf(pmax, p0[r]);
#pragma unroll
  for (int r = 0; r < 16; ++r) pmax = fmaxf(pmax, p1[r]);
  { auto rr = __builtin_amdgcn_permlane32_swap(__float_as_uint(pmax), __float_as_uint(pmax), false, false);
    pmax = fmaxf(__uint_as_float(rr[0]), __uint_as_float(rr[1])); }
  if (__builtin_expect(__all(pmax - m_reg <= THRL), 1)) { mn = m_reg; alpha = 1.f; }
  else { mn = fmaxf(m_reg, pmax); alpha = __builtin_amdgcn_exp2f((m_reg - mn) * QSI); m_reg = mn; }
  const float mnq = -mn * QSI;
#pragma unroll
  for (int r = 0; r < 16; ++r) p0[r] = fmaf(p0[r], QSI, mnq);
#pragma unroll
  for (int r = 0; r < 16; ++r) p1[r] = fmaf(p1[r], QSI, mnq);
#pragma unroll
  for (int r = 0; r < 16; ++r) p0[r] = __builtin_amdgcn_exp2f(p0[r]);
}
__device__ __forceinline__ void finishSM(f32x16& p0, f32x16& p1, float alpha, float& l_reg, bf16x8& pa0, bf16x8& pa1, bf16x8& pa2, bf16x8& pa3) {
#pragma unroll
  for (int r = 0; r < 16; ++r) p1[r] = __builtin_amdgcn_exp2f(p1[r]);
  float ps = 0;
#pragma unroll
  for (int r = 0; r < 16; ++r) ps += p0[r];
#pragma unroll
  for (int r = 0; r < 16; ++r) ps += p1[r];
  { auto rr = __builtin_amdgcn_permlane32_swap(__float_as_uint(ps), __float_as_uint(ps), false, false);
    ps = __uint_as_float(rr[0]) + __uint_as_float(rr[1]); }
  l_reg = l_reg * alpha + ps;
#define PK4(P, BASE, OUT) do { unsigned a0 = cvtpk(P[BASE + 0], P[BASE + 1]), a1 = cvtpk(P[BASE + 2], P[BASE + 3]);   \
    unsigned b0 = cvtpk(P[BASE + 4], P[BASE + 5]), b1 = cvtpk(P[BASE + 6], P[BASE + 7]);                              \
    auto r0 = __builtin_amdgcn_permlane32_swap(a0, b0, false, false); auto r1 = __builtin_amdgcn_permlane32_swap(a1, b1, false, false); \
    u32x4 w = {r0[0], r1[0], r0[1], r1[1]}; OUT = *reinterpret_cast<bf16x8*>(&w); } while (0)
  PK4(p0, 0, pa0); PK4(p0, 8, pa1); PK4(p1, 0, pa2); PK4(p1, 8, pa3);
#undef PK4
}
#ifndef QKT_PF
#define QKT_PF 0
#endif
#if QKT_PF == 0
__device__ __forceinline__ void qkt(f32x16& p0, f32x16& p1, const char* Kn, const char* Kr, const bf16x8* qr, const char* Qr, int r32, int hi) {
  p0 = f32x16{}; p1 = f32x16{};
#pragma unroll
  for (int d0 = 0; d0 < 8; ++d0) { const int cb = (d0 * 16 + hi * 8) * 2;
    bf16x8 b0 = *reinterpret_cast<const bf16x8*>(Kn + KSWZ(r32, cb));
    bf16x8 b1 = *reinterpret_cast<const bf16x8*>(Kn + KSWZ(32 + r32, cb));
    p0 = __builtin_amdgcn_mfma_f32_32x32x16_bf16(b0, qr[d0], p0, 0, 0, 0);
    p1 = __builtin_amdgcn_mfma_f32_32x32x16_bf16(b1, qr[d0], p1, 0, 0, 0);
    if ((d0 & (QKT_GRP - 1)) == QKT_GRP - 1) SBAR(); }
#pragma unroll
  for (int d0 = 0; d0 < 4; ++d0) { const int cb = (d0 * 16 + hi * 8) * 2;
    bf16x8 b0 = *reinterpret_cast<const bf16x8*>(Kr + RSWZ(r32, cb));
    bf16x8 b1 = *reinterpret_cast<const bf16x8*>(Kr + RSWZ(32 + r32, cb));
    const bf16x8 qf = qr[8 + d0];
    p0 = __builtin_amdgcn_mfma_f32_32x32x16_bf16(b0, qf, p0, 0, 0, 0);
    p1 = __builtin_amdgcn_mfma_f32_32x32x16_bf16(b1, qf, p1, 0, 0, 0);
    if ((d0 & (QKT_GRP - 1)) == QKT_GRP - 1) SBAR(); }
}
#else
__device__ __forceinline__ void qkt(f32x16& p0, f32x16& p1, const char* Kn, const char* Kr, const bf16x8* qr, const char* Qr, int r32, int hi) {
  p0 = f32x16{}; p1 = f32x16{};
  constexpr int NB = QKT_PF + 1;
  bf16x8 kb0[NB], kb1[NB], qf[NB];
#define KLD(S) do { constexpr int s_ = (S), i_ = s_ % NB; if constexpr (s_ < 8) { const int cb = (s_ * 16 + hi * 8) * 2; kb0[i_] = *reinterpret_cast<const bf16x8*>(Kn + KSWZ(r32, cb)); kb1[i_] = *reinterpret_cast<const bf16x8*>(Kn + KSWZ(32 + r32, cb)); } \
    else { const int cb = ((s_ - 8) * 16 + hi * 8) * 2; kb0[i_] = *reinterpret_cast<const bf16x8*>(Kr + RSWZ(r32, cb)); kb1[i_] = *reinterpret_cast<const bf16x8*>(Kr + RSWZ(32 + r32, cb)); qf[i_] = *reinterpret_cast<const bf16x8*>(Qr + (s_ - 8) * 1024); } } while (0)
#define KSTEP(S) do { constexpr int s_ = (S), i_ = s_ % NB; if constexpr (s_ + QKT_PF < 12) KLD(S + QKT_PF); const bf16x8 q_ = s_ < 8 ? qr[s_ < 8 ? s_ : 0] : qf[i_]; \
    p0 = __builtin_amdgcn_mfma_f32_32x32x16_bf16(kb0[i_], q_, p0, 0, 0, 0); p1 = __builtin_amdgcn_mfma_f32_32x32x16_bf16(kb1[i_], q_, p1, 0, 0, 0); } while (0)
  KLD(0); if constexpr (QKT_PF >= 2) KLD(1);
  KSTEP(0); KSTEP(1); KSTEP(2); KSTEP(3); KSTEP(4); KSTEP(5); KSTEP(6); KSTEP(7); KSTEP(8); KSTEP(9); KSTEP(10); KSTEP(11);
#undef KLD
#undef KSTEP
}
#endif
__device__ __forceinline__ int v_st(int k, int c) { const int kk = (k & ~0xC) | ((k & 4) << 1) | ((k & 8) >> 1); return ((kk >> 3) * 4 + (c >> 5)) * 512 + ((kk & 7) * 32 + (c & 31)) * 2; }
__device__ __forceinline__ int v_rd_base(int lane) { return ((lane & 3) << 3) | (((lane >> 2) & 3) << 6) | (((lane >> 4) & 1) << 5) | (((lane >> 5) & 1) << 8); }
constexpr int v_rd_off(int d0, int ks, int half) { return d0 * 512 + ks * 4096 + half * 2048; }
template <int OFF> __device__ __forceinline__ s16x4 tr_read(int vb) {
  s16x4 r; asm volatile("ds_read_b64_tr_b16 %0, %1 offset:%2" : "=&v"(r) : "v"(vb), "i"(OFF) : "memory"); return r;
}
template <int D0> __device__ __forceinline__ void pv_one(f32x16& od, int vb, bf16x8 pa0, bf16x8 pa1, bf16x8 pa2, bf16x8 pa3) {
  const s16x4 l0 = tr_read<v_rd_off(D0, 0, 0)>(vb), h0 = tr_read<v_rd_off(D0, 0, 1)>(vb), l1 = tr_read<v_rd_off(D0, 1, 0)>(vb), h1 = tr_read<v_rd_off(D0, 1, 1)>(vb);
  const s16x4 l2 = tr_read<v_rd_off(D0, 2, 0)>(vb), h2 = tr_read<v_rd_off(D0, 2, 1)>(vb), l3 = tr_read<v_rd_off(D0, 3, 0)>(vb), h3 = tr_read<v_rd_off(D0, 3, 1)>(vb);
  asm volatile("s_waitcnt lgkmcnt(0)" ::: "memory"); SBAR();
#define PK(L, H) (bf16x8){L[0], L[1], L[2], L[3], H[0], H[1], H[2], H[3]}
  od = __builtin_amdgcn_mfma_f32_32x32x16_bf16(pa0, PK(l0, h0), od, 0, 0, 0);
  od = __builtin_amdgcn_mfma_f32_32x32x16_bf16(pa1, PK(l1, h1), od, 0, 0, 0);
  od = __builtin_amdgcn_mfma_f32_32x32x16_bf16(pa2, PK(l2, h2), od, 0, 0, 0);
  od = __builtin_amdgcn_mfma_f32_32x32x16_bf16(pa3, PK(l3, h3), od, 0, 0, 0);
#undef PK
}
__device__ __forceinline__ void pv_d0(f32x16* o, int vb, bf16x8 pa0, bf16x8 pa1, bf16x8 pa2, bf16x8 pa3) {
  pv_one<0>(o[0], vb, pa0, pa1, pa2, pa3); pv_one<1>(o[1], vb, pa0, pa1, pa2, pa3); pv_one<2>(o[2], vb, pa0, pa1, pa2, pa3); pv_one<3>(o[3], vb, pa0, pa1, pa2, pa3);
}

typedef short v4i16_t __attribute__((ext_vector_type(4)));
typedef int v8i32_t __attribute__((ext_vector_type(8)));
#define PKF(L_, H_) (bf16x8){L_[0], L_[1], L_[2], L_[3], H_[0], H_[1], H_[2], H_[3]}
#define LDSR128(dst, base, OFF) asm volatile("ds_read_b128 %0, %1 offset:%2" : "=v"(dst) : "v"((unsigned)(uintptr_t)(base)), "i"(OFF) : "memory")
#define LDSRTR(dst, base, OFF) asm volatile("ds_read_b64_tr_b16 %0, %1 offset:%2" : "=v"(dst) : "v"((unsigned)(uintptr_t)(base)), "i"(OFF) : "memory")
#define WAITK4(N, A, B, C, D) asm volatile("s_waitcnt lgkmcnt(" #N ")" : "+v"(A), "+v"(B), "+v"(C), "+v"(D) :: "memory")
#define WAITV(N, VL_, VH_) asm volatile("s_waitcnt lgkmcnt(" #N ")" : "+v"(VL_[0]), "+v"(VL_[1]), "+v"(VL_[2]), "+v"(VL_[3]), "+v"(VH_[0]), "+v"(VH_[1]), "+v"(VH_[2]), "+v"(VH_[3]) :: "memory")
#define MXMFMA(KF, QF, ACC) __builtin_amdgcn_mfma_scale_f32_32x32x64_f8f6f4((v8i32_t){(int)KF[0][0], (int)KF[0][1], (int)KF[0][2], (int)KF[0][3], (int)KF[1][0], (int)KF[1][1], (int)KF[1][2], (int)KF[1][3]}, QF, ACC, 0, 0, 0, 0x7F7F7F7F, 0, 0x7F7F7F7F)
template <bool DO_QK, bool DO_PV, class IssueF>
__device__ __forceinline__ void mat_segment(const IssueF& issue, f32x16& p0, f32x16& p1, f32x16* o, const ALDS char* Kn, const ALDS char* Kr, const ALDS char* Vb, const v8i32_t* qf, bf16x8 pa0, bf16x8 pa1, bf16x8 pa2, bf16x8 pa3, int r32, int hi) {
  u32x4 ka[3][2], kb[3][2]; s16x4 vl[2][4], vh[2][4];
  const int nbase = r32 * 128, nsw = ((r32 >> 1) & 7) << 4, rbase = r32 * 64, rsw = ((r32 >> 2) & 3) << 4, hb = hi * 32;
  asm volatile("s_waitcnt lgkmcnt(0)" ::: "memory");
  if constexpr (DO_QK && DO_PV) {
  p0 = f32x16{}; p1 = f32x16{};
  { const int a_ = nbase + (((0 * 64) + hb) ^ nsw); LDSR128(ka[0][0], Kn + a_, 0); LDSR128(ka[0][1], Kn + (a_ ^ 16), 0); LDSR128(kb[0][0], Kn + a_, 4096); LDSR128(kb[0][1], Kn + (a_ ^ 16), 4096); }
  { const int a_ = nbase + (((1 * 64) + hb) ^ nsw); LDSR128(ka[1][0], Kn + a_, 0); LDSR128(ka[1][1], Kn + (a_ ^ 16), 0); LDSR128(kb[1][0], Kn + a_, 4096); LDSR128(kb[1][1], Kn + (a_ ^ 16), 4096); }
  { const int a_ = rbase + (hb ^ rsw); LDSR128(ka[2][0], Kr + a_, 0); LDSR128(ka[2][1], Kr + (a_ ^ 16), 0); LDSR128(kb[2][0], Kr + a_, 2048); LDSR128(kb[2][1], Kr + (a_ ^ 16), 2048); }
  WAITK4(8, ka[0][0], ka[0][1], kb[0][0], kb[0][1]);
  p0 = MXMFMA(ka[0], qf[0], p0); p1 = MXMFMA(kb[0], qf[0], p1);
  issue(0); issue(1);
  LDSRTR(vl[0][0], Vb, 0); LDSRTR(vh[0][0], Vb, 2048);
  LDSRTR(vl[0][1], Vb, 4096); LDSRTR(vh[0][1], Vb, 6144);
  LDSRTR(vl[0][2], Vb, 8192); LDSRTR(vh[0][2], Vb, 10240);
  LDSRTR(vl[0][3], Vb, 12288); LDSRTR(vh[0][3], Vb, 14336);
  WAITK4(12, ka[1][0], ka[1][1], kb[1][0], kb[1][1]);
  p0 = MXMFMA(ka[1], qf[1], p0); p1 = MXMFMA(kb[1], qf[1], p1);
  issue(2);
  LDSRTR(vl[1][0], Vb, 512); LDSRTR(vh[1][0], Vb, 2560);
  LDSRTR(vl[1][1], Vb, 4608); LDSRTR(vh[1][1], Vb, 6656);
  LDSRTR(vl[1][2], Vb, 8704); LDSRTR(vh[1][2], Vb, 10752);
  LDSRTR(vl[1][3], Vb, 12800); LDSRTR(vh[1][3], Vb, 14848);
  WAITK4(15, ka[2][0], ka[2][1], kb[2][0], kb[2][1]);
  p0 = MXMFMA(ka[2], qf[2], p0); p1 = MXMFMA(kb[2], qf[2], p1);
  issue(3);
  WAITV(8, vl[0], vh[0]);
  o[0] = __builtin_amdgcn_mfma_f32_32x32x16_bf16(pa0, PKF(vl[0][0], vh[0][0]), o[0], 0, 0, 0); o[0] = __builtin_amdgcn_mfma_f32_32x32x16_bf16(pa1, PKF(vl[0][1], vh[0][1]), o[0], 0, 0, 0);
  o[0] = __builtin_amdgcn_mfma_f32_32x32x16_bf16(pa2, PKF(vl[0][2], vh[0][2]), o[0], 0, 0, 0); o[0] = __builtin_amdgcn_mfma_f32_32x32x16_bf16(pa3, PKF(vl[0][3], vh[0][3]), o[0], 0, 0, 0);
  LDSRTR(vl[0][0], Vb, 1024); LDSRTR(vh[0][0], Vb, 3072);
  LDSRTR(vl[0][1], Vb, 5120); LDSRTR(vh[0][1], Vb, 7168);
  LDSRTR(vl[0][2], Vb, 9216); LDSRTR(vh[0][2], Vb, 11264);
  LDSRTR(vl[0][3], Vb, 13312); LDSRTR(vh[0][3], Vb, 15360);
  WAITV(8, vl[1], vh[1]);
  o[1] = __builtin_amdgcn_mfma_f32_32x32x16_bf16(pa0, PKF(vl[1][0], vh[1][0]), o[1], 0, 0, 0); o[1] = __builtin_amdgcn_mfma_f32_32x32x16_bf16(pa1, PKF(vl[1][1], vh[1][1]), o[1], 0, 0, 0);
  o[1] = __builtin_amdgcn_mfma_f32_32x32x16_bf16(pa2, PKF(vl[1][2], vh[1][2]), o[1], 0, 0, 0); o[1] = __builtin_amdgcn_mfma_f32_32x32x16_bf16(pa3, PKF(vl[1][3], vh[1][3]), o[1], 0, 0, 0);
  LDSRTR(vl[1][0], Vb, 1536); LDSRTR(vh[1][0], Vb, 3584);
  LDSRTR(vl[1][1], Vb, 5632); LDSRTR(vh[1][1], Vb, 7680);
  LDSRTR(vl[1][2], Vb, 9728); LDSRTR(vh[1][2], Vb, 11776);
  LDSRTR(vl[1][3], Vb, 13824); LDSRTR(vh[1][3], Vb, 15872);
  WAITV(8, vl[0], vh[0]);
  o[2] = __builtin_amdgcn_mfma_f32_32x32x16_bf16(pa0, PKF(vl[0][0], vh[0][0]), o[2], 0, 0, 0); o[2] = __builtin_amdgcn_mfma_f32_32x32x16_bf16(pa1, PKF(vl[0][1], vh[0][1]), o[2], 0, 0, 0);
  o[2] = __builtin_amdgcn_mfma_f32_32x32x16_bf16(pa2, PKF(vl[0][2], vh[0][2]), o[2], 0, 0, 0); o[2] = __builtin_amdgcn_mfma_f32_32x32x16_bf16(pa3, PKF(vl[0][3], vh[0][3]), o[2], 0, 0, 0);
  WAITV(0, vl[1], vh[1]);
  o[3] = __builtin_amdgcn_mfma_f32_32x32x16_bf16(pa0, PKF(vl[1][0], vh[1][0]), o[3], 0, 0, 0); o[3] = __builtin_amdgcn_mfma_f32_32x32x16_bf16(pa1, PKF(vl[1][1], vh[1][1]), o[3], 0, 0, 0);
  o[3] = __builtin_amdgcn_mfma_f32_32x32x16_bf16(pa2, PKF(vl[1][2], vh[1][2]), o[3], 0, 0, 0); o[3] = __builtin_amdgcn_mfma_f32_32x32x16_bf16(pa3, PKF(vl[1][3], vh[1][3]), o[3], 0, 0, 0);
  } else if constexpr (DO_QK) {
  p0 = f32x16{}; p1 = f32x16{};
  { const int a_ = nbase + (((0 * 64) + hb) ^ nsw); LDSR128(ka[0][0], Kn + a_, 0); LDSR128(ka[0][1], Kn + (a_ ^ 16), 0); LDSR128(kb[0][0], Kn + a_, 4096); LDSR128(kb[0][1], Kn + (a_ ^ 16), 4096); }
  { const int a_ = nbase + (((1 * 64) + hb) ^ nsw); LDSR128(ka[1][0], Kn + a_, 0); LDSR128(ka[1][1], Kn + (a_ ^ 16), 0); LDSR128(kb[1][0], Kn + a_, 4096); LDSR128(kb[1][1], Kn + (a_ ^ 16), 4096); }
  { const int a_ = rbase + (hb ^ rsw); LDSR128(ka[2][0], Kr + a_, 0); LDSR128(ka[2][1], Kr + (a_ ^ 16), 0); LDSR128(kb[2][0], Kr + a_, 2048); LDSR128(kb[2][1], Kr + (a_ ^ 16), 2048); }
  WAITK4(8, ka[0][0], ka[0][1], kb[0][0], kb[0][1]);
  p0 = MXMFMA(ka[0], qf[0], p0); p1 = MXMFMA(kb[0], qf[0], p1);
  issue(0); issue(1);
  WAITK4(4, ka[1][0], ka[1][1], kb[1][0], kb[1][1]);
  p0 = MXMFMA(ka[1], qf[1], p0); p1 = MXMFMA(kb[1], qf[1], p1);
  issue(2);
  WAITK4(0, ka[2][0], ka[2][1], kb[2][0], kb[2][1]);
  p0 = MXMFMA(ka[2], qf[2], p0); p1 = MXMFMA(kb[2], qf[2], p1);
  issue(3);
  } else {
  LDSRTR(vl[0][0], Vb, 0); LDSRTR(vh[0][0], Vb, 2048);
  LDSRTR(vl[0][1], Vb, 4096); LDSRTR(vh[0][1], Vb, 6144);
  LDSRTR(vl[0][2], Vb, 8192); LDSRTR(vh[0][2], Vb, 10240);
  LDSRTR(vl[0][3], Vb, 12288); LDSRTR(vh[0][3], Vb, 14336);
  LDSRTR(vl[1][0], Vb, 512); LDSRTR(vh[1][0], Vb, 2560);
  LDSRTR(vl[1][1], Vb, 4608); LDSRTR(vh[1][1], Vb, 6656);
  LDSRTR(vl[1][2], Vb, 8704); LDSRTR(vh[1][2], Vb, 10752);
  LDSRTR(vl[1][3], Vb, 12800); LDSRTR(vh[1][3], Vb, 14848);
  WAITV(8, vl[0], vh[0]);
  o[0] = __builtin_amdgcn_mfma_f32_32x32x16_bf16(pa0, PKF(vl[0][0], vh[0][0]), o[0], 0, 0, 0); o[0] = __builtin_amdgcn_mfma_f32_32x32x16_bf16(pa1, PKF(vl[0][1], vh[0][1]), o[0], 0, 0, 0);
  o[0] = __builtin_amdgcn_mfma_f32_32x32x16_bf16(pa2, PKF(vl[0][2], vh[0][2]), o[0], 0, 0, 0); o[0] = __builtin_amdgcn_mfma_f32_32x32x16_bf16(pa3, PKF(vl[0][3], vh[0][3]), o[0], 0, 0, 0);
  LDSRTR(vl[0][0], Vb, 1024); LDSRTR(vh[0][0], Vb, 3072);
  LDSRTR(vl[0][1], Vb, 5120); LDSRTR(vh[0][1], Vb, 7168);
  LDSRTR(vl[0][2], Vb, 9216); LDSRTR(vh[0][2], Vb, 11264);
  LDSRTR(vl[0][3], Vb, 13312); LDSRTR(vh[0][3], Vb, 15360);
  WAITV(8, vl[1], vh[1]);
  o[1] = __builtin_amdgcn_mfma_f32_32x32x16_bf16(pa0, PKF(vl[1][0], vh[1][0]), o[1], 0, 0, 0); o[1] = __builtin_amdgcn_mfma_f32_32x32x16_bf16(pa1, PKF(vl[1][1], vh[1][1]), o[1], 0, 0, 0);
  o[1] = __builtin_amdgcn_mfma_f32_32x32x16_bf16(pa2, PKF(vl[1][2], vh[1][2]), o[1], 0, 0, 0); o[1] = __builtin_amdgcn_mfma_f32_32x32x16_bf16(pa3, PKF(vl[1][3], vh[1][3]), o[1], 0, 0, 0);
  LDSRTR(vl[1][0], Vb, 1536); LDSRTR(vh[1][0], Vb, 3584);
  LDSRTR(vl[1][1], Vb, 5632); LDSRTR(vh[1][1], Vb, 7680);
  LDSRTR(vl[1][2], Vb, 9728); LDSRTR(vh[1][2], Vb, 11776);
  LDSRTR(vl[1][3], Vb, 13824); LDSRTR(vh[1][3], Vb, 15872);
  WAITV(8, vl[0], vh[0]);
  o[2] = __builtin_amdgcn_mfma_f32_32x32x16_bf16(pa0, PKF(vl[0][0], vh[0][0]), o[2], 0, 0, 0); o[2] = __builtin_amdgcn_mfma_f32_32x32x16_bf16(pa1, PKF(vl[0][1], vh[0][1]), o[2], 0, 0, 0);
  o[2] = __builtin_amdgcn_mfma_f32_32x32x16_bf16(pa2, PKF(vl[0][2], vh[0][2]), o[2], 0, 0, 0); o[2] = __builtin_amdgcn_mfma_f32_32x32x16_bf16(pa3, PKF(vl[0][3], vh[0][3]), o[2], 0, 0, 0);
  WAITV(0, vl[1], vh[1]);
  o[3] = __builtin_amdgcn_mfma_f32_32x32x16_bf16(pa0, PKF(vl[1][0], vh[1][0]), o[3], 0, 0, 0); o[3] = __builtin_amdgcn_mfma_f32_32x32x16_bf16(pa1, PKF(vl[1][1], vh[1][1]), o[3], 0, 0, 0);
  o[3] = __builtin_amdgcn_mfma_f32_32x32x16_bf16(pa2, PKF(vl[1][2], vh[1][2]), o[3], 0, 0, 0); o[3] = __builtin_amdgcn_mfma_f32_32x32x16_bf16(pa3, PKF(vl[1][3], vh[1][3]), o[3], 0, 0, 0);
  }
}

#define ATT_BAR() do { asm volatile("" ::: "memory"); __builtin_amdgcn_s_barrier(); asm volatile("" ::: "memory"); } while (0)
#define ATT_VM(N) asm volatile("s_waitcnt vmcnt(" #N ")" ::: "memory")
__device__ __forceinline__ void glds16(const bf16* g, ALDS unsigned char* l) { __builtin_amdgcn_global_load_lds((const unsigned*)g, (ALDS unsigned*)l, 16, 0, 0); }
__device__ __forceinline__ void glds8(const unsigned char* g, ALDS unsigned char* l) { __builtin_amdgcn_global_load_lds((const unsigned*)g, (ALDS unsigned*)l, 16, 0, 0); }
__device__ __forceinline__ void attn_unit(const unsigned char* __restrict__ Qb, const unsigned char* __restrict__ Knh, const bf16* __restrict__ Vh, const unsigned char* __restrict__ Krb,
                                          bf16* __restrict__ Ob, int seq, char* lds, ALDS unsigned char* L, const int probe) {
  int tid_ = threadIdx.x; asm volatile("" : "+v"(tid_));
  const int tid = tid_, wid = __builtin_amdgcn_readfirstlane(tid >> 6), lane = tid & 63, r32 = lane & 31, hi = lane >> 5;
  const bool trail = wid >= 4;
  float* ws = (float*)(lds + OFF_WS) + wid * 64; float* li_l = ws; float* al_l = ws + 32;
  float m_reg = -1e30f, l_reg = 0; f32x16 o[4] = {}; v8i32_t qf[3];
  const unsigned char* Qw = Qb + (long)(wid * QBLK + r32) * LDQ + hi * 32;
#pragma unroll
  for (int s_ = 0; s_ < 3; ++s_) { const u32x4 a0 = *reinterpret_cast<const u32x4*>(Qw + s_ * 64), a1 = *reinterpret_cast<const u32x4*>(Qw + s_ * 64 + 16);
    qf[s_] = (v8i32_t){(int)a0[0], (int)a0[1], (int)a0[2], (int)a0[3], (int)a1[0], (int)a1[1], (int)a1[2], (int)a1[3]}; }
#define VOFF(i) ([&]() { const int st = 2 * (2 * wid + (i)) + (lane >> 5), kk = (st >> 2) * 8 + ((lane & 31) >> 2), k = (kk & ~0xC) | ((kk & 4) << 1) | ((kk & 8) >> 1), c = (st & 3) * 32 + (lane & 3) * 8; return k * LDKV + c; }())
#define KOFF() ([&]() { const int row = wid * 8 + (lane >> 3), colB = ((lane & 7) * 16) ^ (((row >> 1) & 7) << 4); return row * LDKV + colB; }())
#define ROFF() ([&]() { const int row = wid * 16 + (lane >> 2), colB = ((lane & 3) * 16) ^ (((row >> 2) & 3) << 4); return row * LDKR + colB; }())
  const ALDS char* KL = (const ALDS char*)L + OFF_KN; const ALDS char* RL = (const ALDS char*)L + OFF_KR; const ALDS char* VL = (const ALDS char*)L + OFF_V + v_rd_base(lane);
#define ISSUE_K(t, s) do { const long kb_ = (long)(t) * KVBLK; const int s_ = (s); \
    glds8(Knh + kb_ * LDKV + KOFF(), L + OFF_KN + s_ * SHM_KN + wid * 1024); if (wid < 4) glds8(Krb + kb_ * LDKR + ROFF(), L + OFF_KR + s_ * SHM_KR + wid * 1024); } while (0)
#define ISSUE_V(t, s) do { const long kb_ = (long)(t) * KVBLK; const int s_ = (s); \
    glds16(Vh + kb_ * LDKV + VOFF(0), L + OFF_V + s_ * SHM_V + (2 * wid) * 1024); glds16(Vh + kb_ * LDKV + VOFF(1), L + OFF_V + s_ * SHM_V + (2 * wid + 1) * 1024); } while (0)
#define ISSUE_NEXT(j) do { if ((j) + 2 < NT) ISSUE_K((j) + 2, sp); if ((j) + 1 < NT) ISSUE_V((j) + 1, sn); } while (0)
#define ROT() do { const int t_ = sc; sc = sn; sn = sp; sp = t_; } while (0)
#define RESC(a) do { if (__any((a) < 1.f)) { if (hi == 0) al_l[r32] = (a); asm volatile("s_waitcnt lgkmcnt(0)" ::: "memory"); \
    _Pragma("unroll") for (int d = 0; d < 4; ++d) _Pragma("unroll") for (int r = 0; r < 16; ++r) o[d][r] *= al_l[crow(r, hi)]; } } while (0)
  f32x16 p0, p1; float mn, al; bf16x8 pa0 = {}, pa1 = {}, pa2 = {}, pa3 = {}; const int NT = seq / KVBLK;
  int sc = 0, sn = 1, sp = 2;
  ISSUE_K(0, 0); ISSUE_K(1, 1); ISSUE_V(0, 0);
  if (trail) ATT_VM(3); else ATT_VM(4);
  ATT_BAR();
  int jj = 0;
  const auto issue = [&](int step) {
    const long kb2 = (long)(jj + 2) * KVBLK, kb1 = (long)(jj + 1) * KVBLK;
    if (jj + 2 < NT) { if (step == 0) glds8(Knh + kb2 * LDKV + KOFF(), L + OFF_KN + sp * SHM_KN + wid * 1024); if (step == 1 && wid < 4) glds8(Krb + kb2 * LDKR + ROFF(), L + OFF_KR + sp * SHM_KR + wid * 1024); }
    if (jj + 1 < NT) { if (step == 2) glds16(Vh + kb1 * LDKV + VOFF(0), L + OFF_V + sn * SHM_V + (2 * wid) * 1024); if (step == 3) glds16(Vh + kb1 * LDKV + VOFF(1), L + OFF_V + sn * SHM_V + (2 * wid + 1) * 1024); } };
  const auto noissue = [](int) {};
  mat_segment<true, false>(issue, p0, p1, o, KL, RL, VL, qf, pa0, pa1, pa2, pa3, r32, hi);
  if (trail) { ATT_VM(3); ATT_BAR(); }
  partialSM(p0, p1, m_reg, mn, al); finishSM(p0, p1, al, l_reg, pa0, pa1, pa2, pa3);
  ROT();
  for (int j = 1; j < NT; ++j) {
    if (!trail) { if (j + 1 < NT) ATT_VM(4); else ATT_VM(0); ATT_BAR(); }
    jj = j;
    mat_segment<true, true>(issue, p0, p1, o, KL + sc * SHM_KN, RL + sc * SHM_KR, VL + sp * SHM_V, qf, pa0, pa1, pa2, pa3, r32, hi);
    if (trail) { if (j + 2 < NT) ATT_VM(3); else ATT_VM(0); ATT_BAR(); }
    partialSM(p0, p1, m_reg, mn, al); RESC(al); finishSM(p0, p1, al, l_reg, pa0, pa1, pa2, pa3);
    ROT();
  }
  if (!trail) { ATT_VM(0); ATT_BAR(); }
  mat_segment<false, true>(noissue, p0, p1, o, KL, RL, VL + sp * SHM_V, qf, pa0, pa1, pa2, pa3, r32, hi);
  if (hi == 0) li_l[r32] = l_reg; asm volatile("s_waitcnt lgkmcnt(0)" ::: "memory");
  float rli[16];
#pragma unroll
  for (int r = 0; r < 16; ++r) rli[r] = __builtin_amdgcn_rcpf(li_l[crow(r, hi)]);
  int lane_e = lane; asm volatile("" : "+v"(lane_e));
  bf16* Ow = Ob + (long)(wid * QBLK + 4 * (lane_e >> 5)) * LDO + (lane_e & 31);
#pragma unroll
  for (int r = 0; r < 16; ++r) { const int orow = (r & 3) + 8 * (r >> 2);
#pragma unroll
    for (int d0 = 0; d0 < 4; ++d0) { const float val = o[d0][r] * rli[r]; Ow[orow * LDO + d0 * 32] = (bf16)(cvtpk(val, val) & 0xffffu); } }
  ATT_VM(0);
  ATT_BAR();
#undef VOFF
#undef KOFF
#undef ROFF
#undef ISSUE_K
#undef ISSUE_V
#undef ISSUE_NEXT
#undef ROT
#undef RESC
}
#undef KSWZ
#undef RSWZ
}

constexpr int DM = 4096, SEQ = 8192, CTXL = 256, MR = SEQ + CTXL;
constexpr int NH = 16, QL = 768, KVL = 512, NIN = 7680, NMODC = 6 * DM;
constexpr int NEXP = 16384;
constexpr float EPS = 1e-6f;
constexpr float C2 = 0.072168783648703220f * 1.4426950408889634f;

#ifndef MK_ONE_LAUNCH
#define MK_ONE_LAUNCH 1
#endif
constexpr int NPHASE = 10;
constexpr int NWAVES = 8, NTHR = NWAVES * 64;

constexpr size_t MiB = 1u << 20;
constexpr size_t a256(size_t x) { return (x + 255) & ~(size_t)255; }
constexpr size_t WS_CTL = 0, CTL_ZERO_BYTES = 1 * MiB;
constexpr int CW_BAR = 4096;
constexpr int CW_END = CW_BAR + 3456;
static_assert((size_t)CW_END * 4 <= CTL_ZERO_BYTES, "CTL words inside the memset region");
constexpr size_t WS_MODF = 1 * MiB;
constexpr size_t WS_ROPE = WS_MODF + a256((size_t)(NMODC + 2 * DM) * 4);
constexpr size_t WS_WIN  = 2 * MiB;
constexpr size_t WS_WUQ  = WS_WIN + (size_t)NIN * DM * 2;
constexpr size_t WS_WUKV = WS_WUQ + (size_t)3072 * 768 * 2;
constexpr size_t WS_WO   = WS_WUKV + (size_t)4096 * 512 * 2;
constexpr size_t WS_WPQ  = WS_WO + (size_t)DM * DM * 2;
constexpr size_t WS_KBD  = WS_WPQ + (size_t)2048 * DM * 2;
constexpr int ROWB = 3072;
constexpr size_t WS_KB2  = WS_KBD + (size_t)2048 * DM * 2;
constexpr size_t WS_UB   = WS_KB2 + (size_t)8 * 256 * 256 * 2;
constexpr size_t WS_VB   = WS_UB + (size_t)NEXP * ROWB;
constexpr size_t WS_SU   = WS_VB + (size_t)NEXP * ROWB;
constexpr size_t WS_HX   = WS_SU + (size_t)2 * NEXP * 4;
constexpr size_t WS_CQ   = WS_HX + (size_t)MR * DM * 2;
constexpr size_t WS_CKV  = WS_CQ + (size_t)SEQ * QL * 2;
constexpr size_t WS_KR   = WS_CKV + (size_t)MR * KVL * 2;
constexpr size_t WS_U    = WS_KR + (size_t)MR * 64 * 2;
constexpr size_t WS_GB   = WS_U + (size_t)SEQ * 2048 * 2;
constexpr size_t WS_Q    = WS_GB + (size_t)SEQ * 2048 * 2;
constexpr size_t WS_KN   = WS_Q + (size_t)SEQ * 3072 * 2;
constexpr size_t WS_V    = WS_KN + (size_t)MR * 2048 * 2;
constexpr size_t WS_ACAT = WS_V + (size_t)MR * 2048 * 2;
constexpr size_t WS_X1   = WS_ACAT + (size_t)SEQ * DM * 2;
constexpr size_t WS_H2   = WS_X1 + (size_t)SEQ * DM * 4;
constexpr size_t WS_QP   = WS_H2 + (size_t)SEQ * DM * 2;
constexpr size_t WS_SC   = WS_QP + (size_t)SEQ * 2048 * 2;
constexpr size_t WS_MODP = WS_SC + (size_t)SEQ * 2048 * 4;
constexpr size_t WS_SQ1  = WS_MODP + (size_t)64 * 32768 * 4;
constexpr size_t WS_SQ2  = WS_SQ1 + (size_t)SEQ * 12 * 4;
constexpr size_t WS_SQ3  = WS_SQ2 + (size_t)MR * 8 * 4;
constexpr size_t WS_END  = WS_SQ3 + (size_t)SEQ * 64 * 4;
static_assert(WS_ROPE + 192 * 32 * 4 <= WS_WIN, "rope table below the weights");

constexpr int RING_BYTES = 158720;
constexpr int MISC_OFF = RING_BYTES + 320;
constexpr int LDS_BYTES = 163840;
static_assert(att::SHM_ATTN <= RING_BYTES && MISC_OFF + 128 <= LDS_BYTES, "LDS map");

#define GAS __attribute__((address_space(1)))
#define LAS __attribute__((address_space(3)))
typedef unsigned short bf16;
typedef unsigned v4u __attribute__((ext_vector_type(4)));
typedef float f32x4 __attribute__((ext_vector_type(4)));
typedef __bf16 bf16x2_t __attribute__((ext_vector_type(2)));
typedef float f32x2 __attribute__((ext_vector_type(2)));
typedef float f32x16v __attribute__((ext_vector_type(16)));
typedef float f32x32v __attribute__((ext_vector_type(32)));
typedef unsigned u32x6v __attribute__((ext_vector_type(6)));
typedef _Float16 h16x2 __attribute__((ext_vector_type(2)));
typedef _Float16 h16x32 __attribute__((ext_vector_type(32)));
#ifndef FP6_INTERLEAVED
#define FP6_INTERLEAVED 1
#endif
#define LDS_WAIT() asm volatile("s_waitcnt lgkmcnt(0)" ::: "memory")
__device__ __forceinline__ unsigned f2bf(float f) { unsigned u = __builtin_bit_cast(unsigned, f); return (u + 0x7fffu + ((u >> 16) & 1u)) >> 16; }
__device__ __forceinline__ unsigned pk2(float lo, float hi) { return f2bf(lo) | (f2bf(hi) << 16); }
__device__ __forceinline__ float bflo(unsigned w) { return __builtin_bit_cast(float, w << 16); }
__device__ __forceinline__ float bfhi(unsigned w) { return __builtin_bit_cast(float, w & 0xffff0000u); }
__device__ __forceinline__ float dot2bf(unsigned a, unsigned b, float c) { return __builtin_amdgcn_fdot2_f32_bf16(__builtin_bit_cast(bf16x2_t, a), __builtin_bit_cast(bf16x2_t, b), c, false); }
#define DPP_F(v, CTRL) __builtin_bit_cast(float, __builtin_amdgcn_update_dpp(0, __builtin_bit_cast(int, (v)), (CTRL), 0xf, 0xf, true))
__device__ __forceinline__ float row16_sum(float v) { v += DPP_F(v, 0xB1); v += DPP_F(v, 0x4E); v += DPP_F(v, 0x141); v += DPP_F(v, 0x140); return v; }
__device__ __forceinline__ float row16_max(float v) { v = fmaxf(v, DPP_F(v, 0xB1)); v = fmaxf(v, DPP_F(v, 0x4E)); v = fmaxf(v, DPP_F(v, 0x141)); v = fmaxf(v, DPP_F(v, 0x140)); return v; }
__device__ __forceinline__ float rl_f(float v, int l) { return __builtin_bit_cast(float, __builtin_amdgcn_readlane(__builtin_bit_cast(int, v), l)); }
__device__ __forceinline__ float wave_sum(float v) { v = row16_sum(v); return (rl_f(v, 0) + rl_f(v, 16)) + (rl_f(v, 32) + rl_f(v, 48)); }
__device__ __forceinline__ float wave_max(float v) { v = row16_max(v); return fmaxf(fmaxf(rl_f(v, 0), rl_f(v, 16)), fmaxf(rl_f(v, 32), rl_f(v, 48))); }

#define XB_TMO      128
#define XB_XCNT(j)  (256  + 64 * (j))
#define XB_XSUB(j)  (1280 + 64 * (j))
#define XB_XGEN(j)  (2304 + 64 * (j))
#define XB_TOP      3328
#define XB_TOPGEN   3392
#define XCD_BAR_WORDS 3456
#define XB_SPIN_CAP (1u << 18)
__device__ __forceinline__ unsigned xb_ld(unsigned* p)              { return __hip_atomic_load(p, __ATOMIC_RELAXED, __HIP_MEMORY_SCOPE_AGENT); }
__device__ __forceinline__ unsigned xb_add(unsigned* p, unsigned v) { return __hip_atomic_fetch_add(p, v, __ATOMIC_RELAXED, __HIP_MEMORY_SCOPE_AGENT); }
__device__ __forceinline__ unsigned xb_xcc_id() { return (unsigned)__builtin_amdgcn_s_getreg((3 << 11) | 20) & 0xFu; }
#define XB_SPIN(cond, bar) do { unsigned _sp = 0; while (cond) { __builtin_amdgcn_s_sleep(1); \
    if ((++_sp & 255u) == 0u) { if (xb_ld(&(bar)[XB_TMO])) break; if (_sp > XB_SPIN_CAP) { atomicAdd(&(bar)[XB_TMO], 1u); break; } } } } while (0)
struct XcdBarrier { unsigned* bar; unsigned x; volatile LAS unsigned* st; };
__device__ __forceinline__ XcdBarrier xcd_barrier_post(unsigned* bar, volatile LAS unsigned* st) {
    XcdBarrier b; b.bar = bar; b.x = xb_xcc_id(); b.st = st;
    if (threadIdx.x == 0) (void)xb_add(&bar[XB_XCNT(b.x)], 1u);
    return b;
}
__device__ __forceinline__ void xcd_barrier_complete(unsigned* bar, unsigned x, unsigned& nloc, unsigned& nx) {
    const unsigned G = gridDim.x * gridDim.y * gridDim.z;
    unsigned sum, cnt, mine, sp = 0u;
    for (;;) {
        sum = 0u; cnt = 0u; mine = 0u;
#pragma unroll
        for (unsigned j = 0; j < 16; ++j) { const unsigned c = xb_ld(&bar[XB_XCNT(j)]); sum += c; cnt += (c > 0u) ? 1u : 0u; mine = (j == x) ? c : mine; }
        if (sum == G) break;
        __builtin_amdgcn_s_sleep(1);
        if ((++sp & 255u) == 0u) { if (xb_ld(&bar[XB_TMO])) break; if (sp > XB_SPIN_CAP) { atomicAdd(&bar[XB_TMO], 1u); break; } }
    }
    nloc = mine > 0u ? mine : 1u; nx = cnt > 0u ? cnt : 1u;
}
__device__ __forceinline__ void xcd_barrier(const XcdBarrier& b) {
    asm volatile("s_waitcnt vmcnt(0)" ::: "memory");
    __syncthreads();
    if (threadIdx.x == 0) {
        unsigned* bar = b.bar;
        __builtin_amdgcn_s_waitcnt(0);
        unsigned nloc = b.st[0], nx = b.st[1];
        if (nloc == 0u) { xcd_barrier_complete(bar, b.x, nloc, nx); b.st[0] = nloc; b.st[1] = nx; }
        const unsigned old = xb_add(&bar[XB_XSUB(b.x)], 1u);
        const unsigned gen = old / nloc;
        if (old + 1u == (gen + 1u) * nloc) {
            __builtin_amdgcn_fence(__ATOMIC_RELEASE, "agent");
            asm volatile("s_waitcnt vmcnt(0)" ::: "memory");
            const unsigned og = xb_add(&bar[XB_TOP], 1u);
            const unsigned tg = og / nx;
            if (og + 1u == (tg + 1u) * nx) xb_add(&bar[XB_TOPGEN], 1u);
            else XB_SPIN(xb_ld(&bar[XB_TOPGEN]) == tg, bar);
            __builtin_amdgcn_fence(__ATOMIC_ACQUIRE, "agent");
            xb_add(&bar[XB_XGEN(b.x)], 1u);
            asm volatile("s_waitcnt vmcnt(0)" ::: "memory");
        } else {
            XB_SPIN(xb_ld(&bar[XB_XGEN(b.x)]) == gen, bar);
            __builtin_amdgcn_fence(__ATOMIC_ACQUIRE, "agent");
            asm volatile("s_waitcnt vmcnt(0)" ::: "memory");
        }
    }
    __syncthreads();
}

__device__ __forceinline__ int pi32(int o) { return 2 * (o & 15) + (o >> 4); }
__device__ __forceinline__ void tr_item(const float* __restrict__ W, int N, int k0, int n0, bf16* __restrict__ WT, int ldk, int drow0, bool perm, const float* __restrict__ gsc, LAS float* scr, int lane) {
    f32x4 w[8]; const int c4 = (lane & 7) * 4, rsub = lane >> 3;
#pragma unroll
    for (int i = 0; i < 8; ++i) w[i] = *(const f32x4*)(W + (size_t)(k0 + 8 * i + rsub) * N + n0 + c4);
#pragma unroll
    for (int i = 0; i < 8; ++i) { const int kk = 8 * i + rsub; const float g = gsc ? gsc[k0 + kk] : 1.f;
        scr[kk * 33 + c4] = w[i][0] * g; scr[kk * 33 + c4 + 1] = w[i][1] * g; scr[kk * 33 + c4 + 2] = w[i][2] * g; scr[kk * 33 + c4 + 3] = w[i][3] * g; }
    LDS_WAIT(); asm volatile("" ::: "memory");
    const int c = lane & 7;
#pragma unroll
    for (int j = 0; j < 4; ++j) { const int n = (lane >> 3) + 8 * j; const LAS float* s = scr + (8 * c) * 33 + n;
        v4u o; o.x = pk2(s[0 * 33], s[1 * 33]); o.y = pk2(s[2 * 33], s[3 * 33]); o.z = pk2(s[4 * 33], s[5 * 33]); o.w = pk2(s[6 * 33], s[7 * 33]);
        const int dn = perm ? pi32(n) : n;
        *(v4u*)(WT + (size_t)(drow0 + dn) * ldk + k0 + 8 * c) = o; }
    LDS_WAIT(); asm volatile("" ::: "memory");
}
__device__ __forceinline__ float silu_f(float v) { return v / (1.f + expf(-v)); }
__device__ __forceinline__ float gelu_erf(float v) { return 0.5f * v * (1.f + erff(v * 0.70710678118654752f)); }
__device__ __forceinline__ unsigned fkey(float f) { const unsigned u = __builtin_bit_cast(unsigned, f); return (u & 0x80000000u) ? ~u : (u | 0x80000000u); }

template <int NV> __device__ __forceinline__ unsigned kth16(const unsigned (&k)[NV]) {
    unsigned T = 0u;
    for (int bit = 31; bit >= 0; --bit) { const unsigned c = T | (1u << bit); int cnt = 0;
#pragma unroll
        for (int v = 0; v < NV; ++v) cnt += __popcll(__ballot(k[v] >= c));
        if (cnt >= 16) T = c; }
    return T;
}
template <int NV> __device__ __forceinline__ void compact16(const unsigned (&k)[NV], const unsigned (&val)[NV], const unsigned (&pay)[NV], unsigned T, LAS unsigned* oval, LAS unsigned* opay, int lane) {
    const unsigned long long lt = (1ull << lane) - 1ull; int pos = 0;
#pragma unroll
    for (int v = 0; v < NV; ++v) { const bool s = k[v] > T; const unsigned long long m = __ballot(s); const int slot = pos + __popcll(m & lt); if (s) { oval[slot] = val[v]; opay[slot] = pay[v]; } pos += __popcll(m); }
#pragma unroll
    for (int v = 0; v < NV; ++v) { const bool s = k[v] == T; const unsigned long long m = __ballot(s); const int slot = pos + __popcll(m & lt); if (s && slot < 16) { oval[slot] = val[v]; opay[slot] = pay[v]; } pos += __popcll(m); }
}

struct Args { const float* in[21]; float* out; unsigned char* ws; int ph_lo, ph_hi, probe, pad; };
static_assert(sizeof(Args) == 23 * 8 + 16, "Args has no padding");

__global__ void __launch_bounds__(NTHR, 2) fwd(Args a) {
    extern __shared__ __attribute__((aligned(16))) unsigned char lds[];
    LAS unsigned char* L = (LAS unsigned char*)lds;
    const int wave = __builtin_amdgcn_readfirstlane((int)threadIdx.x >> 6);
    const int G = gridDim.x, bx = blockIdx.x;
    const int gw = bx * NWAVES + wave, NGW = G * NWAVES;
    const size_t NT = (size_t)G * NTHR;
#define PH_IDS() int tid_ph_ = threadIdx.x; asm volatile("" : "+v"(tid_ph_)); const int tid = tid_ph_, lane = tid & 63; const size_t gt = (size_t)bx * NTHR + tid; (void)lane; (void)gt
    unsigned char* ws = a.ws;
    float* ctlf = (float*)(ws + WS_CTL);
    const float* x = a.in[0]; const float* cvec = a.in[1]; const float* ctx = a.in[2]; const float* cctx = a.in[3]; const float* w_ada = a.in[4]; const float* b_ada = a.in[5];
    const float* norm1_g = a.in[6]; const float* w_in = a.in[7]; const float* q_norm_g = a.in[8]; const float* w_uq = a.in[9]; const float* kv_norm_g = a.in[10]; const float* w_ukv = a.in[11];
    const float* conv_w = a.in[12]; const float* conv_b = a.in[13]; const float* w_o = a.in[14]; const float* norm2_g = a.in[15]; const float* peer_wq = a.in[16]; const float* peer_keys = a.in[17];
    const float* peer_u = a.in[18]; const float* peer_v = a.in[19]; const float* final_g = a.in[20];
    float* modp = (float*)(ws + WS_MODP); float* ssq_cq = (float*)(ws + WS_SQ1); float* ssq_ckv = (float*)(ws + WS_SQ2); float* ssq_x1 = (float*)(ws + WS_SQ3);
    float* modf = (float*)(ws + WS_MODF); float* rope = (float*)(ws + WS_ROPE);
    bf16* WIN = (bf16*)(ws + WS_WIN); bf16* WUQ = (bf16*)(ws + WS_WUQ); bf16* WUKV = (bf16*)(ws + WS_WUKV); bf16* WO = (bf16*)(ws + WS_WO); bf16* WPQ = (bf16*)(ws + WS_WPQ); bf16* KBD = (bf16*)(ws + WS_KBD); bf16* KB2 = (bf16*)(ws + WS_KB2);
    unsigned char* UB = ws + WS_UB; unsigned char* VB = ws + WS_VB; float* SUV = (float*)(ws + WS_SU); bf16* HX = (bf16*)(ws + WS_HX); bf16* CQ = (bf16*)(ws + WS_CQ); bf16* CKV = (bf16*)(ws + WS_CKV); unsigned char* KR = ws + WS_KR;
    bf16* UCV = (bf16*)(ws + WS_U); bf16* GBV = (bf16*)(ws + WS_GB); unsigned char* Q = ws + WS_Q; unsigned char* KN = ws + WS_KN; bf16* V = (bf16*)(ws + WS_V); bf16* ACAT = (bf16*)(ws + WS_ACAT);
    bf16* DLT = (bf16*)(ws + WS_X1); bf16* H2 = (bf16*)(ws + WS_H2); float* SC = (float*)(ws + WS_SC);

    for (int u = threadIdx.x; u < (LDS_BYTES - RING_BYTES) / 4; u += NTHR) ((LAS unsigned*)(L + RING_BYTES))[u] = 0u;
    __syncthreads();
    const int lo = a.ph_lo, hi = a.ph_hi;
    XcdBarrier bar; bar.bar = (unsigned*)ctlf + CW_BAR; bar.x = 0; bar.st = (volatile LAS unsigned*)(L + MISC_OFF);
    if (hi - lo > 1) bar = xcd_barrier_post((unsigned*)ctlf + CW_BAR, (volatile LAS unsigned*)(L + MISC_OFF));
#define IN(k) (lo <= (k) && (k) < hi)
#ifndef PHASE_MASK
#define PHASE_MASK 0x3ff
#endif
#define PH_ON(k) (((PHASE_MASK) >> (k)) & 1)
#ifndef REPEAT_MASK
#define REPEAT_MASK 0
#endif
#define NREP(k) (1 + (((REPEAT_MASK) >> (k)) & 1))
#define GRID_BAR(k) do { if (IN(k) && IN((k) + 1)) xcd_barrier(bar); } while (0)

    if (PH_ON(0) && IN(0)) for (int rep_ = 0; rep_ < NREP(0); ++rep_) {
        PH_IDS();
        const int psel = a.probe ? a.probe : 7;
        if (psel & 1)
        for (int it = gw; it < 64 * 96; it += NGW) {
            const int kb = it / 96, cb = it % 96, col = cb * 256 + lane * 4;
            const float* wp = w_ada + (size_t)(kb * 64) * NMODC + col;
            f32x4 ax = {0.f, 0.f, 0.f, 0.f}, ac = {0.f, 0.f, 0.f, 0.f}; const bool cc = cb < 32;
            const float sxv = silu_f(cvec[kb * 64 + lane]), scv = silu_f(cctx[kb * 64 + lane]);
#pragma unroll 16
            for (int i = 0; i < 64; ++i) { const f32x4 w = __builtin_nontemporal_load((const f32x4*)(wp + (size_t)i * NMODC));
                ax += w * rl_f(sxv, i); ac += w * (cc ? rl_f(scv, i) : 0.f); }
            *(f32x4*)(modp + (size_t)kb * 32768 + col) = ax; if (cc) *(f32x4*)(modp + (size_t)kb * 32768 + NMODC + col) = ac;
        }
        if (psel & 2) {
            LAS float* scr = (LAS float*)(L + wave * 8448);
            constexpr int I_IN = 64 * 234, I_UQ = 12 * 96, I_UKV = 8 * 128, I_O = 64 * 128, NIT = I_IN + I_UQ + I_UKV + I_O;
            for (int it = gw; it < NIT; it += NGW) { int r = it;
                if (r < I_IN) { const int kb = r / 234, n0 = (r % 234) * 32; int drow0; bool perm = false;
                    if (n0 < 1280) drow0 = n0; else if (n0 < 1344) { drow0 = n0; perm = true; }
                    else { const int c0 = n0 - 1344; if (c0 < 2048) drow0 = 1536 + (c0 >> 7) * 256 + (c0 & 127); else if (c0 < 4096) drow0 = 5632 + (c0 - 2048); else { const int c1 = c0 - 4096; drow0 = 1536 + (c1 >> 7) * 256 + 128 + (c1 & 127); } }
                    tr_item(w_in, 7488, kb * 64, n0, WIN, 4096, drow0, perm, nullptr, scr, lane); continue; } r -= I_IN;
                if (r < I_UQ) { const int kb = r / 96, n0 = (r % 96) * 32; tr_item(w_uq, 3072, kb * 64, n0, WUQ, 768, n0, (n0 % 192) >= 128, q_norm_g, scr, lane); continue; } r -= I_UQ;
                if (r < I_UKV) { const int kb = r / 128, n0 = (r % 128) * 32; tr_item(w_ukv, 4096, kb * 64, n0, WUKV, 512, n0, false, kv_norm_g, scr, lane); continue; } r -= I_UKV;
                { const int kb = r / 128, n0 = (r % 128) * 32; tr_item(w_o, 4096, kb * 64, n0, WO, 4096, n0, false, nullptr, scr, lane); }
            }
        }
        for (size_t i = gt; i < (size_t)192 * 512; i += NT) { const v4u z = {0u, 0u, 0u, 0u}; *(v4u*)(WIN + (size_t)1344 * 4096 + i * 8) = z; }
        for (size_t i = gt; i < (size_t)DM * 2048 / 8; i += NT) {
            const int d = (int)(i >> 8), c8 = (int)(i & 255) * 8, h = c8 >> 8, j = c8 & 255; const float* sp_ = peer_wq + (size_t)d * 2048 + c8; const f32x4 a0 = *(const f32x4*)sp_, a1 = *(const f32x4*)(sp_ + 4);
            v4u o; o.x = pk2(a0[0], a0[1]); o.y = pk2(a0[2], a0[3]); o.z = pk2(a1[0], a1[1]); o.w = pk2(a1[2], a1[3]); *(v4u*)(WPQ + ((size_t)h * DM + d) * 256 + j) = o; }
        for (size_t i = gt; i < (size_t)8 * 256 * 32; i += NT) {
            const int d8 = (int)(i & 31) * 8, rr = (int)(i >> 5) & 255, h = (int)(i >> 13), p = rr >> 7, k = rr & 127; v4u o = {0u, 0u, 0u, 0u};
            if ((d8 >> 7) == p) { const float* s_ = peer_keys + ((size_t)((h * 2 + p) * 128 + k)) * 128 + (d8 & 127); const f32x4 a0 = *(const f32x4*)s_, a1 = *(const f32x4*)(s_ + 4);
                o.x = pk2(a0[0], a0[1]); o.y = pk2(a0[2], a0[3]); o.z = pk2(a1[0], a1[1]); o.w = pk2(a1[2], a1[3]); }
            *(v4u*)(KB2 + i * 8) = o; }
        for (size_t i = gt; i < (size_t)192 * 16; i += NT) {
            const int pi = (int)(i >> 4), fi = (int)(i & 15); const int pos = pi < 128 ? pi : pi - 128;
            const float fr = __builtin_amdgcn_exp2f(-(float)fi * 0.83048202372184059f);
            const float turns = (float)pos * fr * 0.15915494309189535f, fx = turns - floorf(turns);
            rope[pi * 32 + 2 * fi] = __builtin_amdgcn_cosf(fx); rope[pi * 32 + 2 * fi + 1] = __builtin_amdgcn_sinf(fx); }
        if (psel & 4)
        for (int r = gw; r < 2 * NEXP; r += NGW) { const bool isv = r >= NEXP; const int e = isv ? r - NEXP : r; const float* src = (isv ? peer_v : peer_u) + (size_t)e * DM + lane * 4;
            f32x4 v[2][8]; float am = 0.f;
#pragma unroll
            for (int b = 0; b < 2; ++b)
#pragma unroll
                for (int q = 0; q < 8; ++q) { v[b][q] = __builtin_nontemporal_load((const f32x4*)(src + b * 2048 + q * 256)); am = fmaxf(am, fmaxf(fmaxf(fabsf(v[b][q][0]), fabsf(v[b][q][1])), fmaxf(fabsf(v[b][q][2]), fabsf(v[b][q][3])))); }
            am = wave_max(am);
            const float sc = am > 0.f ? exp2f(floorf(log2f(7.5f / am))) : 1.f;
            unsigned d[12];
#pragma unroll
            for (int b = 0; b < 2; ++b) { f32x16v s0, s1;
#pragma unroll
                for (int i = 0; i < 16; ++i) { const int i0 = FP6_INTERLEAVED ? 2 * i : i, i1 = FP6_INTERLEAVED ? 2 * i + 1 : 16 + i; s0[i] = v[b][i0 >> 2][i0 & 3] * sc; s1[i] = v[b][i1 >> 2][i1 & 3] * sc; }
                const u32x6v w = __builtin_amdgcn_cvt_scalef32_2xpk16_fp6_f32(s0, s1, 1.0f);
#pragma unroll
                for (int i = 0; i < 6; ++i) d[6 * b + i] = w[i]; }
            unsigned char* dst = (isv ? VB : UB) + (size_t)e * ROWB + lane * 16;
#pragma unroll
            for (int p = 0; p < 3; ++p) { const v4u o = {d[4 * p], d[4 * p + 1], d[4 * p + 2], d[4 * p + 3]}; *(v4u*)(dst + p * 1024) = o; }
            if (lane == 0) SUV[r] = 1.f / sc;
        }
    }
    GRID_BAR(0);

    if (PH_ON(1) && IN(1)) for (int rep_ = 0; rep_ < NREP(1); ++rep_) {
        PH_IDS();
        for (size_t j = gt; j < (size_t)(NMODC + 2 * DM); j += NT) { float sacc = 0.f;
#pragma unroll 8
            for (int kb = 0; kb < 64; ++kb) sacc += modp[(size_t)kb * 32768 + j];
            modf[j] = sacc + b_ada[j < (size_t)NMODC ? j : j - NMODC]; }
        { pg8::Gemm g{KB2, WPQ, 2048, DM, 256, 0, (size_t)DM * 256 * 2}; pg8::StaticOrder S; S.init(2048, DM, G, bx); pg8::EpiB16 E{KBD, DM};
          pg8::gemm_phase<pg8::EpiB16, pg8::StaticOrder, true, true>(L, g, S, E); }
    }
    GRID_BAR(1);

    if (PH_ON(2) && IN(2)) for (int rep_ = 0; rep_ < NREP(2); ++rep_) {
        PH_IDS();
        for (int row = gw; row < MR; row += NGW) {
            const bool lat = row < SEQ; const float* xr = lat ? x + (size_t)row * DM : ctx + (size_t)(row - SEQ) * DM; const float* md = lat ? modf : modf + NMODC;
            f32x4 v[16]; float ss = 0.f;
#pragma unroll
            for (int j = 0; j < 16; ++j) { v[j] = *(const f32x4*)(xr + 4 * (lane + 64 * j)); ss += (v[j][0] * v[j][0] + v[j][1] * v[j][1]) + (v[j][2] * v[j][2] + v[j][3] * v[j][3]); }
            ss = wave_sum(ss); const float rstd = 1.f / sqrtf(ss * (1.f / DM) + EPS);
#pragma unroll
            for (int j = 0; j < 16; ++j) { const int idx = 4 * (lane + 64 * j);
                const f32x4 g = *(const f32x4*)(norm1_g + idx), sh = *(const f32x4*)(md + idx), sc = *(const f32x4*)(md + DM + idx);
                const f32x4 hh = (v[j] * rstd * g) * (sc + 1.f) + sh;
                *(unsigned long long*)(HX + (size_t)row * DM + idx) = (unsigned long long)pk2(hh[0], hh[1]) | ((unsigned long long)pk2(hh[2], hh[3]) << 32); }
        }
    }
    GRID_BAR(2);

    if (PH_ON(3) && IN(3)) for (int rep_ = 0; rep_ < NREP(3); ++rep_) {
        pg8::Gemm g{HX, WIN, MR, NIN, DM, 0, 0}; pg8::OrderIn S; S.init(SEQ, NIN, G, bx);
        pg8::EpiIn E{CQ, CKV, KR, UCV, GBV, ssq_cq, ssq_ckv, rope};
        pg8::gemm_phase<pg8::EpiIn, pg8::OrderIn, true, true>(L, g, S, E);
    }
    GRID_BAR(3);

    if (PH_ON(4) && IN(4)) for (int rep_ = 0; rep_ < NREP(4); ++rep_) {
        PH_IDS();
        if (G == 256) {
            const int nq = bx < 144 ? 1 : bx < 240 ? 2 : 3, qb0 = bx < 144 ? bx : bx < 240 ? 144 + 2 * (bx - 144) : 336 + 3 * (bx - 240);
            const int nkv = bx < 144 ? 3 : bx < 240 ? 1 : 0, kb0 = bx < 144 ? 3 * bx : 432 + (bx - 144);
            { pg8::Gemm g{CQ, WUQ, SEQ, 3072, QL, 0, 0}; pg8::RunOrder S{qb0, nq, 12}; pg8::EpiQ E{Q, ssq_cq, rope, C2 * att::QSC};
              pg8::gemm_phase<pg8::EpiQ, pg8::RunOrder, true, true>(L, g, S, E); }
            { pg8::Gemm g{CKV, WUKV, MR, 4096, KVL, 0, 0}; pg8::RunOrder S{kb0, nkv, 16}; pg8::EpiKV E{KN, V, ssq_ckv};
              pg8::gemm_phase<pg8::EpiKV, pg8::RunOrder, true, true>(L, g, S, E); }
        } else {
            { pg8::Gemm g{CQ, WUQ, SEQ, 3072, QL, 0, 0}; pg8::RunOrder S{(int)(((long)384 * bx) / G), (int)(((long)384 * (bx + 1)) / G - ((long)384 * bx) / G), 12}; pg8::EpiQ E{Q, ssq_cq, rope, C2 * att::QSC};
              pg8::gemm_phase<pg8::EpiQ, pg8::RunOrder, true, true>(L, g, S, E); }
            { pg8::Gemm g{CKV, WUKV, MR, 4096, KVL, 0, 0}; pg8::RunOrder S{(int)(((long)528 * bx) / G), (int)(((long)528 * (bx + 1)) / G - ((long)528 * bx) / G), 16}; pg8::EpiKV E{KN, V, ssq_ckv};
              pg8::gemm_phase<pg8::EpiKV, pg8::RunOrder, true, true>(L, g, S, E); }
        }
        for (size_t it = gt; it < (size_t)SEQ * 256; it += NT) {
            const int t = (int)(it >> 8), c8 = (int)(it & 255) * 8; const v4u z = {0u, 0u, 0u, 0u};
            const v4u um = t > 0 ? *(const v4u*)(UCV + (size_t)(t - 1) * 2048 + c8) : z, u0 = *(const v4u*)(UCV + (size_t)t * 2048 + c8), up = t < SEQ - 1 ? *(const v4u*)(UCV + (size_t)(t + 1) * 2048 + c8) : z;
            const v4u gv = *(const v4u*)(GBV + (size_t)t * 2048 + c8); v4u o;
            float w0[8], w1[8], w2[8], wb[8];
#pragma unroll
            for (int q = 0; q < 2; ++q) { const f32x4 a0 = *(const f32x4*)(conv_w + c8 + 4 * q), a1 = *(const f32x4*)(conv_w + 2048 + c8 + 4 * q), a2 = *(const f32x4*)(conv_w + 4096 + c8 + 4 * q), a3 = *(const f32x4*)(conv_b + c8 + 4 * q);
#pragma unroll
                for (int j = 0; j < 4; ++j) { w0[4 * q + j] = a0[j]; w1[4 * q + j] = a1[j]; w2[4 * q + j] = a2[j]; wb[4 * q + j] = a3[j]; } }
#pragma unroll
            for (int j = 0; j < 4; ++j) {
                const float y0 = w0[2 * j] * bflo(um[j]) + w1[2 * j] * bflo(u0[j]) + w2[2 * j] * bflo(up[j]) + wb[2 * j];
                const float y1 = w0[2 * j + 1] * bfhi(um[j]) + w1[2 * j + 1] * bfhi(u0[j]) + w2[2 * j + 1] * bfhi(up[j]) + wb[2 * j + 1];
                o[j] = pk2(bflo(gv[j]) * y0, bfhi(gv[j]) * y1); }
            *(v4u*)(ACAT + (size_t)t * DM + 2048 + c8) = o; }
    }
    GRID_BAR(4);

    if (PH_ON(5) && IN(5)) for (int rep_ = 0; rep_ < NREP(5); ++rep_) {
        for (int i = 0;; ++i) { int h, qb;
            if (G == 256) { if (i >= 2) break; h = 2 * (bx & 7) + i; qb = bx >> 3; } else { const int Lu = i * G + bx; if (Lu >= 512) break; h = Lu >> 5; qb = Lu & 31; }
            att::attn_unit(Q + (size_t)(qb * 256) * 3072 + h * 192, KN + h * 128, V + h * 128, KR, ACAT + (size_t)(qb * 256) * DM + h * 128, MR, (char*)lds, L, a.probe); }
    }
    GRID_BAR(5);

    if (PH_ON(6) && IN(6)) for (int rep_ = 0; rep_ < NREP(6); ++rep_) {
        pg8::Gemm g{ACAT, WO, SEQ, DM, DM, 0, 0}; pg8::StaticOrder S; S.init(SEQ, DM, G, bx); pg8::EpiO E{modf + 2 * DM, DLT};
        pg8::gemm_phase<pg8::EpiO, pg8::StaticOrder, true, true>(L, g, S, E);
    }
    GRID_BAR(6);

    if (PH_ON(7) && IN(7)) for (int rep_ = 0; rep_ < NREP(7); ++rep_) {
        PH_IDS();
        for (int row = gw; row < SEQ; row += NGW) {
            f32x4 v[16]; float ssq[4] = {0.f, 0.f, 0.f, 0.f};
#pragma unroll
            for (int j = 0; j < 16; ++j) { const int idx = 4 * (lane + 64 * j); const unsigned long long d8 = *(const unsigned long long*)(DLT + (size_t)row * DM + idx); const f32x4 xv = *(const f32x4*)(x + (size_t)row * DM + idx);
                v[j][0] = xv[0] + bflo((unsigned)d8); v[j][1] = xv[1] + bfhi((unsigned)d8); v[j][2] = xv[2] + bflo((unsigned)(d8 >> 32)); v[j][3] = xv[3] + bfhi((unsigned)(d8 >> 32));
#pragma unroll
                for (int c = 0; c < 4; ++c) ssq[c] = fmaf(v[j][c], v[j][c], ssq[c]); }
            const float rstd = 1.f / sqrtf(wave_sum((ssq[0] + ssq[1]) + (ssq[2] + ssq[3])) * (1.f / DM) + EPS);
#pragma unroll
            for (int j = 0; j < 16; ++j) { const int idx = 4 * (lane + 64 * j);
                const f32x4 g = *(const f32x4*)(norm2_g + idx), sh = *(const f32x4*)(modf + 3 * DM + idx), sc = *(const f32x4*)(modf + 4 * DM + idx);
                const f32x4 hh = (v[j] * rstd * g) * (sc + 1.f) + sh;
                *(unsigned long long*)(H2 + (size_t)row * DM + idx) = (unsigned long long)pk2(hh[0], hh[1]) | ((unsigned long long)pk2(hh[2], hh[3]) << 32); }
        }
    }
    GRID_BAR(7);

    if (PH_ON(8) && IN(8)) for (int rep_ = 0; rep_ < NREP(8); ++rep_) {
        pg8::Gemm g{H2, KBD, SEQ, 2048, DM, 0, 0}; pg8::StaticOrder S; S.init(SEQ, 2048, G, bx); pg8::EpiF32 E{SC, 2048};
        pg8::gemm_phase<pg8::EpiF32, pg8::StaticOrder, true, true>(L, g, S, E);
    }
    GRID_BAR(8);

    if (PH_ON(9) && IN(9)) for (int rep_ = 0; rep_ < NREP(9); ++rep_) {
        int lane0_ = threadIdx.x; asm volatile("" : "+v"(lane0_)); lane0_ &= 63;
        LAS unsigned* wl = (LAS unsigned*)(L + wave * 8192);
        LAS unsigned* sV1 = wl, *sI1 = wl + 16, *sV2 = wl + 32, *sI2 = wl + 48, *sVc = wl + 64, *sEc = wl + 80;
        LAS unsigned* eL = wl + 128; LAS float* gL = (LAS float*)(wl + 128 + 512);
        const float* gate2 = modf + 5 * DM; const int emask_ = a.probe ? 63 : 0xffff; float* outp_ = a.probe ? (float*)(ws + WS_HX) : a.out;
        for (int tb = gw * 4; tb < SEQ; tb += NGW * 4) {
            for (int ti = 0; ti < 4; ++ti) { const int t = tb + ti; int lane = lane0_; asm volatile("" : "+v"(lane));
                for (int h = 0; h < 8; ++h) { const float* sp = SC + (size_t)t * 2048 + h * 256;
                    { const float s0 = sp[lane], s1 = sp[64 + lane]; const unsigned k[2] = {fkey(s0), fkey(s1)}, vb[2] = {__builtin_bit_cast(unsigned, s0), __builtin_bit_cast(unsigned, s1)}, pl[2] = {(unsigned)lane, (unsigned)(64 + lane)};
                      const unsigned T = kth16<2>(k); compact16<2>(k, vb, pl, T, sV1, sI1, lane); }
                    { const float s0 = sp[128 + lane], s1 = sp[192 + lane]; const unsigned k[2] = {fkey(s0), fkey(s1)}, vb[2] = {__builtin_bit_cast(unsigned, s0), __builtin_bit_cast(unsigned, s1)}, pl[2] = {(unsigned)lane, (unsigned)(64 + lane)};
                      const unsigned T = kth16<2>(k); compact16<2>(k, vb, pl, T, sV2, sI2, lane); }
                    LDS_WAIT();
                    { const float s2b = __builtin_bit_cast(float, sV2[lane & 15]); const unsigned i2b = sI2[lane & 15]; unsigned k[4], vb[4], pl[4];
#pragma unroll
                      for (int r = 0; r < 4; ++r) { const int aa = (lane >> 4) + 4 * r; const float cv = __builtin_bit_cast(float, sV1[aa]) + s2b; k[r] = fkey(cv); vb[r] = __builtin_bit_cast(unsigned, cv); pl[r] = sI1[aa] * 128u + i2b; }
                      const unsigned T = kth16<4>(k); compact16<4>(k, vb, pl, T, sVc, sEc, lane); }
                    LDS_WAIT();
                    { const float tv = __builtin_bit_cast(float, sVc[lane & 15]); const float mx = row16_max(tv);
                      const float ex = expf(tv - mx); const float sm = row16_sum(ex);
                      if (lane < 16) { eL[ti * 128 + h * 16 + lane] = sEc[lane]; gL[ti * 128 + h * 16 + lane] = ex / sm; } }
                    LDS_WAIT();
                }
                { const unsigned e0 = eL[ti * 128 + lane], e1 = eL[ti * 128 + 64 + lane]; const float g0 = gL[ti * 128 + lane], g1 = gL[ti * 128 + 64 + lane];
                  const unsigned k0 = (e0 << 7) | (unsigned)lane, k1 = (e1 << 7) | (unsigned)(64 + lane); int r0 = 0, r1 = 0;
#pragma unroll 8
                  for (int m = 0; m < 128; ++m) { const unsigned km = (eL[ti * 128 + m] << 7) | (unsigned)m; r0 += km < k0 ? 1 : 0; r1 += km < k1 ? 1 : 0; }
                  LDS_WAIT();
                  eL[ti * 128 + r0] = e0; gL[ti * 128 + r0] = g0; eL[ti * 128 + r1] = e1; gL[ti * 128 + r1] = g1;
                  LDS_WAIT(); }
                h16x2 hh[2][16];
#pragma unroll
                for (int b = 0; b < 2; ++b)
#pragma unroll
                    for (int q = 0; q < 8; ++q) { const unsigned long long a0 = *(const unsigned long long*)(H2 + (size_t)t * DM + b * 2048 + q * 256 + lane * 4);
                        hh[b][2 * q] = (h16x2){(_Float16)bflo((unsigned)a0), (_Float16)bfhi((unsigned)a0)}; hh[b][2 * q + 1] = (h16x2){(_Float16)bflo((unsigned)(a0 >> 32)), (_Float16)bfhi((unsigned)(a0 >> 32))}; }
                v4u rr[6][3]; float rs[6];
#define LDROW(j, TAB, e, SOFF) do { const unsigned char* rp_ = (TAB) + (size_t)(e) * ROWB + lane * 16; _Pragma("unroll") for (int p = 0; p < 3; ++p) rr[j][p] = *(const v4u*)(rp_ + p * 1024); rs[j] = SUV[(SOFF) + (e)]; } while (0)
#define EIDX(k) (__builtin_amdgcn_readfirstlane((int)eL[ti * 128 + (k)]) & emask_)
#define UNPKH(j, b) __builtin_amdgcn_cvt_scalef32_pk32_f16_fp6((b) == 0 ? (u32x6v){rr[j][0][0], rr[j][0][1], rr[j][0][2], rr[j][0][3], rr[j][1][0], rr[j][1][1]} : (u32x6v){rr[j][1][2], rr[j][1][3], rr[j][2][0], rr[j][2][1], rr[j][2][2], rr[j][2][3]}, 1.0f)
#define DOTROW(out, j) do { float a0 = 0.f, a1 = 0.f, a2 = 0.f, a3 = 0.f; _Pragma("unroll") for (int b = 0; b < 2; ++b) { const h16x32 x_ = UNPKH(j, b); \
                    _Pragma("unroll") for (int i = 0; i < 16; i += 4) { a0 = __builtin_amdgcn_fdot2((h16x2){x_[2 * i], x_[2 * i + 1]}, hh[b][i], a0, false); a1 = __builtin_amdgcn_fdot2((h16x2){x_[2 * i + 2], x_[2 * i + 3]}, hh[b][i + 1], a1, false); \
                        a2 = __builtin_amdgcn_fdot2((h16x2){x_[2 * i + 4], x_[2 * i + 5]}, hh[b][i + 2], a2, false); a3 = __builtin_amdgcn_fdot2((h16x2){x_[2 * i + 6], x_[2 * i + 7]}, hh[b][i + 3], a3, false); } } \
                    out = (a0 + a1) + (a2 + a3); } while (0)
                int ei[6];
#pragma unroll
                for (int j = 0; j < 6; ++j) { ei[j] = EIDX(j); LDROW(j, UB, ei[j], 0); }
                for (int k0 = 0; k0 < 126; k0 += 6) {
                    float dsum[6];
#pragma unroll
                    for (int j = 0; j < 6; ++j) { float part; DOTROW(part, j); const float sc_ = rs[j];
                        if (k0 + 6 + j < 128) { ei[j] = EIDX(k0 + 6 + j); LDROW(j, UB, ei[j], 0); }
                        dsum[j] = wave_sum(part) * sc_; }
                    if (lane < 6) { float d = dsum[0];
#pragma unroll
                        for (int j = 1; j < 6; ++j) d = lane == j ? dsum[j] : d;
                        gL[ti * 128 + k0 + lane] = gL[ti * 128 + k0 + lane] * gelu_erf(d); }
                }
                { float dsum[2];
#pragma unroll
                  for (int j = 0; j < 2; ++j) { float part; DOTROW(part, j); dsum[j] = wave_sum(part) * rs[j]; }
                  if (lane < 2) { const float d = lane == 0 ? dsum[0] : dsum[1]; gL[ti * 128 + 126 + lane] = gL[ti * 128 + 126 + lane] * gelu_erf(d); } }
                LDS_WAIT();
            }
            for (int ti = 0; ti < 4; ++ti) { const int t = tb + ti; int lane = lane0_; asm volatile("" : "+v"(lane));
                h16x2 ah[2][16];
#pragma unroll
                for (int b = 0; b < 2; ++b)
#pragma unroll
                    for (int i = 0; i < 16; ++i) ah[b][i] = (h16x2){(_Float16)0.f, (_Float16)0.f};
                v4u rr[6][3]; float rs[6];
#define FMAROW(j, WW) do { const _Float16 wh_ = (_Float16)(WW); const h16x2 w2_ = {wh_, wh_}; _Pragma("unroll") for (int b = 0; b < 2; ++b) { const h16x32 x_ = UNPKH(j, b); \
                    _Pragma("unroll") for (int i = 0; i < 16; ++i) ah[b][i] = __builtin_elementwise_fma(w2_, (h16x2){x_[2 * i], x_[2 * i + 1]}, ah[b][i]); } } while (0)
                int ei[6];
#pragma unroll
                for (int j = 0; j < 6; ++j) { ei[j] = EIDX(j); LDROW(j, VB, ei[j], NEXP); }
                for (int k0 = 0; k0 < 126; k0 += 6) {
#pragma unroll
                    for (int j = 0; j < 6; ++j) { FMAROW(j, gL[ti * 128 + k0 + j] * rs[j]);
                        if (k0 + 6 + j < 128) { ei[j] = EIDX(k0 + 6 + j); LDROW(j, VB, ei[j], NEXP); } }
                }
#pragma unroll
                for (int j = 0; j < 2; ++j) FMAROW(j, gL[ti * 128 + 126 + j] * rs[j]);
                float acc[2][32];
#pragma unroll
                for (int b = 0; b < 2; ++b)
#pragma unroll
                    for (int i = 0; i < 16; ++i) { acc[b][2 * i] = (float)ah[b][i][0]; acc[b][2 * i + 1] = (float)ah[b][i][1]; }
                float ssp[4] = {0.f, 0.f, 0.f, 0.f}; int lane_f = lane; asm volatile("" : "+v"(lane_f));
#pragma unroll
                for (int b = 0; b < 2; ++b)
#pragma unroll
                    for (int q = 0; q < 8; ++q) { unsigned o = (unsigned)(b * 2048 + q * 256 + lane_f * 4); asm volatile("" : "+v"(o)); const unsigned long long d8 = *(const unsigned long long*)(DLT + (size_t)t * DM + o); f32x4 xa = *(const f32x4*)(x + (size_t)t * DM + o); const f32x4 ga = *(const f32x4*)(gate2 + o);
                        xa[0] += bflo((unsigned)d8); xa[1] += bfhi((unsigned)d8); xa[2] += bflo((unsigned)(d8 >> 32)); xa[3] += bfhi((unsigned)(d8 >> 32));
#pragma unroll
                        for (int j = 0; j < 4; ++j) { acc[b][4 * q + j] = fmaf(ga[j], acc[b][4 * q + j], xa[j]); ssp[j] = fmaf(acc[b][4 * q + j], acc[b][4 * q + j], ssp[j]); }
                        if ((q & 1) == 1) asm volatile("" ::: "memory"); }
                const float ss = wave_sum((ssp[0] + ssp[1]) + (ssp[2] + ssp[3])); const float rstd = 1.f / sqrtf(ss * (1.f / DM) + EPS);
#pragma unroll
                for (int b = 0; b < 2; ++b)
#pragma unroll
                    for (int q = 0; q < 8; ++q) { unsigned o = (unsigned)(b * 2048 + q * 256 + lane_f * 4); asm volatile("" : "+v"(o)); const f32x4 fa = *(const f32x4*)(final_g + o); f32x4 oa;
#pragma unroll
                        for (int j = 0; j < 4; ++j) oa[j] = acc[b][4 * q + j] * rstd * fa[j];
                        *(f32x4*)(outp_ + (size_t)t * DM + o) = oa; if ((q & 1) == 1) asm volatile("" ::: "memory"); }
            }
            LDS_WAIT();
#undef LDROW
#undef EIDX
#undef DOTROW
#undef FMAROW
#undef UNPKH
        }
    }
#undef IN
#undef GRID_BAR
}

#ifdef PROBE_MX
typedef int v8i_t __attribute__((ext_vector_type(8)));
typedef float v16f_t __attribute__((ext_vector_type(16)));
__device__ __forceinline__ unsigned char f8enc(int v) {
    if (v == 0) return 0; int e = 0; int m = v; while (m >= 2) { m >>= 1; ++e; } const int frac = (v << 3 >> e) & 7; return (unsigned char)(((e + 7) << 3) | frac); }
__global__ void probe_mx(float* out) {
    const int l = threadIdx.x, r = l & 31, h = l >> 5;
    float code = 0.f;
    for (int hyp = 0; hyp < 2; ++hyp) {
        unsigned char ab[32], bb[32];
        for (int j = 0; j < 32; ++j) { const int k = hyp == 0 ? 32 * h + j : (j < 16 ? 16 * h + j : 32 + 16 * h + (j - 16));
            ab[j] = f8enc(k == (7 * r + 3) % 64 ? 1 : 0); bb[j] = f8enc(1 + ((k + 3 * r) % 13)); }
        v8i_t A, B;
        for (int d = 0; d < 8; ++d) { A[d] = ab[4 * d] | (ab[4 * d + 1] << 8) | (ab[4 * d + 2] << 16) | (ab[4 * d + 3] << 24); B[d] = bb[4 * d] | (bb[4 * d + 1] << 8) | (bb[4 * d + 2] << 16) | (bb[4 * d + 3] << 24); }
        v16f_t c = {};
        c = __builtin_amdgcn_mfma_scale_f32_32x32x64_f8f6f4(A, B, c, 0, 0, 0, 0x7F7F7F7F, 0, 0x7F7F7F7F);
        bool ok = true;
        for (int g = 0; g < 16; ++g) { const int row = (g & 3) + 8 * (g >> 2) + 4 * h, col = r; const int kk = (7 * row + 3) % 64; const float expect = (float)(1 + ((kk + 3 * col) % 13)); ok = ok && (c[g] == expect); }
        const bool all_ok = __all(ok);
        if (all_ok) code += (hyp == 0 ? 1.f : 2.f);
    }
    if (l == 0) out[0] = 1000.f * (1.f + code);
}
#endif

extern "C" void kernel_launch(void* const* d_in, const int* in_sizes, int n_in, void* d_out, int out_size, void* d_ws, size_t ws_size, hipStream_t stream) {
    static int grid = 0;
    if (grid == 0) {
        if (n_in != 21 || in_sizes[0] != SEQ * DM || out_size != SEQ * DM || ws_size < WS_END) {
            fprintf(stderr, "kernel_launch: built for 21 inputs, x/out of %d floats, >= %zu bytes of workspace; got n_in %d, in0 %d, out %d, ws %zu; nothing launched\n", SEQ * DM, (size_t)WS_END, n_in, n_in > 0 ? in_sizes[0] : -1, out_size, ws_size); grid = -1; return; }
        int dev = 0, cus = 0, per_cu = 0;
        if (hipGetDevice(&dev) != hipSuccess || hipDeviceGetAttribute(&cus, hipDeviceAttributeMultiprocessorCount, dev) != hipSuccess) { fprintf(stderr, "kernel_launch: device query failed\n"); grid = -1; return; }
        if (hipFuncSetAttribute((const void*)fwd, hipFuncAttributeMaxDynamicSharedMemorySize, LDS_BYTES) != hipSuccess) { fprintf(stderr, "kernel_launch: hipFuncSetAttribute failed\n"); grid = -1; return; }
        if (hipOccupancyMaxActiveBlocksPerMultiprocessor(&per_cu, (const void*)fwd, NTHR, LDS_BYTES) != hipSuccess || per_cu < 1) fprintf(stderr, "kernel_launch: note: occupancy query reports %d workgroups per CU\n", per_cu);
        (void)hipGetLastError();
        grid = cus;
    }
    if (grid < 0) return;
    if (hipMemsetAsync((char*)d_ws + WS_CTL, 0, CTL_ZERO_BYTES, stream) != hipSuccess) { fprintf(stderr, "kernel_launch: memset failed\n"); return; }
    Args a{};
    for (int i = 0; i < 21; ++i) a.in[i] = (const float*)d_in[i];
    a.out = (float*)d_out; a.ws = (unsigned char*)d_ws;
#if MK_ONE_LAUNCH
    a.ph_lo = 0; a.ph_hi = NPHASE;
    hipLaunchKernelGGL(fwd, dim3(grid), dim3(NTHR), LDS_BYTES, stream, a);
#ifndef PROBE_MODE
#define PROBE_MODE 0
#endif
#ifdef PROBE_PHASES
    for (int p = 0; p < NPHASE; ++p) if ((PROBE_PHASES >> p) & 1) { a.ph_lo = p; a.ph_hi = p + 1; a.probe = PROBE_MODE; hipLaunchKernelGGL(fwd, dim3(grid), dim3(NTHR), LDS_BYTES, stream, a); }
#endif
#else
    for (int p = 0; p < NPHASE; ++p) { a.ph_lo = p; a.ph_hi = p + 1; hipLaunchKernelGGL(fwd, dim3(grid), dim3(NTHR), LDS_BYTES, stream, a); }
#endif
#ifdef PROBE_MX
    hipLaunchKernelGGL(probe_mx, dim3(1), dim3(64), 0, stream, (float*)d_out);
#endif
    const hipError_t le = hipPeekAtLastError();
    if (le != hipSuccess) fprintf(stderr, "kernel_launch: launch failed: %s\n", hipGetErrorName(le));
}
```

```cpp
#include <hip/hip_runtime.h>
#include <cstdio>
#include <cstdint>
#include <cmath>
namespace pg8 {
#define PG8_LAS __attribute__((address_space(3)))
typedef unsigned short bf16_t;
typedef short bf16x8 __attribute__((ext_vector_type(8)));
typedef float f32x4 __attribute__((ext_vector_type(4)));
typedef unsigned u32x4 __attribute__((ext_vector_type(4)));
constexpr int BM = 256, BK = 64, HALF = 128, HTB = HALF * BK * 2  , STAGE_BYTES = 8 * HTB, NXCD = 8, WGM = 8;

__host__ __device__ __forceinline__ int lds_byte(int r, int c) { const int st = (r >> 4) * 2 + (c >> 5), rr = r & 15, cc = c & 31, ob = rr * 64 + cc * 2; return st * 1024 + (ob ^ (((ob >> 9) & 1) << 5)); }
__host__ __device__ __forceinline__ void stage_rc(int b, int& R, int& C) { const int st = b / 1024, sb = b % 1024, swz = sb ^ (((sb >> 9) & 1) << 5); R = (st >> 1) * 16 + swz / 64; C = (st & 1) * 32 + (swz % 64) / 2; }
__host__ __device__ __forceinline__ int perm32(int rho) { const int n = rho >> 4, i = rho & 15; return 8 * (i >> 2) + 4 * n + (i & 3); }

struct Unit { int pm, pn; };
struct Gemm { const bf16_t* A; const bf16_t* Bt; int M, N, K; size_t a_pn; size_t b_pm; };

struct StaticOrder {
    int nM, nN, nwg, G, c;
    __host__ __device__ void init(int M, int N, int G_, int c_) { nM = M / BM; nN = N / BM; nwg = nM * nN; G = G_; c = c_; }
    __host__ __device__ bool next(int i, Unit& u) const {
        const long L = (long)i * G + c; if (L >= nwg) return false;
        int wgid = (int)L; { const int q = nwg / NXCD, r = nwg % NXCD, xcd = wgid % NXCD, off = wgid / NXCD; wgid = (xcd < r ? xcd * (q + 1) : r * (q + 1) + (xcd - r) * q) + off; }
        const int nig = WGM * nN, gid = wgid / nig, fm = gid * WGM, gsz = (nM - fm) < WGM ? (nM - fm) : WGM;
        u.pm = fm + ((wgid % nig) % gsz); u.pn = (wgid % nig) / gsz; return true;
    }
    __device__ __forceinline__ void a_ready(const Unit&) const {}
    __device__ __forceinline__ void done(const Unit&) const {}
};

__device__ __forceinline__ unsigned cvt_pk_bf16(float lo, float hi) { unsigned r; asm volatile("v_cvt_pk_bf16_f32 %0, %1, %2" : "=v"(r) : "v"(lo), "v"(hi)); return r; }
typedef float f32x2 __attribute__((ext_vector_type(2)));
__device__ __forceinline__ f32x2 gelu_pk(f32x2 v) {
    const f32x2 av = __builtin_elementwise_abs(v), d = av * 0.2316418882f + 1.0f;
    f32x2 t; t.x = __builtin_amdgcn_rcpf(d.x); t.y = __builtin_amdgcn_rcpf(d.y);
    f32x2 q = t * 0.5307027145f + (-0.7265760135f); q = q * t + 0.7107068705f; q = q * t + (-0.142248368f); q = q * t + 0.127414796f; q = q * t;
    const f32x2 s = (v * v) * (-0.72134752044f);
    f32x2 e; e.x = __builtin_amdgcn_exp2f(s.x); e.y = __builtin_amdgcn_exp2f(s.y);
    const f32x2 m = v * (q * e), r = v - m;
    f32x2 o; o.x = v.x < 0.f ? m.x : r.x; o.y = v.y < 0.f ? m.y : r.y; return o;
}


__device__ __forceinline__ u32x4 pack8(f32x4 v0, f32x4 v1) { u32x4 w; w.x = cvt_pk_bf16(v0[0], v0[1]); w.y = cvt_pk_bf16(v0[2], v0[3]); w.z = cvt_pk_bf16(v1[0], v1[1]); w.w = cvt_pk_bf16(v1[2], v1[3]); return w; }
__device__ __forceinline__ unsigned long long pack8_fp8(f32x4 v0, f32x4 v1) { int lo = __builtin_amdgcn_cvt_pk_fp8_f32(v0[0], v0[1], 0, false); lo = __builtin_amdgcn_cvt_pk_fp8_f32(v0[2], v0[3], lo, true);
    int hi = __builtin_amdgcn_cvt_pk_fp8_f32(v1[0], v1[1], 0, false); hi = __builtin_amdgcn_cvt_pk_fp8_f32(v1[2], v1[3], hi, true); return (unsigned long long)(unsigned)lo | ((unsigned long long)(unsigned)hi << 32); }
__device__ __forceinline__ float quad_row_sum(float s) { s += __shfl_xor(s, 16); s += __shfl_xor(s, 32); return s; }

__device__ __forceinline__ f32x4 rope4(f32x4 v, const float* tab, int i) {
    const f32x4 cs = *(const f32x4*)(tab + 2 * i);
    f32x4 o; o[0] = v[0] * cs[0] - v[1] * cs[1]; o[1] = v[1] * cs[0] + v[0] * cs[1]; o[2] = v[2] * cs[2] - v[3] * cs[3]; o[3] = v[3] * cs[2] + v[2] * cs[3]; return o;
}

struct EpiIn {
    static constexpr bool PERM = true, AFTER_DRAIN = false;
    bf16_t* cq; bf16_t* ckv; unsigned char* kr; bf16_t* ub; bf16_t* gb; float* ssq_cq; float* ssq_ckv; const float* rope;
    __device__ __forceinline__ void operator()(const f32x4 (&acc)[2][2][4][2], const Unit& u, int wr, int wc, int fr, int fq) const {
        const int pn = u.pn, row0 = u.pm * BM + wr * 64 + fr, cw = wc * 32 + 8 * fq;
        if (pn < 5) {
            bf16_t* dst = pn < 3 ? cq : ckv; const int ld = pn < 3 ? 768 : 512, pl = pn < 3 ? pn : pn - 3, coff = pl * 256 + cw, nsl = pn < 3 ? 12 : 8; float* ssq = pn < 3 ? ssq_cq : ssq_ckv;
#pragma unroll
            for (int ai = 0; ai < 2; ++ai)
#pragma unroll
                for (int m = 0; m < 4; ++m) { const int row = row0 + ai * HALF + m * 16; float s = 0.f;
#pragma unroll
                    for (int bj = 0; bj < 2; ++bj) { const f32x4 v0 = acc[ai][bj][m][0], v1 = acc[ai][bj][m][1];
                        s += (v0[0] * v0[0] + v0[1] * v0[1]) + (v0[2] * v0[2] + v0[3] * v0[3]) + (v1[0] * v1[0] + v1[1] * v1[1]) + (v1[2] * v1[2] + v1[3] * v1[3]);
                        *(u32x4*)(dst + (size_t)row * ld + coff + bj * HALF) = pack8(v0, v1); }
                    s = quad_row_sum(s); if (fq == 0) ssq[(size_t)row * nsl + pl * 4 + wc] = s; }
        } else if (pn == 5) {
            if (wc < 2) {
#pragma unroll
                for (int ai = 0; ai < 2; ++ai)
#pragma unroll
                    for (int m = 0; m < 4; ++m) { const int row = row0 + ai * HALF + m * 16; f32x4 v0 = acc[ai][0][m][0], v1 = acc[ai][0][m][1];
                        if (row < 8192) { const int pos = wc == 0 ? (row >> 6) : 128 + (row & 63); const float* tab = rope + pos * 32; v0 = rope4(v0, tab, 4 * fq); v1 = rope4(v1, tab, 4 * fq + 2); }
                        *(unsigned long long*)(kr + (size_t)row * 64 + cw) = pack8_fp8(v0, v1); }
            }
        } else if (pn < 22) {
            const int j = pn - 6;
#pragma unroll
            for (int ai = 0; ai < 2; ++ai)
#pragma unroll
                for (int m = 0; m < 4; ++m) { const int row = row0 + ai * HALF + m * 16;
                    *(u32x4*)(ub + (size_t)row * 2048 + j * 128 + cw) = pack8(acc[ai][0][m][0] * acc[ai][1][m][0], acc[ai][0][m][1] * acc[ai][1][m][1]); }
        } else {
            const int j = pn - 22;
#pragma unroll
            for (int ai = 0; ai < 2; ++ai)
#pragma unroll
                for (int m = 0; m < 4; ++m) { const int row = row0 + ai * HALF + m * 16;
#pragma unroll
                    for (int bj = 0; bj < 2; ++bj) *(u32x4*)(gb + (size_t)row * 2048 + j * 256 + bj * HALF + cw) = pack8(acc[ai][bj][m][0], acc[ai][bj][m][1]); }
        }
    }
};

struct EpiQ {
    static constexpr bool PERM = true, AFTER_DRAIN = false;
    unsigned char* q; const float* ssq_cq; const float* rope; float c2;
    __device__ __forceinline__ void operator()(const f32x4 (&acc)[2][2][4][2], const Unit& u, int wr, int wc, int fr, int fq) const {
        const int row0 = u.pm * BM + wr * 64 + fr, cw = wc * 32 + 8 * fq;
#pragma unroll
        for (int ai = 0; ai < 2; ++ai)
#pragma unroll
            for (int m = 0; m < 4; ++m) { const int row = row0 + ai * HALF + m * 16; const f32x4 q0 = *(const f32x4*)(ssq_cq + (size_t)row * 12), q1 = *(const f32x4*)(ssq_cq + (size_t)row * 12 + 4), q2 = *(const f32x4*)(ssq_cq + (size_t)row * 12 + 8);
                const float ssum = (((q0[0] + q0[1]) + (q0[2] + q0[3])) + ((q1[0] + q1[1]) + (q1[2] + q1[3]))) + ((q2[0] + q2[1]) + (q2[2] + q2[3])); const float sc = c2 / sqrtf(ssum * (1.f / 768.f) + 1e-6f);
#pragma unroll
                for (int bj = 0; bj < 2; ++bj) { const int col = u.pn * BM + bj * HALF + cw, d = col % 192; f32x4 v0 = acc[ai][bj][m][0] * sc, v1 = acc[ai][bj][m][1] * sc;
                    if (d >= 128) { const int p = d - 128, ax = p >> 5, i = (p & 31) >> 1; const int pos = ax == 0 ? (row >> 6) : 128 + (row & 63); const float* tab = rope + pos * 32;
                        v0 = rope4(v0, tab, i); v1 = rope4(v1, tab, i + 2); }
                    *(unsigned long long*)(q + (size_t)row * 3072 + col) = pack8_fp8(v0, v1); } }
    }
};

struct EpiK {
    static constexpr bool PERM = true, AFTER_DRAIN = false;
    unsigned char* kn; const float* ssq_ckv;
    __device__ __forceinline__ void operator()(const f32x4 (&acc)[2][2][4][2], const Unit& u, int wr, int wc, int fr, int fq) const {
        const int row0 = u.pm * BM + wr * 64 + fr, cw = u.pn * BM + wc * 32 + 8 * fq;
#pragma unroll
        for (int ai = 0; ai < 2; ++ai)
#pragma unroll
            for (int m = 0; m < 4; ++m) { const int row = row0 + ai * HALF + m * 16; const f32x4 q0 = *(const f32x4*)(ssq_ckv + (size_t)row * 8), q1 = *(const f32x4*)(ssq_ckv + (size_t)row * 8 + 4);
                const float ssum = ((q0[0] + q0[1]) + (q0[2] + q0[3])) + ((q1[0] + q1[1]) + (q1[2] + q1[3])); const float sc = 1.f / sqrtf(ssum * (1.f / 512.f) + 1e-6f);
#pragma unroll
                for (int bj = 0; bj < 2; ++bj) *(unsigned long long*)(kn + (size_t)row * 2048 + cw + bj * HALF) = pack8_fp8(acc[ai][bj][m][0] * sc, acc[ai][bj][m][1] * sc); }
    }
};

struct EpiVT {
    static constexpr bool PERM = true, AFTER_DRAIN = false;
    unsigned char* vt; const float* ssq_ckv;
    __device__ __forceinline__ void operator()(const f32x4 (&acc)[2][2][4][2], const Unit& u, int wr, int wc, int fr, int fq) const {
        const int row0 = u.pm * BM + wr * 64 + fr, key0 = u.pn * BM + wc * 32 + 8 * fq;
        f32x4 rs[2][2];
#pragma unroll
        for (int bj = 0; bj < 2; ++bj)
#pragma unroll
            for (int n = 0; n < 2; ++n)
#pragma unroll
                for (int j = 0; j < 4; ++j) { const int key = key0 + bj * HALF + 4 * n + j; const f32x4 q0 = *(const f32x4*)(ssq_ckv + (size_t)key * 8), q1 = *(const f32x4*)(ssq_ckv + (size_t)key * 8 + 4);
                    const float ssum = ((q0[0] + q0[1]) + (q0[2] + q0[3])) + ((q1[0] + q1[1]) + (q1[2] + q1[3])); rs[bj][n][j] = 1.f / sqrtf(ssum * (1.f / 512.f) + 1e-6f); }
#pragma unroll
        for (int ai = 0; ai < 2; ++ai)
#pragma unroll
            for (int m = 0; m < 4; ++m) { const int row = row0 + ai * HALF + m * 16;
#pragma unroll
                for (int bj = 0; bj < 2; ++bj) { const int key8 = key0 + bj * HALF, g = (key8 & 63) >> 3; unsigned char* dst = vt + (size_t)row * 8448 + (key8 & ~63) + 16 * (g >> 2) + 4 * (g & 3);
                    const f32x4 v0 = acc[ai][bj][m][0] * rs[bj][0], v1 = acc[ai][bj][m][1] * rs[bj][1];
                    int w0 = __builtin_amdgcn_cvt_pk_fp8_f32(v0[0], v0[1], 0, false); w0 = __builtin_amdgcn_cvt_pk_fp8_f32(v0[2], v0[3], w0, true);
                    int w1 = __builtin_amdgcn_cvt_pk_fp8_f32(v1[0], v1[1], 0, false); w1 = __builtin_amdgcn_cvt_pk_fp8_f32(v1[2], v1[3], w1, true);
                    *(int*)dst = w0; *(int*)(dst + 32) = w1; } }
    }
};

struct EpiO {
    static constexpr bool PERM = true, AFTER_DRAIN = false;
    const float* gate; bf16_t* dlt;
    __device__ __forceinline__ void operator()(const f32x4 (&acc)[2][2][4][2], const Unit& u, int wr, int wc, int fr, int fq) const {
        const int row0 = u.pm * BM + wr * 64 + fr, c0 = u.pn * BM + wc * 32 + 8 * fq;
        f32x4 g[2][2];
#pragma unroll
        for (int bj = 0; bj < 2; ++bj)
#pragma unroll
            for (int n = 0; n < 2; ++n) g[bj][n] = *(const f32x4*)(gate + c0 + bj * HALF + 4 * n);
#pragma unroll
        for (int ai = 0; ai < 2; ++ai)
#pragma unroll
            for (int m = 0; m < 4; ++m) { const int row = row0 + ai * HALF + m * 16;
#pragma unroll
                for (int bj = 0; bj < 2; ++bj) *(u32x4*)(dlt + (size_t)row * 4096 + c0 + bj * HALF) = pack8(g[bj][0] * acc[ai][bj][m][0], g[bj][1] * acc[ai][bj][m][1]); }
    }
};

struct EpiPQ {
    static constexpr bool PERM = true, AFTER_DRAIN = false;
    bf16_t* qp;
    __device__ __forceinline__ void operator()(const f32x4 (&acc)[2][2][4][2], const Unit& u, int wr, int wc, int fr, int fq) const {
        const int row0 = u.pm * BM + wr * 64 + fr, cw = wc * 32 + 8 * fq; bf16_t* base = qp + (size_t)u.pn * 8192 * 256;
#pragma unroll
        for (int ai = 0; ai < 2; ++ai)
#pragma unroll
            for (int m = 0; m < 4; ++m) { const int row = row0 + ai * HALF + m * 16;
#pragma unroll
                for (int bj = 0; bj < 2; ++bj) *(u32x4*)(base + (size_t)row * 256 + bj * HALF + cw) = pack8(acc[ai][bj][m][0], acc[ai][bj][m][1]); }
    }
};

struct EpiB16 {
    static constexpr bool PERM = true, AFTER_DRAIN = false;
    bf16_t* o; int ldc;
    __device__ __forceinline__ void operator()(const f32x4 (&acc)[2][2][4][2], const Unit& u, int wr, int wc, int fr, int fq) const {
        const int row0 = u.pm * BM + wr * 64 + fr, c0 = u.pn * BM + wc * 32 + 8 * fq;
#pragma unroll
        for (int ai = 0; ai < 2; ++ai)
#pragma unroll
            for (int m = 0; m < 4; ++m) { const int row = row0 + ai * HALF + m * 16;
#pragma unroll
                for (int bj = 0; bj < 2; ++bj) *(u32x4*)(o + (size_t)row * ldc + c0 + bj * HALF) = pack8(acc[ai][bj][m][0], acc[ai][bj][m][1]); }
    }
};

struct EpiF32 {
    static constexpr bool PERM = true, AFTER_DRAIN = false;
    float* o; int ldc;
    __device__ __forceinline__ void operator()(const f32x4 (&acc)[2][2][4][2], const Unit& u, int wr, int wc, int fr, int fq) const {
        const int row0 = u.pm * BM + wr * 64 + fr, c0 = u.pn * BM + wc * 32 + 8 * fq;
#pragma unroll
        for (int ai = 0; ai < 2; ++ai)
#pragma unroll
            for (int m = 0; m < 4; ++m) { const int row = row0 + ai * HALF + m * 16;
#pragma unroll
                for (int bj = 0; bj < 2; ++bj)
#pragma unroll
                    for (int n = 0; n < 2; ++n) *(f32x4*)(o + (size_t)row * ldc + c0 + bj * HALF + 4 * n) = acc[ai][bj][m][n]; }
    }
};

struct OrderIn : StaticOrder {
    __device__ bool next(int i, Unit& u) const {
        const long L = (long)i * G + c;
        if (L < nwg) return StaticOrder::next(i, u);
        if (L < nwg + 3) { u.pm = 32; u.pn = 3 + (int)(L - nwg); return true; }
        return false;
    }
};

struct RunOrder {
    int base, cnt, nN;
    __device__ bool next(int i, Unit& u) const { if (i >= cnt) return false; const int idx = base + i; u.pm = idx / nN; u.pn = idx % nN; return true; }
    __device__ __forceinline__ void a_ready(const Unit&) const {}
    __device__ __forceinline__ void done(const Unit&) const {}
};
template <class Epi, class Sched, bool ALIGN_EPI = false, bool SP2 = false>
__device__ __forceinline__ void gemm_phase(PG8_LAS unsigned char* lds, const Gemm g, const Sched& S, const Epi& E) {
    int tid_o_ = threadIdx.x; asm volatile("" : "+v"(tid_o_));
    const int tid = tid_o_, wid = __builtin_amdgcn_readfirstlane(tid >> 6), lane = tid & 63, wr = wid >> 2, wc = wid & 3, fr = lane & 15, fq = lane >> 4;
    const int K = g.K, nt = K / BK;
    unsigned voffA[2], voffB[2];
#pragma unroll
    for (int i = 0; i < 2; ++i) { int R, C; stage_rc(tid * 16 + i * 8192, R, C); const int Rb = Epi::PERM ? ((R & ~31) + perm32(R & 31)) : R;
        voffA[i] = (unsigned)(R * K + C) * 2u; voffB[i] = (unsigned)(Rb * K + C) * 2u; }
    const size_t kstep = (size_t)(BK * 2);
    const size_t hstep = (size_t)HALF * K * 2;
    const size_t tstep = 2 * hstep;
    const unsigned ldsw = (unsigned)wid * 1024u;
    const int aoff = lds_byte(wr * 64 + fr, fq * 8), boff = lds_byte(wc * 32 + fr, fq * 8);
#define PG8_SA(b, h) (((b) * 2 + (h)) * HTB)
#define PG8_SB(b, h) ((4 + (b) * 2 + (h)) * HTB)
#define PG8_STAGE(bufoff, gbase, voff) do { _Pragma("unroll") for (int _i = 0; _i < 2; ++_i) \
        __builtin_amdgcn_global_load_lds((const unsigned*)((const char*)(gbase) + (voff)[_i]), (PG8_LAS unsigned*)(lds + (bufoff) + ldsw + _i * 8192), 16, 0, 0); } while (0)
#define PG8_LDA(dst, b, h) do { _Pragma("unroll") for (int m = 0; m < 4; ++m) _Pragma("unroll") for (int k = 0; k < 2; ++k) dst[m][k] = *(const PG8_LAS bf16x8*)(lds + PG8_SA(b, h) + aoff + m * 2048 + k * 1024); } while (0)
#define PG8_LDB(dst, b, h) do { _Pragma("unroll") for (int n = 0; n < 2; ++n) _Pragma("unroll") for (int k = 0; k < 2; ++k) dst[n][k] = *(const PG8_LAS bf16x8*)(lds + PG8_SB(b, h) + boff + n * 2048 + k * 1024); } while (0)
#define PG8_MMA(ai, bj, At, Bt) do { __builtin_amdgcn_s_setprio(1); _Pragma("unroll") for (int m = 0; m < 4; ++m) _Pragma("unroll") for (int n = 0; n < 2; ++n) _Pragma("unroll") for (int k = 0; k < 2; ++k) \
        acc[ai][bj][m][n] = __builtin_amdgcn_mfma_f32_16x16x32_bf16(Bt[n][k], At[m][k], acc[ai][bj][m][n], 0, 0, 0); __builtin_amdgcn_s_setprio(0); } while (0)
#define PG8_WAIT_V(n) asm volatile("s_waitcnt vmcnt(" #n ")" ::: "memory")
#define PG8_WAIT_L(n) asm volatile("s_waitcnt lgkmcnt(" #n ")" ::: "memory")
#define PG8_BAR __builtin_amdgcn_s_barrier()
#define PG8_SCHED __builtin_amdgcn_sched_barrier(0)
    Unit cur, nxt; int ui = 0;
    if (!S.next(0, cur)) return;
    f32x4 acc[2][2][4][2];
#pragma unroll
    for (int a = 0; a < 2; ++a)
#pragma unroll
        for (int b = 0; b < 2; ++b)
#pragma unroll
            for (int m = 0; m < 4; ++m)
#pragma unroll
                for (int n = 0; n < 2; ++n) acc[a][b][m][n] = (f32x4){0.f, 0.f, 0.f, 0.f};
    bf16x8 At[4][2], B0[2][2], B1[2][2];
    const char* cA = (const char*)g.A + (size_t)cur.pm * tstep + (size_t)cur.pn * g.a_pn; const char* cB = (const char*)g.Bt + (size_t)cur.pn * tstep + (size_t)cur.pm * g.b_pm;
    S.a_ready(cur);
    if constexpr (SP2) {
        PG8_STAGE(PG8_SB(0, 0), cB, voffB); PG8_STAGE(PG8_SB(0, 1), cB + hstep, voffB); PG8_STAGE(PG8_SA(0, 0), cA, voffA); PG8_STAGE(PG8_SA(0, 1), cA + hstep, voffA);
        if (wr == 1) PG8_BAR;
        PG8_WAIT_V(2); PG8_BAR;
        PG8_STAGE(PG8_SB(1, 0), cB + kstep, voffB); PG8_STAGE(PG8_SA(1, 0), cA + kstep, voffA); PG8_STAGE(PG8_SB(1, 1), cB + hstep + kstep, voffB);
        PG8_WAIT_V(6); PG8_BAR;
    } else {
        PG8_STAGE(PG8_SB(0, 0), cB, voffB); PG8_STAGE(PG8_SA(0, 0), cA, voffA); PG8_STAGE(PG8_SB(0, 1), cB + hstep, voffB); PG8_STAGE(PG8_SA(0, 1), cA + hstep, voffA);
        if (wr == 1) PG8_BAR;
        PG8_WAIT_V(4); PG8_BAR;
        PG8_STAGE(PG8_SB(1, 0), cB + kstep, voffB); PG8_STAGE(PG8_SA(1, 0), cA + kstep, voffA); PG8_STAGE(PG8_SB(1, 1), cB + hstep + kstep, voffB);
        PG8_WAIT_V(6); PG8_BAR;
    }
    for (;;) {
        const bool has_next = S.next(ui + 1, nxt);
        const char* nA = has_next ? (const char*)g.A + (size_t)nxt.pm * tstep + (size_t)nxt.pn * g.a_pn : cA; const char* nB = has_next ? (const char*)g.Bt + (size_t)nxt.pn * tstep + (size_t)nxt.pm * g.b_pm : cB;
        for (int t = 0; t < nt; t += 2) {
            const bool last = (t == nt - 2);
            const char* a1 = cA + (size_t)(t + 1) * kstep;
            const char* a2 = last ? nA : cA + (size_t)(t + 2) * kstep; const char* b2 = last ? nB : cB + (size_t)(t + 2) * kstep;
            const char* a3 = a2 + kstep; const char* b3 = b2 + kstep;
            if (last && has_next) S.a_ready(nxt);
            if constexpr (SP2) {
            PG8_LDB(B0, 0, 0); PG8_LDB(B1, 0, 1); PG8_SCHED; PG8_LDA(At, 0, 0); PG8_STAGE(PG8_SA(1, 1), a1 + hstep, voffA);
            PG8_WAIT_V(8); PG8_WAIT_L(0); PG8_BAR; PG8_MMA(0, 0, At, B0); PG8_MMA(0, 1, At, B1); PG8_BAR; PG8_SCHED;
            PG8_LDA(At, 0, 1); PG8_STAGE(PG8_SB(0, 0), b2, voffB); PG8_STAGE(PG8_SB(0, 1), b2 + hstep, voffB); PG8_STAGE(PG8_SA(0, 0), a2, voffA);
            PG8_WAIT_V(8); PG8_WAIT_L(0); PG8_BAR; PG8_MMA(1, 0, At, B0); PG8_MMA(1, 1, At, B1); PG8_BAR; PG8_SCHED;
            PG8_LDB(B0, 1, 0); PG8_LDB(B1, 1, 1); PG8_SCHED; PG8_LDA(At, 1, 0); PG8_STAGE(PG8_SA(0, 1), a2 + hstep, voffA);
            PG8_WAIT_V(8); PG8_WAIT_L(0); PG8_BAR; PG8_MMA(0, 0, At, B0); PG8_MMA(0, 1, At, B1); PG8_BAR; PG8_SCHED;
            PG8_LDA(At, 1, 1); PG8_STAGE(PG8_SB(1, 0), b3, voffB); PG8_STAGE(PG8_SB(1, 1), b3 + hstep, voffB); PG8_STAGE(PG8_SA(1, 0), a3, voffA);
            PG8_WAIT_V(8); PG8_WAIT_L(0); PG8_BAR; PG8_MMA(1, 0, At, B0); PG8_MMA(1, 1, At, B1); PG8_BAR; PG8_SCHED;
            } else {
            PG8_LDB(B0, 0, 0); PG8_SCHED; PG8_LDA(At, 0, 0); PG8_STAGE(PG8_SA(1, 1), a1 + hstep, voffA);
            PG8_WAIT_L(8); PG8_BAR; PG8_WAIT_L(0); PG8_MMA(0, 0, At, B0); PG8_BAR; PG8_SCHED;
            PG8_LDB(B1, 0, 1); PG8_STAGE(PG8_SB(0, 0), b2, voffB);
            PG8_BAR; PG8_WAIT_L(0); PG8_MMA(0, 1, At, B1); PG8_BAR;
            PG8_LDA(At, 0, 1); PG8_STAGE(PG8_SA(0, 0), a2, voffA);
            PG8_BAR; PG8_WAIT_L(0); PG8_MMA(1, 0, At, B0); PG8_BAR; PG8_SCHED;
            PG8_STAGE(PG8_SB(0, 1), b2 + hstep, voffB);
            PG8_WAIT_V(6); PG8_BAR; PG8_MMA(1, 1, At, B1); PG8_BAR;
            PG8_LDB(B0, 1, 0); PG8_SCHED; PG8_LDA(At, 1, 0); PG8_STAGE(PG8_SA(0, 1), a2 + hstep, voffA);
            PG8_WAIT_L(8); PG8_BAR; PG8_WAIT_L(0); PG8_MMA(0, 0, At, B0); PG8_BAR; PG8_SCHED;
            PG8_LDB(B1, 1, 1); PG8_STAGE(PG8_SB(1, 0), b3, voffB);
            PG8_BAR; PG8_WAIT_L(0); PG8_MMA(0, 1, At, B1); PG8_BAR;
            PG8_LDA(At, 1, 1); PG8_STAGE(PG8_SA(1, 0), a3, voffA);
            PG8_BAR; PG8_WAIT_L(0); PG8_MMA(1, 0, At, B0); PG8_BAR; PG8_SCHED;
            PG8_STAGE(PG8_SB(1, 1), b3 + hstep, voffB);
            PG8_WAIT_V(6); PG8_BAR; PG8_MMA(1, 1, At, B1); PG8_BAR;
            }
        }
        if constexpr (ALIGN_EPI) { if (wr == 0) PG8_BAR; }
        if constexpr (!Epi::AFTER_DRAIN) { E(acc, cur, wr, wc, fr, fq); S.done(cur); }
        if (!has_next) break;
#pragma unroll
        for (int a = 0; a < 2; ++a)
#pragma unroll
            for (int b = 0; b < 2; ++b)
#pragma unroll
                for (int m = 0; m < 4; ++m)
#pragma unroll
                    for (int n = 0; n < 2; ++n) acc[a][b][m][n] = (f32x4){0.f, 0.f, 0.f, 0.f};
        cur = nxt; cA = nA; cB = nB; ++ui;
        if constexpr (ALIGN_EPI) { if (wr == 1) PG8_BAR; }
    }
    PG8_WAIT_V(0);
    if constexpr (!ALIGN_EPI) { if (wr == 0) PG8_BAR; }
    PG8_BAR;
    if constexpr (Epi::AFTER_DRAIN) { E.fused(acc, cur, wr, wc, fr, fq, lds, wid, lane); S.done(cur); }
#undef PG8_SA
#undef PG8_SB
#undef PG8_STAGE
#undef PG8_LDA
#undef PG8_LDB
#undef PG8_MMA
#undef PG8_WAIT_V
#undef PG8_WAIT_L
#undef PG8_BAR
#undef PG8_SCHED
}
}

namespace att {
using bf16x8 = __attribute__((ext_vector_type(8))) short;
using s16x4  = __attribute__((ext_vector_type(4))) short;
using f32x16 = __attribute__((ext_vector_type(16))) float;
using u32x4  = __attribute__((ext_vector_type(4))) unsigned;
typedef unsigned short bf16;
constexpr int NW = 8, QBLK = 32, KVBLK = 64;
#ifndef ATT_SDEPTH
#define ATT_SDEPTH 1
#endif
constexpr int SDEPTH = ATT_SDEPTH;
#ifndef QKT_GRP
#define QKT_GRP 4
#endif
constexpr int LDQ = 3072, LDKV = 2048, LDKR = 64, LDO = 4096, LDVT = 8448;
constexpr int SHM_V = 8192, SHM_KN = 8192, SHM_KR = 4096;
constexpr float QSC = 64.f, QSI = 1.f / 64.f;
constexpr int NSLOT = 3, OFF_V = 0, OFF_KN = NSLOT * SHM_V, OFF_KR = OFF_KN + NSLOT * SHM_KN, OFF_WS = OFF_KR + NSLOT * SHM_KR, SHM_ATTN = OFF_WS + NW * 64 * 4;
#define ALDS __attribute__((address_space(3)))
constexpr float THRL = 2.5f * 1.4426950408889634f * 64.f;
constexpr float PSH = 5.f;
#define KSWZ(row, colB) ((row) * 256 + ((colB) ^ (((row) & 15) << 4)))
#define RSWZ(row, colB) ((row) * 128 + ((colB) ^ ((((row) >> 1) & 7) << 4)))
#define SBAR() __builtin_amdgcn_sched_barrier(0)
__device__ __forceinline__ int crow(int r, int hi) { return (r & 3) + 8 * (r >> 2) + 4 * hi; }
__device__ __forceinline__ unsigned cvtpk(float lo, float hi) { unsigned r; asm volatile("v_cvt_pk_bf16_f32 %0, %1, %2" : "=v"(r) : "v"(lo), "v"(hi)); return r; }

typedef int v8i32_t __attribute__((ext_vector_type(8)));
__device__ __forceinline__ void partialSM(f32x16& p0, f32x16& p1, float& m_reg, float& mn, float& alpha) {
  float pmax = p0[0];
#pragma unroll
  for (int r = 1; r < 16; ++r) pmax = fmaxf(pmax, p0[r]);
#pragma unroll
  for (int r = 0; r < 16; ++r) pmax = fmaxf(pmax, p1[r]);
  { auto rr = __builtin_amdgcn_permlane32_swap(__float_as_uint(pmax), __float_as_uint(pmax), false, false);
    pmax = fmaxf(__uint_as_float(rr[0]), __uint_as_float(rr[1])); }
  if (__builtin_expect(__all(pmax - m_reg <= THRL), 1)) { mn = m_reg; alpha = 1.f; }
  else { mn = fmaxf(m_reg, pmax); alpha = __builtin_amdgcn_exp2f((m_reg - mn) * QSI); m_reg = mn; }
  const float mnq = fmaf(-mn, QSI, PSH);
#pragma unroll
  for (int r = 0; r < 16; ++r) p0[r] = fmaf(p0[r], QSI, mnq);
#pragma unroll
  for (int r = 0; r < 16; ++r) p1[r] = fmaf(p1[r], QSI, mnq);
#pragma unroll
  for (int r = 0; r < 16; ++r) p0[r] = __builtin_amdgcn_exp2f(p0[r]);
}
__device__ __forceinline__ void finishSM(f32x16& p0, f32x16& p1, float alpha, float& l_reg, v8i32_t& pa8) {
#pragma unroll
  for (int r = 0; r < 16; ++r) p1[r] = __builtin_amdgcn_exp2f(p1[r]);
  float ps = 0;
#pragma unroll
  for (int r = 0; r < 16; ++r) ps += p0[r];
#pragma unroll
  for (int r = 0; r < 16; ++r) ps += p1[r];
  { auto rr = __builtin_amdgcn_permlane32_swap(__float_as_uint(ps), __float_as_uint(ps), false, false);
    ps = __uint_as_float(rr[0]) + __uint_as_float(rr[1]); }
  l_reg = l_reg * alpha + ps;
#pragma unroll
  for (int i = 0; i < 4; ++i) { int w = __builtin_amdgcn_cvt_pk_fp8_f32(p0[4 * i], p0[4 * i + 1], 0, false); w = __builtin_amdgcn_cvt_pk_fp8_f32(p0[4 * i + 2], p0[4 * i + 3], w, true); pa8[i] = w;
    int w2 = __builtin_amdgcn_cvt_pk_fp8_f32(p1[4 * i], p1[4 * i + 1], 0, false); w2 = __builtin_amdgcn_cvt_pk_fp8_f32(p1[4 * i + 2], p1[4 * i + 3], w2, true); pa8[4 + i] = w2; }
}
#ifndef QKT_PF
#define QKT_PF 0
#endif
#if QKT_PF == 0
__device__ __forceinline__ void qkt(f32x16& p0, f32x16& p1, const char* Kn, const char* Kr, const bf16x8* qr, const char* Qr, int r32, int hi) {
  p0 = f32x16{}; p1 = f32x16{};
#pragma unroll
  for (int d0 = 0; d0 < 8; ++d0) { const int cb = (d0 * 16 + hi * 8) * 2;
    bf16x8 b0 = *reinterpret_cast<const bf16x8*>(Kn + KSWZ(r32, cb));
    bf16x8 b1 = *reinterpret_cast<const bf16x8*>(Kn + KSWZ(32 + r32, cb));
    p0 = __builtin_amdgcn_mfma_f32_32x32x16_bf16(b0, qr[d0], p0, 0, 0, 0);
    p1 = __builtin_amdgcn_mfma_f32_32x32x16_bf16(b1, qr[d0], p1, 0, 0, 0);
    if ((d0 & (QKT_GRP - 1)) == QKT_GRP - 1) SBAR(); }
#pragma unroll
  for (int d0 = 0; d0 < 4; ++d0) { const int cb = (d0 * 16 + hi * 8) * 2;
    bf16x8 b0 = *reinterpret_cast<const bf16x8*>(Kr + RSWZ(r32, cb));
    bf16x8 b1 = *reinterpret_cast<const bf16x8*>(Kr + RSWZ(32 + r32, cb));
    const bf16x8 qf = qr[8 + d0];
    p0 = __builtin_amdgcn_mfma_f32_32x32x16_bf16(b0, qf, p0, 0, 0, 0);
    p1 = __builtin_amdgcn_mfma_f32_32x32x16_bf16(b1, qf, p1, 0, 0, 0);
    if ((d0 & (QKT_GRP - 1)) == QKT_GRP - 1) SBAR(); }
}
#else
__device__ __forceinline__ void qkt(f32x16& p0, f32x16& p1, const char* Kn, const char* Kr, const bf16x8* qr, const char* Qr, int r32, int hi) {
  p0 = f32x16{}; p1 = f32x16{};
  constexpr int NB = QKT_PF + 1;
  bf16x8 kb0[NB], kb1[NB], qf[NB];
#define KLD(S) do { constexpr int s_ = (S), i_ = s_ % NB; if constexpr (s_ < 8) { const int cb = (s_ * 16 + hi * 8) * 2; kb0[i_] = *reinterpret_cast<const bf16x8*>(Kn + KSWZ(r32, cb)); kb1[i_] = *reinterpret_cast<const bf16x8*>(Kn + KSWZ(32 + r32, cb)); } \
    else { const int cb = ((s_ - 8) * 16 + hi * 8) * 2; kb0[i_] = *reinterpret_cast<const bf16x8*>(Kr + RSWZ(r32, cb)); kb1[i_] = *reinterpret_cast<const bf16x8*>(Kr + RSWZ(32 + r32, cb)); qf[i_] = *reinterpret_cast<const bf16x8*>(Qr + (s_ - 8) * 1024); } } while (0)
#define KSTEP(S) do { constexpr int s_ = (S), i_ = s_ % NB; if constexpr (s_ + QKT_PF < 12) KLD(S + QKT_PF); const bf16x8 q_ = s_ < 8 ? qr[s_ < 8 ? s_ : 0] : qf[i_]; \
    p0 = __builtin_amdgcn_mfma_f32_32x32x16_bf16(kb0[i_], q_, p0, 0, 0, 0); p1 = __builtin_amdgcn_mfma_f32_32x32x16_bf16(kb1[i_], q_, p1, 0, 0, 0); } while (0)
  KLD(0); if constexpr (QKT_PF >= 2) KLD(1);
  KSTEP(0); KSTEP(1); KSTEP(2); KSTEP(3); KSTEP(4); KSTEP(5); KSTEP(6); KSTEP(7); KSTEP(8); KSTEP(9); KSTEP(10); KSTEP(11);
#undef KLD
#undef KSTEP
}
#endif
__device__ __forceinline__ int v_st(int k, int c) { const int kk = (k & ~0xC) | ((k & 4) << 1) | ((k & 8) >> 1); return ((kk >> 3) * 4 + (c >> 5)) * 512 + ((kk & 7) * 32 + (c & 31)) * 2; }
__device__ __forceinline__ int v_rd_base(int lane) { return ((lane & 3) << 3) | (((lane >> 2) & 3) << 6) | (((lane >> 4) & 1) << 5) | (((lane >> 5) & 1) << 8); }
constexpr int v_rd_off(int d0, int ks, int half) { return d0 * 512 + ks * 4096 + half * 2048; }
template <int OFF> __device__ __forceinline__ s16x4 tr_read(int vb) {
  s16x4 r; asm volatile("ds_read_b64_tr_b16 %0, %1 offset:%2" : "=&v"(r) : "v"(vb), "i"(OFF) : "memory"); return r;
}
template <int D0> __device__ __forceinline__ void pv_one(f32x16& od, int vb, bf16x8 pa0, bf16x8 pa1, bf16x8 pa2, bf16x8 pa3) {
  const s16x4 l0 = tr_read<v_rd_off(D0, 0, 0)>(vb), h0 = tr_read<v_rd_off(D0, 0, 1)>(vb), l1 = tr_read<v_rd_off(D0, 1, 0)>(vb), h1 = tr_read<v_rd_off(D0, 1, 1)>(vb);
  const s16x4 l2 = tr_read<v_rd_off(D0, 2, 0)>(vb), h2 = tr_read<v_rd_off(D0, 2, 1)>(vb), l3 = tr_read<v_rd_off(D0, 3, 0)>(vb), h3 = tr_read<v_rd_off(D0, 3, 1)>(vb);
  asm volatile("s_waitcnt lgkmcnt(0)" ::: "memory"); SBAR();
#define PK(L, H) (bf16x8){L[0], L[1], L[2], L[3], H[0], H[1], H[2], H[3]}
  od = __builtin_amdgcn_mfma_f32_32x32x16_bf16(pa0, PK(l0, h0), od, 0, 0, 0);
  od = __builtin_amdgcn_mfma_f32_32x32x16_bf16(pa1, PK(l1, h1), od, 0, 0, 0);
  od = __builtin_amdgcn_mfma_f32_32x32x16_bf16(pa2, PK(l2, h2), od, 0, 0, 0);
  od = __builtin_amdgcn_mfma_f32_32x32x16_bf16(pa3, PK(l3, h3), od, 0, 0, 0);
#undef PK
}
__device__ __forceinline__ void pv_d0(f32x16* o, int vb, bf16x8 pa0, bf16x8 pa1, bf16x8 pa2, bf16x8 pa3) {
  pv_one<0>(o[0], vb, pa0, pa1, pa2, pa3); pv_one<1>(o[1], vb, pa0, pa1, pa2, pa3); pv_one<2>(o[2], vb, pa0, pa1, pa2, pa3); pv_one<3>(o[3], vb, pa0, pa1, pa2, pa3);
}

#define LDSR128(dst, base, OFF) asm volatile("ds_read_b128 %0, %1 offset:%2" : "=v"(dst) : "v"((unsigned)(uintptr_t)(base)), "i"(OFF) : "memory")
#define WAITK4(N, A, B, C, D) asm volatile("s_waitcnt lgkmcnt(" #N ")" : "+v"(A), "+v"(B), "+v"(C), "+v"(D) :: "memory")
#define WAITV2(N, A, B) asm volatile("s_waitcnt lgkmcnt(" #N ")" : "+v"(A), "+v"(B) :: "memory")
#define V8OF(F) (v8i32_t){(int)F[0][0], (int)F[0][1], (int)F[0][2], (int)F[0][3], (int)F[1][0], (int)F[1][1], (int)F[1][2], (int)F[1][3]}
#define MXMFMA(KF, QF, ACC) __builtin_amdgcn_mfma_scale_f32_32x32x64_f8f6f4(V8OF(KF), QF, ACC, 0, 0, 0, 0x7F7F7F7F, 0, 0x7F7F7F7F)
#define MXMFMA2(PA, VF, ACC) __builtin_amdgcn_mfma_scale_f32_32x32x64_f8f6f4(PA, V8OF(VF), ACC, 0, 0, 0, 0x7F7F7F7F, 0, 0x7F7F7F7F)
template <bool DO_QK, bool DO_PV, class IssueF>
__device__ __forceinline__ void mat_segment(const IssueF& issue, f32x16& p0, f32x16& p1, f32x16* o, const ALDS char* Kn, const ALDS char* Kr, const ALDS char* Vb, const v8i32_t* qf, v8i32_t pa8, int r32, int hi) {
  u32x4 ka[3][2], kb[3][2], vf[4][2];
  const int nbase = r32 * 128, nsw = ((r32 >> 1) & 7) << 4, rbase = r32 * 64, rsw = ((r32 >> 2) & 3) << 4, hb = hi * 32;
  asm volatile("s_waitcnt lgkmcnt(0)" ::: "memory");
  if constexpr (DO_QK && DO_PV) {
  p0 = f32x16{}; p1 = f32x16{};
  { const int a_ = nbase + (((0 * 64) + hb) ^ nsw); LDSR128(ka[0][0], Kn + a_, 0); LDSR128(ka[0][1], Kn + (a_ ^ 16), 0); LDSR128(kb[0][0], Kn + a_, 4096); LDSR128(kb[0][1], Kn + (a_ ^ 16), 4096); }
  { const int a_ = nbase + (((1 * 64) + hb) ^ nsw); LDSR128(ka[1][0], Kn + a_, 0); LDSR128(ka[1][1], Kn + (a_ ^ 16), 0); LDSR128(kb[1][0], Kn + a_, 4096); LDSR128(kb[1][1], Kn + (a_ ^ 16), 4096); }
  { const int a_ = rbase + (hb ^ rsw); LDSR128(ka[2][0], Kr + a_, 0); LDSR128(ka[2][1], Kr + (a_ ^ 16), 0); LDSR128(kb[2][0], Kr + a_, 2048); LDSR128(kb[2][1], Kr + (a_ ^ 16), 2048); }
  { const int a_ = rbase + (hb ^ rsw); LDSR128(vf[0][0], Vb + a_, 0); LDSR128(vf[0][1], Vb + (a_ ^ 16), 0); }
  { const int a_ = rbase + (hb ^ rsw); LDSR128(vf[1][0], Vb + a_, 2048); LDSR128(vf[1][1], Vb + (a_ ^ 16), 2048); }
  { const int a_ = rbase + (hb ^ rsw); LDSR128(vf[2][0], Vb + a_, 4096); LDSR128(vf[2][1], Vb + (a_ ^ 16), 4096); }
  { const int a_ = rbase + (hb ^ rsw); LDSR128(vf[3][0], Vb + a_, 6144); LDSR128(vf[3][1], Vb + (a_ ^ 16), 6144); }
  WAITK4(15, ka[0][0], ka[0][1], kb[0][0], kb[0][1]);
  p0 = MXMFMA(ka[0], qf[0], p0); p1 = MXMFMA(kb[0], qf[0], p1);
  issue(0); issue(1);
  WAITK4(12, ka[1][0], ka[1][1], kb[1][0], kb[1][1]);
  p0 = MXMFMA(ka[1], qf[1], p0); p1 = MXMFMA(kb[1], qf[1], p1);
  issue(2);
  WAITK4(8, ka[2][0], ka[2][1], kb[2][0], kb[2][1]);
  p0 = MXMFMA(ka[2], qf[2], p0); p1 = MXMFMA(kb[2], qf[2], p1);
  WAITV2(6, vf[0][0], vf[0][1]);
  o[0] = MXMFMA2(pa8, vf[0], o[0]);
  WAITV2(4, vf[1][0], vf[1][1]);
  o[1] = MXMFMA2(pa8, vf[1], o[1]);
  WAITV2(2, vf[2][0], vf[2][1]);
  o[2] = MXMFMA2(pa8, vf[2], o[2]);
  WAITV2(0, vf[3][0], vf[3][1]);
  o[3] = MXMFMA2(pa8, vf[3], o[3]);
  } else if constexpr (DO_QK) {
  p0 = f32x16{}; p1 = f32x16{};
  { const int a_ = nbase + (((0 * 64) + hb) ^ nsw); LDSR128(ka[0][0], Kn + a_, 0); LDSR128(ka[0][1], Kn + (a_ ^ 16), 0); LDSR128(kb[0][0], Kn + a_, 4096); LDSR128(kb[0][1], Kn + (a_ ^ 16), 4096); }
  { const int a_ = nbase + (((1 * 64) + hb) ^ nsw); LDSR128(ka[1][0], Kn + a_, 0); LDSR128(ka[1][1], Kn + (a_ ^ 16), 0); LDSR128(kb[1][0], Kn + a_, 4096); LDSR128(kb[1][1], Kn + (a_ ^ 16), 4096); }
  { const int a_ = rbase + (hb ^ rsw); LDSR128(ka[2][0], Kr + a_, 0); LDSR128(ka[2][1], Kr + (a_ ^ 16), 0); LDSR128(kb[2][0], Kr + a_, 2048); LDSR128(kb[2][1], Kr + (a_ ^ 16), 2048); }
  WAITK4(8, ka[0][0], ka[0][1], kb[0][0], kb[0][1]);
  p0 = MXMFMA(ka[0], qf[0], p0); p1 = MXMFMA(kb[0], qf[0], p1);
  issue(0); issue(1);
  WAITK4(4, ka[1][0], ka[1][1], kb[1][0], kb[1][1]);
  p0 = MXMFMA(ka[1], qf[1], p0); p1 = MXMFMA(kb[1], qf[1], p1);
  issue(2);
  WAITK4(0, ka[2][0], ka[2][1], kb[2][0], kb[2][1]);
  p0 = MXMFMA(ka[2], qf[2], p0); p1 = MXMFMA(kb[2], qf[2], p1);
  } else {
  { const int a_ = rbase + (hb ^ rsw); LDSR128(vf[0][0], Vb + a_, 0); LDSR128(vf[0][1], Vb + (a_ ^ 16), 0); }
  { const int a_ = rbase + (hb ^ rsw); LDSR128(vf[1][0], Vb + a_, 2048); LDSR128(vf[1][1], Vb + (a_ ^ 16), 2048); }
  { const int a_ = rbase + (hb ^ rsw); LDSR128(vf[2][0], Vb + a_, 4096); LDSR128(vf[2][1], Vb + (a_ ^ 16), 4096); }
  { const int a_ = rbase + (hb ^ rsw); LDSR128(vf[3][0], Vb + a_, 6144); LDSR128(vf[3][1], Vb + (a_ ^ 16), 6144); }
  WAITV2(6, vf[0][0], vf[0][1]);
  o[0] = MXMFMA2(pa8, vf[0], o[0]);
  WAITV2(4, vf[1][0], vf[1][1]);
  o[1] = MXMFMA2(pa8, vf[1], o[1]);
  WAITV2(2, vf[2][0], vf[2][1]);
  o[2] = MXMFMA2(pa8, vf[2], o[2]);
  WAITV2(0, vf[3][0], vf[3][1]);
  o[3] = MXMFMA2(pa8, vf[3], o[3]);
  }
}

#define ATT_BAR() do { asm volatile("" ::: "memory"); __builtin_amdgcn_s_barrier(); asm volatile("" ::: "memory"); } while (0)
#define ATT_VM(N) asm volatile("s_waitcnt vmcnt(" #N ")" ::: "memory")
__device__ __forceinline__ void glds16(const bf16* g, ALDS unsigned char* l) { __builtin_amdgcn_global_load_lds((const unsigned*)g, (ALDS unsigned*)l, 16, 0, 0); }
__device__ __forceinline__ void glds8(const unsigned char* g, ALDS unsigned char* l) { __builtin_amdgcn_global_load_lds((const unsigned*)g, (ALDS unsigned*)l, 16, 0, 0); }
__device__ __forceinline__ void attn_unit(const unsigned char* __restrict__ Qb, const unsigned char* __restrict__ Knh, const unsigned char* __restrict__ Vth, const unsigned char* __restrict__ Krb,
                                          bf16* __restrict__ Ob, int seq, char* lds, ALDS unsigned char* L, const int probe) {
  int tid_ = threadIdx.x; asm volatile("" : "+v"(tid_));
  const int tid = tid_, wid = __builtin_amdgcn_readfirstlane(tid >> 6), lane = tid & 63, r32 = lane & 31, hi = lane >> 5;
  const bool trail = wid >= 4;
  float* ws = (float*)(lds + OFF_WS) + wid * 64; float* li_l = ws; float* al_l = ws + 32;
  float m_reg = -1e30f, l_reg = 0; f32x16 o[4] = {}; v8i32_t qf[3];
  const unsigned char* Qw = Qb + (long)(wid * QBLK + r32) * LDQ + hi * 32;
#pragma unroll
  for (int s_ = 0; s_ < 3; ++s_) { const u32x4 a0 = *reinterpret_cast<const u32x4*>(Qw + s_ * 64), a1 = *reinterpret_cast<const u32x4*>(Qw + s_ * 64 + 16);
    qf[s_] = (v8i32_t){(int)a0[0], (int)a0[1], (int)a0[2], (int)a0[3], (int)a1[0], (int)a1[1], (int)a1[2], (int)a1[3]}; }
#define VOFF() ([&]() { const int row = wid * 16 + (lane >> 2), colB = ((lane & 3) * 16) ^ (((row >> 2) & 3) << 4); return row * LDVT + colB; }())
#define KOFF() ([&]() { const int row = wid * 8 + (lane >> 3), colB = ((lane & 7) * 16) ^ (((row >> 1) & 7) << 4); return row * LDKV + colB; }())
#define ROFF() ([&]() { const int row = wid * 16 + (lane >> 2), colB = ((lane & 3) * 16) ^ (((row >> 2) & 3) << 4); return row * LDKR + colB; }())
  const ALDS char* KL = (const ALDS char*)L + OFF_KN; const ALDS char* RL = (const ALDS char*)L + OFF_KR; const ALDS char* VL = (const ALDS char*)L + OFF_V;
#define ISSUE_K(t, s) do { const long kb_ = (long)(t) * KVBLK; const int s_ = (s); \
    glds8(Knh + kb_ * LDKV + KOFF(), L + OFF_KN + s_ * SHM_KN + wid * 1024); if (wid < 4) glds8(Krb + kb_ * LDKR + ROFF(), L + OFF_KR + s_ * SHM_KR + wid * 1024); } while (0)
#define ISSUE_V(t, s) do { const long kb_ = (long)(t) * KVBLK; const int s_ = (s); glds8(Vth + kb_ + VOFF(), L + OFF_V + s_ * SHM_V + wid * 1024); } while (0)
#define ISSUE_NEXT(j) do { if ((j) + 2 < NT) ISSUE_K((j) + 2, sp); if ((j) + 1 < NT) ISSUE_V((j) + 1, sn); } while (0)
#define ROT() do { const int t_ = sc; sc = sn; sn = sp; sp = t_; } while (0)
#define RESC(a) do { if (__any((a) < 1.f)) { if (hi == 0) al_l[r32] = (a); asm volatile("s_waitcnt lgkmcnt(0)" ::: "memory"); \
    _Pragma("unroll") for (int d = 0; d < 4; ++d) _Pragma("unroll") for (int r = 0; r < 16; ++r) o[d][r] *= al_l[crow(r, hi)]; } } while (0)
  f32x16 p0, p1; float mn, al; v8i32_t pa8 = {}; const int NT = seq / KVBLK;
  int sc = 0, sn = 1, sp = 2;
  ISSUE_K(0, 0); ISSUE_K(1, 1); ISSUE_V(0, 0);
  if (trail) ATT_VM(2); else ATT_VM(3);
  ATT_BAR();
  int jj = 0;
  const auto issue = [&](int step) {
    const long kb2 = (long)(jj + 2) * KVBLK, kb1 = (long)(jj + 1) * KVBLK;
    if (jj + 2 < NT) { if (step == 0) glds8(Knh + kb2 * LDKV + KOFF(), L + OFF_KN + sp * SHM_KN + wid * 1024); if (step == 1 && wid < 4) glds8(Krb + kb2 * LDKR + ROFF(), L + OFF_KR + sp * SHM_KR + wid * 1024); }
    if (jj + 1 < NT) { if (step == 2) glds8(Vth + kb1 + VOFF(), L + OFF_V + sn * SHM_V + wid * 1024); } };
  const auto noissue = [](int) {};
  mat_segment<true, false>(issue, p0, p1, o, KL, RL, VL, qf, pa8, r32, hi);
  if (trail) { ATT_VM(2); ATT_BAR(); }
  partialSM(p0, p1, m_reg, mn, al); finishSM(p0, p1, al, l_reg, pa8);
  ROT();
  for (int j = 1; j < NT; ++j) {
    if (!trail) { if (j + 1 < NT) ATT_VM(3); else ATT_VM(0); ATT_BAR(); }
    jj = j;
    mat_segment<true, true>(issue, p0, p1, o, KL + sc * SHM_KN, RL + sc * SHM_KR, VL + sp * SHM_V, qf, pa8, r32, hi);
    if (trail) { if (j + 2 < NT) ATT_VM(2); else ATT_VM(0); ATT_BAR(); }
    partialSM(p0, p1, m_reg, mn, al); RESC(al); finishSM(p0, p1, al, l_reg, pa8);
    ROT();
  }
  if (!trail) { ATT_VM(0); ATT_BAR(); }
  mat_segment<false, true>(noissue, p0, p1, o, KL, RL, VL + sp * SHM_V, qf, pa8, r32, hi);
  if (hi == 0) li_l[r32] = l_reg; asm volatile("s_waitcnt lgkmcnt(0)" ::: "memory");
  float rli[16];
#pragma unroll
  for (int r = 0; r < 16; ++r) rli[r] = __builtin_amdgcn_rcpf(li_l[crow(r, hi)]);
  int lane_e = lane; asm volatile("" : "+v"(lane_e));
  bf16* Ow = Ob + (long)(wid * QBLK + 4 * (lane_e >> 5)) * LDO + (lane_e & 31);
#pragma unroll
  for (int r = 0; r < 16; ++r) { const int orow = (r & 3) + 8 * (r >> 2);
#pragma unroll
    for (int d0 = 0; d0 < 4; ++d0) { const float val = o[d0][r] * rli[r]; Ow[orow * LDO + d0 * 32] = (bf16)(cvtpk(val, val) & 0xffffu); } }
  ATT_VM(0);
  ATT_BAR();
#undef VOFF
#undef KOFF
#undef ROFF
#undef ISSUE_K
#undef ISSUE_V
#undef ISSUE_NEXT
#undef ROT
#undef RESC
}
#undef KSWZ
#undef RSWZ
}

constexpr int DM = 4096, SEQ = 8192, CTXL = 256, MR = SEQ + CTXL;
constexpr int NH = 16, QL = 768, KVL = 512, NIN = 7680, NMODC = 6 * DM;
constexpr int NEXP = 16384;
constexpr float EPS = 1e-6f;
constexpr float C2 = 0.072168783648703220f * 1.4426950408889634f;

#ifndef MK_ONE_LAUNCH
#define MK_ONE_LAUNCH 1
#endif
constexpr int NPHASE = 10;
constexpr int NWAVES = 8, NTHR = NWAVES * 64;

constexpr size_t MiB = 1u << 20;
constexpr size_t a256(size_t x) { return (x + 255) & ~(size_t)255; }
constexpr size_t WS_CTL = 0, CTL_ZERO_BYTES = 1 * MiB;
constexpr int CW_BAR = 4096;
constexpr int CW_END = CW_BAR + 3456;
static_assert((size_t)CW_END * 4 <= CTL_ZERO_BYTES, "CTL words inside the memset region");
constexpr size_t WS_MODF = 1 * MiB;
constexpr size_t WS_ROPE = WS_MODF + a256((size_t)(NMODC + 2 * DM) * 4);
constexpr size_t WS_WIN  = 2 * MiB;
constexpr size_t WS_WUQ  = WS_WIN + (size_t)NIN * DM * 2;
constexpr size_t WS_WUKV = WS_WUQ + (size_t)3072 * 768 * 2;
constexpr size_t WS_WO   = WS_WUKV + (size_t)4096 * 512 * 2;
constexpr size_t WS_WPQ  = WS_WO + (size_t)DM * DM * 2;
constexpr size_t WS_KBD  = WS_WPQ + (size_t)2048 * DM * 2;
constexpr int ROWB = 3072;
constexpr size_t WS_KB2  = WS_KBD + (size_t)2048 * DM * 2;
constexpr size_t WS_UB   = WS_KB2 + (size_t)8 * 256 * 256 * 2;
constexpr size_t WS_VB   = WS_UB + (size_t)NEXP * ROWB;
constexpr size_t WS_SU   = WS_VB + (size_t)NEXP * ROWB;
constexpr size_t WS_HX   = WS_SU + (size_t)2 * NEXP * 4;
constexpr size_t WS_CQ   = WS_HX + (size_t)MR * DM * 2;
constexpr size_t WS_CKV  = WS_CQ + (size_t)SEQ * QL * 2;
constexpr size_t WS_KR   = WS_CKV + (size_t)MR * KVL * 2;
constexpr size_t WS_U    = WS_KR + (size_t)MR * 64 * 2;
constexpr size_t WS_GB   = WS_U + (size_t)SEQ * 2048 * 2;
constexpr size_t WS_Q    = WS_GB + (size_t)SEQ * 2048 * 2;
constexpr size_t WS_KN   = WS_Q + (size_t)SEQ * 3072 * 2;
constexpr size_t WS_V    = WS_KN + (size_t)MR * 2048 * 2;
constexpr size_t WS_ACAT = WS_V + (size_t)MR * 2048 * 2;
constexpr size_t WS_X1   = WS_ACAT + (size_t)SEQ * DM * 2;
constexpr size_t WS_H2   = WS_X1 + (size_t)SEQ * DM * 4;
constexpr size_t WS_QP   = WS_H2 + (size_t)SEQ * DM * 2;
constexpr size_t WS_SC   = WS_QP + (size_t)SEQ * 2048 * 2;
constexpr size_t WS_MODP = WS_SC + (size_t)SEQ * 2048 * 4;
constexpr size_t WS_SQ1  = WS_MODP + (size_t)64 * 32768 * 4;
constexpr size_t WS_SQ2  = WS_SQ1 + (size_t)SEQ * 12 * 4;
constexpr size_t WS_SQ3  = WS_SQ2 + (size_t)MR * 8 * 4;
constexpr size_t WS_END  = WS_SQ3 + (size_t)SEQ * 64 * 4;
static_assert(WS_ROPE + 192 * 32 * 4 <= WS_WIN, "rope table below the weights");

constexpr int RING_BYTES = 158720;
constexpr int MISC_OFF = RING_BYTES + 320;
constexpr int LDS_BYTES = 163840;
static_assert(att::SHM_ATTN <= RING_BYTES && MISC_OFF + 128 <= LDS_BYTES, "LDS map");

#define GAS __attribute__((address_space(1)))
#define LAS __attribute__((address_space(3)))
typedef unsigned short bf16;
typedef unsigned v4u __attribute__((ext_vector_type(4)));
typedef float f32x4 __attribute__((ext_vector_type(4)));
typedef __bf16 bf16x2_t __attribute__((ext_vector_type(2)));
typedef float f32x2 __attribute__((ext_vector_type(2)));
typedef float f32x16v __attribute__((ext_vector_type(16)));
typedef float f32x32v __attribute__((ext_vector_type(32)));
typedef unsigned u32x6v __attribute__((ext_vector_type(6)));
typedef _Float16 h16x2 __attribute__((ext_vector_type(2)));
typedef _Float16 h16x32 __attribute__((ext_vector_type(32)));
#ifndef FP6_INTERLEAVED
#define FP6_INTERLEAVED 1
#endif
#define LDS_WAIT() asm volatile("s_waitcnt lgkmcnt(0)" ::: "memory")
__device__ __forceinline__ unsigned f2bf(float f) { unsigned u = __builtin_bit_cast(unsigned, f); return (u + 0x7fffu + ((u >> 16) & 1u)) >> 16; }
__device__ __forceinline__ unsigned pk2(float lo, float hi) { return f2bf(lo) | (f2bf(hi) << 16); }
__device__ __forceinline__ float bflo(unsigned w) { return __builtin_bit_cast(float, w << 16); }
__device__ __forceinline__ float bfhi(unsigned w) { return __builtin_bit_cast(float, w & 0xffff0000u); }
__device__ __forceinline__ float dot2bf(unsigned a, unsigned b, float c) { return __builtin_amdgcn_fdot2_f32_bf16(__builtin_bit_cast(bf16x2_t, a), __builtin_bit_cast(bf16x2_t, b), c, false); }
#define DPP_F(v, CTRL) __builtin_bit_cast(float, __builtin_amdgcn_update_dpp(0, __builtin_bit_cast(int, (v)), (CTRL), 0xf, 0xf, true))
__device__ __forceinline__ float row16_sum(float v) { v += DPP_F(v, 0xB1); v += DPP_F(v, 0x4E); v += DPP_F(v, 0x141); v += DPP_F(v, 0x140); return v; }
__device__ __forceinline__ float row16_max(float v) { v = fmaxf(v, DPP_F(v, 0xB1)); v = fmaxf(v, DPP_F(v, 0x4E)); v = fmaxf(v, DPP_F(v, 0x141)); v = fmaxf(v, DPP_F(v, 0x140)); return v; }
__device__ __forceinline__ float rl_f(float v, int l) { return __builtin_bit_cast(float, __builtin_amdgcn_readlane(__builtin_bit_cast(int, v), l)); }
__device__ __forceinline__ float wave_sum(float v) { v = row16_sum(v); return (rl_f(v, 0) + rl_f(v, 16)) + (rl_f(v, 32) + rl_f(v, 48)); }
__device__ __forceinline__ float wave_max(float v) { v = row16_max(v); return fmaxf(fmaxf(rl_f(v, 0), rl_f(v, 16)), fmaxf(rl_f(v, 32), rl_f(v, 48))); }

#define XB_TMO      128
#define XB_XCNT(j)  (256  + 64 * (j))
#define XB_XSUB(j)  (1280 + 64 * (j))
#define XB_XGEN(j)  (2304 + 64 * (j))
#define XB_TOP      3328
#define XB_TOPGEN   3392
#define XCD_BAR_WORDS 3456
#define XB_SPIN_CAP (1u << 18)
__device__ __forceinline__ unsigned xb_ld(unsigned* p)              { return __hip_atomic_load(p, __ATOMIC_RELAXED, __HIP_MEMORY_SCOPE_AGENT); }
__device__ __forceinline__ unsigned xb_add(unsigned* p, unsigned v) { return __hip_atomic_fetch_add(p, v, __ATOMIC_RELAXED, __HIP_MEMORY_SCOPE_AGENT); }
__device__ __forceinline__ unsigned xb_xcc_id() { return (unsigned)__builtin_amdgcn_s_getreg((3 << 11) | 20) & 0xFu; }
#define XB_SPIN(cond, bar) do { unsigned _sp = 0; while (cond) { __builtin_amdgcn_s_sleep(1); \
    if ((++_sp & 255u) == 0u) { if (xb_ld(&(bar)[XB_TMO])) break; if (_sp > XB_SPIN_CAP) { atomicAdd(&(bar)[XB_TMO], 1u); break; } } } } while (0)
struct XcdBarrier { unsigned* bar; unsigned x; volatile LAS unsigned* st; };
__device__ __forceinline__ XcdBarrier xcd_barrier_post(unsigned* bar, volatile LAS unsigned* st) {
    XcdBarrier b; b.bar = bar; b.x = xb_xcc_id(); b.st = st;
    if (threadIdx.x == 0) (void)xb_add(&bar[XB_XCNT(b.x)], 1u);
    return b;
}
__device__ __forceinline__ void xcd_barrier_complete(unsigned* bar, unsigned x, unsigned& nloc, unsigned& nx) {
    const unsigned G = gridDim.x * gridDim.y * gridDim.z;
    unsigned sum, cnt, mine, sp = 0u;
    for (;;) {
        sum = 0u; cnt = 0u; mine = 0u;
#pragma unroll
        for (unsigned j = 0; j < 16; ++j) { const unsigned c = xb_ld(&bar[XB_XCNT(j)]); sum += c; cnt += (c > 0u) ? 1u : 0u; mine = (j == x) ? c : mine; }
        if (sum == G) break;
        __builtin_amdgcn_s_sleep(1);
        if ((++sp & 255u) == 0u) { if (xb_ld(&bar[XB_TMO])) break; if (sp > XB_SPIN_CAP) { atomicAdd(&bar[XB_TMO], 1u); break; } }
    }
    nloc = mine > 0u ? mine : 1u; nx = cnt > 0u ? cnt : 1u;
}
__device__ __forceinline__ void xcd_barrier(const XcdBarrier& b) {
    asm volatile("s_waitcnt vmcnt(0)" ::: "memory");
    __syncthreads();
    if (threadIdx.x == 0) {
        unsigned* bar = b.bar;
        __builtin_amdgcn_s_waitcnt(0);
        unsigned nloc = b.st[0], nx = b.st[1];
        if (nloc == 0u) { xcd_barrier_complete(bar, b.x, nloc, nx); b.st[0] = nloc; b.st[1] = nx; }
        const unsigned old = xb_add(&bar[XB_XSUB(b.x)], 1u);
        const unsigned gen = old / nloc;
        if (old + 1u == (gen + 1u) * nloc) {
            __builtin_amdgcn_fence(__ATOMIC_RELEASE, "agent");
            asm volatile("s_waitcnt vmcnt(0)" ::: "memory");
            const unsigned og = xb_add(&bar[XB_TOP], 1u);
            const unsigned tg = og / nx;
            if (og + 1u == (tg + 1u) * nx) xb_add(&bar[XB_TOPGEN], 1u);
            else XB_SPIN(xb_ld(&bar[XB_TOPGEN]) == tg, bar);
            __builtin_amdgcn_fence(__ATOMIC_ACQUIRE, "agent");
            xb_add(&bar[XB_XGEN(b.x)], 1u);
            asm volatile("s_waitcnt vmcnt(0)" ::: "memory");
        } else {
            XB_SPIN(xb_ld(&bar[XB_XGEN(b.x)]) == gen, bar);
            __builtin_amdgcn_fence(__ATOMIC_ACQUIRE, "agent");
            asm volatile("s_waitcnt vmcnt(0)" ::: "memory");
        }
    }
    __syncthreads();
}

__device__ __forceinline__ int pi32(int o) { return 2 * (o & 15) + (o >> 4); }
__device__ __forceinline__ void tr_item(const float* __restrict__ W, int N, int k0, int n0, bf16* __restrict__ WT, int ldk, int drow0, bool perm, const float* __restrict__ gsc, LAS float* scr, int lane) {
    f32x4 w[8]; const int c4 = (lane & 7) * 4, rsub = lane >> 3;
#pragma unroll
    for (int i = 0; i < 8; ++i) w[i] = *(const f32x4*)(W + (size_t)(k0 + 8 * i + rsub) * N + n0 + c4);
#pragma unroll
    for (int i = 0; i < 8; ++i) { const int kk = 8 * i + rsub; const float g = gsc ? gsc[k0 + kk] : 1.f;
        scr[kk * 33 + c4] = w[i][0] * g; scr[kk * 33 + c4 + 1] = w[i][1] * g; scr[kk * 33 + c4 + 2] = w[i][2] * g; scr[kk * 33 + c4 + 3] = w[i][3] * g; }
    LDS_WAIT(); asm volatile("" ::: "memory");
    const int c = lane & 7;
#pragma unroll
    for (int j = 0; j < 4; ++j) { const int n = (lane >> 3) + 8 * j; const LAS float* s = scr + (8 * c) * 33 + n;
        v4u o; o.x = pk2(s[0 * 33], s[1 * 33]); o.y = pk2(s[2 * 33], s[3 * 33]); o.z = pk2(s[4 * 33], s[5 * 33]); o.w = pk2(s[6 * 33], s[7 * 33]);
        const int dn = perm ? pi32(n) : n;
        *(v4u*)(WT + (size_t)(drow0 + dn) * ldk + k0 + 8 * c) = o; }
    LDS_WAIT(); asm volatile("" ::: "memory");
}
__device__ __forceinline__ float silu_f(float v) { return v / (1.f + expf(-v)); }
__device__ __forceinline__ float gelu_erf(float v) { return 0.5f * v * (1.f + erff(v * 0.70710678118654752f)); }
__device__ __forceinline__ unsigned fkey(float f) { const unsigned u = __builtin_bit_cast(unsigned, f); return (u & 0x80000000u) ? ~u : (u | 0x80000000u); }

template <int NV> __device__ __forceinline__ unsigned kth16(const unsigned (&k)[NV]) {
    unsigned T = 0u;
    for (int bit = 31; bit >= 0; --bit) { const unsigned c = T | (1u << bit); int cnt = 0;
#pragma unroll
        for (int v = 0; v < NV; ++v) cnt += __popcll(__ballot(k[v] >= c));
        if (cnt >= 16) T = c; }
    return T;
}
template <int NV> __device__ __forceinline__ void compact16(const unsigned (&k)[NV], const unsigned (&val)[NV], const unsigned (&pay)[NV], unsigned T, LAS unsigned* oval, LAS unsigned* opay, int lane) {
    const unsigned long long lt = (1ull << lane) - 1ull; int pos = 0;
#pragma unroll
    for (int v = 0; v < NV; ++v) { const bool s = k[v] > T; const unsigned long long m = __ballot(s); const int slot = pos + __popcll(m & lt); if (s) { oval[slot] = val[v]; opay[slot] = pay[v]; } pos += __popcll(m); }
#pragma unroll
    for (int v = 0; v < NV; ++v) { const bool s = k[v] == T; const unsigned long long m = __ballot(s); const int slot = pos + __popcll(m & lt); if (s && slot < 16) { oval[slot] = val[v]; opay[slot] = pay[v]; } pos += __popcll(m); }
}

struct Args { const float* in[21]; float* out; unsigned char* ws; int ph_lo, ph_hi, probe, pad; };
static_assert(sizeof(Args) == 23 * 8 + 16, "Args has no padding");

__global__ void __launch_bounds__(NTHR, 2) fwd(Args a) {
    extern __shared__ __attribute__((aligned(16))) unsigned char lds[];
    LAS unsigned char* L = (LAS unsigned char*)lds;
    const int wave = __builtin_amdgcn_readfirstlane((int)threadIdx.x >> 6);
    const int G = gridDim.x, bx = blockIdx.x;
    const int gw = bx * NWAVES + wave, NGW = G * NWAVES;
    const size_t NT = (size_t)G * NTHR;
#define PH_IDS() int tid_ph_ = threadIdx.x; asm volatile("" : "+v"(tid_ph_)); const int tid = tid_ph_, lane = tid & 63; const size_t gt = (size_t)bx * NTHR + tid; (void)lane; (void)gt
    unsigned char* ws = a.ws;
    float* ctlf = (float*)(ws + WS_CTL);
    const float* x = a.in[0]; const float* cvec = a.in[1]; const float* ctx = a.in[2]; const float* cctx = a.in[3]; const float* w_ada = a.in[4]; const float* b_ada = a.in[5];
    const float* norm1_g = a.in[6]; const float* w_in = a.in[7]; const float* q_norm_g = a.in[8]; const float* w_uq = a.in[9]; const float* kv_norm_g = a.in[10]; const float* w_ukv = a.in[11];
    const float* conv_w = a.in[12]; const float* conv_b = a.in[13]; const float* w_o = a.in[14]; const float* norm2_g = a.in[15]; const float* peer_wq = a.in[16]; const float* peer_keys = a.in[17];
    const float* peer_u = a.in[18]; const float* peer_v = a.in[19]; const float* final_g = a.in[20];
    float* modp = (float*)(ws + WS_MODP); float* ssq_cq = (float*)(ws + WS_SQ1); float* ssq_ckv = (float*)(ws + WS_SQ2); float* ssq_x1 = (float*)(ws + WS_SQ3);
    float* modf = (float*)(ws + WS_MODF); float* rope = (float*)(ws + WS_ROPE);
    bf16* WIN = (bf16*)(ws + WS_WIN); bf16* WUQ = (bf16*)(ws + WS_WUQ); bf16* WUKV = (bf16*)(ws + WS_WUKV); bf16* WO = (bf16*)(ws + WS_WO); bf16* WPQ = (bf16*)(ws + WS_WPQ); bf16* KBD = (bf16*)(ws + WS_KBD); bf16* KB2 = (bf16*)(ws + WS_KB2);
    unsigned char* UB = ws + WS_UB; unsigned char* VB = ws + WS_VB; float* SUV = (float*)(ws + WS_SU); bf16* HX = (bf16*)(ws + WS_HX); bf16* CQ = (bf16*)(ws + WS_CQ); bf16* CKV = (bf16*)(ws + WS_CKV); unsigned char* KR = ws + WS_KR;
    bf16* UCV = (bf16*)(ws + WS_U); bf16* GBV = (bf16*)(ws + WS_GB); unsigned char* Q = ws + WS_Q; unsigned char* KN = ws + WS_KN; unsigned char* VT = ws + WS_V; bf16* ACAT = (bf16*)(ws + WS_ACAT);
    bf16* DLT = (bf16*)(ws + WS_X1); bf16* H2 = (bf16*)(ws + WS_H2); float* SC = (float*)(ws + WS_SC);

    for (int u = threadIdx.x; u < (LDS_BYTES - RING_BYTES) / 4; u += NTHR) ((LAS unsigned*)(L + RING_BYTES))[u] = 0u;
    __syncthreads();
    const int lo = a.ph_lo, hi = a.ph_hi;
    XcdBarrier bar; bar.bar = (unsigned*)ctlf + CW_BAR; bar.x = 0; bar.st = (volatile LAS unsigned*)(L + MISC_OFF);
    if (hi - lo > 1) bar = xcd_barrier_post((unsigned*)ctlf + CW_BAR, (volatile LAS unsigned*)(L + MISC_OFF));
#define IN(k) (lo <= (k) && (k) < hi)
#ifndef PHASE_MASK
#define PHASE_MASK 0x3ff
#endif
#define PH_ON(k) (((PHASE_MASK) >> (k)) & 1)
#ifndef REPEAT_MASK
#define REPEAT_MASK 0
#endif
#define NREP(k) (1 + (((REPEAT_MASK) >> (k)) & 1))
#define GRID_BAR(k) do { if (IN(k) && IN((k) + 1)) xcd_barrier(bar); } while (0)

    if (PH_ON(0) && IN(0)) for (int rep_ = 0; rep_ < NREP(0); ++rep_) {
        PH_IDS();
        const int psel = a.probe ? a.probe : 7;
        if (psel & 1)
        for (int it = gw; it < 64 * 96; it += NGW) {
            const int kb = it / 96, cb = it % 96, col = cb * 256 + lane * 4;
            const float* wp = w_ada + (size_t)(kb * 64) * NMODC + col;
            f32x4 ax = {0.f, 0.f, 0.f, 0.f}, ac = {0.f, 0.f, 0.f, 0.f}; const bool cc = cb < 32;
            const float sxv = silu_f(cvec[kb * 64 + lane]), scv = silu_f(cctx[kb * 64 + lane]);
#pragma unroll 16
            for (int i = 0; i < 64; ++i) { const f32x4 w = __builtin_nontemporal_load((const f32x4*)(wp + (size_t)i * NMODC));
                ax += w * rl_f(sxv, i); ac += w * (cc ? rl_f(scv, i) : 0.f); }
            *(f32x4*)(modp + (size_t)kb * 32768 + col) = ax; if (cc) *(f32x4*)(modp + (size_t)kb * 32768 + NMODC + col) = ac;
        }
        if (psel & 2) {
            LAS float* scr = (LAS float*)(L + wave * 8448);
            constexpr int I_IN = 64 * 234, I_UQ = 12 * 96, I_UKV = 8 * 128, I_O = 64 * 128, NIT = I_IN + I_UQ + I_UKV + I_O;
            for (int it = gw; it < NIT; it += NGW) { int r = it;
                if (r < I_IN) { const int kb = r / 234, n0 = (r % 234) * 32; int drow0; bool perm = false;
                    if (n0 < 1280) drow0 = n0; else if (n0 < 1344) { drow0 = n0; perm = true; }
                    else { const int c0 = n0 - 1344; if (c0 < 2048) drow0 = 1536 + (c0 >> 7) * 256 + (c0 & 127); else if (c0 < 4096) drow0 = 5632 + (c0 - 2048); else { const int c1 = c0 - 4096; drow0 = 1536 + (c1 >> 7) * 256 + 128 + (c1 & 127); } }
                    tr_item(w_in, 7488, kb * 64, n0, WIN, 4096, drow0, perm, nullptr, scr, lane); continue; } r -= I_IN;
                if (r < I_UQ) { const int kb = r / 96, n0 = (r % 96) * 32; tr_item(w_uq, 3072, kb * 64, n0, WUQ, 768, n0, (n0 % 192) >= 128, q_norm_g, scr, lane); continue; } r -= I_UQ;
                if (r < I_UKV) { const int kb = r / 128, n0 = (r % 128) * 32; tr_item(w_ukv, 4096, kb * 64, n0, WUKV, 512, ((n0 & 255) < 128 ? 0 : 2048) + (n0 >> 8) * 128 + (n0 & 127), false, kv_norm_g, scr, lane); continue; } r -= I_UKV;
                { const int kb = r / 128, n0 = (r % 128) * 32; tr_item(w_o, 4096, kb * 64, n0, WO, 4096, n0, false, nullptr, scr, lane); }
            }
        }
        for (size_t i = gt; i < (size_t)192 * 512; i += NT) { const v4u z = {0u, 0u, 0u, 0u}; *(v4u*)(WIN + (size_t)1344 * 4096 + i * 8) = z; }
        for (size_t i = gt; i < (size_t)DM * 2048 / 8; i += NT) {
            const int d = (int)(i >> 8), c8 = (int)(i & 255) * 8, h = c8 >> 8, j = c8 & 255; const float* sp_ = peer_wq + (size_t)d * 2048 + c8; const f32x4 a0 = *(const f32x4*)sp_, a1 = *(const f32x4*)(sp_ + 4);
            v4u o; o.x = pk2(a0[0], a0[1]); o.y = pk2(a0[2], a0[3]); o.z = pk2(a1[0], a1[1]); o.w = pk2(a1[2], a1[3]); *(v4u*)(WPQ + ((size_t)h * DM + d) * 256 + j) = o; }
        for (size_t i = gt; i < (size_t)8 * 256 * 32; i += NT) {
            const int d8 = (int)(i & 31) * 8, rr = (int)(i >> 5) & 255, h = (int)(i >> 13), p = rr >> 7, k = rr & 127; v4u o = {0u, 0u, 0u, 0u};
            if ((d8 >> 7) == p) { const float* s_ = peer_keys + ((size_t)((h * 2 + p) * 128 + k)) * 128 + (d8 & 127); const f32x4 a0 = *(const f32x4*)s_, a1 = *(const f32x4*)(s_ + 4);
                o.x = pk2(a0[0], a0[1]); o.y = pk2(a0[2], a0[3]); o.z = pk2(a1[0], a1[1]); o.w = pk2(a1[2], a1[3]); }
            *(v4u*)(KB2 + i * 8) = o; }
        for (size_t i = gt; i < (size_t)192 * 16; i += NT) {
            const int pi = (int)(i >> 4), fi = (int)(i & 15); const int pos = pi < 128 ? pi : pi - 128;
            const float fr = __builtin_amdgcn_exp2f(-(float)fi * 0.83048202372184059f);
            const float turns = (float)pos * fr * 0.15915494309189535f, fx = turns - floorf(turns);
            rope[pi * 32 + 2 * fi] = __builtin_amdgcn_cosf(fx); rope[pi * 32 + 2 * fi + 1] = __builtin_amdgcn_sinf(fx); }
        if (psel & 4)
        for (int r = gw; r < 2 * NEXP; r += NGW) { const bool isv = r >= NEXP; const int e = isv ? r - NEXP : r; const float* src = (isv ? peer_v : peer_u) + (size_t)e * DM + lane * 4;
            f32x4 v[2][8]; float am = 0.f;
#pragma unroll
            for (int b = 0; b < 2; ++b)
#pragma unroll
                for (int q = 0; q < 8; ++q) { v[b][q] = __builtin_nontemporal_load((const f32x4*)(src + b * 2048 + q * 256)); am = fmaxf(am, fmaxf(fmaxf(fabsf(v[b][q][0]), fabsf(v[b][q][1])), fmaxf(fabsf(v[b][q][2]), fabsf(v[b][q][3])))); }
            am = wave_max(am);
            const float sc = am > 0.f ? exp2f(floorf(log2f(7.5f / am))) : 1.f;
            unsigned d[12];
#pragma unroll
            for (int b = 0; b < 2; ++b) { f32x16v s0, s1;
#pragma unroll
                for (int i = 0; i < 16; ++i) { const int i0 = FP6_INTERLEAVED ? 2 * i : i, i1 = FP6_INTERLEAVED ? 2 * i + 1 : 16 + i; s0[i] = v[b][i0 >> 2][i0 & 3] * sc; s1[i] = v[b][i1 >> 2][i1 & 3] * sc; }
                const u32x6v w = __builtin_amdgcn_cvt_scalef32_2xpk16_fp6_f32(s0, s1, 1.0f);
#pragma unroll
                for (int i = 0; i < 6; ++i) d[6 * b + i] = w[i]; }
            unsigned char* dst = (isv ? VB : UB) + (size_t)e * ROWB + lane * 16;
#pragma unroll
            for (int p = 0; p < 3; ++p) { const v4u o = {d[4 * p], d[4 * p + 1], d[4 * p + 2], d[4 * p + 3]}; *(v4u*)(dst + p * 1024) = o; }
            if (lane == 0) SUV[r] = 1.f / sc;
        }
    }
    GRID_BAR(0);

    if (PH_ON(1) && IN(1)) for (int rep_ = 0; rep_ < NREP(1); ++rep_) {
        PH_IDS();
        for (size_t j = gt; j < (size_t)(NMODC + 2 * DM); j += NT) { float sacc = 0.f;
#pragma unroll 8
            for (int kb = 0; kb < 64; ++kb) sacc += modp[(size_t)kb * 32768 + j];
            modf[j] = sacc + b_ada[j < (size_t)NMODC ? j : j - NMODC]; }
        { pg8::Gemm g{KB2, WPQ, 2048, DM, 256, 0, (size_t)DM * 256 * 2}; pg8::StaticOrder S; S.init(2048, DM, G, bx); pg8::EpiB16 E{KBD, DM};
          pg8::gemm_phase<pg8::EpiB16, pg8::StaticOrder, true, true>(L, g, S, E); }
    }
    GRID_BAR(1);

    if (PH_ON(2) && IN(2)) for (int rep_ = 0; rep_ < NREP(2); ++rep_) {
        PH_IDS();
        for (int row = gw; row < MR; row += NGW) {
            const bool lat = row < SEQ; const float* xr = lat ? x + (size_t)row * DM : ctx + (size_t)(row - SEQ) * DM; const float* md = lat ? modf : modf + NMODC;
            f32x4 v[16]; float ss = 0.f;
#pragma unroll
            for (int j = 0; j < 16; ++j) { v[j] = *(const f32x4*)(xr + 4 * (lane + 64 * j)); ss += (v[j][0] * v[j][0] + v[j][1] * v[j][1]) + (v[j][2] * v[j][2] + v[j][3] * v[j][3]); }
            ss = wave_sum(ss); const float rstd = 1.f / sqrtf(ss * (1.f / DM) + EPS);
#pragma unroll
            for (int j = 0; j < 16; ++j) { const int idx = 4 * (lane + 64 * j);
                const f32x4 g = *(const f32x4*)(norm1_g + idx), sh = *(const f32x4*)(md + idx), sc = *(const f32x4*)(md + DM + idx);
                const f32x4 hh = (v[j] * rstd * g) * (sc + 1.f) + sh;
                *(unsigned long long*)(HX + (size_t)row * DM + idx) = (unsigned long long)pk2(hh[0], hh[1]) | ((unsigned long long)pk2(hh[2], hh[3]) << 32); }
        }
    }
    GRID_BAR(2);

    if (PH_ON(3) && IN(3)) for (int rep_ = 0; rep_ < NREP(3); ++rep_) {
        pg8::Gemm g{HX, WIN, MR, NIN, DM, 0, 0}; pg8::OrderIn S; S.init(SEQ, NIN, G, bx);
        pg8::EpiIn E{CQ, CKV, KR, UCV, GBV, ssq_cq, ssq_ckv, rope};
        pg8::gemm_phase<pg8::EpiIn, pg8::OrderIn, true, true>(L, g, S, E);
    }
    GRID_BAR(3);

    if (PH_ON(4) && IN(4)) for (int rep_ = 0; rep_ < NREP(4); ++rep_) {
        PH_IDS();
        {
            int nq, qb0, nkv, kb0;
            if (G == 256) { nq = bx < 144 ? 1 : bx < 240 ? 2 : 3; qb0 = bx < 144 ? bx : bx < 240 ? 144 + 2 * (bx - 144) : 336 + 3 * (bx - 240); nkv = bx < 144 ? 3 : bx < 240 ? 1 : 0; kb0 = bx < 144 ? 3 * bx : 432 + (bx - 144); }
            else { qb0 = (int)(((long)384 * bx) / G); nq = (int)(((long)384 * (bx + 1)) / G) - qb0; kb0 = (int)(((long)528 * bx) / G); nkv = (int)(((long)528 * (bx + 1)) / G) - kb0; }
            const int k0 = kb0 < 264 ? kb0 : 264, k1 = kb0 + nkv < 264 ? kb0 + nkv : 264;
            const int v0 = (kb0 > 264 ? kb0 : 264) - 264, v1 = (kb0 + nkv > 264 ? kb0 + nkv : 264) - 264;
            { pg8::Gemm g{CQ, WUQ, SEQ, 3072, QL, 0, 0}; pg8::RunOrder S{qb0, nq, 12}; pg8::EpiQ E{Q, ssq_cq, rope, C2 * att::QSC};
              pg8::gemm_phase<pg8::EpiQ, pg8::RunOrder, true, true>(L, g, S, E); }
            { pg8::Gemm g{CKV, WUKV, MR, 2048, KVL, 0, 0}; pg8::RunOrder S{k0, k1 - k0, 8}; pg8::EpiK E{KN, ssq_ckv};
              pg8::gemm_phase<pg8::EpiK, pg8::RunOrder, true, true>(L, g, S, E); }
            { pg8::Gemm g{WUKV + (size_t)2048 * KVL, CKV, 2048, MR, KVL, 0, 0}; pg8::RunOrder S{v0, v1 - v0, 33}; pg8::EpiVT E{VT, ssq_ckv};
              pg8::gemm_phase<pg8::EpiVT, pg8::RunOrder, true, true>(L, g, S, E); }
        }
        for (size_t it = gt; it < (size_t)SEQ * 256; it += NT) {
            const int t = (int)(it >> 8), c8 = (int)(it & 255) * 8; const v4u z = {0u, 0u, 0u, 0u};
            const v4u um = t > 0 ? *(const v4u*)(UCV + (size_t)(t - 1) * 2048 + c8) : z, u0 = *(const v4u*)(UCV + (size_t)t * 2048 + c8), up = t < SEQ - 1 ? *(const v4u*)(UCV + (size_t)(t + 1) * 2048 + c8) : z;
            const v4u gv = *(const v4u*)(GBV + (size_t)t * 2048 + c8); v4u o;
            float w0[8], w1[8], w2[8], wb[8];
#pragma unroll
            for (int q = 0; q < 2; ++q) { const f32x4 a0 = *(const f32x4*)(conv_w + c8 + 4 * q), a1 = *(const f32x4*)(conv_w + 2048 + c8 + 4 * q), a2 = *(const f32x4*)(conv_w + 4096 + c8 + 4 * q), a3 = *(const f32x4*)(conv_b + c8 + 4 * q);
#pragma unroll
                for (int j = 0; j < 4; ++j) { w0[4 * q + j] = a0[j]; w1[4 * q + j] = a1[j]; w2[4 * q + j] = a2[j]; wb[4 * q + j] = a3[j]; } }
#pragma unroll
            for (int j = 0; j < 4; ++j) {
                const float y0 = w0[2 * j] * bflo(um[j]) + w1[2 * j] * bflo(u0[j]) + w2[2 * j] * bflo(up[j]) + wb[2 * j];
                const float y1 = w0[2 * j + 1] * bfhi(um[j]) + w1[2 * j + 1] * bfhi(u0[j]) + w2[2 * j + 1] * bfhi(up[j]) + wb[2 * j + 1];
                o[j] = pk2(bflo(gv[j]) * y0, bfhi(gv[j]) * y1); }
            *(v4u*)(ACAT + (size_t)t * DM + 2048 + c8) = o; }
    }
    GRID_BAR(4);

    if (PH_ON(5) && IN(5)) for (int rep_ = 0; rep_ < NREP(5); ++rep_) {
        for (int i = 0;; ++i) { int h, qb;
            if (G == 256) { if (i >= 2) break; h = 2 * (bx & 7) + i; qb = bx >> 3; } else { const int Lu = i * G + bx; if (Lu >= 512) break; h = Lu >> 5; qb = Lu & 31; }
            att::attn_unit(Q + (size_t)(qb * 256) * 3072 + h * 192, KN + h * 128, VT + (size_t)(h * 128) * 8448, KR, ACAT + (size_t)(qb * 256) * DM + h * 128, MR, (char*)lds, L, a.probe); }
    }
    GRID_BAR(5);

    if (PH_ON(6) && IN(6)) for (int rep_ = 0; rep_ < NREP(6); ++rep_) {
        pg8::Gemm g{ACAT, WO, SEQ, DM, DM, 0, 0}; pg8::StaticOrder S; S.init(SEQ, DM, G, bx); pg8::EpiO E{modf + 2 * DM, DLT};
        pg8::gemm_phase<pg8::EpiO, pg8::StaticOrder, true, true>(L, g, S, E);
    }
    GRID_BAR(6);

    if (PH_ON(7) && IN(7)) for (int rep_ = 0; rep_ < NREP(7); ++rep_) {
        PH_IDS();
        for (int row = gw; row < SEQ; row += NGW) {
            f32x4 v[16]; float ssq[4] = {0.f, 0.f, 0.f, 0.f};
#pragma unroll
            for (int j = 0; j < 16; ++j) { const int idx = 4 * (lane + 64 * j); const unsigned long long d8 = *(const unsigned long long*)(DLT + (size_t)row * DM + idx); const f32x4 xv = *(const f32x4*)(x + (size_t)row * DM + idx);
                v[j][0] = xv[0] + bflo((unsigned)d8); v[j][1] = xv[1] + bfhi((unsigned)d8); v[j][2] = xv[2] + bflo((unsigned)(d8 >> 32)); v[j][3] = xv[3] + bfhi((unsigned)(d8 >> 32));
#pragma unroll
                for (int c = 0; c < 4; ++c) ssq[c] = fmaf(v[j][c], v[j][c], ssq[c]); }
            const float rstd = 1.f / sqrtf(wave_sum((ssq[0] + ssq[1]) + (ssq[2] + ssq[3])) * (1.f / DM) + EPS);
#pragma unroll
            for (int j = 0; j < 16; ++j) { const int idx = 4 * (lane + 64 * j);
                const f32x4 g = *(const f32x4*)(norm2_g + idx), sh = *(const f32x4*)(modf + 3 * DM + idx), sc = *(const f32x4*)(modf + 4 * DM + idx);
                const f32x4 hh = (v[j] * rstd * g) * (sc + 1.f) + sh;
                *(unsigned long long*)(H2 + (size_t)row * DM + idx) = (unsigned long long)pk2(hh[0], hh[1]) | ((unsigned long long)pk2(hh[2], hh[3]) << 32); }
        }
    }
    GRID_BAR(7);

    if (PH_ON(8) && IN(8)) for (int rep_ = 0; rep_ < NREP(8); ++rep_) {
        pg8::Gemm g{H2, KBD, SEQ, 2048, DM, 0, 0}; pg8::StaticOrder S; S.init(SEQ, 2048, G, bx); pg8::EpiF32 E{SC, 2048};
        pg8::gemm_phase<pg8::EpiF32, pg8::StaticOrder, true, true>(L, g, S, E);
    }
    GRID_BAR(8);

    if (PH_ON(9) && IN(9)) for (int rep_ = 0; rep_ < NREP(9); ++rep_) {
        int lane0_ = threadIdx.x; asm volatile("" : "+v"(lane0_)); lane0_ &= 63;
        LAS unsigned* wl = (LAS unsigned*)(L + wave * 8192);
        LAS unsigned* sV1 = wl, *sI1 = wl + 16, *sV2 = wl + 32, *sI2 = wl + 48, *sVc = wl + 64, *sEc = wl + 80;
        LAS unsigned* eL = wl + 128; LAS float* gL = (LAS float*)(wl + 128 + 512);
        const float* gate2 = modf + 5 * DM; const int emask_ = a.probe ? 63 : 0xffff; float* outp_ = a.probe ? (float*)(ws + WS_HX) : a.out;
        for (int tb = gw * 4; tb < SEQ; tb += NGW * 4) {
            for (int ti = 0; ti < 4; ++ti) { const int t = tb + ti; int lane = lane0_; asm volatile("" : "+v"(lane));
                for (int h = 0; h < 8; ++h) { const float* sp = SC + (size_t)t * 2048 + h * 256;
                    { const float s0 = sp[lane], s1 = sp[64 + lane]; const unsigned k[2] = {fkey(s0), fkey(s1)}, vb[2] = {__builtin_bit_cast(unsigned, s0), __builtin_bit_cast(unsigned, s1)}, pl[2] = {(unsigned)lane, (unsigned)(64 + lane)};
                      const unsigned T = kth16<2>(k); compact16<2>(k, vb, pl, T, sV1, sI1, lane); }
                    { const float s0 = sp[128 + lane], s1 = sp[192 + lane]; const unsigned k[2] = {fkey(s0), fkey(s1)}, vb[2] = {__builtin_bit_cast(unsigned, s0), __builtin_bit_cast(unsigned, s1)}, pl[2] = {(unsigned)lane, (unsigned)(64 + lane)};
                      const unsigned T = kth16<2>(k); compact16<2>(k, vb, pl, T, sV2, sI2, lane); }
                    LDS_WAIT();
                    { const float s2b = __builtin_bit_cast(float, sV2[lane & 15]); const unsigned i2b = sI2[lane & 15]; unsigned k[4], vb[4], pl[4];
#pragma unroll
                      for (int r = 0; r < 4; ++r) { const int aa = (lane >> 4) + 4 * r; const float cv = __builtin_bit_cast(float, sV1[aa]) + s2b; k[r] = fkey(cv); vb[r] = __builtin_bit_cast(unsigned, cv); pl[r] = sI1[aa] * 128u + i2b; }
                      const unsigned T = kth16<4>(k); compact16<4>(k, vb, pl, T, sVc, sEc, lane); }
                    LDS_WAIT();
                    { const float tv = __builtin_bit_cast(float, sVc[lane & 15]); const float mx = row16_max(tv);
                      const float ex = expf(tv - mx); const float sm = row16_sum(ex);
                      if (lane < 16) { eL[ti * 128 + h * 16 + lane] = sEc[lane]; gL[ti * 128 + h * 16 + lane] = ex / sm; } }
                    LDS_WAIT();
                }
                { const unsigned e0 = eL[ti * 128 + lane], e1 = eL[ti * 128 + 64 + lane]; const float g0 = gL[ti * 128 + lane], g1 = gL[ti * 128 + 64 + lane];
                  const unsigned k0 = (e0 << 7) | (unsigned)lane, k1 = (e1 << 7) | (unsigned)(64 + lane); int r0 = 0, r1 = 0;
#pragma unroll 8
                  for (int m = 0; m < 128; ++m) { const unsigned km = (eL[ti * 128 + m] << 7) | (unsigned)m; r0 += km < k0 ? 1 : 0; r1 += km < k1 ? 1 : 0; }
                  LDS_WAIT();
                  eL[ti * 128 + r0] = e0; gL[ti * 128 + r0] = g0; eL[ti * 128 + r1] = e1; gL[ti * 128 + r1] = g1;
                  LDS_WAIT(); }
                h16x2 hh[2][16];
#pragma unroll
                for (int b = 0; b < 2; ++b)
#pragma unroll
                    for (int q = 0; q < 8; ++q) { const unsigned long long a0 = *(const unsigned long long*)(H2 + (size_t)t * DM + b * 2048 + q * 256 + lane * 4);
                        hh[b][2 * q] = (h16x2){(_Float16)bflo((unsigned)a0), (_Float16)bfhi((unsigned)a0)}; hh[b][2 * q + 1] = (h16x2){(_Float16)bflo((unsigned)(a0 >> 32)), (_Float16)bfhi((unsigned)(a0 >> 32))}; }
                v4u rr[6][3]; float rs[6];
#define LDROW(j, TAB, e, SOFF) do { const unsigned char* rp_ = (TAB) + (size_t)(e) * ROWB + lane * 16; _Pragma("unroll") for (int p = 0; p < 3; ++p) rr[j][p] = *(const v4u*)(rp_ + p * 1024); rs[j] = SUV[(SOFF) + (e)]; } while (0)
#define EIDX(k) (__builtin_amdgcn_readfirstlane((int)eL[ti * 128 + (k)]) & emask_)
#define UNPKH(j, b) __builtin_amdgcn_cvt_scalef32_pk32_f16_fp6((b) == 0 ? (u32x6v){rr[j][0][0], rr[j][0][1], rr[j][0][2], rr[j][0][3], rr[j][1][0], rr[j][1][1]} : (u32x6v){rr[j][1][2], rr[j][1][3], rr[j][2][0], rr[j][2][1], rr[j][2][2], rr[j][2][3]}, 1.0f)
#define DOTROW(out, j) do { float a0 = 0.f, a1 = 0.f, a2 = 0.f, a3 = 0.f; _Pragma("unroll") for (int b = 0; b < 2; ++b) { const h16x32 x_ = UNPKH(j, b); \
                    _Pragma("unroll") for (int i = 0; i < 16; i += 4) { a0 = __builtin_amdgcn_fdot2((h16x2){x_[2 * i], x_[2 * i + 1]}, hh[b][i], a0, false); a1 = __builtin_amdgcn_fdot2((h16x2){x_[2 * i + 2], x_[2 * i + 3]}, hh[b][i + 1], a1, false); \
                        a2 = __builtin_amdgcn_fdot2((h16x2){x_[2 * i + 4], x_[2 * i + 5]}, hh[b][i + 2], a2, false); a3 = __builtin_amdgcn_fdot2((h16x2){x_[2 * i + 6], x_[2 * i + 7]}, hh[b][i + 3], a3, false); } } \
                    out = (a0 + a1) + (a2 + a3); } while (0)
                int ei[6];
#pragma unroll
                for (int j = 0; j < 6; ++j) { ei[j] = EIDX(j); LDROW(j, UB, ei[j], 0); }
                for (int k0 = 0; k0 < 126; k0 += 6) {
                    float dsum[6];
#pragma unroll
                    for (int j = 0; j < 6; ++j) { float part; DOTROW(part, j); const float sc_ = rs[j];
                        if (k0 + 6 + j < 128) { ei[j] = EIDX(k0 + 6 + j); LDROW(j, UB, ei[j], 0); }
                        dsum[j] = wave_sum(part) * sc_; }
                    if (lane < 6) { float d = dsum[0];
#pragma unroll
                        for (int j = 1; j < 6; ++j) d = lane == j ? dsum[j] : d;
                        gL[ti * 128 + k0 + lane] = gL[ti * 128 + k0 + lane] * gelu_erf(d); }
                }
                { float dsum[2];
#pragma unroll
                  for (int j = 0; j < 2; ++j) { float part; DOTROW(part, j); dsum[j] = wave_sum(part) * rs[j]; }
                  if (lane < 2) { const float d = lane == 0 ? dsum[0] : dsum[1]; gL[ti * 128 + 126 + lane] = gL[ti * 128 + 126 + lane] * gelu_erf(d); } }
                LDS_WAIT();
            }
            for (int ti = 0; ti < 4; ++ti) { const int t = tb + ti; int lane = lane0_; asm volatile("" : "+v"(lane));
                h16x2 ah[2][16];
#pragma unroll
                for (int b = 0; b < 2; ++b)
#pragma unroll
                    for (int i = 0; i < 16; ++i) ah[b][i] = (h16x2){(_Float16)0.f, (_Float16)0.f};
                v4u rr[6][3]; float rs[6];
#define FMAROW(j, WW) do { const _Float16 wh_ = (_Float16)(WW); const h16x2 w2_ = {wh_, wh_}; _Pragma("unroll") for (int b = 0; b < 2; ++b) { const h16x32 x_ = UNPKH(j, b); \
                    _Pragma("unroll") for (int i = 0; i < 16; ++i) ah[b][i] = __builtin_elementwise_fma(w2_, (h16x2){x_[2 * i], x_[2 * i + 1]}, ah[b][i]); } } while (0)
                int ei[6];
#pragma unroll
                for (int j = 0; j < 6; ++j) { ei[j] = EIDX(j); LDROW(j, VB, ei[j], NEXP); }
                for (int k0 = 0; k0 < 126; k0 += 6) {
#pragma unroll
                    for (int j = 0; j < 6; ++j) { FMAROW(j, gL[ti * 128 + k0 + j] * rs[j]);
                        if (k0 + 6 + j < 128) { ei[j] = EIDX(k0 + 6 + j); LDROW(j, VB, ei[j], NEXP); } }
                }
#pragma unroll
                for (int j = 0; j < 2; ++j) FMAROW(j, gL[ti * 128 + 126 + j] * rs[j]);
                float acc[2][32];
#pragma unroll
                for (int b = 0; b < 2; ++b)
#pragma unroll
                    for (int i = 0; i < 16; ++i) { acc[b][2 * i] = (float)ah[b][i][0]; acc[b][2 * i + 1] = (float)ah[b][i][1]; }
                float ssp[4] = {0.f, 0.f, 0.f, 0.f}; int lane_f = lane; asm volatile("" : "+v"(lane_f));
#pragma unroll
                for (int b = 0; b < 2; ++b)
#pragma unroll
                    for (int q = 0; q < 8; ++q) { unsigned o = (unsigned)(b * 2048 + q * 256 + lane_f * 4); asm volatile("" : "+v"(o)); const unsigned long long d8 = *(const unsigned long long*)(DLT + (size_t)t * DM + o); f32x4 xa = *(const f32x4*)(x + (size_t)t * DM + o); const f32x4 ga = *(const f32x4*)(gate2 + o);
                        xa[0] += bflo((unsigned)d8); xa[1] += bfhi((unsigned)d8); xa[2] += bflo((unsigned)(d8 >> 32)); xa[3] += bfhi((unsigned)(d8 >> 32));
#pragma unroll
                        for (int j = 0; j < 4; ++j) { acc[b][4 * q + j] = fmaf(ga[j], acc[b][4 * q + j], xa[j]); ssp[j] = fmaf(acc[b][4 * q + j], acc[b][4 * q + j], ssp[j]); }
                        if ((q & 1) == 1) asm volatile("" ::: "memory"); }
                const float ss = wave_sum((ssp[0] + ssp[1]) + (ssp[2] + ssp[3])); const float rstd = 1.f / sqrtf(ss * (1.f / DM) + EPS);
#pragma unroll
                for (int b = 0; b < 2; ++b)
#pragma unroll
                    for (int q = 0; q < 8; ++q) { unsigned o = (unsigned)(b * 2048 + q * 256 + lane_f * 4); asm volatile("" : "+v"(o)); const f32x4 fa = *(const f32x4*)(final_g + o); f32x4 oa;
#pragma unroll
                        for (int j = 0; j < 4; ++j) oa[j] = acc[b][4 * q + j] * rstd * fa[j];
                        *(f32x4*)(outp_ + (size_t)t * DM + o) = oa; if ((q & 1) == 1) asm volatile("" ::: "memory"); }
            }
            LDS_WAIT();
#undef LDROW
#undef EIDX
#undef DOTROW
#undef FMAROW
#undef UNPKH
        }
    }
#undef IN
#undef GRID_BAR
}

#ifdef PROBE_MX
typedef int v8i_t __attribute__((ext_vector_type(8)));
typedef float v16f_t __attribute__((ext_vector_type(16)));
__device__ __forceinline__ unsigned char f8enc(int v) {
    if (v == 0) return 0; int e = 0; int m = v; while (m >= 2) { m >>= 1; ++e; } const int frac = (v << 3 >> e) & 7; return (unsigned char)(((e + 7) << 3) | frac); }
__global__ void probe_mx(float* out) {
    const int l = threadIdx.x, r = l & 31, h = l >> 5;
    float code = 0.f;
    for (int hyp = 0; hyp < 2; ++hyp) {
        unsigned char ab[32], bb[32];
        for (int j = 0; j < 32; ++j) { const int k = hyp == 0 ? 32 * h + j : (j < 16 ? 16 * h + j : 32 + 16 * h + (j - 16));
            ab[j] = f8enc(k == (7 * r + 3) % 64 ? 1 : 0); bb[j] = f8enc(1 + ((k + 3 * r) % 13)); }
        v8i_t A, B;
        for (int d = 0; d < 8; ++d) { A[d] = ab[4 * d] | (ab[4 * d + 1] << 8) | (ab[4 * d + 2] << 16) | (ab[4 * d + 3] << 24); B[d] = bb[4 * d] | (bb[4 * d + 1] << 8) | (bb[4 * d + 2] << 16) | (bb[4 * d + 3] << 24); }
        v16f_t c = {};
        c = __builtin_amdgcn_mfma_scale_f32_32x32x64_f8f6f4(A, B, c, 0, 0, 0, 0x7F7F7F7F, 0, 0x7F7F7F7F);
        bool ok = true;
        for (int g = 0; g < 16; ++g) { const int row = (g & 3) + 8 * (g >> 2) + 4 * h, col = r; const int kk = (7 * row + 3) % 64; const float expect = (float)(1 + ((kk + 3 * col) % 13)); ok = ok && (c[g] == expect); }
        const bool all_ok = __all(ok);
        if (all_ok) code += (hyp == 0 ? 1.f : 2.f);
    }
    if (l == 0) out[0] = 1000.f * (1.f + code);
}
#endif

extern "C" void kernel_launch(void* const* d_in, const int* in_sizes, int n_in, void* d_out, int out_size, void* d_ws, size_t ws_size, hipStream_t stream) {
    static int grid = 0;
    if (grid == 0) {
        if (n_in != 21 || in_sizes[0] != SEQ * DM || out_size != SEQ * DM || ws_size < WS_END) {
            fprintf(stderr, "kernel_launch: built for 21 inputs, x/out of %d floats, >= %zu bytes of workspace; got n_in %d, in0 %d, out %d, ws %zu; nothing launched\n", SEQ * DM, (size_t)WS_END, n_in, n_in > 0 ? in_sizes[0] : -1, out_size, ws_size); grid = -1; return; }
        int dev = 0, cus = 0, per_cu = 0;
        if (hipGetDevice(&dev) != hipSuccess || hipDeviceGetAttribute(&cus, hipDeviceAttributeMultiprocessorCount, dev) != hipSuccess) { fprintf(stderr, "kernel_launch: device query failed\n"); grid = -1; return; }
        if (hipFuncSetAttribute((const void*)fwd, hipFuncAttributeMaxDynamicSharedMemorySize, LDS_BYTES) != hipSuccess) { fprintf(stderr, "kernel_launch: hipFuncSetAttribute failed\n"); grid = -1; return; }
        if (hipOccupancyMaxActiveBlocksPerMultiprocessor(&per_cu, (const void*)fwd, NTHR, LDS_BYTES) != hipSuccess || per_cu < 1) fprintf(stderr, "kernel_launch: note: occupancy query reports %d workgroups per CU\n", per_cu);
        (void)hipGetLastError();
        grid = cus;
    }
    if (grid < 0) return;
    if (hipMemsetAsync((char*)d_ws + WS_CTL, 0, CTL_ZERO_BYTES, stream) != hipSuccess) { fprintf(stderr, "kernel_launch: memset failed\n"); return; }
    Args a{};
    for (int i = 0; i < 21; ++i) a.in[i] = (const float*)d_in[i];
    a.out = (float*)d_out; a.ws = (unsigned char*)d_ws;
#if MK_ONE_LAUNCH
    a.ph_lo = 0; a.ph_hi = NPHASE;
    hipLaunchKernelGGL(fwd, dim3(grid), dim3(NTHR), LDS_BYTES, stream, a);
#ifndef PROBE_MODE
#define PROBE_MODE 0
#endif
#ifdef PROBE_PHASES
    for (int p = 0; p < NPHASE; ++p) if ((PROBE_PHASES >> p) & 1) { a.ph_lo = p; a.ph_hi = p + 1; a.probe = PROBE_MODE; hipLaunchKernelGGL(fwd, dim3(grid), dim3(NTHR), LDS_BYTES, stream, a); }
#endif
#else
    for (int p = 0; p < NPHASE; ++p) { a.ph_lo = p; a.ph_hi = p + 1; hipLaunchKernelGGL(fwd, dim3(grid), dim3(NTHR), LDS_BYTES, stream, a); }
#endif
#ifdef PROBE_MX
    hipLaunchKernelGGL(probe_mx, dim3(1), dim3(64), 0, stream, (float*)d_out);
#endif
    const hipError_t le = hipPeekAtLastError();
    if (le != hipSuccess) fprintf(stderr, "kernel_launch: launch failed: %s\n", hipGetErrorName(le));
}
```

```cpp
#include <hip/hip_runtime.h>
#include <cstdio>
#include <cstdint>
#include <cmath>
namespace pg8 {
#define PG8_LAS __attribute__((address_space(3)))
typedef unsigned short bf16_t;
typedef short bf16x8 __attribute__((ext_vector_type(8)));
typedef float f32x4 __attribute__((ext_vector_type(4)));
typedef unsigned u32x4 __attribute__((ext_vector_type(4)));
constexpr int BM = 256, BK = 64, HALF = 128, HTB = HALF * BK * 2  , STAGE_BYTES = 8 * HTB, NXCD = 8, WGM = 8;

__host__ __device__ __forceinline__ int lds_byte(int r, int c) { const int st = (r >> 4) * 2 + (c >> 5), rr = r & 15, cc = c & 31, ob = rr * 64 + cc * 2; return st * 1024 + (ob ^ (((ob >> 9) & 1) << 5)); }
__host__ __device__ __forceinline__ void stage_rc(int b, int& R, int& C) { const int st = b / 1024, sb = b % 1024, swz = sb ^ (((sb >> 9) & 1) << 5); R = (st >> 1) * 16 + swz / 64; C = (st & 1) * 32 + (swz % 64) / 2; }
__host__ __device__ __forceinline__ int perm32(int rho) { const int n = rho >> 4, i = rho & 15; return 8 * (i >> 2) + 4 * n + (i & 3); }

struct Unit { int pm, pn; };
struct Gemm { const bf16_t* A; const bf16_t* Bt; int M, N, K; size_t a_pn; size_t b_pm; };

struct StaticOrder {
    int nM, nN, nwg, G, c;
    __host__ __device__ void init(int M, int N, int G_, int c_) { nM = M / BM; nN = N / BM; nwg = nM * nN; G = G_; c = c_; }
    __host__ __device__ bool next(int i, Unit& u) const {
        const long L = (long)i * G + c; if (L >= nwg) return false;
        int wgid = (int)L; { const int q = nwg / NXCD, r = nwg % NXCD, xcd = wgid % NXCD, off = wgid / NXCD; wgid = (xcd < r ? xcd * (q + 1) : r * (q + 1) + (xcd - r) * q) + off; }
        const int nig = WGM * nN, gid = wgid / nig, fm = gid * WGM, gsz = (nM - fm) < WGM ? (nM - fm) : WGM;
        u.pm = fm + ((wgid % nig) % gsz); u.pn = (wgid % nig) / gsz; return true;
    }
    __device__ __forceinline__ void a_ready(const Unit&) const {}
    __device__ __forceinline__ void done(const Unit&) const {}
};

__device__ __forceinline__ unsigned cvt_pk_bf16(float lo, float hi) { unsigned r; asm volatile("v_cvt_pk_bf16_f32 %0, %1, %2" : "=v"(r) : "v"(lo), "v"(hi)); return r; }
typedef float f32x2 __attribute__((ext_vector_type(2)));
__device__ __forceinline__ f32x2 gelu_pk(f32x2 v) {
    const f32x2 av = __builtin_elementwise_abs(v), d = av * 0.2316418882f + 1.0f;
    f32x2 t; t.x = __builtin_amdgcn_rcpf(d.x); t.y = __builtin_amdgcn_rcpf(d.y);
    f32x2 q = t * 0.5307027145f + (-0.7265760135f); q = q * t + 0.7107068705f; q = q * t + (-0.142248368f); q = q * t + 0.127414796f; q = q * t;
    const f32x2 s = (v * v) * (-0.72134752044f);
    f32x2 e; e.x = __builtin_amdgcn_exp2f(s.x); e.y = __builtin_amdgcn_exp2f(s.y);
    const f32x2 m = v * (q * e), r = v - m;
    f32x2 o; o.x = v.x < 0.f ? m.x : r.x; o.y = v.y < 0.f ? m.y : r.y; return o;
}


__device__ __forceinline__ u32x4 pack8(f32x4 v0, f32x4 v1) { u32x4 w; w.x = cvt_pk_bf16(v0[0], v0[1]); w.y = cvt_pk_bf16(v0[2], v0[3]); w.z = cvt_pk_bf16(v1[0], v1[1]); w.w = cvt_pk_bf16(v1[2], v1[3]); return w; }
__device__ __forceinline__ unsigned long long pack8_fp8(f32x4 v0, f32x4 v1) { int lo = __builtin_amdgcn_cvt_pk_fp8_f32(v0[0], v0[1], 0, false); lo = __builtin_amdgcn_cvt_pk_fp8_f32(v0[2], v0[3], lo, true);
    int hi = __builtin_amdgcn_cvt_pk_fp8_f32(v1[0], v1[1], 0, false); hi = __builtin_amdgcn_cvt_pk_fp8_f32(v1[2], v1[3], hi, true); return (unsigned long long)(unsigned)lo | ((unsigned long long)(unsigned)hi << 32); }
__device__ __forceinline__ float quad_row_sum(float s) { s += __shfl_xor(s, 16); s += __shfl_xor(s, 32); return s; }

__device__ __forceinline__ f32x4 rope4(f32x4 v, const float* tab, int i) {
    const f32x4 cs = *(const f32x4*)(tab + 2 * i);
    f32x4 o; o[0] = v[0] * cs[0] - v[1] * cs[1]; o[1] = v[1] * cs[0] + v[0] * cs[1]; o[2] = v[2] * cs[2] - v[3] * cs[3]; o[3] = v[3] * cs[2] + v[2] * cs[3]; return o;
}

struct EpiIn {
    static constexpr bool PERM = true, AFTER_DRAIN = false;
    bf16_t* cq; bf16_t* ckv; unsigned char* kr; bf16_t* ub; bf16_t* gb; float* ssq_cq; float* ssq_ckv; const float* rope;
    __device__ __forceinline__ void operator()(const f32x4 (&acc)[2][2][4][2], const Unit& u, int wr, int wc, int fr, int fq) const {
        const int pn = u.pn, row0 = u.pm * BM + wr * 64 + fr, cw = wc * 32 + 8 * fq;
        if (pn < 5) {
            bf16_t* dst = pn < 3 ? cq : ckv; const int ld = pn < 3 ? 768 : 512, pl = pn < 3 ? pn : pn - 3, coff = pl * 256 + cw, nsl = pn < 3 ? 12 : 8; float* ssq = pn < 3 ? ssq_cq : ssq_ckv;
#pragma unroll
            for (int ai = 0; ai < 2; ++ai)
#pragma unroll
                for (int m = 0; m < 4; ++m) { const int row = row0 + ai * HALF + m * 16; float s = 0.f;
#pragma unroll
                    for (int bj = 0; bj < 2; ++bj) { const f32x4 v0 = acc[ai][bj][m][0], v1 = acc[ai][bj][m][1];
                        s += (v0[0] * v0[0] + v0[1] * v0[1]) + (v0[2] * v0[2] + v0[3] * v0[3]) + (v1[0] * v1[0] + v1[1] * v1[1]) + (v1[2] * v1[2] + v1[3] * v1[3]);
                        *(u32x4*)(dst + (size_t)row * ld + coff + bj * HALF) = pack8(v0, v1); }
                    s = quad_row_sum(s); if (fq == 0) ssq[(size_t)row * nsl + pl * 4 + wc] = s; }
        } else if (pn == 5) {
            if (wc < 2) {
#pragma unroll
                for (int ai = 0; ai < 2; ++ai)
#pragma unroll
                    for (int m = 0; m < 4; ++m) { const int row = row0 + ai * HALF + m * 16; f32x4 v0 = acc[ai][0][m][0], v1 = acc[ai][0][m][1];
                        if (row < 8192) { const int pos = wc == 0 ? (row >> 6) : 128 + (row & 63); const float* tab = rope + pos * 32; v0 = rope4(v0, tab, 4 * fq); v1 = rope4(v1, tab, 4 * fq + 2); }
                        *(unsigned long long*)(kr + (size_t)row * 64 + cw) = pack8_fp8(v0, v1); }
            }
        } else if (pn < 22) {
            const int j = pn - 6;
#pragma unroll
            for (int ai = 0; ai < 2; ++ai)
#pragma unroll
                for (int m = 0; m < 4; ++m) { const int row = row0 + ai * HALF + m * 16;
                    *(u32x4*)(ub + (size_t)row * 2048 + j * 128 + cw) = pack8(acc[ai][0][m][0] * acc[ai][1][m][0], acc[ai][0][m][1] * acc[ai][1][m][1]); }
        } else {
            const int j = pn - 22;
#pragma unroll
            for (int ai = 0; ai < 2; ++ai)
#pragma unroll
                for (int m = 0; m < 4; ++m) { const int row = row0 + ai * HALF + m * 16;
#pragma unroll
                    for (int bj = 0; bj < 2; ++bj) *(u32x4*)(gb + (size_t)row * 2048 + j * 256 + bj * HALF + cw) = pack8(acc[ai][bj][m][0], acc[ai][bj][m][1]); }
        }
    }
};

struct EpiQ {
    static constexpr bool PERM = true, AFTER_DRAIN = false;
    unsigned char* q; const float* ssq_cq; const float* rope; float c2;
    __device__ __forceinline__ void operator()(const f32x4 (&acc)[2][2][4][2], const Unit& u, int wr, int wc, int fr, int fq) const {
        const int row0 = u.pm * BM + wr * 64 + fr, cw = wc * 32 + 8 * fq;
#pragma unroll
        for (int ai = 0; ai < 2; ++ai)
#pragma unroll
            for (int m = 0; m < 4; ++m) { const int row = row0 + ai * HALF + m * 16; const f32x4 q0 = *(const f32x4*)(ssq_cq + (size_t)row * 12), q1 = *(const f32x4*)(ssq_cq + (size_t)row * 12 + 4), q2 = *(const f32x4*)(ssq_cq + (size_t)row * 12 + 8);
                const float ssum = (((q0[0] + q0[1]) + (q0[2] + q0[3])) + ((q1[0] + q1[1]) + (q1[2] + q1[3]))) + ((q2[0] + q2[1]) + (q2[2] + q2[3])); const float sc = c2 / sqrtf(ssum * (1.f / 768.f) + 1e-6f);
#pragma unroll
                for (int bj = 0; bj < 2; ++bj) { const int col = u.pn * BM + bj * HALF + cw, d = col % 192; f32x4 v0 = acc[ai][bj][m][0] * sc, v1 = acc[ai][bj][m][1] * sc;
                    if (d >= 128) { const int p = d - 128, ax = p >> 5, i = (p & 31) >> 1; const int pos = ax == 0 ? (row >> 6) : 128 + (row & 63); const float* tab = rope + pos * 32;
                        v0 = rope4(v0, tab, i); v1 = rope4(v1, tab, i + 2); }
                    *(unsigned long long*)(q + (size_t)row * 3072 + col) = pack8_fp8(v0, v1); } }
    }
};

struct EpiK {
    static constexpr bool PERM = true, AFTER_DRAIN = false;
    unsigned char* kn; const float* ssq_ckv;
    __device__ __forceinline__ void operator()(const f32x4 (&acc)[2][2][4][2], const Unit& u, int wr, int wc, int fr, int fq) const {
        const int row0 = u.pm * BM + wr * 64 + fr, cw = u.pn * BM + wc * 32 + 8 * fq;
#pragma unroll
        for (int ai = 0; ai < 2; ++ai)
#pragma unroll
            for (int m = 0; m < 4; ++m) { const int row = row0 + ai * HALF + m * 16; const f32x4 q0 = *(const f32x4*)(ssq_ckv + (size_t)row * 8), q1 = *(const f32x4*)(ssq_ckv + (size_t)row * 8 + 4);
                const float ssum = ((q0[0] + q0[1]) + (q0[2] + q0[3])) + ((q1[0] + q1[1]) + (q1[2] + q1[3])); const float sc = 1.f / sqrtf(ssum * (1.f / 512.f) + 1e-6f);
#pragma unroll
                for (int bj = 0; bj < 2; ++bj) *(unsigned long long*)(kn + (size_t)row * 2048 + cw + bj * HALF) = pack8_fp8(acc[ai][bj][m][0] * sc, acc[ai][bj][m][1] * sc); }
    }
};

struct EpiVT {
    static constexpr bool PERM = true, AFTER_DRAIN = false;
    unsigned char* vt; const float* ssq_ckv;
    __device__ __forceinline__ void operator()(const f32x4 (&acc)[2][2][4][2], const Unit& u, int wr, int wc, int fr, int fq) const {
        const int row0 = u.pm * BM + wr * 64 + fr, key0 = u.pn * BM + wc * 32 + 8 * fq;
        f32x4 rs[2][2];
#pragma unroll
        for (int bj = 0; bj < 2; ++bj)
#pragma unroll
            for (int n = 0; n < 2; ++n)
#pragma unroll
                for (int j = 0; j < 4; ++j) { const int key = key0 + bj * HALF + 4 * n + j; const f32x4 q0 = *(const f32x4*)(ssq_ckv + (size_t)key * 8), q1 = *(const f32x4*)(ssq_ckv + (size_t)key * 8 + 4);
                    const float ssum = ((q0[0] + q0[1]) + (q0[2] + q0[3])) + ((q1[0] + q1[1]) + (q1[2] + q1[3])); rs[bj][n][j] = 1.f / sqrtf(ssum * (1.f / 512.f) + 1e-6f); }
#pragma unroll
        for (int ai = 0; ai < 2; ++ai)
#pragma unroll
            for (int m = 0; m < 4; ++m) { const int row = row0 + ai * HALF + m * 16;
#pragma unroll
                for (int bj = 0; bj < 2; ++bj) { const int key8 = key0 + bj * HALF, g = (key8 & 63) >> 3; unsigned char* dst = vt + (size_t)row * 8448 + (key8 & ~63) + 16 * (g >> 2) + 4 * (g & 3);
                    const f32x4 v0 = acc[ai][bj][m][0] * rs[bj][0], v1 = acc[ai][bj][m][1] * rs[bj][1];
                    int w0 = __builtin_amdgcn_cvt_pk_fp8_f32(v0[0], v0[1], 0, false); w0 = __builtin_amdgcn_cvt_pk_fp8_f32(v0[2], v0[3], w0, true);
                    int w1 = __builtin_amdgcn_cvt_pk_fp8_f32(v1[0], v1[1], 0, false); w1 = __builtin_amdgcn_cvt_pk_fp8_f32(v1[2], v1[3], w1, true);
                    *(int*)dst = w0; *(int*)(dst + 32) = w1; } }
    }
};

struct EpiO {
    static constexpr bool PERM = true, AFTER_DRAIN = false;
    const float* gate; bf16_t* dlt;
    __device__ __forceinline__ void operator()(const f32x4 (&acc)[2][2][4][2], const Unit& u, int wr, int wc, int fr, int fq) const {
        const int row0 = u.pm * BM + wr * 64 + fr, c0 = u.pn * BM + wc * 32 + 8 * fq;
        f32x4 g[2][2];
#pragma unroll
        for (int bj = 0; bj < 2; ++bj)
#pragma unroll
            for (int n = 0; n < 2; ++n) g[bj][n] = *(const f32x4*)(gate + c0 + bj * HALF + 4 * n);
#pragma unroll
        for (int ai = 0; ai < 2; ++ai)
#pragma unroll
            for (int m = 0; m < 4; ++m) { const int row = row0 + ai * HALF + m * 16;
#pragma unroll
                for (int bj = 0; bj < 2; ++bj) *(u32x4*)(dlt + (size_t)row * 4096 + c0 + bj * HALF) = pack8(g[bj][0] * acc[ai][bj][m][0], g[bj][1] * acc[ai][bj][m][1]); }
    }
};

struct EpiPQ {
    static constexpr bool PERM = true, AFTER_DRAIN = false;
    bf16_t* qp;
    __device__ __forceinline__ void operator()(const f32x4 (&acc)[2][2][4][2], const Unit& u, int wr, int wc, int fr, int fq) const {
        const int row0 = u.pm * BM + wr * 64 + fr, cw = wc * 32 + 8 * fq; bf16_t* base = qp + (size_t)u.pn * 8192 * 256;
#pragma unroll
        for (int ai = 0; ai < 2; ++ai)
#pragma unroll
            for (int m = 0; m < 4; ++m) { const int row = row0 + ai * HALF + m * 16;
#pragma unroll
                for (int bj = 0; bj < 2; ++bj) *(u32x4*)(base + (size_t)row * 256 + bj * HALF + cw) = pack8(acc[ai][bj][m][0], acc[ai][bj][m][1]); }
    }
};

struct EpiB16 {
    static constexpr bool PERM = true, AFTER_DRAIN = false;
    bf16_t* o; int ldc;
    __device__ __forceinline__ void operator()(const f32x4 (&acc)[2][2][4][2], const Unit& u, int wr, int wc, int fr, int fq) const {
        const int row0 = u.pm * BM + wr * 64 + fr, c0 = u.pn * BM + wc * 32 + 8 * fq;
#pragma unroll
        for (int ai = 0; ai < 2; ++ai)
#pragma unroll
            for (int m = 0; m < 4; ++m) { const int row = row0 + ai * HALF + m * 16;
#pragma unroll
                for (int bj = 0; bj < 2; ++bj) *(u32x4*)(o + (size_t)row * ldc + c0 + bj * HALF) = pack8(acc[ai][bj][m][0], acc[ai][bj][m][1]); }
    }
};

struct EpiF32 {
    static constexpr bool PERM = true, AFTER_DRAIN = false;
    float* o; int ldc;
    __device__ __forceinline__ void operator()(const f32x4 (&acc)[2][2][4][2], const Unit& u, int wr, int wc, int fr, int fq) const {
        const int row0 = u.pm * BM + wr * 64 + fr, c0 = u.pn * BM + wc * 32 + 8 * fq;
#pragma unroll
        for (int ai = 0; ai < 2; ++ai)
#pragma unroll
            for (int m = 0; m < 4; ++m) { const int row = row0 + ai * HALF + m * 16;
#pragma unroll
                for (int bj = 0; bj < 2; ++bj)
#pragma unroll
                    for (int n = 0; n < 2; ++n) *(f32x4*)(o + (size_t)row * ldc + c0 + bj * HALF + 4 * n) = acc[ai][bj][m][n]; }
    }
};

struct OrderIn : StaticOrder {
    __device__ bool next(int i, Unit& u) const {
        const long L = (long)i * G + c;
        if (L < nwg) return StaticOrder::next(i, u);
        if (L < nwg + 3) { u.pm = 32; u.pn = 3 + (int)(L - nwg); return true; }
        return false;
    }
};

struct RunOrder {
    int base, cnt, nN;
    __device__ bool next(int i, Unit& u) const { if (i >= cnt) return false; const int idx = base + i; u.pm = idx / nN; u.pn = idx % nN; return true; }
    __device__ __forceinline__ void a_ready(const Unit&) const {}
    __device__ __forceinline__ void done(const Unit&) const {}
};
template <class Epi, class Sched, bool ALIGN_EPI = false, bool SP2 = false>
__device__ __forceinline__ void gemm_phase(PG8_LAS unsigned char* lds, const Gemm g, const Sched& S, const Epi& E) {
    int tid_o_ = threadIdx.x; asm volatile("" : "+v"(tid_o_));
    const int tid = tid_o_, wid = __builtin_amdgcn_readfirstlane(tid >> 6), lane = tid & 63, wr = wid >> 2, wc = wid & 3, fr = lane & 15, fq = lane >> 4;
    const int K = g.K, nt = K / BK;
    unsigned voffA[2], voffB[2];
#pragma unroll
    for (int i = 0; i < 2; ++i) { int R, C; stage_rc(tid * 16 + i * 8192, R, C); const int Rb = Epi::PERM ? ((R & ~31) + perm32(R & 31)) : R;
        voffA[i] = (unsigned)(R * K + C) * 2u; voffB[i] = (unsigned)(Rb * K + C) * 2u; }
    const size_t kstep = (size_t)(BK * 2);
    const size_t hstep = (size_t)HALF * K * 2;
    const size_t tstep = 2 * hstep;
    const unsigned ldsw = (unsigned)wid * 1024u;
    const int aoff = lds_byte(wr * 64 + fr, fq * 8), boff = lds_byte(wc * 32 + fr, fq * 8);
#define PG8_SA(b, h) (((b) * 2 + (h)) * HTB)
#define PG8_SB(b, h) ((4 + (b) * 2 + (h)) * HTB)
#define PG8_STAGE(bufoff, gbase, voff) do { _Pragma("unroll") for (int _i = 0; _i < 2; ++_i) \
        __builtin_amdgcn_global_load_lds((const unsigned*)((const char*)(gbase) + (voff)[_i]), (PG8_LAS unsigned*)(lds + (bufoff) + ldsw + _i * 8192), 16, 0, 0); } while (0)
#define PG8_LDA(dst, b, h) do { _Pragma("unroll") for (int m = 0; m < 4; ++m) _Pragma("unroll") for (int k = 0; k < 2; ++k) dst[m][k] = *(const PG8_LAS bf16x8*)(lds + PG8_SA(b, h) + aoff + m * 2048 + k * 1024); } while (0)
#define PG8_LDB(dst, b, h) do { _Pragma("unroll") for (int n = 0; n < 2; ++n) _Pragma("unroll") for (int k = 0; k < 2; ++k) dst[n][k] = *(const PG8_LAS bf16x8*)(lds + PG8_SB(b, h) + boff + n * 2048 + k * 1024); } while (0)
#define PG8_MMA(ai, bj, At, Bt) do { __builtin_amdgcn_s_setprio(1); _Pragma("unroll") for (int m = 0; m < 4; ++m) _Pragma("unroll") for (int n = 0; n < 2; ++n) _Pragma("unroll") for (int k = 0; k < 2; ++k) \
        acc[ai][bj][m][n] = __builtin_amdgcn_mfma_f32_16x16x32_bf16(Bt[n][k], At[m][k], acc[ai][bj][m][n], 0, 0, 0); __builtin_amdgcn_s_setprio(0); } while (0)
#define PG8_WAIT_V(n) asm volatile("s_waitcnt vmcnt(" #n ")" ::: "memory")
#define PG8_WAIT_L(n) asm volatile("s_waitcnt lgkmcnt(" #n ")" ::: "memory")
#define PG8_BAR __builtin_amdgcn_s_barrier()
#define PG8_SCHED __builtin_amdgcn_sched_barrier(0)
    Unit cur, nxt; int ui = 0;
    if (!S.next(0, cur)) return;
    f32x4 acc[2][2][4][2];
#pragma unroll
    for (int a = 0; a < 2; ++a)
#pragma unroll
        for (int b = 0; b < 2; ++b)
#pragma unroll
            for (int m = 0; m < 4; ++m)
#pragma unroll
                for (int n = 0; n < 2; ++n) acc[a][b][m][n] = (f32x4){0.f, 0.f, 0.f, 0.f};
    bf16x8 At[4][2], B0[2][2], B1[2][2];
    const char* cA = (const char*)g.A + (size_t)cur.pm * tstep + (size_t)cur.pn * g.a_pn; const char* cB = (const char*)g.Bt + (size_t)cur.pn * tstep + (size_t)cur.pm * g.b_pm;
    S.a_ready(cur);
    if constexpr (SP2) {
        PG8_STAGE(PG8_SB(0, 0), cB, voffB); PG8_STAGE(PG8_SB(0, 1), cB + hstep, voffB); PG8_STAGE(PG8_SA(0, 0), cA, voffA); PG8_STAGE(PG8_SA(0, 1), cA + hstep, voffA);
        if (wr == 1) PG8_BAR;
        PG8_WAIT_V(2); PG8_BAR;
        PG8_STAGE(PG8_SB(1, 0), cB + kstep, voffB); PG8_STAGE(PG8_SA(1, 0), cA + kstep, voffA); PG8_STAGE(PG8_SB(1, 1), cB + hstep + kstep, voffB);
        PG8_WAIT_V(6); PG8_BAR;
    } else {
        PG8_STAGE(PG8_SB(0, 0), cB, voffB); PG8_STAGE(PG8_SA(0, 0), cA, voffA); PG8_STAGE(PG8_SB(0, 1), cB + hstep, voffB); PG8_STAGE(PG8_SA(0, 1), cA + hstep, voffA);
        if (wr == 1) PG8_BAR;
        PG8_WAIT_V(4); PG8_BAR;
        PG8_STAGE(PG8_SB(1, 0), cB + kstep, voffB); PG8_STAGE(PG8_SA(1, 0), cA + kstep, voffA); PG8_STAGE(PG8_SB(1, 1), cB + hstep + kstep, voffB);
        PG8_WAIT_V(6); PG8_BAR;
    }
    for (;;) {
        const bool has_next = S.next(ui + 1, nxt);
        const char* nA = has_next ? (const char*)g.A + (size_t)nxt.pm * tstep + (size_t)nxt.pn * g.a_pn : cA; const char* nB = has_next ? (const char*)g.Bt + (size_t)nxt.pn * tstep + (size_t)nxt.pm * g.b_pm : cB;
        for (int t = 0; t < nt; t += 2) {
            const bool last = (t == nt - 2);
            const char* a1 = cA + (size_t)(t + 1) * kstep;
            const char* a2 = last ? nA : cA + (size_t)(t + 2) * kstep; const char* b2 = last ? nB : cB + (size_t)(t + 2) * kstep;
            const char* a3 = a2 + kstep; const char* b3 = b2 + kstep;
            if (last && has_next) S.a_ready(nxt);
            if constexpr (SP2) {
            PG8_LDB(B0, 0, 0); PG8_LDB(B1, 0, 1); PG8_SCHED; PG8_LDA(At, 0, 0); PG8_STAGE(PG8_SA(1, 1), a1 + hstep, voffA);
            PG8_WAIT_V(8); PG8_WAIT_L(0); PG8_BAR; PG8_MMA(0, 0, At, B0); PG8_MMA(0, 1, At, B1); PG8_BAR; PG8_SCHED;
            PG8_LDA(At, 0, 1); PG8_STAGE(PG8_SB(0, 0), b2, voffB); PG8_STAGE(PG8_SB(0, 1), b2 + hstep, voffB); PG8_STAGE(PG8_SA(0, 0), a2, voffA);
            PG8_WAIT_V(8); PG8_WAIT_L(0); PG8_BAR; PG8_MMA(1, 0, At, B0); PG8_MMA(1, 1, At, B1); PG8_BAR; PG8_SCHED;
            PG8_LDB(B0, 1, 0); PG8_LDB(B1, 1, 1); PG8_SCHED; PG8_LDA(At, 1, 0); PG8_STAGE(PG8_SA(0, 1), a2 + hstep, voffA);
            PG8_WAIT_V(8); PG8_WAIT_L(0); PG8_BAR; PG8_MMA(0, 0, At, B0); PG8_MMA(0, 1, At, B1); PG8_BAR; PG8_SCHED;
            PG8_LDA(At, 1, 1); PG8_STAGE(PG8_SB(1, 0), b3, voffB); PG8_STAGE(PG8_SB(1, 1), b3 + hstep, voffB); PG8_STAGE(PG8_SA(1, 0), a3, voffA);
            PG8_WAIT_V(8); PG8_WAIT_L(0); PG8_BAR; PG8_MMA(1, 0, At, B0); PG8_MMA(1, 1, At, B1); PG8_BAR; PG8_SCHED;
            } else {
            PG8_LDB(B0, 0, 0); PG8_SCHED; PG8_LDA(At, 0, 0); PG8_STAGE(PG8_SA(1, 1), a1 + hstep, voffA);
            PG8_WAIT_L(8); PG8_BAR; PG8_WAIT_L(0); PG8_MMA(0, 0, At, B0); PG8_BAR; PG8_SCHED;
            PG8_LDB(B1, 0, 1); PG8_STAGE(PG8_SB(0, 0), b2, voffB);
            PG8_BAR; PG8_WAIT_L(0); PG8_MMA(0, 1, At, B1); PG8_BAR;
            PG8_LDA(At, 0, 1); PG8_STAGE(PG8_SA(0, 0), a2, voffA);
            PG8_BAR; PG8_WAIT_L(0); PG8_MMA(1, 0, At, B0); PG8_BAR; PG8_SCHED;
            PG8_STAGE(PG8_SB(0, 1), b2 + hstep, voffB);
            PG8_WAIT_V(6); PG8_BAR; PG8_MMA(1, 1, At, B1); PG8_BAR;
            PG8_LDB(B0, 1, 0); PG8_SCHED; PG8_LDA(At, 1, 0); PG8_STAGE(PG8_SA(0, 1), a2 + hstep, voffA);
            PG8_WAIT_L(8); PG8_BAR; PG8_WAIT_L(0); PG8_MMA(0, 0, At, B0); PG8_BAR; PG8_SCHED;
            PG8_LDB(B1, 1, 1); PG8_STAGE(PG8_SB(1, 0), b3, voffB);
            PG8_BAR; PG8_WAIT_L(0); PG8_MMA(0, 1, At, B1); PG8_BAR;
            PG8_LDA(At, 1, 1); PG8_STAGE(PG8_SA(1, 0), a3, voffA);
            PG8_BAR; PG8_WAIT_L(0); PG8_MMA(1, 0, At, B0); PG8_BAR; PG8_SCHED;
            PG8_STAGE(PG8_SB(1, 1), b3 + hstep, voffB);
            PG8_WAIT_V(6); PG8_BAR; PG8_MMA(1, 1, At, B1); PG8_BAR;
            }
        }
        if constexpr (ALIGN_EPI) { if (wr == 0) PG8_BAR; }
        if constexpr (!Epi::AFTER_DRAIN) { E(acc, cur, wr, wc, fr, fq); S.done(cur); }
        if (!has_next) break;
#pragma unroll
        for (int a = 0; a < 2; ++a)
#pragma unroll
            for (int b = 0; b < 2; ++b)
#pragma unroll
                for (int m = 0; m < 4; ++m)
#pragma unroll
                    for (int n = 0; n < 2; ++n) acc[a][b][m][n] = (f32x4){0.f, 0.f, 0.f, 0.f};
        cur = nxt; cA = nA; cB = nB; ++ui;
        if constexpr (ALIGN_EPI) { if (wr == 1) PG8_BAR; }
    }
    PG8_WAIT_V(0);
    if constexpr (!ALIGN_EPI) { if (wr == 0) PG8_BAR; }
    PG8_BAR;
    if constexpr (Epi::AFTER_DRAIN) { E.fused(acc, cur, wr, wc, fr, fq, lds, wid, lane); S.done(cur); }
#undef PG8_SA
#undef PG8_SB
#undef PG8_STAGE
#undef PG8_LDA
#undef PG8_LDB
#undef PG8_MMA
#undef PG8_WAIT_V
#undef PG8_WAIT_L
#undef PG8_BAR
#undef PG8_SCHED
}
}

namespace att {
using bf16x8 = __attribute__((ext_vector_type(8))) short;
using s16x4  = __attribute__((ext_vector_type(4))) short;
using f32x16 = __attribute__((ext_vector_type(16))) float;
using u32x4  = __attribute__((ext_vector_type(4))) unsigned;
typedef unsigned short bf16;
constexpr int NW = 8, QBLK = 32, KVBLK = 64;
#ifndef ATT_SDEPTH
#define ATT_SDEPTH 1
#endif
constexpr int SDEPTH = ATT_SDEPTH;
#ifndef QKT_GRP
#define QKT_GRP 4
#endif
constexpr int LDQ = 3072, LDKV = 2048, LDKR = 64, LDO = 4096, LDVT = 8448;
constexpr int SHM_V = 8192, SHM_KN = 8192, SHM_KR = 4096;
constexpr float QSC = 64.f, QSI = 1.f / 64.f;
constexpr int NSLOT = 3, OFF_V = 0, OFF_KN = NSLOT * SHM_V, OFF_KR = OFF_KN + NSLOT * SHM_KN, OFF_WS = OFF_KR + NSLOT * SHM_KR, SHM_ATTN = OFF_WS + NW * 64 * 4;
#define ALDS __attribute__((address_space(3)))
constexpr float THRL = 2.5f * 1.4426950408889634f * 64.f;
constexpr float PSH = 5.f;
#define KSWZ(row, colB) ((row) * 256 + ((colB) ^ (((row) & 15) << 4)))
#define RSWZ(row, colB) ((row) * 128 + ((colB) ^ ((((row) >> 1) & 7) << 4)))
#define SBAR() __builtin_amdgcn_sched_barrier(0)
__device__ __forceinline__ int crow(int r, int hi) { return (r & 3) + 8 * (r >> 2) + 4 * hi; }
__device__ __forceinline__ unsigned cvtpk(float lo, float hi) { unsigned r; asm volatile("v_cvt_pk_bf16_f32 %0, %1, %2" : "=v"(r) : "v"(lo), "v"(hi)); return r; }

typedef int v8i32_t __attribute__((ext_vector_type(8)));
__device__ __forceinline__ void partialSM(f32x16& p0, f32x16& p1, float& m_reg, float& mn, float& alpha, const int prb) {
  float pmax = p0[0];
#pragma unroll
  for (int r = 1; r < 16; ++r) pmax = fmaxf(pmax, p0[r]);
#pragma unroll
  for (int r = 0; r < 16; ++r) pmax = fmaxf(pmax, p1[r]);
  { auto rr = __builtin_amdgcn_permlane32_swap(__float_as_uint(pmax), __float_as_uint(pmax), false, false);
    pmax = fmaxf(__uint_as_float(rr[0]), __uint_as_float(rr[1])); }
  if (__builtin_expect(__all(pmax - m_reg <= THRL), 1)) { mn = m_reg; alpha = 1.f; }
  else { mn = fmaxf(m_reg, pmax); alpha = __builtin_amdgcn_exp2f((m_reg - mn) * QSI); m_reg = mn; }
  const float mnq = fmaf(-mn, QSI, PSH);
#pragma unroll
  for (int r = 0; r < 16; ++r) p0[r] = fmaf(p0[r], QSI, mnq);
#pragma unroll
  for (int r = 0; r < 16; ++r) p1[r] = fmaf(p1[r], QSI, mnq);
  if (!(prb & 1)) {
#pragma unroll
  for (int r = 0; r < 16; ++r) p0[r] = __builtin_amdgcn_exp2f(p0[r]); }
}
__device__ __forceinline__ void finishSM(f32x16& p0, f32x16& p1, float alpha, float& l_reg, v8i32_t& pa8, const int prb) {
  if (!(prb & 1)) {
#pragma unroll
  for (int r = 0; r < 16; ++r) p1[r] = __builtin_amdgcn_exp2f(p1[r]); }
  float ps = 0;
#pragma unroll
  for (int r = 0; r < 16; ++r) ps += p0[r];
#pragma unroll
  for (int r = 0; r < 16; ++r) ps += p1[r];
  { auto rr = __builtin_amdgcn_permlane32_swap(__float_as_uint(ps), __float_as_uint(ps), false, false);
    ps = __uint_as_float(rr[0]) + __uint_as_float(rr[1]); }
  l_reg = l_reg * alpha + ps;
#pragma unroll
  for (int i = 0; i < 4; ++i) { int w = __builtin_amdgcn_cvt_pk_fp8_f32(p0[4 * i], p0[4 * i + 1], 0, false); w = __builtin_amdgcn_cvt_pk_fp8_f32(p0[4 * i + 2], p0[4 * i + 3], w, true); pa8[i] = w;
    int w2 = __builtin_amdgcn_cvt_pk_fp8_f32(p1[4 * i], p1[4 * i + 1], 0, false); w2 = __builtin_amdgcn_cvt_pk_fp8_f32(p1[4 * i + 2], p1[4 * i + 3], w2, true); pa8[4 + i] = w2; }
}
#ifndef QKT_PF
#define QKT_PF 0
#endif
#if QKT_PF == 0
__device__ __forceinline__ void qkt(f32x16& p0, f32x16& p1, const char* Kn, const char* Kr, const bf16x8* qr, const char* Qr, int r32, int hi) {
  p0 = f32x16{}; p1 = f32x16{};
#pragma unroll
  for (int d0 = 0; d0 < 8; ++d0) { const int cb = (d0 * 16 + hi * 8) * 2;
    bf16x8 b0 = *reinterpret_cast<const bf16x8*>(Kn + KSWZ(r32, cb));
    bf16x8 b1 = *reinterpret_cast<const bf16x8*>(Kn + KSWZ(32 + r32, cb));
    p0 = __builtin_amdgcn_mfma_f32_32x32x16_bf16(b0, qr[d0], p0, 0, 0, 0);
    p1 = __builtin_amdgcn_mfma_f32_32x32x16_bf16(b1, qr[d0], p1, 0, 0, 0);
    if ((d0 & (QKT_GRP - 1)) == QKT_GRP - 1) SBAR(); }
#pragma unroll
  for (int d0 = 0; d0 < 4; ++d0) { const int cb = (d0 * 16 + hi * 8) * 2;
    bf16x8 b0 = *reinterpret_cast<const bf16x8*>(Kr + RSWZ(r32, cb));
    bf16x8 b1 = *reinterpret_cast<const bf16x8*>(Kr + RSWZ(32 + r32, cb));
    const bf16x8 qf = qr[8 + d0];
    p0 = __builtin_amdgcn_mfma_f32_32x32x16_bf16(b0, qf, p0, 0, 0, 0);
    p1 = __builtin_amdgcn_mfma_f32_32x32x16_bf16(b1, qf, p1, 0, 0, 0);
    if ((d0 & (QKT_GRP - 1)) == QKT_GRP - 1) SBAR(); }
}
#else
__device__ __forceinline__ void qkt(f32x16& p0, f32x16& p1, const char* Kn, const char* Kr, const bf16x8* qr, const char* Qr, int r32, int hi) {
  p0 = f32x16{}; p1 = f32x16{};
  constexpr int NB = QKT_PF + 1;
  bf16x8 kb0[NB], kb1[NB], qf[NB];
#define KLD(S) do { constexpr int s_ = (S), i_ = s_ % NB; if constexpr (s_ < 8) { const int cb = (s_ * 16 + hi * 8) * 2; kb0[i_] = *reinterpret_cast<const bf16x8*>(Kn + KSWZ(r32, cb)); kb1[i_] = *reinterpret_cast<const bf16x8*>(Kn + KSWZ(32 + r32, cb)); } \
    else { const int cb = ((s_ - 8) * 16 + hi * 8) * 2; kb0[i_] = *reinterpret_cast<const bf16x8*>(Kr + RSWZ(r32, cb)); kb1[i_] = *reinterpret_cast<const bf16x8*>(Kr + RSWZ(32 + r32, cb)); qf[i_] = *reinterpret_cast<const bf16x8*>(Qr + (s_ - 8) * 1024); } } while (0)
#define KSTEP(S) do { constexpr int s_ = (S), i_ = s_ % NB; if constexpr (s_ + QKT_PF < 12) KLD(S + QKT_PF); const bf16x8 q_ = s_ < 8 ? qr[s_ < 8 ? s_ : 0] : qf[i_]; \
    p0 = __builtin_amdgcn_mfma_f32_32x32x16_bf16(kb0[i_], q_, p0, 0, 0, 0); p1 = __builtin_amdgcn_mfma_f32_32x32x16_bf16(kb1[i_], q_, p1, 0, 0, 0); } while (0)
  KLD(0); if constexpr (QKT_PF >= 2) KLD(1);
  KSTEP(0); KSTEP(1); KSTEP(2); KSTEP(3); KSTEP(4); KSTEP(5); KSTEP(6); KSTEP(7); KSTEP(8); KSTEP(9); KSTEP(10); KSTEP(11);
#undef KLD
#undef KSTEP
}
#endif
__device__ __forceinline__ int v_st(int k, int c) { const int kk = (k & ~0xC) | ((k & 4) << 1) | ((k & 8) >> 1); return ((kk >> 3) * 4 + (c >> 5)) * 512 + ((kk & 7) * 32 + (c & 31)) * 2; }
__device__ __forceinline__ int v_rd_base(int lane) { return ((lane & 3) << 3) | (((lane >> 2) & 3) << 6) | (((lane >> 4) & 1) << 5) | (((lane >> 5) & 1) << 8); }
constexpr int v_rd_off(int d0, int ks, int half) { return d0 * 512 + ks * 4096 + half * 2048; }
template <int OFF> __device__ __forceinline__ s16x4 tr_read(int vb) {
  s16x4 r; asm volatile("ds_read_b64_tr_b16 %0, %1 offset:%2" : "=&v"(r) : "v"(vb), "i"(OFF) : "memory"); return r;
}
template <int D0> __device__ __forceinline__ void pv_one(f32x16& od, int vb, bf16x8 pa0, bf16x8 pa1, bf16x8 pa2, bf16x8 pa3) {
  const s16x4 l0 = tr_read<v_rd_off(D0, 0, 0)>(vb), h0 = tr_read<v_rd_off(D0, 0, 1)>(vb), l1 = tr_read<v_rd_off(D0, 1, 0)>(vb), h1 = tr_read<v_rd_off(D0, 1, 1)>(vb);
  const s16x4 l2 = tr_read<v_rd_off(D0, 2, 0)>(vb), h2 = tr_read<v_rd_off(D0, 2, 1)>(vb), l3 = tr_read<v_rd_off(D0, 3, 0)>(vb), h3 = tr_read<v_rd_off(D0, 3, 1)>(vb);
  asm volatile("s_waitcnt lgkmcnt(0)" ::: "memory"); SBAR();
#define PK(L, H) (bf16x8){L[0], L[1], L[2], L[3], H[0], H[1], H[2], H[3]}
  od = __builtin_amdgcn_mfma_f32_32x32x16_bf16(pa0, PK(l0, h0), od, 0, 0, 0);
  od = __builtin_amdgcn_mfma_f32_32x32x16_bf16(pa1, PK(l1, h1), od, 0, 0, 0);
  od = __builtin_amdgcn_mfma_f32_32x32x16_bf16(pa2, PK(l2, h2), od, 0, 0, 0);
  od = __builtin_amdgcn_mfma_f32_32x32x16_bf16(pa3, PK(l3, h3), od, 0, 0, 0);
#undef PK
}
__device__ __forceinline__ void pv_d0(f32x16* o, int vb, bf16x8 pa0, bf16x8 pa1, bf16x8 pa2, bf16x8 pa3) {
  pv_one<0>(o[0], vb, pa0, pa1, pa2, pa3); pv_one<1>(o[1], vb, pa0, pa1, pa2, pa3); pv_one<2>(o[2], vb, pa0, pa1, pa2, pa3); pv_one<3>(o[3], vb, pa0, pa1, pa2, pa3);
}

#define LDSR128(dst, base, OFF) asm volatile("ds_read_b128 %0, %1 offset:%2" : "=v"(dst) : "v"((unsigned)(uintptr_t)(base)), "i"(OFF) : "memory")
#define WAITK4(N, A, B, C, D) asm volatile("s_waitcnt lgkmcnt(" #N ")" : "+v"(A), "+v"(B), "+v"(C), "+v"(D) :: "memory")
#ifndef PADN
#define PADN 13
#endif
#define PAD_STR2(x) #x
#define PAD_STR(x) PAD_STR2(x)
#define MFMA_PAD1() asm volatile("s_nop " PAD_STR(PADN))
#define PINACC2(A, B) asm volatile("" : "+v"(A), "+v"(B))
#define PINACC1(A) asm volatile("" : "+v"(A))
#define WAITV2(N, A, B) asm volatile("s_waitcnt lgkmcnt(" #N ")" : "+v"(A), "+v"(B) :: "memory")
#define V8OF(F) (v8i32_t){(int)F[0][0], (int)F[0][1], (int)F[0][2], (int)F[0][3], (int)F[1][0], (int)F[1][1], (int)F[1][2], (int)F[1][3]}
#define MXMFMA(KF, QF, ACC) __builtin_amdgcn_mfma_scale_f32_32x32x64_f8f6f4(V8OF(KF), QF, ACC, 0, 0, 0, 0x7F7F7F7F, 0, 0x7F7F7F7F)
#define MXMFMA2(PA, VF, ACC) __builtin_amdgcn_mfma_scale_f32_32x32x64_f8f6f4(PA, V8OF(VF), ACC, 0, 0, 0, 0x7F7F7F7F, 0, 0x7F7F7F7F)
template <bool DO_QK, bool DO_PV, class IssueF>
__device__ __forceinline__ void mat_segment(const IssueF& issue, f32x16& p0, f32x16& p1, f32x16* o, const ALDS char* Kn, const ALDS char* Kr, const ALDS char* Vb, const v8i32_t* qf, v8i32_t pa8, int r32, int hi, const int prb) {
  u32x4 ka[3][2], kb[3][2], vf[4][2];
  const int nbase = r32 * 128, nsw = ((r32 >> 1) & 7) << 4, rbase = r32 * 64, rsw = ((r32 >> 2) & 3) << 4, hb = hi * 32;
  asm volatile("s_waitcnt lgkmcnt(0)" ::: "memory");
  if constexpr (DO_QK && DO_PV) {
  p0 = f32x16{}; p1 = f32x16{};
  if (!(prb & 4))   { const int a_ = nbase + (((0 * 64) + hb) ^ nsw); LDSR128(ka[0][0], Kn + a_, 0); LDSR128(ka[0][1], Kn + (a_ ^ 16), 0); LDSR128(kb[0][0], Kn + a_, 4096); LDSR128(kb[0][1], Kn + (a_ ^ 16), 4096); }
  if (!(prb & 4))   { const int a_ = nbase + (((1 * 64) + hb) ^ nsw); LDSR128(ka[1][0], Kn + a_, 0); LDSR128(ka[1][1], Kn + (a_ ^ 16), 0); LDSR128(kb[1][0], Kn + a_, 4096); LDSR128(kb[1][1], Kn + (a_ ^ 16), 4096); }
  if (!(prb & 4))   { const int a_ = rbase + (hb ^ rsw); LDSR128(ka[2][0], Kr + a_, 0); LDSR128(ka[2][1], Kr + (a_ ^ 16), 0); LDSR128(kb[2][0], Kr + a_, 2048); LDSR128(kb[2][1], Kr + (a_ ^ 16), 2048); }
  if (!(prb & 4))   { const int a_ = rbase + (hb ^ rsw); LDSR128(vf[0][0], Vb + a_, 0); LDSR128(vf[0][1], Vb + (a_ ^ 16), 0); }
  if (!(prb & 4))   { const int a_ = rbase + (hb ^ rsw); LDSR128(vf[1][0], Vb + a_, 2048); LDSR128(vf[1][1], Vb + (a_ ^ 16), 2048); }
  if (!(prb & 4))   { const int a_ = rbase + (hb ^ rsw); LDSR128(vf[2][0], Vb + a_, 4096); LDSR128(vf[2][1], Vb + (a_ ^ 16), 4096); }
  if (!(prb & 4))   { const int a_ = rbase + (hb ^ rsw); LDSR128(vf[3][0], Vb + a_, 6144); LDSR128(vf[3][1], Vb + (a_ ^ 16), 6144); }
  WAITK4(15, ka[0][0], ka[0][1], kb[0][0], kb[0][1]);
  if (!(prb & 2)) { p0 = MXMFMA(ka[0], qf[0], p0); PINACC1(p0); MFMA_PAD1(); p1 = MXMFMA(kb[0], qf[0], p1); PINACC1(p1); MFMA_PAD1(); }
  issue(0); issue(1);
  WAITK4(12, ka[1][0], ka[1][1], kb[1][0], kb[1][1]);
  if (!(prb & 2)) { p0 = MXMFMA(ka[1], qf[1], p0); PINACC1(p0); MFMA_PAD1(); p1 = MXMFMA(kb[1], qf[1], p1); PINACC1(p1); MFMA_PAD1(); }
  issue(2);
  WAITK4(8, ka[2][0], ka[2][1], kb[2][0], kb[2][1]);
  if (!(prb & 2)) { p0 = MXMFMA(ka[2], qf[2], p0); PINACC1(p0); MFMA_PAD1(); p1 = MXMFMA(kb[2], qf[2], p1); PINACC1(p1); MFMA_PAD1(); }
  WAITV2(6, vf[0][0], vf[0][1]);
  if (!(prb & 2)) { o[0] = MXMFMA2(pa8, vf[0], o[0]); PINACC1(o[0]); MFMA_PAD1(); }
  WAITV2(4, vf[1][0], vf[1][1]);
  if (!(prb & 2)) { o[1] = MXMFMA2(pa8, vf[1], o[1]); PINACC1(o[1]); MFMA_PAD1(); }
  WAITV2(2, vf[2][0], vf[2][1]);
  if (!(prb & 2)) { o[2] = MXMFMA2(pa8, vf[2], o[2]); PINACC1(o[2]); MFMA_PAD1(); }
  WAITV2(0, vf[3][0], vf[3][1]);
  if (!(prb & 2)) { o[3] = MXMFMA2(pa8, vf[3], o[3]); PINACC1(o[3]); MFMA_PAD1(); }
  } else if constexpr (DO_QK) {
  p0 = f32x16{}; p1 = f32x16{};
  if (!(prb & 4))   { const int a_ = nbase + (((0 * 64) + hb) ^ nsw); LDSR128(ka[0][0], Kn + a_, 0); LDSR128(ka[0][1], Kn + (a_ ^ 16), 0); LDSR128(kb[0][0], Kn + a_, 4096); LDSR128(kb[0][1], Kn + (a_ ^ 16), 4096); }
  if (!(prb & 4))   { const int a_ = nbase + (((1 * 64) + hb) ^ nsw); LDSR128(ka[1][0], Kn + a_, 0); LDSR128(ka[1][1], Kn + (a_ ^ 16), 0); LDSR128(kb[1][0], Kn + a_, 4096); LDSR128(kb[1][1], Kn + (a_ ^ 16), 4096); }
  if (!(prb & 4))   { const int a_ = rbase + (hb ^ rsw); LDSR128(ka[2][0], Kr + a_, 0); LDSR128(ka[2][1], Kr + (a_ ^ 16), 0); LDSR128(kb[2][0], Kr + a_, 2048); LDSR128(kb[2][1], Kr + (a_ ^ 16), 2048); }
  WAITK4(8, ka[0][0], ka[0][1], kb[0][0], kb[0][1]);
  if (!(prb & 2)) { p0 = MXMFMA(ka[0], qf[0], p0); PINACC1(p0); MFMA_PAD1(); p1 = MXMFMA(kb[0], qf[0], p1); PINACC1(p1); MFMA_PAD1(); }
  issue(0); issue(1);
  WAITK4(4, ka[1][0], ka[1][1], kb[1][0], kb[1][1]);
  if (!(prb & 2)) { p0 = MXMFMA(ka[1], qf[1], p0); PINACC1(p0); MFMA_PAD1(); p1 = MXMFMA(kb[1], qf[1], p1); PINACC1(p1); MFMA_PAD1(); }
  issue(2);
  WAITK4(0, ka[2][0], ka[2][1], kb[2][0], kb[2][1]);
  if (!(prb & 2)) { p0 = MXMFMA(ka[2], qf[2], p0); PINACC1(p0); MFMA_PAD1(); p1 = MXMFMA(kb[2], qf[2], p1); PINACC1(p1); MFMA_PAD1(); }
  } else {
  if (!(prb & 4))   { const int a_ = rbase + (hb ^ rsw); LDSR128(vf[0][0], Vb + a_, 0); LDSR128(vf[0][1], Vb + (a_ ^ 16), 0); }
  if (!(prb & 4))   { const int a_ = rbase + (hb ^ rsw); LDSR128(vf[1][0], Vb + a_, 2048); LDSR128(vf[1][1], Vb + (a_ ^ 16), 2048); }
  if (!(prb & 4))   { const int a_ = rbase + (hb ^ rsw); LDSR128(vf[2][0], Vb + a_, 4096); LDSR128(vf[2][1], Vb + (a_ ^ 16), 4096); }
  if (!(prb & 4))   { const int a_ = rbase + (hb ^ rsw); LDSR128(vf[3][0], Vb + a_, 6144); LDSR128(vf[3][1], Vb + (a_ ^ 16), 6144); }
  WAITV2(6, vf[0][0], vf[0][1]);
  if (!(prb & 2)) { o[0] = MXMFMA2(pa8, vf[0], o[0]); PINACC1(o[0]); MFMA_PAD1(); }
  WAITV2(4, vf[1][0], vf[1][1]);
  if (!(prb & 2)) { o[1] = MXMFMA2(pa8, vf[1], o[1]); PINACC1(o[1]); MFMA_PAD1(); }
  WAITV2(2, vf[2][0], vf[2][1]);
  if (!(prb & 2)) { o[2] = MXMFMA2(pa8, vf[2], o[2]); PINACC1(o[2]); MFMA_PAD1(); }
  WAITV2(0, vf[3][0], vf[3][1]);
  if (!(prb & 2)) { o[3] = MXMFMA2(pa8, vf[3], o[3]); PINACC1(o[3]); MFMA_PAD1(); }
  }
}

#define ATT_BAR() do { asm volatile("" ::: "memory"); __builtin_amdgcn_s_barrier(); asm volatile("" ::: "memory"); } while (0)
#define ATT_VM(N) asm volatile("s_waitcnt vmcnt(" #N ")" ::: "memory")
__device__ __forceinline__ void glds16(const bf16* g, ALDS unsigned char* l) { __builtin_amdgcn_global_load_lds((const unsigned*)g, (ALDS unsigned*)l, 16, 0, 0); }
__device__ __forceinline__ void glds8(const unsigned char* g, ALDS unsigned char* l) { __builtin_amdgcn_global_load_lds((const unsigned*)g, (ALDS unsigned*)l, 16, 0, 0); }
template <int PRB> __device__ __forceinline__ void attn_unit(const unsigned char* __restrict__ Qb, const unsigned char* __restrict__ Knh, const unsigned char* __restrict__ Vth, const unsigned char* __restrict__ Krb,
                                          bf16* __restrict__ Ob, int seq, char* lds, ALDS unsigned char* L, const int probe) {
  int tid_ = threadIdx.x; asm volatile("" : "+v"(tid_));
  const int tid = tid_, wid = __builtin_amdgcn_readfirstlane(tid >> 6), lane = tid & 63, r32 = lane & 31, hi = lane >> 5;
  constexpr int prb = PRB; (void)probe;
  const bool trail = wid >= 4;
  float* ws = (float*)(lds + OFF_WS) + wid * 64; float* li_l = ws; float* al_l = ws + 32;
  float m_reg = -1e30f, l_reg = 0; f32x16 o[4] = {}; v8i32_t qf[3];
  const unsigned char* Qw = Qb + (long)(wid * QBLK + r32) * LDQ + hi * 32;
#pragma unroll
  for (int s_ = 0; s_ < 3; ++s_) { const u32x4 a0 = *reinterpret_cast<const u32x4*>(Qw + s_ * 64), a1 = *reinterpret_cast<const u32x4*>(Qw + s_ * 64 + 16);
    qf[s_] = (v8i32_t){(int)a0[0], (int)a0[1], (int)a0[2], (int)a0[3], (int)a1[0], (int)a1[1], (int)a1[2], (int)a1[3]}; }
#define VOFF() ([&]() { const int row = wid * 16 + (lane >> 2), colB = ((lane & 3) * 16) ^ (((row >> 2) & 3) << 4); return row * LDVT + colB; }())
#define KOFF() ([&]() { const int row = wid * 8 + (lane >> 3), colB = ((lane & 7) * 16) ^ (((row >> 1) & 7) << 4); return row * LDKV + colB; }())
#define ROFF() ([&]() { const int row = wid * 16 + (lane >> 2), colB = ((lane & 3) * 16) ^ (((row >> 2) & 3) << 4); return row * LDKR + colB; }())
  const ALDS char* KL = (const ALDS char*)L + OFF_KN; const ALDS char* RL = (const ALDS char*)L + OFF_KR; const ALDS char* VL = (const ALDS char*)L + OFF_V;
#define ISSUE_K(t, s) do { const long kb_ = (long)(t) * KVBLK; const int s_ = (s); \
    glds8(Knh + kb_ * LDKV + KOFF(), L + OFF_KN + s_ * SHM_KN + wid * 1024); if (wid < 4) glds8(Krb + kb_ * LDKR + ROFF(), L + OFF_KR + s_ * SHM_KR + wid * 1024); } while (0)
#define ISSUE_V(t, s) do { const long kb_ = (long)(t) * KVBLK; const int s_ = (s); glds8(Vth + kb_ + VOFF(), L + OFF_V + s_ * SHM_V + wid * 1024); } while (0)
#define ISSUE_NEXT(j) do { if ((j) + 2 < NT) ISSUE_K((j) + 2, sp); if ((j) + 1 < NT) ISSUE_V((j) + 1, sn); } while (0)
#define ROT() do { const int t_ = sc; sc = sn; sn = sp; sp = t_; } while (0)
#define RESC(a) do { if (__any((a) < 1.f)) { if (hi == 0) al_l[r32] = (a); asm volatile("s_waitcnt lgkmcnt(0)" ::: "memory"); \
    _Pragma("unroll") for (int d = 0; d < 4; ++d) _Pragma("unroll") for (int r = 0; r < 16; ++r) o[d][r] *= al_l[crow(r, hi)]; } } while (0)
  f32x16 p0, p1; float mn, al; v8i32_t pa8 = {}; const int NT = (prb & 64) ? 2 : seq / KVBLK;
  int sc = 0, sn = 1, sp = 2;
  ISSUE_K(0, 0); ISSUE_K(1, 1); ISSUE_V(0, 0);
  if (trail) ATT_VM(2); else ATT_VM(3);
  ATT_BAR();
  int jj = 0;
  const auto issue = [&](int step) { if (prb & 8) return;
    const long kb2 = (long)(jj + 2) * KVBLK, kb1 = (long)(jj + 1) * KVBLK;
    if (jj + 2 < NT) { if (step == 0) glds8(Knh + kb2 * LDKV + KOFF(), L + OFF_KN + sp * SHM_KN + wid * 1024); if (step == 1 && wid < 4) glds8(Krb + kb2 * LDKR + ROFF(), L + OFF_KR + sp * SHM_KR + wid * 1024); }
    if (jj + 1 < NT) { if (step == 2) glds8(Vth + kb1 + VOFF(), L + OFF_V + sn * SHM_V + wid * 1024); } };
  const auto noissue = [](int) {};
  mat_segment<true, false>(issue, p0, p1, o, KL, RL, VL, qf, pa8, r32, hi, prb);
  if (trail) { ATT_VM(2); ATT_BAR(); }
  if (!(prb & 16)) { partialSM(p0, p1, m_reg, mn, al, prb); finishSM(p0, p1, al, l_reg, pa8, prb); }
  ROT();
  for (int j = 1; j < NT; ++j) {
    if (!trail) { if (j + 1 < NT) ATT_VM(3); else ATT_VM(0); ATT_BAR(); }
    jj = j;
    mat_segment<true, true>(issue, p0, p1, o, KL + sc * SHM_KN, RL + sc * SHM_KR, VL + sp * SHM_V, qf, pa8, r32, hi, prb);
    if (trail) { if (j + 2 < NT) ATT_VM(2); else ATT_VM(0); ATT_BAR(); }
    if (!(prb & 16)) { partialSM(p0, p1, m_reg, mn, al, prb); RESC(al); finishSM(p0, p1, al, l_reg, pa8, prb); }
    ROT();
  }
  if (!trail) { ATT_VM(0); ATT_BAR(); }
  mat_segment<false, true>(noissue, p0, p1, o, KL, RL, VL + sp * SHM_V, qf, pa8, r32, hi, prb);
  if (hi == 0) li_l[r32] = l_reg; asm volatile("s_waitcnt lgkmcnt(0)" ::: "memory");
  float rli[16];
#pragma unroll
  for (int r = 0; r < 16; ++r) rli[r] = __builtin_amdgcn_rcpf(li_l[crow(r, hi)]);
  int lane_e = lane; asm volatile("" : "+v"(lane_e));
  bf16* Ow = Ob + (long)(wid * QBLK + 4 * (lane_e >> 5)) * LDO + (lane_e & 31);
#pragma unroll
  for (int r = 0; r < 16; ++r) { const int orow = (r & 3) + 8 * (r >> 2);
#pragma unroll
    for (int d0 = 0; d0 < 4; ++d0) { const float val = o[d0][r] * rli[r]; if (!(prb & 32)) Ow[orow * LDO + d0 * 32] = (bf16)(cvtpk(val, val) & 0xffffu); } }
  ATT_VM(0);
  ATT_BAR();
#undef VOFF
#undef KOFF
#undef ROFF
#undef ISSUE_K
#undef ISSUE_V
#undef ISSUE_NEXT
#undef ROT
#undef RESC
}
#undef KSWZ
#undef RSWZ
}

constexpr int DM = 4096, SEQ = 8192, CTXL = 256, MR = SEQ + CTXL;
constexpr int NH = 16, QL = 768, KVL = 512, NIN = 7680, NMODC = 6 * DM;
constexpr int NEXP = 16384;
constexpr float EPS = 1e-6f;
constexpr float C2 = 0.072168783648703220f * 1.4426950408889634f;

#ifndef MK_ONE_LAUNCH
#define MK_ONE_LAUNCH 1
#endif
constexpr int NPHASE = 10;
constexpr int NWAVES = 8, NTHR = NWAVES * 64;

constexpr size_t MiB = 1u << 20;
constexpr size_t a256(size_t x) { return (x + 255) & ~(size_t)255; }
constexpr size_t WS_CTL = 0, CTL_ZERO_BYTES = 1 * MiB;
constexpr int CW_BAR = 4096;
constexpr int CW_END = CW_BAR + 3456;
static_assert((size_t)CW_END * 4 <= CTL_ZERO_BYTES, "CTL words inside the memset region");
constexpr size_t WS_MODF = 1 * MiB;
constexpr size_t WS_ROPE = WS_MODF + a256((size_t)(NMODC + 2 * DM) * 4);
constexpr size_t WS_WIN  = 2 * MiB;
constexpr size_t WS_WUQ  = WS_WIN + (size_t)NIN * DM * 2;
constexpr size_t WS_WUKV = WS_WUQ + (size_t)3072 * 768 * 2;
constexpr size_t WS_WO   = WS_WUKV + (size_t)4096 * 512 * 2;
constexpr size_t WS_WPQ  = WS_WO + (size_t)DM * DM * 2;
constexpr size_t WS_KBD  = WS_WPQ + (size_t)2048 * DM * 2;
constexpr int ROWB = 3072;
constexpr size_t WS_KB2  = WS_KBD + (size_t)2048 * DM * 2;
constexpr size_t WS_UB   = WS_KB2 + (size_t)8 * 256 * 256 * 2;
constexpr size_t WS_VB   = WS_UB + (size_t)NEXP * ROWB;
constexpr size_t WS_SU   = WS_VB + (size_t)NEXP * ROWB;
constexpr size_t WS_HX   = WS_SU + (size_t)2 * NEXP * 4;
constexpr size_t WS_CQ   = WS_HX + (size_t)MR * DM * 2;
constexpr size_t WS_CKV  = WS_CQ + (size_t)SEQ * QL * 2;
constexpr size_t WS_KR   = WS_CKV + (size_t)MR * KVL * 2;
constexpr size_t WS_U    = WS_KR + (size_t)MR * 64 * 2;
constexpr size_t WS_GB   = WS_U + (size_t)SEQ * 2048 * 2;
constexpr size_t WS_Q    = WS_GB + (size_t)SEQ * 2048 * 2;
constexpr size_t WS_KN   = WS_Q + (size_t)SEQ * 3072 * 2;
constexpr size_t WS_V    = WS_KN + (size_t)MR * 2048 * 2;
constexpr size_t WS_ACAT = WS_V + (size_t)MR * 2048 * 2;
constexpr size_t WS_X1   = WS_ACAT + (size_t)SEQ * DM * 2;
constexpr size_t WS_H2   = WS_X1 + (size_t)SEQ * DM * 4;
constexpr size_t WS_QP   = WS_H2 + (size_t)SEQ * DM * 2;
constexpr size_t WS_SC   = WS_QP + (size_t)SEQ * 2048 * 2;
constexpr size_t WS_MODP = WS_SC + (size_t)SEQ * 2048 * 4;
constexpr size_t WS_SQ1  = WS_MODP + (size_t)64 * 32768 * 4;
constexpr size_t WS_SQ2  = WS_SQ1 + (size_t)SEQ * 12 * 4;
constexpr size_t WS_SQ3  = WS_SQ2 + (size_t)MR * 8 * 4;
constexpr size_t WS_END  = WS_SQ3 + (size_t)SEQ * 64 * 4;
static_assert(WS_ROPE + 192 * 32 * 4 <= WS_WIN, "rope table below the weights");

constexpr int RING_BYTES = 158720;
constexpr int MISC_OFF = RING_BYTES + 320;
constexpr int LDS_BYTES = 163840;
static_assert(att::SHM_ATTN <= RING_BYTES && MISC_OFF + 128 <= LDS_BYTES, "LDS map");

#define GAS __attribute__((address_space(1)))
#define LAS __attribute__((address_space(3)))
typedef unsigned short bf16;
typedef unsigned v4u __attribute__((ext_vector_type(4)));
typedef float f32x4 __attribute__((ext_vector_type(4)));
typedef __bf16 bf16x2_t __attribute__((ext_vector_type(2)));
typedef float f32x2 __attribute__((ext_vector_type(2)));
typedef float f32x16v __attribute__((ext_vector_type(16)));
typedef float f32x32v __attribute__((ext_vector_type(32)));
typedef unsigned u32x6v __attribute__((ext_vector_type(6)));
typedef _Float16 h16x2 __attribute__((ext_vector_type(2)));
typedef _Float16 h16x32 __attribute__((ext_vector_type(32)));
#ifndef FP6_INTERLEAVED
#define FP6_INTERLEAVED 1
#endif
#define LDS_WAIT() asm volatile("s_waitcnt lgkmcnt(0)" ::: "memory")
__device__ __forceinline__ unsigned f2bf(float f) { unsigned u = __builtin_bit_cast(unsigned, f); return (u + 0x7fffu + ((u >> 16) & 1u)) >> 16; }
__device__ __forceinline__ unsigned pk2(float lo, float hi) { return f2bf(lo) | (f2bf(hi) << 16); }
__device__ __forceinline__ float bflo(unsigned w) { return __builtin_bit_cast(float, w << 16); }
__device__ __forceinline__ float bfhi(unsigned w) { return __builtin_bit_cast(float, w & 0xffff0000u); }
__device__ __forceinline__ float dot2bf(unsigned a, unsigned b, float c) { return __builtin_amdgcn_fdot2_f32_bf16(__builtin_bit_cast(bf16x2_t, a), __builtin_bit_cast(bf16x2_t, b), c, false); }
#define DPP_F(v, CTRL) __builtin_bit_cast(float, __builtin_amdgcn_update_dpp(0, __builtin_bit_cast(int, (v)), (CTRL), 0xf, 0xf, true))
__device__ __forceinline__ float row16_sum(float v) { v += DPP_F(v, 0xB1); v += DPP_F(v, 0x4E); v += DPP_F(v, 0x141); v += DPP_F(v, 0x140); return v; }
__device__ __forceinline__ float row16_max(float v) { v = fmaxf(v, DPP_F(v, 0xB1)); v = fmaxf(v, DPP_F(v, 0x4E)); v = fmaxf(v, DPP_F(v, 0x141)); v = fmaxf(v, DPP_F(v, 0x140)); return v; }
__device__ __forceinline__ float rl_f(float v, int l) { return __builtin_bit_cast(float, __builtin_amdgcn_readlane(__builtin_bit_cast(int, v), l)); }
__device__ __forceinline__ float wave_sum(float v) { v = row16_sum(v); return (rl_f(v, 0) + rl_f(v, 16)) + (rl_f(v, 32) + rl_f(v, 48)); }
__device__ __forceinline__ float wave_max(float v) { v = row16_max(v); return fmaxf(fmaxf(rl_f(v, 0), rl_f(v, 16)), fmaxf(rl_f(v, 32), rl_f(v, 48))); }

#define XB_TMO      128
#define XB_XCNT(j)  (256  + 64 * (j))
#define XB_XSUB(j)  (1280 + 64 * (j))
#define XB_XGEN(j)  (2304 + 64 * (j))
#define XB_TOP      3328
#define XB_TOPGEN   3392
#define XCD_BAR_WORDS 3456
#define XB_SPIN_CAP (1u << 18)
__device__ __forceinline__ unsigned xb_ld(unsigned* p)              { return __hip_atomic_load(p, __ATOMIC_RELAXED, __HIP_MEMORY_SCOPE_AGENT); }
__device__ __forceinline__ unsigned xb_add(unsigned* p, unsigned v) { return __hip_atomic_fetch_add(p, v, __ATOMIC_RELAXED, __HIP_MEMORY_SCOPE_AGENT); }
__device__ __forceinline__ unsigned xb_xcc_id() { return (unsigned)__builtin_amdgcn_s_getreg((3 << 11) | 20) & 0xFu; }
#define XB_SPIN(cond, bar) do { unsigned _sp = 0; while (cond) { __builtin_amdgcn_s_sleep(1); \
    if ((++_sp & 255u) == 0u) { if (xb_ld(&(bar)[XB_TMO])) break; if (_sp > XB_SPIN_CAP) { atomicAdd(&(bar)[XB_TMO], 1u); break; } } } } while (0)
struct XcdBarrier { unsigned* bar; unsigned x; volatile LAS unsigned* st; };
__device__ __forceinline__ XcdBarrier xcd_barrier_post(unsigned* bar, volatile LAS unsigned* st) {
    XcdBarrier b; b.bar = bar; b.x = xb_xcc_id(); b.st = st;
    if (threadIdx.x == 0) (void)xb_add(&bar[XB_XCNT(b.x)], 1u);
    return b;
}
__device__ __forceinline__ void xcd_barrier_complete(unsigned* bar, unsigned x, unsigned& nloc, unsigned& nx) {
    const unsigned G = gridDim.x * gridDim.y * gridDim.z;
    unsigned sum, cnt, mine, sp = 0u;
    for (;;) {
        sum = 0u; cnt = 0u; mine = 0u;
#pragma unroll
        for (unsigned j = 0; j < 16; ++j) { const unsigned c = xb_ld(&bar[XB_XCNT(j)]); sum += c; cnt += (c > 0u) ? 1u : 0u; mine = (j == x) ? c : mine; }
        if (sum == G) break;
        __builtin_amdgcn_s_sleep(1);
        if ((++sp & 255u) == 0u) { if (xb_ld(&bar[XB_TMO])) break; if (sp > XB_SPIN_CAP) { atomicAdd(&bar[XB_TMO], 1u); break; } }
    }
    nloc = mine > 0u ? mine : 1u; nx = cnt > 0u ? cnt : 1u;
}
__device__ __forceinline__ void xcd_barrier(const XcdBarrier& b) {
    asm volatile("s_waitcnt vmcnt(0)" ::: "memory");
    __syncthreads();
    if (threadIdx.x == 0) {
        unsigned* bar = b.bar;
        __builtin_amdgcn_s_waitcnt(0);
        unsigned nloc = b.st[0], nx = b.st[1];
        if (nloc == 0u) { xcd_barrier_complete(bar, b.x, nloc, nx); b.st[0] = nloc; b.st[1] = nx; }
        const unsigned old = xb_add(&bar[XB_XSUB(b.x)], 1u);
        const unsigned gen = old / nloc;
        if (old + 1u == (gen + 1u) * nloc) {
            __builtin_amdgcn_fence(__ATOMIC_RELEASE, "agent");
            asm volatile("s_waitcnt vmcnt(0)" ::: "memory");
            const unsigned og = xb_add(&bar[XB_TOP], 1u);
            const unsigned tg = og / nx;
            if (og + 1u == (tg + 1u) * nx) xb_add(&bar[XB_TOPGEN], 1u);
            else XB_SPIN(xb_ld(&bar[XB_TOPGEN]) == tg, bar);
            __builtin_amdgcn_fence(__ATOMIC_ACQUIRE, "agent");
            xb_add(&bar[XB_XGEN(b.x)], 1u);
            asm volatile("s_waitcnt vmcnt(0)" ::: "memory");
        } else {
            XB_SPIN(xb_ld(&bar[XB_XGEN(b.x)]) == gen, bar);
            __builtin_amdgcn_fence(__ATOMIC_ACQUIRE, "agent");
            asm volatile("s_waitcnt vmcnt(0)" ::: "memory");
        }
    }
    __syncthreads();
}

__device__ __forceinline__ int pi32(int o) { return 2 * (o & 15) + (o >> 4); }
__device__ __forceinline__ void tr_item(const float* __restrict__ W, int N, int k0, int n0, bf16* __restrict__ WT, int ldk, int drow0, bool perm, const float* __restrict__ gsc, LAS float* scr, int lane) {
    f32x4 w[8]; const int c4 = (lane & 7) * 4, rsub = lane >> 3;
#pragma unroll
    for (int i = 0; i < 8; ++i) w[i] = *(const f32x4*)(W + (size_t)(k0 + 8 * i + rsub) * N + n0 + c4);
#pragma unroll
    for (int i = 0; i < 8; ++i) { const int kk = 8 * i + rsub; const float g = gsc ? gsc[k0 + kk] : 1.f;
        scr[kk * 33 + c4] = w[i][0] * g; scr[kk * 33 + c4 + 1] = w[i][1] * g; scr[kk * 33 + c4 + 2] = w[i][2] * g; scr[kk * 33 + c4 + 3] = w[i][3] * g; }
    LDS_WAIT(); asm volatile("" ::: "memory");
    const int c = lane & 7;
#pragma unroll
    for (int j = 0; j < 4; ++j) { const int n = (lane >> 3) + 8 * j; const LAS float* s = scr + (8 * c) * 33 + n;
        v4u o; o.x = pk2(s[0 * 33], s[1 * 33]); o.y = pk2(s[2 * 33], s[3 * 33]); o.z = pk2(s[4 * 33], s[5 * 33]); o.w = pk2(s[6 * 33], s[7 * 33]);
        const int dn = perm ? pi32(n) : n;
        *(v4u*)(WT + (size_t)(drow0 + dn) * ldk + k0 + 8 * c) = o; }
    LDS_WAIT(); asm volatile("" ::: "memory");
}
__device__ __forceinline__ float silu_f(float v) { return v / (1.f + expf(-v)); }
__device__ __forceinline__ float gelu_erf(float v) { return 0.5f * v * (1.f + erff(v * 0.70710678118654752f)); }
__device__ __forceinline__ unsigned fkey(float f) { const unsigned u = __builtin_bit_cast(unsigned, f); return (u & 0x80000000u) ? ~u : (u | 0x80000000u); }

template <int NV> __device__ __forceinline__ unsigned kth16(const unsigned (&k)[NV]) {
    unsigned T = 0u;
    for (int bit = 31; bit >= 0; --bit) { const unsigned c = T | (1u << bit); int cnt = 0;
#pragma unroll
        for (int v = 0; v < NV; ++v) cnt += __popcll(__ballot(k[v] >= c));
        if (cnt >= 16) T = c; }
    return T;
}
template <int NV> __device__ __forceinline__ void compact16(const unsigned (&k)[NV], const unsigned (&val)[NV], const unsigned (&pay)[NV], unsigned T, LAS unsigned* oval, LAS unsigned* opay, int lane) {
    const unsigned long long lt = (1ull << lane) - 1ull; int pos = 0;
#pragma unroll
    for (int v = 0; v < NV; ++v) { const bool s = k[v] > T; const unsigned long long m = __ballot(s); const int slot = pos + __popcll(m & lt); if (s) { oval[slot] = val[v]; opay[slot] = pay[v]; } pos += __popcll(m); }
#pragma unroll
    for (int v = 0; v < NV; ++v) { const bool s = k[v] == T; const unsigned long long m = __ballot(s); const int slot = pos + __popcll(m & lt); if (s && slot < 16) { oval[slot] = val[v]; opay[slot] = pay[v]; } pos += __popcll(m); }
}

struct Args { const float* in[21]; float* out; unsigned char* ws; int ph_lo, ph_hi, probe, pad; };
static_assert(sizeof(Args) == 23 * 8 + 16, "Args has no padding");

template <int PRB, bool PK> __device__ __forceinline__ void fwd_body(const Args& a) {
    extern __shared__ __attribute__((aligned(16))) unsigned char lds[];
    LAS unsigned char* L = (LAS unsigned char*)lds;
    const int wave = __builtin_amdgcn_readfirstlane((int)threadIdx.x >> 6);
    const int G = gridDim.x, bx = blockIdx.x;
    const int gw = bx * NWAVES + wave, NGW = G * NWAVES;
    const size_t NT = (size_t)G * NTHR;
#define PH_IDS() int tid_ph_ = threadIdx.x; asm volatile("" : "+v"(tid_ph_)); const int tid = tid_ph_, lane = tid & 63; const size_t gt = (size_t)bx * NTHR + tid; (void)lane; (void)gt
    unsigned char* ws = a.ws;
    float* ctlf = (float*)(ws + WS_CTL);
    const float* x = a.in[0]; const float* cvec = a.in[1]; const float* ctx = a.in[2]; const float* cctx = a.in[3]; const float* w_ada = a.in[4]; const float* b_ada = a.in[5];
    const float* norm1_g = a.in[6]; const float* w_in = a.in[7]; const float* q_norm_g = a.in[8]; const float* w_uq = a.in[9]; const float* kv_norm_g = a.in[10]; const float* w_ukv = a.in[11];
    const float* conv_w = a.in[12]; const float* conv_b = a.in[13]; const float* w_o = a.in[14]; const float* norm2_g = a.in[15]; const float* peer_wq = a.in[16]; const float* peer_keys = a.in[17];
    const float* peer_u = a.in[18]; const float* peer_v = a.in[19]; const float* final_g = a.in[20];
    float* modp = (float*)(ws + WS_MODP); float* ssq_cq = (float*)(ws + WS_SQ1); float* ssq_ckv = (float*)(ws + WS_SQ2); float* ssq_x1 = (float*)(ws + WS_SQ3);
    float* modf = (float*)(ws + WS_MODF); float* rope = (float*)(ws + WS_ROPE);
    bf16* WIN = (bf16*)(ws + WS_WIN); bf16* WUQ = (bf16*)(ws + WS_WUQ); bf16* WUKV = (bf16*)(ws + WS_WUKV); bf16* WO = (bf16*)(ws + WS_WO); bf16* WPQ = (bf16*)(ws + WS_WPQ); bf16* KBD = (bf16*)(ws + WS_KBD); bf16* KB2 = (bf16*)(ws + WS_KB2);
    unsigned char* UB = ws + WS_UB; unsigned char* VB = ws + WS_VB; float* SUV = (float*)(ws + WS_SU); bf16* HX = (bf16*)(ws + WS_HX); bf16* CQ = (bf16*)(ws + WS_CQ); bf16* CKV = (bf16*)(ws + WS_CKV); unsigned char* KR = ws + WS_KR;
    bf16* UCV = (bf16*)(ws + WS_U); bf16* GBV = (bf16*)(ws + WS_GB); unsigned char* Q = ws + WS_Q; unsigned char* KN = ws + WS_KN; unsigned char* VT = ws + WS_V; bf16* ACAT = (bf16*)(ws + WS_ACAT);
    bf16* DLT = (bf16*)(ws + WS_X1); bf16* H2 = (bf16*)(ws + WS_H2); float* SC = (float*)(ws + WS_SC);

    for (int u = threadIdx.x; u < (LDS_BYTES - RING_BYTES) / 4; u += NTHR) ((LAS unsigned*)(L + RING_BYTES))[u] = 0u;
    __syncthreads();
    const int lo = a.ph_lo, hi = a.ph_hi;
    XcdBarrier bar; bar.bar = (unsigned*)ctlf + CW_BAR; bar.x = 0; bar.st = (volatile LAS unsigned*)(L + MISC_OFF);
    if (hi - lo > 1) bar = xcd_barrier_post((unsigned*)ctlf + CW_BAR, (volatile LAS unsigned*)(L + MISC_OFF));
#define IN(k) (lo <= (k) && (k) < hi)
#ifndef PHASE_MASK
#define PHASE_MASK 0x3ff
#endif
#ifndef PROBE_PHASES
#define PROBE_PHASES_ 0
#else
#define PROBE_PHASES_ PROBE_PHASES
#endif
#define PH_ON(k) ((((PK) ? (PROBE_PHASES_) : (PHASE_MASK)) >> (k)) & 1)
#ifndef REPEAT_MASK
#define REPEAT_MASK 0
#endif
#define NREP(k) (1 + (((REPEAT_MASK) >> (k)) & 1))
#define GRID_BAR(k) do { if (IN(k) && IN((k) + 1)) xcd_barrier(bar); } while (0)

    if (PH_ON(0) && IN(0)) for (int rep_ = 0; rep_ < NREP(0); ++rep_) {
        PH_IDS();
        const int psel = a.probe ? a.probe : 7;
        if (psel & 1)
        for (int it = gw; it < 64 * 96; it += NGW) {
            const int kb = it / 96, cb = it % 96, col = cb * 256 + lane * 4;
            const float* wp = w_ada + (size_t)(kb * 64) * NMODC + col;
            f32x4 ax = {0.f, 0.f, 0.f, 0.f}, ac = {0.f, 0.f, 0.f, 0.f}; const bool cc = cb < 32;
            const float sxv = silu_f(cvec[kb * 64 + lane]), scv = silu_f(cctx[kb * 64 + lane]);
#pragma unroll 16
            for (int i = 0; i < 64; ++i) { const f32x4 w = __builtin_nontemporal_load((const f32x4*)(wp + (size_t)i * NMODC));
                ax += w * rl_f(sxv, i); ac += w * (cc ? rl_f(scv, i) : 0.f); }
            *(f32x4*)(modp + (size_t)kb * 32768 + col) = ax; if (cc) *(f32x4*)(modp + (size_t)kb * 32768 + NMODC + col) = ac;
        }
        if (psel & 2) {
            LAS float* scr = (LAS float*)(L + wave * 8448);
            constexpr int I_IN = 64 * 234, I_UQ = 12 * 96, I_UKV = 8 * 128, I_O = 64 * 128, NIT = I_IN + I_UQ + I_UKV + I_O;
            for (int it = gw; it < NIT; it += NGW) { int r = it;
                if (r < I_IN) { const int kb = r / 234, n0 = (r % 234) * 32; int drow0; bool perm = false;
                    if (n0 < 1280) drow0 = n0; else if (n0 < 1344) { drow0 = n0; perm = true; }
                    else { const int c0 = n0 - 1344; if (c0 < 2048) drow0 = 1536 + (c0 >> 7) * 256 + (c0 & 127); else if (c0 < 4096) drow0 = 5632 + (c0 - 2048); else { const int c1 = c0 - 4096; drow0 = 1536 + (c1 >> 7) * 256 + 128 + (c1 & 127); } }
                    tr_item(w_in, 7488, kb * 64, n0, WIN, 4096, drow0, perm, nullptr, scr, lane); continue; } r -= I_IN;
                if (r < I_UQ) { const int kb = r / 96, n0 = (r % 96) * 32; tr_item(w_uq, 3072, kb * 64, n0, WUQ, 768, n0, (n0 % 192) >= 128, q_norm_g, scr, lane); continue; } r -= I_UQ;
                if (r < I_UKV) { const int kb = r / 128, n0 = (r % 128) * 32; tr_item(w_ukv, 4096, kb * 64, n0, WUKV, 512, ((n0 & 255) < 128 ? 0 : 2048) + (n0 >> 8) * 128 + (n0 & 127), false, kv_norm_g, scr, lane); continue; } r -= I_UKV;
                { const int kb = r / 128, n0 = (r % 128) * 32; tr_item(w_o, 4096, kb * 64, n0, WO, 4096, n0, false, nullptr, scr, lane); }
            }
        }
        for (size_t i = gt; i < (size_t)192 * 512; i += NT) { const v4u z = {0u, 0u, 0u, 0u}; *(v4u*)(WIN + (size_t)1344 * 4096 + i * 8) = z; }
        for (size_t i = gt; i < (size_t)DM * 2048 / 8; i += NT) {
            const int d = (int)(i >> 8), c8 = (int)(i & 255) * 8, h = c8 >> 8, j = c8 & 255; const float* sp_ = peer_wq + (size_t)d * 2048 + c8; const f32x4 a0 = *(const f32x4*)sp_, a1 = *(const f32x4*)(sp_ + 4);
            v4u o; o.x = pk2(a0[0], a0[1]); o.y = pk2(a0[2], a0[3]); o.z = pk2(a1[0], a1[1]); o.w = pk2(a1[2], a1[3]); *(v4u*)(WPQ + ((size_t)h * DM + d) * 256 + j) = o; }
        for (size_t i = gt; i < (size_t)8 * 256 * 32; i += NT) {
            const int d8 = (int)(i & 31) * 8, rr = (int)(i >> 5) & 255, h = (int)(i >> 13), p = rr >> 7, k = rr & 127; v4u o = {0u, 0u, 0u, 0u};
            if ((d8 >> 7) == p) { const float* s_ = peer_keys + ((size_t)((h * 2 + p) * 128 + k)) * 128 + (d8 & 127); const f32x4 a0 = *(const f32x4*)s_, a1 = *(const f32x4*)(s_ + 4);
                o.x = pk2(a0[0], a0[1]); o.y = pk2(a0[2], a0[3]); o.z = pk2(a1[0], a1[1]); o.w = pk2(a1[2], a1[3]); }
            *(v4u*)(KB2 + i * 8) = o; }
        for (size_t i = gt; i < (size_t)192 * 16; i += NT) {
            const int pi = (int)(i >> 4), fi = (int)(i & 15); const int pos = pi < 128 ? pi : pi - 128;
            const float fr = __builtin_amdgcn_exp2f(-(float)fi * 0.83048202372184059f);
            const float turns = (float)pos * fr * 0.15915494309189535f, fx = turns - floorf(turns);
            rope[pi * 32 + 2 * fi] = __builtin_amdgcn_cosf(fx); rope[pi * 32 + 2 * fi + 1] = __builtin_amdgcn_sinf(fx); }
        if (psel & 4)
        for (int r = gw; r < 2 * NEXP; r += NGW) { const bool isv = r >= NEXP; const int e = isv ? r - NEXP : r; const float* src = (isv ? peer_v : peer_u) + (size_t)e * DM + lane * 4;
            f32x4 v[2][8]; float am = 0.f;
#pragma unroll
            for (int b = 0; b < 2; ++b)
#pragma unroll
                for (int q = 0; q < 8; ++q) { v[b][q] = __builtin_nontemporal_load((const f32x4*)(src + b * 2048 + q * 256)); am = fmaxf(am, fmaxf(fmaxf(fabsf(v[b][q][0]), fabsf(v[b][q][1])), fmaxf(fabsf(v[b][q][2]), fabsf(v[b][q][3])))); }
            am = wave_max(am);
            const float sc = am > 0.f ? exp2f(floorf(log2f(7.5f / am))) : 1.f;
            unsigned d[12];
#pragma unroll
            for (int b = 0; b < 2; ++b) { f32x16v s0, s1;
#pragma unroll
                for (int i = 0; i < 16; ++i) { const int i0 = FP6_INTERLEAVED ? 2 * i : i, i1 = FP6_INTERLEAVED ? 2 * i + 1 : 16 + i; s0[i] = v[b][i0 >> 2][i0 & 3] * sc; s1[i] = v[b][i1 >> 2][i1 & 3] * sc; }
                const u32x6v w = __builtin_amdgcn_cvt_scalef32_2xpk16_fp6_f32(s0, s1, 1.0f);
#pragma unroll
                for (int i = 0; i < 6; ++i) d[6 * b + i] = w[i]; }
            unsigned char* dst = (isv ? VB : UB) + (size_t)e * ROWB + lane * 16;
#pragma unroll
            for (int p = 0; p < 3; ++p) { const v4u o = {d[4 * p], d[4 * p + 1], d[4 * p + 2], d[4 * p + 3]}; *(v4u*)(dst + p * 1024) = o; }
            if (lane == 0) SUV[r] = 1.f / sc;
        }
    }
    GRID_BAR(0);

    if (PH_ON(1) && IN(1)) for (int rep_ = 0; rep_ < NREP(1); ++rep_) {
        PH_IDS();
        for (size_t j = gt; j < (size_t)(NMODC + 2 * DM); j += NT) { float sacc = 0.f;
#pragma unroll 8
            for (int kb = 0; kb < 64; ++kb) sacc += modp[(size_t)kb * 32768 + j];
            modf[j] = sacc + b_ada[j < (size_t)NMODC ? j : j - NMODC]; }
        { pg8::Gemm g{KB2, WPQ, 2048, DM, 256, 0, (size_t)DM * 256 * 2}; pg8::StaticOrder S; S.init(2048, DM, G, bx); pg8::EpiB16 E{KBD, DM};
          pg8::gemm_phase<pg8::EpiB16, pg8::StaticOrder, true, true>(L, g, S, E); }
    }
    GRID_BAR(1);

    if (PH_ON(2) && IN(2)) for (int rep_ = 0; rep_ < NREP(2); ++rep_) {
        PH_IDS();
        for (int row = gw; row < MR; row += NGW) {
            const bool lat = row < SEQ; const float* xr = lat ? x + (size_t)row * DM : ctx + (size_t)(row - SEQ) * DM; const float* md = lat ? modf : modf + NMODC;
            f32x4 v[16]; float ss = 0.f;
#pragma unroll
            for (int j = 0; j < 16; ++j) { v[j] = *(const f32x4*)(xr + 4 * (lane + 64 * j)); ss += (v[j][0] * v[j][0] + v[j][1] * v[j][1]) + (v[j][2] * v[j][2] + v[j][3] * v[j][3]); }
            ss = wave_sum(ss); const float rstd = 1.f / sqrtf(ss * (1.f / DM) + EPS);
#pragma unroll
            for (int j = 0; j < 16; ++j) { const int idx = 4 * (lane + 64 * j);
                const f32x4 g = *(const f32x4*)(norm1_g + idx), sh = *(const f32x4*)(md + idx), sc = *(const f32x4*)(md + DM + idx);
                const f32x4 hh = (v[j] * rstd * g) * (sc + 1.f) + sh;
                *(unsigned long long*)(HX + (size_t)row * DM + idx) = (unsigned long long)pk2(hh[0], hh[1]) | ((unsigned long long)pk2(hh[2], hh[3]) << 32); }
        }
    }
    GRID_BAR(2);

    if (PH_ON(3) && IN(3)) for (int rep_ = 0; rep_ < NREP(3); ++rep_) {
        pg8::Gemm g{HX, WIN, MR, NIN, DM, 0, 0}; pg8::OrderIn S; S.init(SEQ, NIN, G, bx);
        pg8::EpiIn E{CQ, CKV, KR, UCV, GBV, ssq_cq, ssq_ckv, rope};
        pg8::gemm_phase<pg8::EpiIn, pg8::OrderIn, true, true>(L, g, S, E);
    }
    GRID_BAR(3);

    if (PH_ON(4) && IN(4)) for (int rep_ = 0; rep_ < NREP(4); ++rep_) {
        PH_IDS();
        {
            int nq, qb0, nkv, kb0;
            if (G == 256) { nq = bx < 144 ? 1 : bx < 240 ? 2 : 3; qb0 = bx < 144 ? bx : bx < 240 ? 144 + 2 * (bx - 144) : 336 + 3 * (bx - 240); nkv = bx < 144 ? 3 : bx < 240 ? 1 : 0; kb0 = bx < 144 ? 3 * bx : 432 + (bx - 144); }
            else { qb0 = (int)(((long)384 * bx) / G); nq = (int)(((long)384 * (bx + 1)) / G) - qb0; kb0 = (int)(((long)528 * bx) / G); nkv = (int)(((long)528 * (bx + 1)) / G) - kb0; }
            const int k0 = kb0 < 264 ? kb0 : 264, k1 = kb0 + nkv < 264 ? kb0 + nkv : 264;
            const int v0 = (kb0 > 264 ? kb0 : 264) - 264, v1 = (kb0 + nkv > 264 ? kb0 + nkv : 264) - 264;
            { pg8::Gemm g{CQ, WUQ, SEQ, 3072, QL, 0, 0}; pg8::RunOrder S{qb0, nq, 12}; pg8::EpiQ E{Q, ssq_cq, rope, C2 * att::QSC};
              pg8::gemm_phase<pg8::EpiQ, pg8::RunOrder, true, true>(L, g, S, E); }
            { pg8::Gemm g{CKV, WUKV, MR, 2048, KVL, 0, 0}; pg8::RunOrder S{k0, k1 - k0, 8}; pg8::EpiK E{KN, ssq_ckv};
              pg8::gemm_phase<pg8::EpiK, pg8::RunOrder, true, true>(L, g, S, E); }
            { pg8::Gemm g{WUKV + (size_t)2048 * KVL, CKV, 2048, MR, KVL, 0, 0}; pg8::RunOrder S{v0, v1 - v0, 33}; pg8::EpiVT E{VT, ssq_ckv};
              pg8::gemm_phase<pg8::EpiVT, pg8::RunOrder, true, true>(L, g, S, E); }
        }
        for (size_t it = gt; it < (size_t)SEQ * 256; it += NT) {
            const int t = (int)(it >> 8), c8 = (int)(it & 255) * 8; const v4u z = {0u, 0u, 0u, 0u};
            const v4u um = t > 0 ? *(const v4u*)(UCV + (size_t)(t - 1) * 2048 + c8) : z, u0 = *(const v4u*)(UCV + (size_t)t * 2048 + c8), up = t < SEQ - 1 ? *(const v4u*)(UCV + (size_t)(t + 1) * 2048 + c8) : z;
            const v4u gv = *(const v4u*)(GBV + (size_t)t * 2048 + c8); v4u o;
            float w0[8], w1[8], w2[8], wb[8];
#pragma unroll
            for (int q = 0; q < 2; ++q) { const f32x4 a0 = *(const f32x4*)(conv_w + c8 + 4 * q), a1 = *(const f32x4*)(conv_w + 2048 + c8 + 4 * q), a2 = *(const f32x4*)(conv_w + 4096 + c8 + 4 * q), a3 = *(const f32x4*)(conv_b + c8 + 4 * q);
#pragma unroll
                for (int j = 0; j < 4; ++j) { w0[4 * q + j] = a0[j]; w1[4 * q + j] = a1[j]; w2[4 * q + j] = a2[j]; wb[4 * q + j] = a3[j]; } }
#pragma unroll
            for (int j = 0; j < 4; ++j) {
                const float y0 = w0[2 * j] * bflo(um[j]) + w1[2 * j] * bflo(u0[j]) + w2[2 * j] * bflo(up[j]) + wb[2 * j];
                const float y1 = w0[2 * j + 1] * bfhi(um[j]) + w1[2 * j + 1] * bfhi(u0[j]) + w2[2 * j + 1] * bfhi(up[j]) + wb[2 * j + 1];
                o[j] = pk2(bflo(gv[j]) * y0, bfhi(gv[j]) * y1); }
            *(v4u*)(ACAT + (size_t)t * DM + 2048 + c8) = o; }
    }
    GRID_BAR(4);
#ifdef PROBE_CLK
    if (bx == 0 && threadIdx.x == 0) { unsigned long long* ck = (unsigned long long*)(ws + WS_CTL + 524288); ck[0] = __builtin_readcyclecounter(); ck[2] = __builtin_amdgcn_s_memrealtime(); }
#endif

    if (PH_ON(5) && IN(5)) for (int rep_ = 0; rep_ < NREP(5); ++rep_) {
        for (int i = 0;; ++i) { int h, qb;
            if (G == 256) { if (i >= 2) break; h = 2 * (bx & 7) + i; qb = bx >> 3; } else { const int Lu = i * G + bx; if (Lu >= 512) break; h = Lu >> 5; qb = Lu & 31; }
            att::attn_unit<PRB>(Q + (size_t)(qb * 256) * 3072 + h * 192, KN + h * 128, VT + (size_t)(h * 128) * 8448, KR, ACAT + (size_t)(qb * 256) * DM + h * 128, MR, (char*)lds, L, a.probe); }
    }
#ifdef PROBE_CLK
    if (bx == 0 && threadIdx.x == 0) { unsigned long long* ck = (unsigned long long*)(ws + WS_CTL + 524288); ck[1] = __builtin_readcyclecounter(); ck[3] = __builtin_amdgcn_s_memrealtime(); }
#endif
    GRID_BAR(5);

    if (PH_ON(6) && IN(6)) for (int rep_ = 0; rep_ < NREP(6); ++rep_) {
        pg8::Gemm g{ACAT, WO, SEQ, DM, DM, 0, 0}; pg8::StaticOrder S; S.init(SEQ, DM, G, bx); pg8::EpiO E{modf + 2 * DM, DLT};
        pg8::gemm_phase<pg8::EpiO, pg8::StaticOrder, true, true>(L, g, S, E);
    }
    GRID_BAR(6);

    if (PH_ON(7) && IN(7)) for (int rep_ = 0; rep_ < NREP(7); ++rep_) {
        PH_IDS();
        for (int row = gw; row < SEQ; row += NGW) {
            f32x4 v[16]; float ssq[4] = {0.f, 0.f, 0.f, 0.f};
#pragma unroll
            for (int j = 0; j < 16; ++j) { const int idx = 4 * (lane + 64 * j); const unsigned long long d8 = *(const unsigned long long*)(DLT + (size_t)row * DM + idx); const f32x4 xv = *(const f32x4*)(x + (size_t)row * DM + idx);
                v[j][0] = xv[0] + bflo((unsigned)d8); v[j][1] = xv[1] + bfhi((unsigned)d8); v[j][2] = xv[2] + bflo((unsigned)(d8 >> 32)); v[j][3] = xv[3] + bfhi((unsigned)(d8 >> 32));
#pragma unroll
                for (int c = 0; c < 4; ++c) ssq[c] = fmaf(v[j][c], v[j][c], ssq[c]); }
            const float rstd = 1.f / sqrtf(wave_sum((ssq[0] + ssq[1]) + (ssq[2] + ssq[3])) * (1.f / DM) + EPS);
#pragma unroll
            for (int j = 0; j < 16; ++j) { const int idx = 4 * (lane + 64 * j);
                const f32x4 g = *(const f32x4*)(norm2_g + idx), sh = *(const f32x4*)(modf + 3 * DM + idx), sc = *(const f32x4*)(modf + 4 * DM + idx);
                const f32x4 hh = (v[j] * rstd * g) * (sc + 1.f) + sh;
                *(unsigned long long*)(H2 + (size_t)row * DM + idx) = (unsigned long long)pk2(hh[0], hh[1]) | ((unsigned long long)pk2(hh[2], hh[3]) << 32); }
        }
    }
    GRID_BAR(7);

    if (PH_ON(8) && IN(8)) for (int rep_ = 0; rep_ < NREP(8); ++rep_) {
        pg8::Gemm g{H2, KBD, SEQ, 2048, DM, 0, 0}; pg8::StaticOrder S; S.init(SEQ, 2048, G, bx); pg8::EpiF32 E{SC, 2048};
        pg8::gemm_phase<pg8::EpiF32, pg8::StaticOrder, true, true>(L, g, S, E);
    }
    GRID_BAR(8);

    if (PH_ON(9) && IN(9)) for (int rep_ = 0; rep_ < NREP(9); ++rep_) {
        int lane0_ = threadIdx.x; asm volatile("" : "+v"(lane0_)); lane0_ &= 63;
        LAS unsigned* wl = (LAS unsigned*)(L + wave * 8192);
        LAS unsigned* sV1 = wl, *sI1 = wl + 16, *sV2 = wl + 32, *sI2 = wl + 48, *sVc = wl + 64, *sEc = wl + 80;
        LAS unsigned* eL = wl + 128; LAS float* gL = (LAS float*)(wl + 128 + 512);
        const float* gate2 = modf + 5 * DM; const int emask_ = a.probe ? 63 : 0xffff; float* outp_ = a.probe ? (float*)(ws + WS_HX) : a.out;
        for (int tb = gw * 4; tb < SEQ; tb += NGW * 4) {
            for (int ti = 0; ti < 4; ++ti) { const int t = tb + ti; int lane = lane0_; asm volatile("" : "+v"(lane));
                for (int h = 0; h < 8; ++h) { const float* sp = SC + (size_t)t * 2048 + h * 256;
                    { const float s0 = sp[lane], s1 = sp[64 + lane]; const unsigned k[2] = {fkey(s0), fkey(s1)}, vb[2] = {__builtin_bit_cast(unsigned, s0), __builtin_bit_cast(unsigned, s1)}, pl[2] = {(unsigned)lane, (unsigned)(64 + lane)};
                      const unsigned T = kth16<2>(k); compact16<2>(k, vb, pl, T, sV1, sI1, lane); }
                    { const float s0 = sp[128 + lane], s1 = sp[192 + lane]; const unsigned k[2] = {fkey(s0), fkey(s1)}, vb[2] = {__builtin_bit_cast(unsigned, s0), __builtin_bit_cast(unsigned, s1)}, pl[2] = {(unsigned)lane, (unsigned)(64 + lane)};
                      const unsigned T = kth16<2>(k); compact16<2>(k, vb, pl, T, sV2, sI2, lane); }
                    LDS_WAIT();
                    { const float s2b = __builtin_bit_cast(float, sV2[lane & 15]); const unsigned i2b = sI2[lane & 15]; unsigned k[4], vb[4], pl[4];
#pragma unroll
                      for (int r = 0; r < 4; ++r) { const int aa = (lane >> 4) + 4 * r; const float cv = __builtin_bit_cast(float, sV1[aa]) + s2b; k[r] = fkey(cv); vb[r] = __builtin_bit_cast(unsigned, cv); pl[r] = sI1[aa] * 128u + i2b; }
                      const unsigned T = kth16<4>(k); compact16<4>(k, vb, pl, T, sVc, sEc, lane); }
                    LDS_WAIT();
                    { const float tv = __builtin_bit_cast(float, sVc[lane & 15]); const float mx = row16_max(tv);
                      const float ex = expf(tv - mx); const float sm = row16_sum(ex);
                      if (lane < 16) { eL[ti * 128 + h * 16 + lane] = sEc[lane]; gL[ti * 128 + h * 16 + lane] = ex / sm; } }
                    LDS_WAIT();
                }
                { const unsigned e0 = eL[ti * 128 + lane], e1 = eL[ti * 128 + 64 + lane]; const float g0 = gL[ti * 128 + lane], g1 = gL[ti * 128 + 64 + lane];
                  const unsigned k0 = (e0 << 7) | (unsigned)lane, k1 = (e1 << 7) | (unsigned)(64 + lane); int r0 = 0, r1 = 0;
#pragma unroll 8
                  for (int m = 0; m < 128; ++m) { const unsigned km = (eL[ti * 128 + m] << 7) | (unsigned)m; r0 += km < k0 ? 1 : 0; r1 += km < k1 ? 1 : 0; }
                  LDS_WAIT();
                  eL[ti * 128 + r0] = e0; gL[ti * 128 + r0] = g0; eL[ti * 128 + r1] = e1; gL[ti * 128 + r1] = g1;
                  LDS_WAIT(); }
                h16x2 hh[2][16];
#pragma unroll
                for (int b = 0; b < 2; ++b)
#pragma unroll
                    for (int q = 0; q < 8; ++q) { const unsigned long long a0 = *(const unsigned long long*)(H2 + (size_t)t * DM + b * 2048 + q * 256 + lane * 4);
                        hh[b][2 * q] = (h16x2){(_Float16)bflo((unsigned)a0), (_Float16)bfhi((unsigned)a0)}; hh[b][2 * q + 1] = (h16x2){(_Float16)bflo((unsigned)(a0 >> 32)), (_Float16)bfhi((unsigned)(a0 >> 32))}; }
                v4u rr[6][3]; float rs[6];
#define LDROW(j, TAB, e, SOFF) do { const unsigned char* rp_ = (TAB) + (size_t)(e) * ROWB + lane * 16; _Pragma("unroll") for (int p = 0; p < 3; ++p) rr[j][p] = *(const v4u*)(rp_ + p * 1024); rs[j] = SUV[(SOFF) + (e)]; } while (0)
#define EIDX(k) (__builtin_amdgcn_readfirstlane((int)eL[ti * 128 + (k)]) & emask_)
#define UNPKH(j, b) __builtin_amdgcn_cvt_scalef32_pk32_f16_fp6((b) == 0 ? (u32x6v){rr[j][0][0], rr[j][0][1], rr[j][0][2], rr[j][0][3], rr[j][1][0], rr[j][1][1]} : (u32x6v){rr[j][1][2], rr[j][1][3], rr[j][2][0], rr[j][2][1], rr[j][2][2], rr[j][2][3]}, 1.0f)
#define DOTROW(out, j) do { float a0 = 0.f, a1 = 0.f, a2 = 0.f, a3 = 0.f; _Pragma("unroll") for (int b = 0; b < 2; ++b) { const h16x32 x_ = UNPKH(j, b); \
                    _Pragma("unroll") for (int i = 0; i < 16; i += 4) { a0 = __builtin_amdgcn_fdot2((h16x2){x_[2 * i], x_[2 * i + 1]}, hh[b][i], a0, false); a1 = __builtin_amdgcn_fdot2((h16x2){x_[2 * i + 2], x_[2 * i + 3]}, hh[b][i + 1], a1, false); \
                        a2 = __builtin_amdgcn_fdot2((h16x2){x_[2 * i + 4], x_[2 * i + 5]}, hh[b][i + 2], a2, false); a3 = __builtin_amdgcn_fdot2((h16x2){x_[2 * i + 6], x_[2 * i + 7]}, hh[b][i + 3], a3, false); } } \
                    out = (a0 + a1) + (a2 + a3); } while (0)
                int ei[6];
#pragma unroll
                for (int j = 0; j < 6; ++j) { ei[j] = EIDX(j); LDROW(j, UB, ei[j], 0); }
                for (int k0 = 0; k0 < 126; k0 += 6) {
                    float dsum[6];
#pragma unroll
                    for (int j = 0; j < 6; ++j) { float part; DOTROW(part, j); const float sc_ = rs[j];
                        if (k0 + 6 + j < 128) { ei[j] = EIDX(k0 + 6 + j); LDROW(j, UB, ei[j], 0); }
                        dsum[j] = wave_sum(part) * sc_; }
                    if (lane < 6) { float d = dsum[0];
#pragma unroll
                        for (int j = 1; j < 6; ++j) d = lane == j ? dsum[j] : d;
                        gL[ti * 128 + k0 + lane] = gL[ti * 128 + k0 + lane] * gelu_erf(d); }
                }
                { float dsum[2];
#pragma unroll
                  for (int j = 0; j < 2; ++j) { float part; DOTROW(part, j); dsum[j] = wave_sum(part) * rs[j]; }
                  if (lane < 2) { const float d = lane == 0 ? dsum[0] : dsum[1]; gL[ti * 128 + 126 + lane] = gL[ti * 128 + 126 + lane] * gelu_erf(d); } }
                LDS_WAIT();
            }
            for (int ti = 0; ti < 4; ++ti) { const int t = tb + ti; int lane = lane0_; asm volatile("" : "+v"(lane));
                h16x2 ah[2][16];
#pragma unroll
                for (int b = 0; b < 2; ++b)
#pragma unroll
                    for (int i = 0; i < 16; ++i) ah[b][i] = (h16x2){(_Float16)0.f, (_Float16)0.f};
                v4u rr[6][3]; float rs[6];
#define FMAROW(j, WW) do { const _Float16 wh_ = (_Float16)(WW); const h16x2 w2_ = {wh_, wh_}; _Pragma("unroll") for (int b = 0; b < 2; ++b) { const h16x32 x_ = UNPKH(j, b); \
                    _Pragma("unroll") for (int i = 0; i < 16; ++i) ah[b][i] = __builtin_elementwise_fma(w2_, (h16x2){x_[2 * i], x_[2 * i + 1]}, ah[b][i]); } } while (0)
                int ei[6];
#pragma unroll
                for (int j = 0; j < 6; ++j) { ei[j] = EIDX(j); LDROW(j, VB, ei[j], NEXP); }
                for (int k0 = 0; k0 < 126; k0 += 6) {
#pragma unroll
                    for (int j = 0; j < 6; ++j) { FMAROW(j, gL[ti * 128 + k0 + j] * rs[j]);
                        if (k0 + 6 + j < 128) { ei[j] = EIDX(k0 + 6 + j); LDROW(j, VB, ei[j], NEXP); } }
                }
#pragma unroll
                for (int j = 0; j < 2; ++j) FMAROW(j, gL[ti * 128 + 126 + j] * rs[j]);
                float acc[2][32];
#pragma unroll
                for (int b = 0; b < 2; ++b)
#pragma unroll
                    for (int i = 0; i < 16; ++i) { acc[b][2 * i] = (float)ah[b][i][0]; acc[b][2 * i + 1] = (float)ah[b][i][1]; }
                float ssp[4] = {0.f, 0.f, 0.f, 0.f}; int lane_f = lane; asm volatile("" : "+v"(lane_f));
#pragma unroll
                for (int b = 0; b < 2; ++b)
#pragma unroll
                    for (int q = 0; q < 8; ++q) { unsigned o = (unsigned)(b * 2048 + q * 256 + lane_f * 4); asm volatile("" : "+v"(o)); const unsigned long long d8 = *(const unsigned long long*)(DLT + (size_t)t * DM + o); f32x4 xa = *(const f32x4*)(x + (size_t)t * DM + o); const f32x4 ga = *(const f32x4*)(gate2 + o);
                        xa[0] += bflo((unsigned)d8); xa[1] += bfhi((unsigned)d8); xa[2] += bflo((unsigned)(d8 >> 32)); xa[3] += bfhi((unsigned)(d8 >> 32));
#pragma unroll
                        for (int j = 0; j < 4; ++j) { acc[b][4 * q + j] = fmaf(ga[j], acc[b][4 * q + j], xa[j]); ssp[j] = fmaf(acc[b][4 * q + j], acc[b][4 * q + j], ssp[j]); }
                        if ((q & 1) == 1) asm volatile("" ::: "memory"); }
                const float ss = wave_sum((ssp[0] + ssp[1]) + (ssp[2] + ssp[3])); const float rstd = 1.f / sqrtf(ss * (1.f / DM) + EPS);
#pragma unroll
                for (int b = 0; b < 2; ++b)
#pragma unroll
                    for (int q = 0; q < 8; ++q) { unsigned o = (unsigned)(b * 2048 + q * 256 + lane_f * 4); asm volatile("" : "+v"(o)); const f32x4 fa = *(const f32x4*)(final_g + o); f32x4 oa;
#pragma unroll
                        for (int j = 0; j < 4; ++j) oa[j] = acc[b][4 * q + j] * rstd * fa[j];
                        *(f32x4*)(outp_ + (size_t)t * DM + o) = oa; if ((q & 1) == 1) asm volatile("" ::: "memory"); }
            }
            LDS_WAIT();
#undef LDROW
#undef EIDX
#undef DOTROW
#undef FMAROW
#undef UNPKH
        }
    }
#undef IN
#undef GRID_BAR
}

__global__ void __launch_bounds__(NTHR, 2) fwd(Args a) { fwd_body<0, false>(a); }
#ifdef PROBE_PHASES
#ifndef PROBE_MODE
#define PROBE_MODE 0
#endif
__global__ void __launch_bounds__(NTHR, 2) fwd_p(Args a) { fwd_body<PROBE_MODE, true>(a); }
#endif

#ifdef PROBE_MX
typedef int v8i_t __attribute__((ext_vector_type(8)));
typedef float v16f_t __attribute__((ext_vector_type(16)));
__device__ __forceinline__ unsigned char f8enc(int v) {
    if (v == 0) return 0; int e = 0; int m = v; while (m >= 2) { m >>= 1; ++e; } const int frac = (v << 3 >> e) & 7; return (unsigned char)(((e + 7) << 3) | frac); }
__global__ void probe_mx(float* out) {
    const int l = threadIdx.x, r = l & 31, h = l >> 5;
    float code = 0.f;
    for (int hyp = 0; hyp < 2; ++hyp) {
        unsigned char ab[32], bb[32];
        for (int j = 0; j < 32; ++j) { const int k = hyp == 0 ? 32 * h + j : (j < 16 ? 16 * h + j : 32 + 16 * h + (j - 16));
            ab[j] = f8enc(k == (7 * r + 3) % 64 ? 1 : 0); bb[j] = f8enc(1 + ((k + 3 * r) % 13)); }
        v8i_t A, B;
        for (int d = 0; d < 8; ++d) { A[d] = ab[4 * d] | (ab[4 * d + 1] << 8) | (ab[4 * d + 2] << 16) | (ab[4 * d + 3] << 24); B[d] = bb[4 * d] | (bb[4 * d + 1] << 8) | (bb[4 * d + 2] << 16) | (bb[4 * d + 3] << 24); }
        v16f_t c = {};
        c = __builtin_amdgcn_mfma_scale_f32_32x32x64_f8f6f4(A, B, c, 0, 0, 0, 0x7F7F7F7F, 0, 0x7F7F7F7F);
        bool ok = true;
        for (int g = 0; g < 16; ++g) { const int row = (g & 3) + 8 * (g >> 2) + 4 * h, col = r; const int kk = (7 * row + 3) % 64; const float expect = (float)(1 + ((kk + 3 * col) % 13)); ok = ok && (c[g] == expect); }
        const bool all_ok = __all(ok);
        if (all_ok) code += (hyp == 0 ? 1.f : 2.f);
    }
    if (l == 0) out[0] = 1000.f * (1.f + code);
}
#endif

#ifdef PROBE_CLK
__global__ void probe_clk_k(const unsigned long long* c, float* out) { if (threadIdx.x == 0) { const double cyc = (double)(c[1] - c[0]), tk = (double)(c[3] - c[2]); out[0] = PROBE_CLK == 1 ? 300.f * (float)(int)(cyc / 264.0 / 300.0 + 0.5) : 1000.f * (float)(int)(cyc / tk + 0.5); } }
#endif
extern "C" void kernel_launch(void* const* d_in, const int* in_sizes, int n_in, void* d_out, int out_size, void* d_ws, size_t ws_size, hipStream_t stream) {
    static int grid = 0;
    if (grid == 0) {
        if (n_in != 21 || in_sizes[0] != SEQ * DM || out_size != SEQ * DM || ws_size < WS_END) {
            fprintf(stderr, "kernel_launch: built for 21 inputs, x/out of %d floats, >= %zu bytes of workspace; got n_in %d, in0 %d, out %d, ws %zu; nothing launched\n", SEQ * DM, (size_t)WS_END, n_in, n_in > 0 ? in_sizes[0] : -1, out_size, ws_size); grid = -1; return; }
        int dev = 0, cus = 0, per_cu = 0;
        if (hipGetDevice(&dev) != hipSuccess || hipDeviceGetAttribute(&cus, hipDeviceAttributeMultiprocessorCount, dev) != hipSuccess) { fprintf(stderr, "kernel_launch: device query failed\n"); grid = -1; return; }
        if (hipFuncSetAttribute((const void*)fwd, hipFuncAttributeMaxDynamicSharedMemorySize, LDS_BYTES) != hipSuccess) { fprintf(stderr, "kernel_launch: hipFuncSetAttribute failed\n"); grid = -1; return; }
        if (hipOccupancyMaxActiveBlocksPerMultiprocessor(&per_cu, (const void*)fwd, NTHR, LDS_BYTES) != hipSuccess || per_cu < 1) fprintf(stderr, "kernel_launch: note: occupancy query reports %d workgroups per CU\n", per_cu);
        (void)hipGetLastError();
        grid = cus;
    }
    if (grid < 0) return;
    if (hipMemsetAsync((char*)d_ws + WS_CTL, 0, CTL_ZERO_BYTES, stream) != hipSuccess) { fprintf(stderr, "kernel_launch: memset failed\n"); return; }
    Args a{};
    for (int i = 0; i < 21; ++i) a.in[i] = (const float*)d_in[i];
    a.out = (float*)d_out; a.ws = (unsigned char*)d_ws;
#if MK_ONE_LAUNCH
    a.ph_lo = 0; a.ph_hi = NPHASE;
    hipLaunchKernelGGL(fwd, dim3(grid), dim3(NTHR), LDS_BYTES, stream, a);
#ifndef PROBE_MODE
#define PROBE_MODE 0
#endif
#ifdef PROBE_PHASES
    for (int p = 0; p < NPHASE; ++p) if ((PROBE_PHASES >> p) & 1) { a.ph_lo = p; a.ph_hi = p + 1; a.probe = PROBE_MODE; hipFuncSetAttribute((const void*)fwd_p, hipFuncAttributeMaxDynamicSharedMemorySize, LDS_BYTES); hipLaunchKernelGGL(fwd_p, dim3(grid), dim3(NTHR), LDS_BYTES, stream, a); }
#endif
#else
    for (int p = 0; p < NPHASE; ++p) { a.ph_lo = p; a.ph_hi = p + 1; hipLaunchKernelGGL(fwd, dim3(grid), dim3(NTHR), LDS_BYTES, stream, a); }
#endif
#ifdef PROBE_UB
    hipFuncSetAttribute((const void*)probe_ub, hipFuncAttributeMaxDynamicSharedMemorySize, LDS_BYTES);
    hipLaunchKernelGGL(probe_ub, dim3(256), dim3(512), LDS_BYTES, stream, (float*)((char*)d_ws + WS_CTL + 600000), 400);
#endif
#ifdef PROBE_CLK
    hipLaunchKernelGGL(probe_clk_k, dim3(1), dim3(64), 0, stream, (const unsigned long long*)((char*)d_ws + WS_CTL + 524288), (float*)d_out);
#endif
#ifdef PROBE_MX
    hipLaunchKernelGGL(probe_mx, dim3(1), dim3(64), 0, stream, (float*)d_out);
#endif
    const hipError_t le = hipPeekAtLastError();
    if (le != hipSuccess) fprintf(stderr, "kernel_launch: launch failed: %s\n", hipGetErrorName(le));
}
```

```cpp
#include <hip/hip_runtime.h>
#include <cstdio>
#include <cstdint>
#include <cmath>
namespace pg8 {
#define PG8_LAS __attribute__((address_space(3)))
typedef unsigned short bf16_t;
typedef short bf16x8 __attribute__((ext_vector_type(8)));
typedef float f32x4 __attribute__((ext_vector_type(4)));
typedef unsigned u32x4 __attribute__((ext_vector_type(4)));
constexpr int BM = 256, BK = 64, HALF = 128, HTB = HALF * BK * 2  , STAGE_BYTES = 8 * HTB, NXCD = 8, WGM = 8;

__host__ __device__ __forceinline__ int lds_byte(int r, int c) { const int st = (r >> 4) * 2 + (c >> 5), rr = r & 15, cc = c & 31, ob = rr * 64 + cc * 2; return st * 1024 + (ob ^ (((ob >> 9) & 1) << 5)); }
__host__ __device__ __forceinline__ void stage_rc(int b, int& R, int& C) { const int st = b / 1024, sb = b % 1024, swz = sb ^ (((sb >> 9) & 1) << 5); R = (st >> 1) * 16 + swz / 64; C = (st & 1) * 32 + (swz % 64) / 2; }
__host__ __device__ __forceinline__ int perm32(int rho) { const int n = rho >> 4, i = rho & 15; return 8 * (i >> 2) + 4 * n + (i & 3); }

struct Unit { int pm, pn; };
struct Gemm { const bf16_t* A; const bf16_t* Bt; int M, N, K; size_t a_pn; size_t b_pm; };

struct StaticOrder {
    int nM, nN, nwg, G, c;
    __host__ __device__ void init(int M, int N, int G_, int c_) { nM = M / BM; nN = N / BM; nwg = nM * nN; G = G_; c = c_; }
    __host__ __device__ bool next(int i, Unit& u) const {
        const long L = (long)i * G + c; if (L >= nwg) return false;
        int wgid = (int)L; { const int q = nwg / NXCD, r = nwg % NXCD, xcd = wgid % NXCD, off = wgid / NXCD; wgid = (xcd < r ? xcd * (q + 1) : r * (q + 1) + (xcd - r) * q) + off; }
        const int nig = WGM * nN, gid = wgid / nig, fm = gid * WGM, gsz = (nM - fm) < WGM ? (nM - fm) : WGM;
        u.pm = fm + ((wgid % nig) % gsz); u.pn = (wgid % nig) / gsz; return true;
    }
    __device__ __forceinline__ void a_ready(const Unit&) const {}
    __device__ __forceinline__ void done(const Unit&) const {}
};

__device__ __forceinline__ unsigned cvt_pk_bf16(float lo, float hi) { unsigned r; asm volatile("v_cvt_pk_bf16_f32 %0, %1, %2" : "=v"(r) : "v"(lo), "v"(hi)); return r; }
typedef float f32x2 __attribute__((ext_vector_type(2)));
__device__ __forceinline__ f32x2 gelu_pk(f32x2 v) {
    const f32x2 av = __builtin_elementwise_abs(v), d = av * 0.2316418882f + 1.0f;
    f32x2 t; t.x = __builtin_amdgcn_rcpf(d.x); t.y = __builtin_amdgcn_rcpf(d.y);
    f32x2 q = t * 0.5307027145f + (-0.7265760135f); q = q * t + 0.7107068705f; q = q * t + (-0.142248368f); q = q * t + 0.127414796f; q = q * t;
    const f32x2 s = (v * v) * (-0.72134752044f);
    f32x2 e; e.x = __builtin_amdgcn_exp2f(s.x); e.y = __builtin_amdgcn_exp2f(s.y);
    const f32x2 m = v * (q * e), r = v - m;
    f32x2 o; o.x = v.x < 0.f ? m.x : r.x; o.y = v.y < 0.f ? m.y : r.y; return o;
}


__device__ __forceinline__ u32x4 pack8(f32x4 v0, f32x4 v1) { u32x4 w; w.x = cvt_pk_bf16(v0[0], v0[1]); w.y = cvt_pk_bf16(v0[2], v0[3]); w.z = cvt_pk_bf16(v1[0], v1[1]); w.w = cvt_pk_bf16(v1[2], v1[3]); return w; }
__device__ __forceinline__ unsigned long long pack8_fp8(f32x4 v0, f32x4 v1) { int lo = __builtin_amdgcn_cvt_pk_fp8_f32(v0[0], v0[1], 0, false); lo = __builtin_amdgcn_cvt_pk_fp8_f32(v0[2], v0[3], lo, true);
    int hi = __builtin_amdgcn_cvt_pk_fp8_f32(v1[0], v1[1], 0, false); hi = __builtin_amdgcn_cvt_pk_fp8_f32(v1[2], v1[3], hi, true); return (unsigned long long)(unsigned)lo | ((unsigned long long)(unsigned)hi << 32); }
__device__ __forceinline__ float quad_row_sum(float s) { s += __shfl_xor(s, 16); s += __shfl_xor(s, 32); return s; }

__device__ __forceinline__ f32x4 rope4(f32x4 v, const float* tab, int i) {
    const f32x4 cs = *(const f32x4*)(tab + 2 * i);
    f32x4 o; o[0] = v[0] * cs[0] - v[1] * cs[1]; o[1] = v[1] * cs[0] + v[0] * cs[1]; o[2] = v[2] * cs[2] - v[3] * cs[3]; o[3] = v[3] * cs[2] + v[2] * cs[3]; return o;
}

struct EpiIn {
    static constexpr bool PERM = true, AFTER_DRAIN = false;
    bf16_t* cq; bf16_t* ckv; unsigned char* kr; bf16_t* ub; bf16_t* gb; float* ssq_cq; float* ssq_ckv; const float* rope;
    __device__ __forceinline__ void operator()(const f32x4 (&acc)[2][2][4][2], const Unit& u, int wr, int wc, int fr, int fq) const {
        const int pn = u.pn, row0 = u.pm * BM + wr * 64 + fr, cw = wc * 32 + 8 * fq;
        if (pn < 5) {
            bf16_t* dst = pn < 3 ? cq : ckv; const int ld = pn < 3 ? 768 : 512, pl = pn < 3 ? pn : pn - 3, coff = pl * 256 + cw, nsl = pn < 3 ? 12 : 8; float* ssq = pn < 3 ? ssq_cq : ssq_ckv;
#pragma unroll
            for (int ai = 0; ai < 2; ++ai)
#pragma unroll
                for (int m = 0; m < 4; ++m) { const int row = row0 + ai * HALF + m * 16; float s = 0.f;
#pragma unroll
                    for (int bj = 0; bj < 2; ++bj) { const f32x4 v0 = acc[ai][bj][m][0], v1 = acc[ai][bj][m][1];
                        s += (v0[0] * v0[0] + v0[1] * v0[1]) + (v0[2] * v0[2] + v0[3] * v0[3]) + (v1[0] * v1[0] + v1[1] * v1[1]) + (v1[2] * v1[2] + v1[3] * v1[3]);
                        *(u32x4*)(dst + (size_t)row * ld + coff + bj * HALF) = pack8(v0, v1); }
                    s = quad_row_sum(s); if (fq == 0) ssq[(size_t)row * nsl + pl * 4 + wc] = s; }
        } else if (pn == 5) {
            if (wc < 2) {
#pragma unroll
                for (int ai = 0; ai < 2; ++ai)
#pragma unroll
                    for (int m = 0; m < 4; ++m) { const int row = row0 + ai * HALF + m * 16; f32x4 v0 = acc[ai][0][m][0], v1 = acc[ai][0][m][1];
                        if (row < 8192) { const int pos = wc == 0 ? (row >> 6) : 128 + (row & 63); const float* tab = rope + pos * 32; v0 = rope4(v0, tab, 4 * fq); v1 = rope4(v1, tab, 4 * fq + 2); }
                        *(unsigned long long*)(kr + (size_t)row * 64 + cw) = pack8_fp8(v0, v1); }
            }
        } else if (pn < 22) {
            const int j = pn - 6;
#pragma unroll
            for (int ai = 0; ai < 2; ++ai)
#pragma unroll
                for (int m = 0; m < 4; ++m) { const int row = row0 + ai * HALF + m * 16;
                    *(u32x4*)(ub + (size_t)row * 2048 + j * 128 + cw) = pack8(acc[ai][0][m][0] * acc[ai][1][m][0], acc[ai][0][m][1] * acc[ai][1][m][1]); }
        } else {
            const int j = pn - 22;
#pragma unroll
            for (int ai = 0; ai < 2; ++ai)
#pragma unroll
                for (int m = 0; m < 4; ++m) { const int row = row0 + ai * HALF + m * 16;
#pragma unroll
                    for (int bj = 0; bj < 2; ++bj) *(u32x4*)(gb + (size_t)row * 2048 + j * 256 + bj * HALF + cw) = pack8(acc[ai][bj][m][0], acc[ai][bj][m][1]); }
        }
    }
};

struct EpiQ {
    static constexpr bool PERM = true, AFTER_DRAIN = false;
    unsigned char* q; const float* ssq_cq; const float* rope; float c2;
    __device__ __forceinline__ void operator()(const f32x4 (&acc)[2][2][4][2], const Unit& u, int wr, int wc, int fr, int fq) const {
        const int row0 = u.pm * BM + wr * 64 + fr, cw = wc * 32 + 8 * fq;
#pragma unroll
        for (int ai = 0; ai < 2; ++ai)
#pragma unroll
            for (int m = 0; m < 4; ++m) { const int row = row0 + ai * HALF + m * 16; const f32x4 q0 = *(const f32x4*)(ssq_cq + (size_t)row * 12), q1 = *(const f32x4*)(ssq_cq + (size_t)row * 12 + 4), q2 = *(const f32x4*)(ssq_cq + (size_t)row * 12 + 8);
                const float ssum = (((q0[0] + q0[1]) + (q0[2] + q0[3])) + ((q1[0] + q1[1]) + (q1[2] + q1[3]))) + ((q2[0] + q2[1]) + (q2[2] + q2[3])); const float sc = c2 / sqrtf(ssum * (1.f / 768.f) + 1e-6f);
#pragma unroll
                for (int bj = 0; bj < 2; ++bj) { const int col = u.pn * BM + bj * HALF + cw, d = col % 192; f32x4 v0 = acc[ai][bj][m][0] * sc, v1 = acc[ai][bj][m][1] * sc;
                    if (d >= 128) { const int p = d - 128, ax = p >> 5, i = (p & 31) >> 1; const int pos = ax == 0 ? (row >> 6) : 128 + (row & 63); const float* tab = rope + pos * 32;
                        v0 = rope4(v0, tab, i); v1 = rope4(v1, tab, i + 2); }
                    *(unsigned long long*)(q + (size_t)row * 3072 + col) = pack8_fp8(v0, v1); } }
    }
};

struct EpiK {
    static constexpr bool PERM = true, AFTER_DRAIN = false;
    unsigned char* kn; const float* ssq_ckv;
    __device__ __forceinline__ void operator()(const f32x4 (&acc)[2][2][4][2], const Unit& u, int wr, int wc, int fr, int fq) const {
        const int row0 = u.pm * BM + wr * 64 + fr, cw = u.pn * BM + wc * 32 + 8 * fq;
#pragma unroll
        for (int ai = 0; ai < 2; ++ai)
#pragma unroll
            for (int m = 0; m < 4; ++m) { const int row = row0 + ai * HALF + m * 16; const f32x4 q0 = *(const f32x4*)(ssq_ckv + (size_t)row * 8), q1 = *(const f32x4*)(ssq_ckv + (size_t)row * 8 + 4);
                const float ssum = ((q0[0] + q0[1]) + (q0[2] + q0[3])) + ((q1[0] + q1[1]) + (q1[2] + q1[3])); const float sc = 1.f / sqrtf(ssum * (1.f / 512.f) + 1e-6f);
#pragma unroll
                for (int bj = 0; bj < 2; ++bj) *(unsigned long long*)(kn + (size_t)row * 2048 + cw + bj * HALF) = pack8_fp8(acc[ai][bj][m][0] * sc, acc[ai][bj][m][1] * sc); }
    }
};

struct EpiVT {
    static constexpr bool PERM = true, AFTER_DRAIN = false;
    unsigned char* vt; const float* ssq_ckv;
    __device__ __forceinline__ void operator()(const f32x4 (&acc)[2][2][4][2], const Unit& u, int wr, int wc, int fr, int fq) const {
        const int row0 = u.pm * BM + wr * 64 + fr, key0 = u.pn * BM + wc * 32 + 8 * fq;
        f32x4 rs[2][2];
#pragma unroll
        for (int bj = 0; bj < 2; ++bj)
#pragma unroll
            for (int n = 0; n < 2; ++n)
#pragma unroll
                for (int j = 0; j < 4; ++j) { const int key = key0 + bj * HALF + 4 * n + j; const f32x4 q0 = *(const f32x4*)(ssq_ckv + (size_t)key * 8), q1 = *(const f32x4*)(ssq_ckv + (size_t)key * 8 + 4);
                    const float ssum = ((q0[0] + q0[1]) + (q0[2] + q0[3])) + ((q1[0] + q1[1]) + (q1[2] + q1[3])); rs[bj][n][j] = 1.f / sqrtf(ssum * (1.f / 512.f) + 1e-6f); }
#pragma unroll
        for (int ai = 0; ai < 2; ++ai)
#pragma unroll
            for (int m = 0; m < 4; ++m) { const int row = row0 + ai * HALF + m * 16;
#pragma unroll
                for (int bj = 0; bj < 2; ++bj) { const int key8 = key0 + bj * HALF, g = (key8 & 63) >> 3; unsigned char* dst = vt + (size_t)row * 8448 + (key8 & ~63) + 16 * (g >> 2) + 4 * (g & 3);
                    const f32x4 v0 = acc[ai][bj][m][0] * rs[bj][0], v1 = acc[ai][bj][m][1] * rs[bj][1];
                    int w0 = __builtin_amdgcn_cvt_pk_fp8_f32(v0[0], v0[1], 0, false); w0 = __builtin_amdgcn_cvt_pk_fp8_f32(v0[2], v0[3], w0, true);
                    int w1 = __builtin_amdgcn_cvt_pk_fp8_f32(v1[0], v1[1], 0, false); w1 = __builtin_amdgcn_cvt_pk_fp8_f32(v1[2], v1[3], w1, true);
                    *(int*)dst = w0; *(int*)(dst + 32) = w1; } }
    }
};

struct EpiO {
    static constexpr bool PERM = true, AFTER_DRAIN = false;
    const float* gate; bf16_t* dlt;
    __device__ __forceinline__ void operator()(const f32x4 (&acc)[2][2][4][2], const Unit& u, int wr, int wc, int fr, int fq) const {
        const int row0 = u.pm * BM + wr * 64 + fr, c0 = u.pn * BM + wc * 32 + 8 * fq;
        f32x4 g[2][2];
#pragma unroll
        for (int bj = 0; bj < 2; ++bj)
#pragma unroll
            for (int n = 0; n < 2; ++n) g[bj][n] = *(const f32x4*)(gate + c0 + bj * HALF + 4 * n);
#pragma unroll
        for (int ai = 0; ai < 2; ++ai)
#pragma unroll
            for (int m = 0; m < 4; ++m) { const int row = row0 + ai * HALF + m * 16;
#pragma unroll
                for (int bj = 0; bj < 2; ++bj) *(u32x4*)(dlt + (size_t)row * 4096 + c0 + bj * HALF) = pack8(g[bj][0] * acc[ai][bj][m][0], g[bj][1] * acc[ai][bj][m][1]); }
    }
};

struct EpiPQ {
    static constexpr bool PERM = true, AFTER_DRAIN = false;
    bf16_t* qp;
    __device__ __forceinline__ void operator()(const f32x4 (&acc)[2][2][4][2], const Unit& u, int wr, int wc, int fr, int fq) const {
        const int row0 = u.pm * BM + wr * 64 + fr, cw = wc * 32 + 8 * fq; bf16_t* base = qp + (size_t)u.pn * 8192 * 256;
#pragma unroll
        for (int ai = 0; ai < 2; ++ai)
#pragma unroll
            for (int m = 0; m < 4; ++m) { const int row = row0 + ai * HALF + m * 16;
#pragma unroll
                for (int bj = 0; bj < 2; ++bj) *(u32x4*)(base + (size_t)row * 256 + bj * HALF + cw) = pack8(acc[ai][bj][m][0], acc[ai][bj][m][1]); }
    }
};

struct EpiB16 {
    static constexpr bool PERM = true, AFTER_DRAIN = false;
    bf16_t* o; int ldc;
    __device__ __forceinline__ void operator()(const f32x4 (&acc)[2][2][4][2], const Unit& u, int wr, int wc, int fr, int fq) const {
        const int row0 = u.pm * BM + wr * 64 + fr, c0 = u.pn * BM + wc * 32 + 8 * fq;
#pragma unroll
        for (int ai = 0; ai < 2; ++ai)
#pragma unroll
            for (int m = 0; m < 4; ++m) { const int row = row0 + ai * HALF + m * 16;
#pragma unroll
                for (int bj = 0; bj < 2; ++bj) *(u32x4*)(o + (size_t)row * ldc + c0 + bj * HALF) = pack8(acc[ai][bj][m][0], acc[ai][bj][m][1]); }
    }
};

struct EpiF32 {
    static constexpr bool PERM = true, AFTER_DRAIN = false;
    float* o; int ldc;
    __device__ __forceinline__ void operator()(const f32x4 (&acc)[2][2][4][2], const Unit& u, int wr, int wc, int fr, int fq) const {
        const int row0 = u.pm * BM + wr * 64 + fr, c0 = u.pn * BM + wc * 32 + 8 * fq;
#pragma unroll
        for (int ai = 0; ai < 2; ++ai)
#pragma unroll
            for (int m = 0; m < 4; ++m) { const int row = row0 + ai * HALF + m * 16;
#pragma unroll
                for (int bj = 0; bj < 2; ++bj)
#pragma unroll
                    for (int n = 0; n < 2; ++n) *(f32x4*)(o + (size_t)row * ldc + c0 + bj * HALF + 4 * n) = acc[ai][bj][m][n]; }
    }
};

struct OrderIn : StaticOrder {
    __device__ bool next(int i, Unit& u) const {
        const long L = (long)i * G + c;
        if (L < nwg) return StaticOrder::next(i, u);
        if (L < nwg + 3) { u.pm = 32; u.pn = 3 + (int)(L - nwg); return true; }
        return false;
    }
};

struct RunOrder {
    int base, cnt, nN;
    __device__ bool next(int i, Unit& u) const { if (i >= cnt) return false; const int idx = base + i; u.pm = idx / nN; u.pn = idx % nN; return true; }
    __device__ __forceinline__ void a_ready(const Unit&) const {}
    __device__ __forceinline__ void done(const Unit&) const {}
};
template <class Epi, class Sched, bool ALIGN_EPI = false, bool SP2 = false>
__device__ __forceinline__ void gemm_phase(PG8_LAS unsigned char* lds, const Gemm g, const Sched& S, const Epi& E) {
    int tid_o_ = threadIdx.x; asm volatile("" : "+v"(tid_o_));
    const int tid = tid_o_, wid = __builtin_amdgcn_readfirstlane(tid >> 6), lane = tid & 63, wr = wid >> 2, wc = wid & 3, fr = lane & 15, fq = lane >> 4;
    const int K = g.K, nt = K / BK;
    unsigned voffA[2], voffB[2];
#pragma unroll
    for (int i = 0; i < 2; ++i) { int R, C; stage_rc(tid * 16 + i * 8192, R, C); const int Rb = Epi::PERM ? ((R & ~31) + perm32(R & 31)) : R;
        voffA[i] = (unsigned)(R * K + C) * 2u; voffB[i] = (unsigned)(Rb * K + C) * 2u; }
    const size_t kstep = (size_t)(BK * 2);
    const size_t hstep = (size_t)HALF * K * 2;
    const size_t tstep = 2 * hstep;
    const unsigned ldsw = (unsigned)wid * 1024u;
    const int aoff = lds_byte(wr * 64 + fr, fq * 8), boff = lds_byte(wc * 32 + fr, fq * 8);
#define PG8_SA(b, h) (((b) * 2 + (h)) * HTB)
#define PG8_SB(b, h) ((4 + (b) * 2 + (h)) * HTB)
#define PG8_STAGE(bufoff, gbase, voff) do { _Pragma("unroll") for (int _i = 0; _i < 2; ++_i) \
        __builtin_amdgcn_global_load_lds((const unsigned*)((const char*)(gbase) + (voff)[_i]), (PG8_LAS unsigned*)(lds + (bufoff) + ldsw + _i * 8192), 16, 0, 0); } while (0)
#define PG8_LDA(dst, b, h) do { _Pragma("unroll") for (int m = 0; m < 4; ++m) _Pragma("unroll") for (int k = 0; k < 2; ++k) dst[m][k] = *(const PG8_LAS bf16x8*)(lds + PG8_SA(b, h) + aoff + m * 2048 + k * 1024); } while (0)
#define PG8_LDB(dst, b, h) do { _Pragma("unroll") for (int n = 0; n < 2; ++n) _Pragma("unroll") for (int k = 0; k < 2; ++k) dst[n][k] = *(const PG8_LAS bf16x8*)(lds + PG8_SB(b, h) + boff + n * 2048 + k * 1024); } while (0)
#define PG8_MMA(ai, bj, At, Bt) do { __builtin_amdgcn_s_setprio(1); _Pragma("unroll") for (int m = 0; m < 4; ++m) _Pragma("unroll") for (int n = 0; n < 2; ++n) _Pragma("unroll") for (int k = 0; k < 2; ++k) \
        acc[ai][bj][m][n] = __builtin_amdgcn_mfma_f32_16x16x32_bf16(Bt[n][k], At[m][k], acc[ai][bj][m][n], 0, 0, 0); __builtin_amdgcn_s_setprio(0); } while (0)
#define PG8_WAIT_V(n) asm volatile("s_waitcnt vmcnt(" #n ")" ::: "memory")
#define PG8_WAIT_L(n) asm volatile("s_waitcnt lgkmcnt(" #n ")" ::: "memory")
#define PG8_BAR __builtin_amdgcn_s_barrier()
#define PG8_SCHED __builtin_amdgcn_sched_barrier(0)
    Unit cur, nxt; int ui = 0;
    if (!S.next(0, cur)) return;
    f32x4 acc[2][2][4][2];
#pragma unroll
    for (int a = 0; a < 2; ++a)
#pragma unroll
        for (int b = 0; b < 2; ++b)
#pragma unroll
            for (int m = 0; m < 4; ++m)
#pragma unroll
                for (int n = 0; n < 2; ++n) acc[a][b][m][n] = (f32x4){0.f, 0.f, 0.f, 0.f};
    bf16x8 At[4][2], B0[2][2], B1[2][2];
    const char* cA = (const char*)g.A + (size_t)cur.pm * tstep + (size_t)cur.pn * g.a_pn; const char* cB = (const char*)g.Bt + (size_t)cur.pn * tstep + (size_t)cur.pm * g.b_pm;
    S.a_ready(cur);
    if constexpr (SP2) {
        PG8_STAGE(PG8_SB(0, 0), cB, voffB); PG8_STAGE(PG8_SB(0, 1), cB + hstep, voffB); PG8_STAGE(PG8_SA(0, 0), cA, voffA); PG8_STAGE(PG8_SA(0, 1), cA + hstep, voffA);
        if (wr == 1) PG8_BAR;
        PG8_WAIT_V(2); PG8_BAR;
        PG8_STAGE(PG8_SB(1, 0), cB + kstep, voffB); PG8_STAGE(PG8_SA(1, 0), cA + kstep, voffA); PG8_STAGE(PG8_SB(1, 1), cB + hstep + kstep, voffB);
        PG8_WAIT_V(6); PG8_BAR;
    } else {
        PG8_STAGE(PG8_SB(0, 0), cB, voffB); PG8_STAGE(PG8_SA(0, 0), cA, voffA); PG8_STAGE(PG8_SB(0, 1), cB + hstep, voffB); PG8_STAGE(PG8_SA(0, 1), cA + hstep, voffA);
        if (wr == 1) PG8_BAR;
        PG8_WAIT_V(4); PG8_BAR;
        PG8_STAGE(PG8_SB(1, 0), cB + kstep, voffB); PG8_STAGE(PG8_SA(1, 0), cA + kstep, voffA); PG8_STAGE(PG8_SB(1, 1), cB + hstep + kstep, voffB);
        PG8_WAIT_V(6); PG8_BAR;
    }
    for (;;) {
        const bool has_next = S.next(ui + 1, nxt);
        const char* nA = has_next ? (const char*)g.A + (size_t)nxt.pm * tstep + (size_t)nxt.pn * g.a_pn : cA; const char* nB = has_next ? (const char*)g.Bt + (size_t)nxt.pn * tstep + (size_t)nxt.pm * g.b_pm : cB;
        for (int t = 0; t < nt; t += 2) {
            const bool last = (t == nt - 2);
            const char* a1 = cA + (size_t)(t + 1) * kstep;
            const char* a2 = last ? nA : cA + (size_t)(t + 2) * kstep; const char* b2 = last ? nB : cB + (size_t)(t + 2) * kstep;
            const char* a3 = a2 + kstep; const char* b3 = b2 + kstep;
            if (last && has_next) S.a_ready(nxt);
            if constexpr (SP2) {
            PG8_LDB(B0, 0, 0); PG8_LDB(B1, 0, 1); PG8_SCHED; PG8_LDA(At, 0, 0); PG8_STAGE(PG8_SA(1, 1), a1 + hstep, voffA);
            PG8_WAIT_V(8); PG8_WAIT_L(0); PG8_BAR; PG8_MMA(0, 0, At, B0); PG8_MMA(0, 1, At, B1); PG8_BAR; PG8_SCHED;
            PG8_LDA(At, 0, 1); PG8_STAGE(PG8_SB(0, 0), b2, voffB); PG8_STAGE(PG8_SB(0, 1), b2 + hstep, voffB); PG8_STAGE(PG8_SA(0, 0), a2, voffA);
            PG8_WAIT_V(8); PG8_WAIT_L(0); PG8_BAR; PG8_MMA(1, 0, At, B0); PG8_MMA(1, 1, At, B1); PG8_BAR; PG8_SCHED;
            PG8_LDB(B0, 1, 0); PG8_LDB(B1, 1, 1); PG8_SCHED; PG8_LDA(At, 1, 0); PG8_STAGE(PG8_SA(0, 1), a2 + hstep, voffA);
            PG8_WAIT_V(8); PG8_WAIT_L(0); PG8_BAR; PG8_MMA(0, 0, At, B0); PG8_MMA(0, 1, At, B1); PG8_BAR; PG8_SCHED;
            PG8_LDA(At, 1, 1); PG8_STAGE(PG8_SB(1, 0), b3, voffB); PG8_STAGE(PG8_SB(1, 1), b3 + hstep, voffB); PG8_STAGE(PG8_SA(1, 0), a3, voffA);
            PG8_WAIT_V(8); PG8_WAIT_L(0); PG8_BAR; PG8_MMA(1, 0, At, B0); PG8_MMA(1, 1, At, B1); PG8_BAR; PG8_SCHED;
            } else {
            PG8_LDB(B0, 0, 0); PG8_SCHED; PG8_LDA(At, 0, 0); PG8_STAGE(PG8_SA(1, 1), a1 + hstep, voffA);
            PG8_WAIT_L(8); PG8_BAR; PG8_WAIT_L(0); PG8_MMA(0, 0, At, B0); PG8_BAR; PG8_SCHED;
            PG8_LDB(B1, 0, 1); PG8_STAGE(PG8_SB(0, 0), b2, voffB);
            PG8_BAR; PG8_WAIT_L(0); PG8_MMA(0, 1, At, B1); PG8_BAR;
            PG8_LDA(At, 0, 1); PG8_STAGE(PG8_SA(0, 0), a2, voffA);
            PG8_BAR; PG8_WAIT_L(0); PG8_MMA(1, 0, At, B0); PG8_BAR; PG8_SCHED;
            PG8_STAGE(PG8_SB(0, 1), b2 + hstep, voffB);
            PG8_WAIT_V(6); PG8_BAR; PG8_MMA(1, 1, At, B1); PG8_BAR;
            PG8_LDB(B0, 1, 0); PG8_SCHED; PG8_LDA(At, 1, 0); PG8_STAGE(PG8_SA(0, 1), a2 + hstep, voffA);
            PG8_WAIT_L(8); PG8_BAR; PG8_WAIT_L(0); PG8_MMA(0, 0, At, B0); PG8_BAR; PG8_SCHED;
            PG8_LDB(B1, 1, 1); PG8_STAGE(PG8_SB(1, 0), b3, voffB);
            PG8_BAR; PG8_WAIT_L(0); PG8_MMA(0, 1, At, B1); PG8_BAR;
            PG8_LDA(At, 1, 1); PG8_STAGE(PG8_SA(1, 0), a3, voffA);
            PG8_BAR; PG8_WAIT_L(0); PG8_MMA(1, 0, At, B0); PG8_BAR; PG8_SCHED;
            PG8_STAGE(PG8_SB(1, 1), b3 + hstep, voffB);
            PG8_WAIT_V(6); PG8_BAR; PG8_MMA(1, 1, At, B1); PG8_BAR;
            }
        }
        if constexpr (ALIGN_EPI) { if (wr == 0) PG8_BAR; }
        if constexpr (!Epi::AFTER_DRAIN) { E(acc, cur, wr, wc, fr, fq); S.done(cur); }
        if (!has_next) break;
#pragma unroll
        for (int a = 0; a < 2; ++a)
#pragma unroll
            for (int b = 0; b < 2; ++b)
#pragma unroll
                for (int m = 0; m < 4; ++m)
#pragma unroll
                    for (int n = 0; n < 2; ++n) acc[a][b][m][n] = (f32x4){0.f, 0.f, 0.f, 0.f};
        cur = nxt; cA = nA; cB = nB; ++ui;
        if constexpr (ALIGN_EPI) { if (wr == 1) PG8_BAR; }
    }
    PG8_WAIT_V(0);
    if constexpr (!ALIGN_EPI) { if (wr == 0) PG8_BAR; }
    PG8_BAR;
    if constexpr (Epi::AFTER_DRAIN) { E.fused(acc, cur, wr, wc, fr, fq, lds, wid, lane); S.done(cur); }
#undef PG8_SA
#undef PG8_SB
#undef PG8_STAGE
#undef PG8_LDA
#undef PG8_LDB
#undef PG8_MMA
#undef PG8_WAIT_V
#undef PG8_WAIT_L
#undef PG8_BAR
#undef PG8_SCHED
}
}

namespace att {
using bf16x8 = __attribute__((ext_vector_type(8))) short;
using s16x4  = __attribute__((ext_vector_type(4))) short;
using f32x16 = __attribute__((ext_vector_type(16))) float;
using u32x4  = __attribute__((ext_vector_type(4))) unsigned;
typedef unsigned short bf16;
constexpr int NW = 8, QBLK = 32, KVBLK = 64;
#ifndef ATT_SDEPTH
#define ATT_SDEPTH 1
#endif
constexpr int SDEPTH = ATT_SDEPTH;
#ifndef QKT_GRP
#define QKT_GRP 4
#endif
constexpr int LDQ = 3072, LDKV = 2048, LDKR = 64, LDO = 4096, LDVT = 8448;
constexpr int SHM_V = 8192, SHM_KN = 8192, SHM_KR = 4096;
constexpr float QSC = 64.f, QSI = 1.f / 64.f;
constexpr int NSLOT = 3, OFF_V = 0, OFF_KN = NSLOT * SHM_V, OFF_KR = OFF_KN + NSLOT * SHM_KN, OFF_WS = OFF_KR + NSLOT * SHM_KR, SHM_ATTN = OFF_WS + NW * 64 * 4;
#define ALDS __attribute__((address_space(3)))
constexpr float THRL = 2.5f * 1.4426950408889634f * 64.f;
constexpr float PSH = 5.f;
#define KSWZ(row, colB) ((row) * 256 + ((colB) ^ (((row) & 15) << 4)))
#define RSWZ(row, colB) ((row) * 128 + ((colB) ^ ((((row) >> 1) & 7) << 4)))
#define SBAR() __builtin_amdgcn_sched_barrier(0)
__device__ __forceinline__ int crow(int r, int hi) { return (r & 3) + 8 * (r >> 2) + 4 * hi; }
__device__ __forceinline__ unsigned cvtpk(float lo, float hi) { unsigned r; asm volatile("v_cvt_pk_bf16_f32 %0, %1, %2" : "=v"(r) : "v"(lo), "v"(hi)); return r; }

typedef int v8i32_t __attribute__((ext_vector_type(8)));
__device__ __forceinline__ void partialSM(f32x16& p0, f32x16& p1, float& m_reg, float& mn, float& alpha, const int prb) {
  float pmax = p0[0];
#pragma unroll
  for (int r = 1; r < 16; ++r) pmax = fmaxf(pmax, p0[r]);
#pragma unroll
  for (int r = 0; r < 16; ++r) pmax = fmaxf(pmax, p1[r]);
  { auto rr = __builtin_amdgcn_permlane32_swap(__float_as_uint(pmax), __float_as_uint(pmax), false, false);
    pmax = fmaxf(__uint_as_float(rr[0]), __uint_as_float(rr[1])); }
  if (__builtin_expect(__all(pmax - m_reg <= THRL), 1)) { mn = m_reg; alpha = 1.f; }
  else { mn = fmaxf(m_reg, pmax); alpha = __builtin_amdgcn_exp2f((m_reg - mn) * QSI); m_reg = mn; }
  const float mnq = fmaf(-mn, QSI, PSH);
#pragma unroll
  for (int r = 0; r < 16; ++r) p0[r] = fmaf(p0[r], QSI, mnq);
#pragma unroll
  for (int r = 0; r < 16; ++r) p1[r] = fmaf(p1[r], QSI, mnq);
  if (!(prb & 1)) {
#pragma unroll
  for (int r = 0; r < 16; ++r) p0[r] = __builtin_amdgcn_exp2f(p0[r]); }
}
__device__ __forceinline__ void finishSM(f32x16& p0, f32x16& p1, float alpha, float& l_reg, v8i32_t& pa8, const int prb) {
  if (!(prb & 1)) {
#pragma unroll
  for (int r = 0; r < 16; ++r) p1[r] = __builtin_amdgcn_exp2f(p1[r]); }
  float ps = 0;
#pragma unroll
  for (int r = 0; r < 16; ++r) ps += p0[r];
#pragma unroll
  for (int r = 0; r < 16; ++r) ps += p1[r];
  { auto rr = __builtin_amdgcn_permlane32_swap(__float_as_uint(ps), __float_as_uint(ps), false, false);
    ps = __uint_as_float(rr[0]) + __uint_as_float(rr[1]); }
  l_reg = l_reg * alpha + ps;
#pragma unroll
  for (int i = 0; i < 4; ++i) { int w = __builtin_amdgcn_cvt_pk_fp8_f32(p0[4 * i], p0[4 * i + 1], 0, false); w = __builtin_amdgcn_cvt_pk_fp8_f32(p0[4 * i + 2], p0[4 * i + 3], w, true); pa8[i] = w;
    int w2 = __builtin_amdgcn_cvt_pk_fp8_f32(p1[4 * i], p1[4 * i + 1], 0, false); w2 = __builtin_amdgcn_cvt_pk_fp8_f32(p1[4 * i + 2], p1[4 * i + 3], w2, true); pa8[4 + i] = w2; }
}
#ifndef QKT_PF
#define QKT_PF 0
#endif
#if QKT_PF == 0
__device__ __forceinline__ void qkt(f32x16& p0, f32x16& p1, const char* Kn, const char* Kr, const bf16x8* qr, const char* Qr, int r32, int hi) {
  p0 = f32x16{}; p1 = f32x16{};
#pragma unroll
  for (int d0 = 0; d0 < 8; ++d0) { const int cb = (d0 * 16 + hi * 8) * 2;
    bf16x8 b0 = *reinterpret_cast<const bf16x8*>(Kn + KSWZ(r32, cb));
    bf16x8 b1 = *reinterpret_cast<const bf16x8*>(Kn + KSWZ(32 + r32, cb));
    p0 = __builtin_amdgcn_mfma_f32_32x32x16_bf16(b0, qr[d0], p0, 0, 0, 0);
    p1 = __builtin_amdgcn_mfma_f32_32x32x16_bf16(b1, qr[d0], p1, 0, 0, 0);
    if ((d0 & (QKT_GRP - 1)) == QKT_GRP - 1) SBAR(); }
#pragma unroll
  for (int d0 = 0; d0 < 4; ++d0) { const int cb = (d0 * 16 + hi * 8) * 2;
    bf16x8 b0 = *reinterpret_cast<const bf16x8*>(Kr + RSWZ(r32, cb));
    bf16x8 b1 = *reinterpret_cast<const bf16x8*>(Kr + RSWZ(32 + r32, cb));
    const bf16x8 qf = qr[8 + d0];
    p0 = __builtin_amdgcn_mfma_f32_32x32x16_bf16(b0, qf, p0, 0, 0, 0);
    p1 = __builtin_amdgcn_mfma_f32_32x32x16_bf16(b1, qf, p1, 0, 0, 0);
    if ((d0 & (QKT_GRP - 1)) == QKT_GRP - 1) SBAR(); }
}
#else
__device__ __forceinline__ void qkt(f32x16& p0, f32x16& p1, const char* Kn, const char* Kr, const bf16x8* qr, const char* Qr, int r32, int hi) {
  p0 = f32x16{}; p1 = f32x16{};
  constexpr int NB = QKT_PF + 1;
  bf16x8 kb0[NB], kb1[NB], qf[NB];
#define KLD(S) do { constexpr int s_ = (S), i_ = s_ % NB; if constexpr (s_ < 8) { const int cb = (s_ * 16 + hi * 8) * 2; kb0[i_] = *reinterpret_cast<const bf16x8*>(Kn + KSWZ(r32, cb)); kb1[i_] = *reinterpret_cast<const bf16x8*>(Kn + KSWZ(32 + r32, cb)); } \
    else { const int cb = ((s_ - 8) * 16 + hi * 8) * 2; kb0[i_] = *reinterpret_cast<const bf16x8*>(Kr + RSWZ(r32, cb)); kb1[i_] = *reinterpret_cast<const bf16x8*>(Kr + RSWZ(32 + r32, cb)); qf[i_] = *reinterpret_cast<const bf16x8*>(Qr + (s_ - 8) * 1024); } } while (0)
#define KSTEP(S) do { constexpr int s_ = (S), i_ = s_ % NB; if constexpr (s_ + QKT_PF < 12) KLD(S + QKT_PF); const bf16x8 q_ = s_ < 8 ? qr[s_ < 8 ? s_ : 0] : qf[i_]; \
    p0 = __builtin_amdgcn_mfma_f32_32x32x16_bf16(kb0[i_], q_, p0, 0, 0, 0); p1 = __builtin_amdgcn_mfma_f32_32x32x16_bf16(kb1[i_], q_, p1, 0, 0, 0); } while (0)
  KLD(0); if constexpr (QKT_PF >= 2) KLD(1);
  KSTEP(0); KSTEP(1); KSTEP(2); KSTEP(3); KSTEP(4); KSTEP(5); KSTEP(6); KSTEP(7); KSTEP(8); KSTEP(9); KSTEP(10); KSTEP(11);
#undef KLD
#undef KSTEP
}
#endif
__device__ __forceinline__ int v_st(int k, int c) { const int kk = (k & ~0xC) | ((k & 4) << 1) | ((k & 8) >> 1); return ((kk >> 3) * 4 + (c >> 5)) * 512 + ((kk & 7) * 32 + (c & 31)) * 2; }
__device__ __forceinline__ int v_rd_base(int lane) { return ((lane & 3) << 3) | (((lane >> 2) & 3) << 6) | (((lane >> 4) & 1) << 5) | (((lane >> 5) & 1) << 8); }
constexpr int v_rd_off(int d0, int ks, int half) { return d0 * 512 + ks * 4096 + half * 2048; }
template <int OFF> __device__ __forceinline__ s16x4 tr_read(int vb) {
  s16x4 r; asm volatile("ds_read_b64_tr_b16 %0, %1 offset:%2" : "=&v"(r) : "v"(vb), "i"(OFF) : "memory"); return r;
}
template <int D0> __device__ __forceinline__ void pv_one(f32x16& od, int vb, bf16x8 pa0, bf16x8 pa1, bf16x8 pa2, bf16x8 pa3) {
  const s16x4 l0 = tr_read<v_rd_off(D0, 0, 0)>(vb), h0 = tr_read<v_rd_off(D0, 0, 1)>(vb), l1 = tr_read<v_rd_off(D0, 1, 0)>(vb), h1 = tr_read<v_rd_off(D0, 1, 1)>(vb);
  const s16x4 l2 = tr_read<v_rd_off(D0, 2, 0)>(vb), h2 = tr_read<v_rd_off(D0, 2, 1)>(vb), l3 = tr_read<v_rd_off(D0, 3, 0)>(vb), h3 = tr_read<v_rd_off(D0, 3, 1)>(vb);
  asm volatile("s_waitcnt lgkmcnt(0)" ::: "memory"); SBAR();
#define PK(L, H) (bf16x8){L[0], L[1], L[2], L[3], H[0], H[1], H[2], H[3]}
  od = __builtin_amdgcn_mfma_f32_32x32x16_bf16(pa0, PK(l0, h0), od, 0, 0, 0);
  od = __builtin_amdgcn_mfma_f32_32x32x16_bf16(pa1, PK(l1, h1), od, 0, 0, 0);
  od = __builtin_amdgcn_mfma_f32_32x32x16_bf16(pa2, PK(l2, h2), od, 0, 0, 0);
  od = __builtin_amdgcn_mfma_f32_32x32x16_bf16(pa3, PK(l3, h3), od, 0, 0, 0);
#undef PK
}
__device__ __forceinline__ void pv_d0(f32x16* o, int vb, bf16x8 pa0, bf16x8 pa1, bf16x8 pa2, bf16x8 pa3) {
  pv_one<0>(o[0], vb, pa0, pa1, pa2, pa3); pv_one<1>(o[1], vb, pa0, pa1, pa2, pa3); pv_one<2>(o[2], vb, pa0, pa1, pa2, pa3); pv_one<3>(o[3], vb, pa0, pa1, pa2, pa3);
}

#define LDSR128(dst, base, OFF) asm volatile("ds_read_b128 %0, %1 offset:%2" : "=v"(dst) : "v"((unsigned)(uintptr_t)(base)), "i"(OFF) : "memory")
#define WAITK4(N, A, B, C, D) asm volatile("s_waitcnt lgkmcnt(" #N ")" : "+v"(A), "+v"(B), "+v"(C), "+v"(D) :: "memory")
#ifndef PADN
#define PADN 13
#endif
#define PAD_STR2(x) #x
#define PAD_STR(x) PAD_STR2(x)
#define MFMA_PAD1() asm volatile("s_nop " PAD_STR(PADN))
#define PINACC2(A, B) asm volatile("" : "+v"(A), "+v"(B))
#define PINACC1(A) asm volatile("" : "+v"(A))
#define WAITV2(N, A, B) asm volatile("s_waitcnt lgkmcnt(" #N ")" : "+v"(A), "+v"(B) :: "memory")
#define V8OF(F) (v8i32_t){(int)F[0][0], (int)F[0][1], (int)F[0][2], (int)F[0][3], (int)F[1][0], (int)F[1][1], (int)F[1][2], (int)F[1][3]}
#define MXMFMA(KF, QF, ACC) __builtin_amdgcn_mfma_scale_f32_32x32x64_f8f6f4(V8OF(KF), QF, ACC, 0, 0, 0, 0x7F7F7F7F, 0, 0x7F7F7F7F)
#define MXMFMA2(PA, VF, ACC) __builtin_amdgcn_mfma_scale_f32_32x32x64_f8f6f4(PA, V8OF(VF), ACC, 0, 0, 0, 0x7F7F7F7F, 0, 0x7F7F7F7F)
template <bool DO_QK, bool DO_PV, class IssueF>
__device__ __forceinline__ void mat_segment(const IssueF& issue, f32x16& p0, f32x16& p1, f32x16* o, const ALDS char* Kn, const ALDS char* Kr, const ALDS char* Vb, const v8i32_t* qf, v8i32_t pa8, int r32, int hi, const int prb) {
  u32x4 ka[3][2], kb[3][2], vf[4][2];
  const int nbase = r32 * 128, nsw = ((r32 >> 1) & 7) << 4, rbase = r32 * 64, rsw = ((r32 >> 2) & 3) << 4, hb = hi * 32;
  asm volatile("s_waitcnt lgkmcnt(0)" ::: "memory");
#if 1
  asm volatile("s_setprio 1");
#endif
  if constexpr (DO_QK && DO_PV) {
  p0 = f32x16{}; p1 = f32x16{};
  if (!(prb & 4))   { const int a_ = nbase + (((0 * 64) + hb) ^ nsw); LDSR128(ka[0][0], Kn + a_, 0); LDSR128(ka[0][1], Kn + (a_ ^ 16), 0); LDSR128(kb[0][0], Kn + a_, 4096); LDSR128(kb[0][1], Kn + (a_ ^ 16), 4096); }
  if (!(prb & 4))   { const int a_ = nbase + (((1 * 64) + hb) ^ nsw); LDSR128(ka[1][0], Kn + a_, 0); LDSR128(ka[1][1], Kn + (a_ ^ 16), 0); LDSR128(kb[1][0], Kn + a_, 4096); LDSR128(kb[1][1], Kn + (a_ ^ 16), 4096); }
  if (!(prb & 4))   { const int a_ = rbase + (hb ^ rsw); LDSR128(ka[2][0], Kr + a_, 0); LDSR128(ka[2][1], Kr + (a_ ^ 16), 0); LDSR128(kb[2][0], Kr + a_, 2048); LDSR128(kb[2][1], Kr + (a_ ^ 16), 2048); }
  if (!(prb & 4))   { const int a_ = rbase + (hb ^ rsw); LDSR128(vf[0][0], Vb + a_, 0); LDSR128(vf[0][1], Vb + (a_ ^ 16), 0); }
  if (!(prb & 4))   { const int a_ = rbase + (hb ^ rsw); LDSR128(vf[1][0], Vb + a_, 2048); LDSR128(vf[1][1], Vb + (a_ ^ 16), 2048); }
  if (!(prb & 4))   { const int a_ = rbase + (hb ^ rsw); LDSR128(vf[2][0], Vb + a_, 4096); LDSR128(vf[2][1], Vb + (a_ ^ 16), 4096); }
  if (!(prb & 4))   { const int a_ = rbase + (hb ^ rsw); LDSR128(vf[3][0], Vb + a_, 6144); LDSR128(vf[3][1], Vb + (a_ ^ 16), 6144); }
  WAITK4(15, ka[0][0], ka[0][1], kb[0][0], kb[0][1]);
  if (!(prb & 2)) { p0 = MXMFMA(ka[0], qf[0], p0); PINACC1(p0); MFMA_PAD1(); p1 = MXMFMA(kb[0], qf[0], p1); PINACC1(p1); MFMA_PAD1(); }
  issue(0); issue(1);
  WAITK4(12, ka[1][0], ka[1][1], kb[1][0], kb[1][1]);
  if (!(prb & 2)) { p0 = MXMFMA(ka[1], qf[1], p0); PINACC1(p0); MFMA_PAD1(); p1 = MXMFMA(kb[1], qf[1], p1); PINACC1(p1); MFMA_PAD1(); }
  issue(2);
  WAITK4(8, ka[2][0], ka[2][1], kb[2][0], kb[2][1]);
  if (!(prb & 2)) { p0 = MXMFMA(ka[2], qf[2], p0); PINACC1(p0); MFMA_PAD1(); p1 = MXMFMA(kb[2], qf[2], p1); PINACC1(p1); MFMA_PAD1(); }
  WAITV2(6, vf[0][0], vf[0][1]);
  if (!(prb & 2)) { o[0] = MXMFMA2(pa8, vf[0], o[0]); PINACC1(o[0]); MFMA_PAD1(); }
  WAITV2(4, vf[1][0], vf[1][1]);
  if (!(prb & 2)) { o[1] = MXMFMA2(pa8, vf[1], o[1]); PINACC1(o[1]); MFMA_PAD1(); }
  WAITV2(2, vf[2][0], vf[2][1]);
  if (!(prb & 2)) { o[2] = MXMFMA2(pa8, vf[2], o[2]); PINACC1(o[2]); MFMA_PAD1(); }
  WAITV2(0, vf[3][0], vf[3][1]);
  if (!(prb & 2)) { o[3] = MXMFMA2(pa8, vf[3], o[3]); PINACC1(o[3]); MFMA_PAD1(); }
  } else if constexpr (DO_QK) {
  p0 = f32x16{}; p1 = f32x16{};
  if (!(prb & 4))   { const int a_ = nbase + (((0 * 64) + hb) ^ nsw); LDSR128(ka[0][0], Kn + a_, 0); LDSR128(ka[0][1], Kn + (a_ ^ 16), 0); LDSR128(kb[0][0], Kn + a_, 4096); LDSR128(kb[0][1], Kn + (a_ ^ 16), 4096); }
  if (!(prb & 4))   { const int a_ = nbase + (((1 * 64) + hb) ^ nsw); LDSR128(ka[1][0], Kn + a_, 0); LDSR128(ka[1][1], Kn + (a_ ^ 16), 0); LDSR128(kb[1][0], Kn + a_, 4096); LDSR128(kb[1][1], Kn + (a_ ^ 16), 4096); }
  if (!(prb & 4))   { const int a_ = rbase + (hb ^ rsw); LDSR128(ka[2][0], Kr + a_, 0); LDSR128(ka[2][1], Kr + (a_ ^ 16), 0); LDSR128(kb[2][0], Kr + a_, 2048); LDSR128(kb[2][1], Kr + (a_ ^ 16), 2048); }
  WAITK4(8, ka[0][0], ka[0][1], kb[0][0], kb[0][1]);
  if (!(prb & 2)) { p0 = MXMFMA(ka[0], qf[0], p0); PINACC1(p0); MFMA_PAD1(); p1 = MXMFMA(kb[0], qf[0], p1); PINACC1(p1); MFMA_PAD1(); }
  issue(0); issue(1);
  WAITK4(4, ka[1][0], ka[1][1], kb[1][0], kb[1][1]);
  if (!(prb & 2)) { p0 = MXMFMA(ka[1], qf[1], p0); PINACC1(p0); MFMA_PAD1(); p1 = MXMFMA(kb[1], qf[1], p1); PINACC1(p1); MFMA_PAD1(); }
  issue(2);
  WAITK4(0, ka[2][0], ka[2][1], kb[2][0], kb[2][1]);
  if (!(prb & 2)) { p0 = MXMFMA(ka[2], qf[2], p0); PINACC1(p0); MFMA_PAD1(); p1 = MXMFMA(kb[2], qf[2], p1); PINACC1(p1); MFMA_PAD1(); }
  } else {
  if (!(prb & 4))   { const int a_ = rbase + (hb ^ rsw); LDSR128(vf[0][0], Vb + a_, 0); LDSR128(vf[0][1], Vb + (a_ ^ 16), 0); }
  if (!(prb & 4))   { const int a_ = rbase + (hb ^ rsw); LDSR128(vf[1][0], Vb + a_, 2048); LDSR128(vf[1][1], Vb + (a_ ^ 16), 2048); }
  if (!(prb & 4))   { const int a_ = rbase + (hb ^ rsw); LDSR128(vf[2][0], Vb + a_, 4096); LDSR128(vf[2][1], Vb + (a_ ^ 16), 4096); }
  if (!(prb & 4))   { const int a_ = rbase + (hb ^ rsw); LDSR128(vf[3][0], Vb + a_, 6144); LDSR128(vf[3][1], Vb + (a_ ^ 16), 6144); }
  WAITV2(6, vf[0][0], vf[0][1]);
  if (!(prb & 2)) { o[0] = MXMFMA2(pa8, vf[0], o[0]); PINACC1(o[0]); MFMA_PAD1(); }
  WAITV2(4, vf[1][0], vf[1][1]);
  if (!(prb & 2)) { o[1] = MXMFMA2(pa8, vf[1], o[1]); PINACC1(o[1]); MFMA_PAD1(); }
  WAITV2(2, vf[2][0], vf[2][1]);
  if (!(prb & 2)) { o[2] = MXMFMA2(pa8, vf[2], o[2]); PINACC1(o[2]); MFMA_PAD1(); }
  WAITV2(0, vf[3][0], vf[3][1]);
  if (!(prb & 2)) { o[3] = MXMFMA2(pa8, vf[3], o[3]); PINACC1(o[3]); MFMA_PAD1(); }
  }
#if 1
  asm volatile("s_setprio 0");
#endif
}

#define ATT_BAR() do { asm volatile("" ::: "memory"); __builtin_amdgcn_s_barrier(); asm volatile("" ::: "memory"); } while (0)
#define ATT_VM(N) asm volatile("s_waitcnt vmcnt(" #N ")" ::: "memory")
__device__ __forceinline__ void glds16(const bf16* g, ALDS unsigned char* l) { __builtin_amdgcn_global_load_lds((const unsigned*)g, (ALDS unsigned*)l, 16, 0, 0); }
__device__ __forceinline__ void glds8(const unsigned char* g, ALDS unsigned char* l) { __builtin_amdgcn_global_load_lds((const unsigned*)g, (ALDS unsigned*)l, 16, 0, 0); }
#ifdef PROBE_STAMP
__device__ unsigned long long g_stamp[8][6];
#define STAMP(k) do { const unsigned long long t_ = __builtin_readcyclecounter(); acc_[k] += t_ - tl_; tl_ = t_; } while (0)
#else
#define STAMP(k) do { } while (0)
#endif
template <int PRB> __device__ __forceinline__ void attn_unit(const unsigned char* __restrict__ Qb, const unsigned char* __restrict__ Knh, const unsigned char* __restrict__ Vth, const unsigned char* __restrict__ Krb,
                                          bf16* __restrict__ Ob, int seq, char* lds, ALDS unsigned char* L, const int probe) {
  int tid_ = threadIdx.x; asm volatile("" : "+v"(tid_));
  const int tid = tid_, wid = __builtin_amdgcn_readfirstlane(tid >> 6), lane = tid & 63, r32 = lane & 31, hi = lane >> 5;
  constexpr int prb = PRB; (void)probe;
  const bool trail = wid >= 4;
  float* ws = (float*)(lds + OFF_WS) + wid * 64; float* li_l = ws; float* al_l = ws + 32;
  float m_reg = -1e30f, l_reg = 0; f32x16 o[4] = {}; v8i32_t qf[3];
  const unsigned char* Qw = Qb + (long)(wid * QBLK + r32) * LDQ + hi * 32;
#pragma unroll
  for (int s_ = 0; s_ < 3; ++s_) { const u32x4 a0 = *reinterpret_cast<const u32x4*>(Qw + s_ * 64), a1 = *reinterpret_cast<const u32x4*>(Qw + s_ * 64 + 16);
    qf[s_] = (v8i32_t){(int)a0[0], (int)a0[1], (int)a0[2], (int)a0[3], (int)a1[0], (int)a1[1], (int)a1[2], (int)a1[3]}; }
#define VOFF() ([&]() { const int row = wid * 16 + (lane >> 2), colB = ((lane & 3) * 16) ^ (((row >> 2) & 3) << 4); return row * LDVT + colB; }())
#define KOFF() ([&]() { const int row = wid * 8 + (lane >> 3), colB = ((lane & 7) * 16) ^ (((row >> 1) & 7) << 4); return row * LDKV + colB; }())
#define ROFF() ([&]() { const int row = wid * 16 + (lane >> 2), colB = ((lane & 3) * 16) ^ (((row >> 2) & 3) << 4); return row * LDKR + colB; }())
  const ALDS char* KL = (const ALDS char*)L + OFF_KN; const ALDS char* RL = (const ALDS char*)L + OFF_KR; const ALDS char* VL = (const ALDS char*)L + OFF_V;
#define ISSUE_K(t, s) do { const long kb_ = (long)(t) * KVBLK; const int s_ = (s); \
    glds8(Knh + kb_ * LDKV + KOFF(), L + OFF_KN + s_ * SHM_KN + wid * 1024); if (wid < 4) glds8(Krb + kb_ * LDKR + ROFF(), L + OFF_KR + s_ * SHM_KR + wid * 1024); } while (0)
#define ISSUE_V(t, s) do { const long kb_ = (long)(t) * KVBLK; const int s_ = (s); glds8(Vth + kb_ + VOFF(), L + OFF_V + s_ * SHM_V + wid * 1024); } while (0)
#define ISSUE_NEXT(j) do { if ((j) + 2 < NT) ISSUE_K((j) + 2, sp); if ((j) + 1 < NT) ISSUE_V((j) + 1, sn); } while (0)
#define ROT() do { const int t_ = sc; sc = sn; sn = sp; sp = t_; } while (0)
#define RESC(a) do { if (__any((a) < 1.f)) { if (hi == 0) al_l[r32] = (a); asm volatile("s_waitcnt lgkmcnt(0)" ::: "memory"); \
    _Pragma("unroll") for (int d = 0; d < 4; ++d) _Pragma("unroll") for (int r = 0; r < 16; ++r) o[d][r] *= al_l[crow(r, hi)]; } } while (0)
  f32x16 p0, p1; float mn, al; v8i32_t pa8 = {}; const int NT = (prb & 64) ? 2 : seq / KVBLK;
  int sc = 0, sn = 1, sp = 2;
  ISSUE_K(0, 0); ISSUE_K(1, 1); ISSUE_V(0, 0);
  if (trail) ATT_VM(2); else ATT_VM(3);
  ATT_BAR();
  int jj = 0;
  const auto issue = [&](int step) { if (prb & 8) return;
    const long kb2 = (long)(jj + 2) * KVBLK, kb1 = (long)(jj + 1) * KVBLK;
    if (jj + 2 < NT) { if (step == 0) glds8(Knh + kb2 * LDKV + KOFF(), L + OFF_KN + sp * SHM_KN + wid * 1024); if (step == 1 && wid < 4) glds8(Krb + kb2 * LDKR + ROFF(), L + OFF_KR + sp * SHM_KR + wid * 1024); }
    if (jj + 1 < NT) { if (step == 2) glds8(Vth + kb1 + VOFF(), L + OFF_V + sn * SHM_V + wid * 1024); } };
  const auto noissue = [](int) {};
  mat_segment<true, false>(issue, p0, p1, o, KL, RL, VL, qf, pa8, r32, hi, prb);
  if (trail) { ATT_VM(2); ATT_BAR(); }
  if (!(prb & 16)) { partialSM(p0, p1, m_reg, mn, al, prb); finishSM(p0, p1, al, l_reg, pa8, prb); }
  ROT();
#ifdef PROBE_STAMP
  unsigned long long acc_[6] = {0, 0, 0, 0, 0, 0}, tl_ = __builtin_readcyclecounter();
#endif
  for (int j = 1; j < NT; ++j) {
    if (!trail) { if (j + 1 < NT) ATT_VM(3); else ATT_VM(0); STAMP(4); ATT_BAR(); }
    STAMP(0);
    jj = j;
    mat_segment<true, true>(issue, p0, p1, o, KL + sc * SHM_KN, RL + sc * SHM_KR, VL + sp * SHM_V, qf, pa8, r32, hi, prb);
    STAMP(1);
    if (trail) { if (j + 2 < NT) ATT_VM(2); else ATT_VM(0); STAMP(5); ATT_BAR(); }
    STAMP(2);
    if (!(prb & 16)) { partialSM(p0, p1, m_reg, mn, al, prb); RESC(al); finishSM(p0, p1, al, l_reg, pa8, prb); }
    ROT();
    STAMP(3);
  }
#ifdef PROBE_STAMP
  if (blockIdx.x == 0 && lane == 0) { for (int k = 0; k < 6; ++k) g_stamp[wid][k] += acc_[k]; }
#endif
  if (!trail) { ATT_VM(0); ATT_BAR(); }
  mat_segment<false, true>(noissue, p0, p1, o, KL, RL, VL + sp * SHM_V, qf, pa8, r32, hi, prb);
  if (hi == 0) li_l[r32] = l_reg; asm volatile("s_waitcnt lgkmcnt(0)" ::: "memory");
  float rli[16];
#pragma unroll
  for (int r = 0; r < 16; ++r) rli[r] = __builtin_amdgcn_rcpf(li_l[crow(r, hi)]);
  int lane_e = lane; asm volatile("" : "+v"(lane_e));
  bf16* Ow = Ob + (long)(wid * QBLK + 4 * (lane_e >> 5)) * LDO + (lane_e & 31);
#pragma unroll
  for (int r = 0; r < 16; ++r) { const int orow = (r & 3) + 8 * (r >> 2);
#pragma unroll
    for (int d0 = 0; d0 < 4; ++d0) { const float val = o[d0][r] * rli[r]; if (!(prb & 32)) Ow[orow * LDO + d0 * 32] = (bf16)(cvtpk(val, val) & 0xffffu); } }
  ATT_VM(0);
  ATT_BAR();
#undef VOFF
#undef KOFF
#undef ROFF
#undef ISSUE_K
#undef ISSUE_V
#undef ISSUE_NEXT
#undef ROT
#undef RESC
}
#undef KSWZ
#undef RSWZ
}

constexpr int DM = 4096, SEQ = 8192, CTXL = 256, MR = SEQ + CTXL;
constexpr int NH = 16, QL = 768, KVL = 512, NIN = 7680, NMODC = 6 * DM;
constexpr int NEXP = 16384;
constexpr float EPS = 1e-6f;
constexpr float C2 = 0.072168783648703220f * 1.4426950408889634f;

#ifndef MK_ONE_LAUNCH
#define MK_ONE_LAUNCH 1
#endif
constexpr int NPHASE = 10;
constexpr int NWAVES = 8, NTHR = NWAVES * 64;

constexpr size_t MiB = 1u << 20;
constexpr size_t a256(size_t x) { return (x + 255) & ~(size_t)255; }
constexpr size_t WS_CTL = 0, CTL_ZERO_BYTES = 1 * MiB;
constexpr int CW_BAR = 4096;
constexpr int CW_END = CW_BAR + 3456;
static_assert((size_t)CW_END * 4 <= CTL_ZERO_BYTES, "CTL words inside the memset region");
constexpr size_t WS_MODF = 1 * MiB;
constexpr size_t WS_ROPE = WS_MODF + a256((size_t)(NMODC + 2 * DM) * 4);
constexpr size_t WS_WIN  = 2 * MiB;
constexpr size_t WS_WUQ  = WS_WIN + (size_t)NIN * DM * 2;
constexpr size_t WS_WUKV = WS_WUQ + (size_t)3072 * 768 * 2;
constexpr size_t WS_WO   = WS_WUKV + (size_t)4096 * 512 * 2;
constexpr size_t WS_WPQ  = WS_WO + (size_t)DM * DM * 2;
constexpr size_t WS_KBD  = WS_WPQ + (size_t)2048 * DM * 2;
constexpr int ROWB = 3072;
constexpr size_t WS_KB2  = WS_KBD + (size_t)2048 * DM * 2;
constexpr size_t WS_UB   = WS_KB2 + (size_t)8 * 256 * 256 * 2;
constexpr size_t WS_VB   = WS_UB + (size_t)NEXP * ROWB;
constexpr size_t WS_SU   = WS_VB + (size_t)NEXP * ROWB;
constexpr size_t WS_HX   = WS_SU + (size_t)2 * NEXP * 4;
constexpr size_t WS_CQ   = WS_HX + (size_t)MR * DM * 2;
constexpr size_t WS_CKV  = WS_CQ + (size_t)SEQ * QL * 2;
constexpr size_t WS_KR   = WS_CKV + (size_t)MR * KVL * 2;
constexpr size_t WS_U    = WS_KR + (size_t)MR * 64 * 2;
constexpr size_t WS_GB   = WS_U + (size_t)SEQ * 2048 * 2;
constexpr size_t WS_Q    = WS_GB + (size_t)SEQ * 2048 * 2;
constexpr size_t WS_KN   = WS_Q + (size_t)SEQ * 3072 * 2;
constexpr size_t WS_V    = WS_KN + (size_t)MR * 2048 * 2;
constexpr size_t WS_ACAT = WS_V + (size_t)MR * 2048 * 2;
constexpr size_t WS_X1   = WS_ACAT + (size_t)SEQ * DM * 2;
constexpr size_t WS_H2   = WS_X1 + (size_t)SEQ * DM * 4;
constexpr size_t WS_QP   = WS_H2 + (size_t)SEQ * DM * 2;
constexpr size_t WS_SC   = WS_QP + (size_t)SEQ * 2048 * 2;
constexpr size_t WS_MODP = WS_SC + (size_t)SEQ * 2048 * 4;
constexpr size_t WS_SQ1  = WS_MODP + (size_t)64 * 32768 * 4;
constexpr size_t WS_SQ2  = WS_SQ1 + (size_t)SEQ * 12 * 4;
constexpr size_t WS_SQ3  = WS_SQ2 + (size_t)MR * 8 * 4;
constexpr size_t WS_END  = WS_SQ3 + (size_t)SEQ * 64 * 4;
static_assert(WS_ROPE + 192 * 32 * 4 <= WS_WIN, "rope table below the weights");

constexpr int RING_BYTES = 158720;
constexpr int MISC_OFF = RING_BYTES + 320;
constexpr int LDS_BYTES = 163840;
static_assert(att::SHM_ATTN <= RING_BYTES && MISC_OFF + 128 <= LDS_BYTES, "LDS map");

#define GAS __attribute__((address_space(1)))
#define LAS __attribute__((address_space(3)))
typedef unsigned short bf16;
typedef unsigned v4u __attribute__((ext_vector_type(4)));
typedef float f32x4 __attribute__((ext_vector_type(4)));
typedef __bf16 bf16x2_t __attribute__((ext_vector_type(2)));
typedef float f32x2 __attribute__((ext_vector_type(2)));
typedef float f32x16v __attribute__((ext_vector_type(16)));
typedef float f32x32v __attribute__((ext_vector_type(32)));
typedef unsigned u32x6v __attribute__((ext_vector_type(6)));
typedef _Float16 h16x2 __attribute__((ext_vector_type(2)));
typedef _Float16 h16x32 __attribute__((ext_vector_type(32)));
#ifndef FP6_INTERLEAVED
#define FP6_INTERLEAVED 1
#endif
#define LDS_WAIT() asm volatile("s_waitcnt lgkmcnt(0)" ::: "memory")
__device__ __forceinline__ unsigned f2bf(float f) { unsigned u = __builtin_bit_cast(unsigned, f); return (u + 0x7fffu + ((u >> 16) & 1u)) >> 16; }
__device__ __forceinline__ unsigned pk2(float lo, float hi) { return f2bf(lo) | (f2bf(hi) << 16); }
__device__ __forceinline__ float bflo(unsigned w) { return __builtin_bit_cast(float, w << 16); }
__device__ __forceinline__ float bfhi(unsigned w) { return __builtin_bit_cast(float, w & 0xffff0000u); }
__device__ __forceinline__ float dot2bf(unsigned a, unsigned b, float c) { return __builtin_amdgcn_fdot2_f32_bf16(__builtin_bit_cast(bf16x2_t, a), __builtin_bit_cast(bf16x2_t, b), c, false); }
#define DPP_F(v, CTRL) __builtin_bit_cast(float, __builtin_amdgcn_update_dpp(0, __builtin_bit_cast(int, (v)), (CTRL), 0xf, 0xf, true))
__device__ __forceinline__ float row16_sum(float v) { v += DPP_F(v, 0xB1); v += DPP_F(v, 0x4E); v += DPP_F(v, 0x141); v += DPP_F(v, 0x140); return v; }
__device__ __forceinline__ float row16_max(float v) { v = fmaxf(v, DPP_F(v, 0xB1)); v = fmaxf(v, DPP_F(v, 0x4E)); v = fmaxf(v, DPP_F(v, 0x141)); v = fmaxf(v, DPP_F(v, 0x140)); return v; }
__device__ __forceinline__ float rl_f(float v, int l) { return __builtin_bit_cast(float, __builtin_amdgcn_readlane(__builtin_bit_cast(int, v), l)); }
__device__ __forceinline__ float wave_sum(float v) { v = row16_sum(v); return (rl_f(v, 0) + rl_f(v, 16)) + (rl_f(v, 32) + rl_f(v, 48)); }
__device__ __forceinline__ float wave_max(float v) { v = row16_max(v); return fmaxf(fmaxf(rl_f(v, 0), rl_f(v, 16)), fmaxf(rl_f(v, 32), rl_f(v, 48))); }

#define XB_TMO      128
#define XB_XCNT(j)  (256  + 64 * (j))
#define XB_XSUB(j)  (1280 + 64 * (j))
#define XB_XGEN(j)  (2304 + 64 * (j))
#define XB_TOP      3328
#define XB_TOPGEN   3392
#define XCD_BAR_WORDS 3456
#define XB_SPIN_CAP (1u << 18)
__device__ __forceinline__ unsigned xb_ld(unsigned* p)              { return __hip_atomic_load(p, __ATOMIC_RELAXED, __HIP_MEMORY_SCOPE_AGENT); }
__device__ __forceinline__ unsigned xb_add(unsigned* p, unsigned v) { return __hip_atomic_fetch_add(p, v, __ATOMIC_RELAXED, __HIP_MEMORY_SCOPE_AGENT); }
__device__ __forceinline__ unsigned xb_xcc_id() { return (unsigned)__builtin_amdgcn_s_getreg((3 << 11) | 20) & 0xFu; }
#define XB_SPIN(cond, bar) do { unsigned _sp = 0; while (cond) { __builtin_amdgcn_s_sleep(1); \
    if ((++_sp & 255u) == 0u) { if (xb_ld(&(bar)[XB_TMO])) break; if (_sp > XB_SPIN_CAP) { atomicAdd(&(bar)[XB_TMO], 1u); break; } } } } while (0)
struct XcdBarrier { unsigned* bar; unsigned x; volatile LAS unsigned* st; };
__device__ __forceinline__ XcdBarrier xcd_barrier_post(unsigned* bar, volatile LAS unsigned* st) {
    XcdBarrier b; b.bar = bar; b.x = xb_xcc_id(); b.st = st;
    if (threadIdx.x == 0) (void)xb_add(&bar[XB_XCNT(b.x)], 1u);
    return b;
}
__device__ __forceinline__ void xcd_barrier_complete(unsigned* bar, unsigned x, unsigned& nloc, unsigned& nx) {
    const unsigned G = gridDim.x * gridDim.y * gridDim.z;
    unsigned sum, cnt, mine, sp = 0u;
    for (;;) {
        sum = 0u; cnt = 0u; mine = 0u;
#pragma unroll
        for (unsigned j = 0; j < 16; ++j) { const unsigned c = xb_ld(&bar[XB_XCNT(j)]); sum += c; cnt += (c > 0u) ? 1u : 0u; mine = (j == x) ? c : mine; }
        if (sum == G) break;
        __builtin_amdgcn_s_sleep(1);
        if ((++sp & 255u) == 0u) { if (xb_ld(&bar[XB_TMO])) break; if (sp > XB_SPIN_CAP) { atomicAdd(&bar[XB_TMO], 1u); break; } }
    }
    nloc = mine > 0u ? mine : 1u; nx = cnt > 0u ? cnt : 1u;
}
__device__ __forceinline__ void xcd_barrier(const XcdBarrier& b) {
    asm volatile("s_waitcnt vmcnt(0)" ::: "memory");
    __syncthreads();
    if (threadIdx.x == 0) {
        unsigned* bar = b.bar;
        __builtin_amdgcn_s_waitcnt(0);
        unsigned nloc = b.st[0], nx = b.st[1];
        if (nloc == 0u) { xcd_barrier_complete(bar, b.x, nloc, nx); b.st[0] = nloc; b.st[1] = nx; }
        const unsigned old = xb_add(&bar[XB_XSUB(b.x)], 1u);
        const unsigned gen = old / nloc;
        if (old + 1u == (gen + 1u) * nloc) {
            __builtin_amdgcn_fence(__ATOMIC_RELEASE, "agent");
            asm volatile("s_waitcnt vmcnt(0)" ::: "memory");
            const unsigned og = xb_add(&bar[XB_TOP], 1u);
            const unsigned tg = og / nx;
            if (og + 1u == (tg + 1u) * nx) xb_add(&bar[XB_TOPGEN], 1u);
            else XB_SPIN(xb_ld(&bar[XB_TOPGEN]) == tg, bar);
            __builtin_amdgcn_fence(__ATOMIC_ACQUIRE, "agent");
            xb_add(&bar[XB_XGEN(b.x)], 1u);
            asm volatile("s_waitcnt vmcnt(0)" ::: "memory");
        } else {
            XB_SPIN(xb_ld(&bar[XB_XGEN(b.x)]) == gen, bar);
            __builtin_amdgcn_fence(__ATOMIC_ACQUIRE, "agent");
            asm volatile("s_waitcnt vmcnt(0)" ::: "memory");
        }
    }
    __syncthreads();
}

__device__ __forceinline__ int pi32(int o) { return 2 * (o & 15) + (o >> 4); }
__device__ __forceinline__ void tr_item(const float* __restrict__ W, int N, int k0, int n0, bf16* __restrict__ WT, int ldk, int drow0, bool perm, const float* __restrict__ gsc, LAS float* scr, int lane) {
    f32x4 w[8]; const int c4 = (lane & 7) * 4, rsub = lane >> 3;
#pragma unroll
    for (int i = 0; i < 8; ++i) w[i] = *(const f32x4*)(W + (size_t)(k0 + 8 * i + rsub) * N + n0 + c4);
#pragma unroll
    for (int i = 0; i < 8; ++i) { const int kk = 8 * i + rsub; const float g = gsc ? gsc[k0 + kk] : 1.f;
        scr[kk * 33 + c4] = w[i][0] * g; scr[kk * 33 + c4 + 1] = w[i][1] * g; scr[kk * 33 + c4 + 2] = w[i][2] * g; scr[kk * 33 + c4 + 3] = w[i][3] * g; }
    LDS_WAIT(); asm volatile("" ::: "memory");
    const int c = lane & 7;
#pragma unroll
    for (int j = 0; j < 4; ++j) { const int n = (lane >> 3) + 8 * j; const LAS float* s = scr + (8 * c) * 33 + n;
        v4u o; o.x = pk2(s[0 * 33], s[1 * 33]); o.y = pk2(s[2 * 33], s[3 * 33]); o.z = pk2(s[4 * 33], s[5 * 33]); o.w = pk2(s[6 * 33], s[7 * 33]);
        const int dn = perm ? pi32(n) : n;
        *(v4u*)(WT + (size_t)(drow0 + dn) * ldk + k0 + 8 * c) = o; }
    LDS_WAIT(); asm volatile("" ::: "memory");
}
__device__ __forceinline__ float silu_f(float v) { return v / (1.f + expf(-v)); }
__device__ __forceinline__ float gelu_erf(float v) { return 0.5f * v * (1.f + erff(v * 0.70710678118654752f)); }
__device__ __forceinline__ unsigned fkey(float f) { const unsigned u = __builtin_bit_cast(unsigned, f); return (u & 0x80000000u) ? ~u : (u | 0x80000000u); }

template <int NV> __device__ __forceinline__ unsigned kth16(const unsigned (&k)[NV]) {
    unsigned T = 0u;
    for (int bit = 31; bit >= 0; --bit) { const unsigned c = T | (1u << bit); int cnt = 0;
#pragma unroll
        for (int v = 0; v < NV; ++v) cnt += __popcll(__ballot(k[v] >= c));
        if (cnt >= 16) T = c; }
    return T;
}
template <int NV> __device__ __forceinline__ void compact16(const unsigned (&k)[NV], const unsigned (&val)[NV], const unsigned (&pay)[NV], unsigned T, LAS unsigned* oval, LAS unsigned* opay, int lane) {
    const unsigned long long lt = (1ull << lane) - 1ull; int pos = 0;
#pragma unroll
    for (int v = 0; v < NV; ++v) { const bool s = k[v] > T; const unsigned long long m = __ballot(s); const int slot = pos + __popcll(m & lt); if (s) { oval[slot] = val[v]; opay[slot] = pay[v]; } pos += __popcll(m); }
#pragma unroll
    for (int v = 0; v < NV; ++v) { const bool s = k[v] == T; const unsigned long long m = __ballot(s); const int slot = pos + __popcll(m & lt); if (s && slot < 16) { oval[slot] = val[v]; opay[slot] = pay[v]; } pos += __popcll(m); }
}

struct Args { const float* in[21]; float* out; unsigned char* ws; int ph_lo, ph_hi, probe, pad; };
static_assert(sizeof(Args) == 23 * 8 + 16, "Args has no padding");

template <int PRB, bool PK> __device__ __forceinline__ void fwd_body(const Args& a) {
    extern __shared__ __attribute__((aligned(16))) unsigned char lds[];
    LAS unsigned char* L = (LAS unsigned char*)lds;
    const int wave = __builtin_amdgcn_readfirstlane((int)threadIdx.x >> 6);
    const int G = gridDim.x, bx = blockIdx.x;
    const int gw = bx * NWAVES + wave, NGW = G * NWAVES;
    const size_t NT = (size_t)G * NTHR;
#define PH_IDS() int tid_ph_ = threadIdx.x; asm volatile("" : "+v"(tid_ph_)); const int tid = tid_ph_, lane = tid & 63; const size_t gt = (size_t)bx * NTHR + tid; (void)lane; (void)gt
    unsigned char* ws = a.ws;
    float* ctlf = (float*)(ws + WS_CTL);
    const float* x = a.in[0]; const float* cvec = a.in[1]; const float* ctx = a.in[2]; const float* cctx = a.in[3]; const float* w_ada = a.in[4]; const float* b_ada = a.in[5];
    const float* norm1_g = a.in[6]; const float* w_in = a.in[7]; const float* q_norm_g = a.in[8]; const float* w_uq = a.in[9]; const float* kv_norm_g = a.in[10]; const float* w_ukv = a.in[11];
    const float* conv_w = a.in[12]; const float* conv_b = a.in[13]; const float* w_o = a.in[14]; const float* norm2_g = a.in[15]; const float* peer_wq = a.in[16]; const float* peer_keys = a.in[17];
    const float* peer_u = a.in[18]; const float* peer_v = a.in[19]; const float* final_g = a.in[20];
    float* modp = (float*)(ws + WS_MODP); float* ssq_cq = (float*)(ws + WS_SQ1); float* ssq_ckv = (float*)(ws + WS_SQ2); float* ssq_x1 = (float*)(ws + WS_SQ3);
    float* modf = (float*)(ws + WS_MODF); float* rope = (float*)(ws + WS_ROPE);
    bf16* WIN = (bf16*)(ws + WS_WIN); bf16* WUQ = (bf16*)(ws + WS_WUQ); bf16* WUKV = (bf16*)(ws + WS_WUKV); bf16* WO = (bf16*)(ws + WS_WO); bf16* WPQ = (bf16*)(ws + WS_WPQ); bf16* KBD = (bf16*)(ws + WS_KBD); bf16* KB2 = (bf16*)(ws + WS_KB2);
    unsigned char* UB = ws + WS_UB; unsigned char* VB = ws + WS_VB; float* SUV = (float*)(ws + WS_SU); bf16* HX = (bf16*)(ws + WS_HX); bf16* CQ = (bf16*)(ws + WS_CQ); bf16* CKV = (bf16*)(ws + WS_CKV); unsigned char* KR = ws + WS_KR;
    bf16* UCV = (bf16*)(ws + WS_U); bf16* GBV = (bf16*)(ws + WS_GB); unsigned char* Q = ws + WS_Q; unsigned char* KN = ws + WS_KN; unsigned char* VT = ws + WS_V; bf16* ACAT = (bf16*)(ws + WS_ACAT);
    bf16* DLT = (bf16*)(ws + WS_X1); bf16* H2 = (bf16*)(ws + WS_H2); float* SC = (float*)(ws + WS_SC);

    for (int u = threadIdx.x; u < (LDS_BYTES - RING_BYTES) / 4; u += NTHR) ((LAS unsigned*)(L + RING_BYTES))[u] = 0u;
    __syncthreads();
    const int lo = a.ph_lo, hi = a.ph_hi;
    XcdBarrier bar; bar.bar = (unsigned*)ctlf + CW_BAR; bar.x = 0; bar.st = (volatile LAS unsigned*)(L + MISC_OFF);
    if (hi - lo > 1) bar = xcd_barrier_post((unsigned*)ctlf + CW_BAR, (volatile LAS unsigned*)(L + MISC_OFF));
#define IN(k) (lo <= (k) && (k) < hi)
#ifndef PHASE_MASK
#define PHASE_MASK 0x3ff
#endif
#ifndef PROBE_PHASES
#define PROBE_PHASES_ 0
#else
#define PROBE_PHASES_ PROBE_PHASES
#endif
#define PH_ON(k) ((((PK) ? (PROBE_PHASES_) : (PHASE_MASK)) >> (k)) & 1)
#ifndef REPEAT_MASK
#define REPEAT_MASK 0
#endif
#define NREP(k) (1 + (((REPEAT_MASK) >> (k)) & 1))
#define GRID_BAR(k) do { if (IN(k) && IN((k) + 1)) xcd_barrier(bar); } while (0)

    if (PH_ON(0) && IN(0)) for (int rep_ = 0; rep_ < NREP(0); ++rep_) {
        PH_IDS();
        const int psel = a.probe ? a.probe : 7;
        if (psel & 1)
        for (int it = gw; it < 64 * 96; it += NGW) {
            const int kb = it / 96, cb = it % 96, col = cb * 256 + lane * 4;
            const float* wp = w_ada + (size_t)(kb * 64) * NMODC + col;
            f32x4 ax = {0.f, 0.f, 0.f, 0.f}, ac = {0.f, 0.f, 0.f, 0.f}; const bool cc = cb < 32;
            const float sxv = silu_f(cvec[kb * 64 + lane]), scv = silu_f(cctx[kb * 64 + lane]);
#pragma unroll 16
            for (int i = 0; i < 64; ++i) { const f32x4 w = __builtin_nontemporal_load((const f32x4*)(wp + (size_t)i * NMODC));
                ax += w * rl_f(sxv, i); ac += w * (cc ? rl_f(scv, i) : 0.f); }
            *(f32x4*)(modp + (size_t)kb * 32768 + col) = ax; if (cc) *(f32x4*)(modp + (size_t)kb * 32768 + NMODC + col) = ac;
        }
        if (psel & 2) {
            LAS float* scr = (LAS float*)(L + wave * 8448);
            constexpr int I_IN = 64 * 234, I_UQ = 12 * 96, I_UKV = 8 * 128, I_O = 64 * 128, NIT = I_IN + I_UQ + I_UKV + I_O;
            for (int it = gw; it < NIT; it += NGW) { int r = it;
                if (r < I_IN) { const int kb = r / 234, n0 = (r % 234) * 32; int drow0; bool perm = false;
                    if (n0 < 1280) drow0 = n0; else if (n0 < 1344) { drow0 = n0; perm = true; }
                    else { const int c0 = n0 - 1344; if (c0 < 2048) drow0 = 1536 + (c0 >> 7) * 256 + (c0 & 127); else if (c0 < 4096) drow0 = 5632 + (c0 - 2048); else { const int c1 = c0 - 4096; drow0 = 1536 + (c1 >> 7) * 256 + 128 + (c1 & 127); } }
                    tr_item(w_in, 7488, kb * 64, n0, WIN, 4096, drow0, perm, nullptr, scr, lane); continue; } r -= I_IN;
                if (r < I_UQ) { const int kb = r / 96, n0 = (r % 96) * 32; tr_item(w_uq, 3072, kb * 64, n0, WUQ, 768, n0, (n0 % 192) >= 128, q_norm_g, scr, lane); continue; } r -= I_UQ;
                if (r < I_UKV) { const int kb = r / 128, n0 = (r % 128) * 32; tr_item(w_ukv, 4096, kb * 64, n0, WUKV, 512, ((n0 & 255) < 128 ? 0 : 2048) + (n0 >> 8) * 128 + (n0 & 127), false, kv_norm_g, scr, lane); continue; } r -= I_UKV;
                { const int kb = r / 128, n0 = (r % 128) * 32; tr_item(w_o, 4096, kb * 64, n0, WO, 4096, n0, false, nullptr, scr, lane); }
            }
        }
        for (size_t i = gt; i < (size_t)192 * 512; i += NT) { const v4u z = {0u, 0u, 0u, 0u}; *(v4u*)(WIN + (size_t)1344 * 4096 + i * 8) = z; }
        for (size_t i = gt; i < (size_t)DM * 2048 / 8; i += NT) {
            const int d = (int)(i >> 8), c8 = (int)(i & 255) * 8, h = c8 >> 8, j = c8 & 255; const float* sp_ = peer_wq + (size_t)d * 2048 + c8; const f32x4 a0 = *(const f32x4*)sp_, a1 = *(const f32x4*)(sp_ + 4);
            v4u o; o.x = pk2(a0[0], a0[1]); o.y = pk2(a0[2], a0[3]); o.z = pk2(a1[0], a1[1]); o.w = pk2(a1[2], a1[3]); *(v4u*)(WPQ + ((size_t)h * DM + d) * 256 + j) = o; }
        for (size_t i = gt; i < (size_t)8 * 256 * 32; i += NT) {
            const int d8 = (int)(i & 31) * 8, rr = (int)(i >> 5) & 255, h = (int)(i >> 13), p = rr >> 7, k = rr & 127; v4u o = {0u, 0u, 0u, 0u};
            if ((d8 >> 7) == p) { const float* s_ = peer_keys + ((size_t)((h * 2 + p) * 128 + k)) * 128 + (d8 & 127); const f32x4 a0 = *(const f32x4*)s_, a1 = *(const f32x4*)(s_ + 4);
                o.x = pk2(a0[0], a0[1]); o.y = pk2(a0[2], a0[3]); o.z = pk2(a1[0], a1[1]); o.w = pk2(a1[2], a1[3]); }
            *(v4u*)(KB2 + i * 8) = o; }
        for (size_t i = gt; i < (size_t)192 * 16; i += NT) {
            const int pi = (int)(i >> 4), fi = (int)(i & 15); const int pos = pi < 128 ? pi : pi - 128;
            const float fr = __builtin_amdgcn_exp2f(-(float)fi * 0.83048202372184059f);
            const float turns = (float)pos * fr * 0.15915494309189535f, fx = turns - floorf(turns);
            rope[pi * 32 + 2 * fi] = __builtin_amdgcn_cosf(fx); rope[pi * 32 + 2 * fi + 1] = __builtin_amdgcn_sinf(fx); }
        if (psel & 4)
        for (int r = gw; r < 2 * NEXP; r += NGW) { const bool isv = r >= NEXP; const int e = isv ? r - NEXP : r; const float* src = (isv ? peer_v : peer_u) + (size_t)e * DM + lane * 4;
            f32x4 v[2][8]; float am = 0.f;
#pragma unroll
            for (int b = 0; b < 2; ++b)
#pragma unroll
                for (int q = 0; q < 8; ++q) { v[b][q] = __builtin_nontemporal_load((const f32x4*)(src + b * 2048 + q * 256)); am = fmaxf(am, fmaxf(fmaxf(fabsf(v[b][q][0]), fabsf(v[b][q][1])), fmaxf(fabsf(v[b][q][2]), fabsf(v[b][q][3])))); }
            am = wave_max(am);
            const float sc = am > 0.f ? exp2f(floorf(log2f(7.5f / am))) : 1.f;
            unsigned d[12];
#pragma unroll
            for (int b = 0; b < 2; ++b) { f32x16v s0, s1;
#pragma unroll
                for (int i = 0; i < 16; ++i) { const int i0 = FP6_INTERLEAVED ? 2 * i : i, i1 = FP6_INTERLEAVED ? 2 * i + 1 : 16 + i; s0[i] = v[b][i0 >> 2][i0 & 3] * sc; s1[i] = v[b][i1 >> 2][i1 & 3] * sc; }
                const u32x6v w = __builtin_amdgcn_cvt_scalef32_2xpk16_fp6_f32(s0, s1, 1.0f);
#pragma unroll
                for (int i = 0; i < 6; ++i) d[6 * b + i] = w[i]; }
            unsigned char* dst = (isv ? VB : UB) + (size_t)e * ROWB + lane * 16;
#pragma unroll
            for (int p = 0; p < 3; ++p) { const v4u o = {d[4 * p], d[4 * p + 1], d[4 * p + 2], d[4 * p + 3]}; *(v4u*)(dst + p * 1024) = o; }
            if (lane == 0) SUV[r] = 1.f / sc;
        }
    }
    GRID_BAR(0);

    if (PH_ON(1) && IN(1)) for (int rep_ = 0; rep_ < NREP(1); ++rep_) {
        PH_IDS();
        for (size_t j = gt; j < (size_t)(NMODC + 2 * DM); j += NT) { float sacc = 0.f;
#pragma unroll 8
            for (int kb = 0; kb < 64; ++kb) sacc += modp[(size_t)kb * 32768 + j];
            modf[j] = sacc + b_ada[j < (size_t)NMODC ? j : j - NMODC]; }
        { pg8::Gemm g{KB2, WPQ, 2048, DM, 256, 0, (size_t)DM * 256 * 2}; pg8::StaticOrder S; S.init(2048, DM, G, bx); pg8::EpiB16 E{KBD, DM};
          pg8::gemm_phase<pg8::EpiB16, pg8::StaticOrder, true, true>(L, g, S, E); }
    }
    GRID_BAR(1);

    if (PH_ON(2) && IN(2)) for (int rep_ = 0; rep_ < NREP(2); ++rep_) {
        PH_IDS();
        for (int row = gw; row < MR; row += NGW) {
            const bool lat = row < SEQ; const float* xr = lat ? x + (size_t)row * DM : ctx + (size_t)(row - SEQ) * DM; const float* md = lat ? modf : modf + NMODC;
            f32x4 v[16]; float ss = 0.f;
#pragma unroll
            for (int j = 0; j < 16; ++j) { v[j] = *(const f32x4*)(xr + 4 * (lane + 64 * j)); ss += (v[j][0] * v[j][0] + v[j][1] * v[j][1]) + (v[j][2] * v[j][2] + v[j][3] * v[j][3]); }
            ss = wave_sum(ss); const float rstd = 1.f / sqrtf(ss * (1.f / DM) + EPS);
#pragma unroll
            for (int j = 0; j < 16; ++j) { const int idx = 4 * (lane + 64 * j);
                const f32x4 g = *(const f32x4*)(norm1_g + idx), sh = *(const f32x4*)(md + idx), sc = *(const f32x4*)(md + DM + idx);
                const f32x4 hh = (v[j] * rstd * g) * (sc + 1.f) + sh;
                *(unsigned long long*)(HX + (size_t)row * DM + idx) = (unsigned long long)pk2(hh[0], hh[1]) | ((unsigned long long)pk2(hh[2], hh[3]) << 32); }
        }
    }
    GRID_BAR(2);

    if (PH_ON(3) && IN(3)) for (int rep_ = 0; rep_ < NREP(3); ++rep_) {
        pg8::Gemm g{HX, WIN, MR, NIN, DM, 0, 0}; pg8::OrderIn S; S.init(SEQ, NIN, G, bx);
        pg8::EpiIn E{CQ, CKV, KR, UCV, GBV, ssq_cq, ssq_ckv, rope};
        pg8::gemm_phase<pg8::EpiIn, pg8::OrderIn, true, true>(L, g, S, E);
    }
    GRID_BAR(3);

    if (PH_ON(4) && IN(4)) for (int rep_ = 0; rep_ < NREP(4); ++rep_) {
        PH_IDS();
        {
            int nq, qb0, nkv, kb0;
            if (G == 256) { nq = bx < 144 ? 1 : bx < 240 ? 2 : 3; qb0 = bx < 144 ? bx : bx < 240 ? 144 + 2 * (bx - 144) : 336 + 3 * (bx - 240); nkv = bx < 144 ? 3 : bx < 240 ? 1 : 0; kb0 = bx < 144 ? 3 * bx : 432 + (bx - 144); }
            else { qb0 = (int)(((long)384 * bx) / G); nq = (int)(((long)384 * (bx + 1)) / G) - qb0; kb0 = (int)(((long)528 * bx) / G); nkv = (int)(((long)528 * (bx + 1)) / G) - kb0; }
            const int k0 = kb0 < 264 ? kb0 : 264, k1 = kb0 + nkv < 264 ? kb0 + nkv : 264;
            const int v0 = (kb0 > 264 ? kb0 : 264) - 264, v1 = (kb0 + nkv > 264 ? kb0 + nkv : 264) - 264;
            { pg8::Gemm g{CQ, WUQ, SEQ, 3072, QL, 0, 0}; pg8::RunOrder S{qb0, nq, 12}; pg8::EpiQ E{Q, ssq_cq, rope, C2 * att::QSC};
              pg8::gemm_phase<pg8::EpiQ, pg8::RunOrder, true, true>(L, g, S, E); }
            { pg8::Gemm g{CKV, WUKV, MR, 2048, KVL, 0, 0}; pg8::RunOrder S{k0, k1 - k0, 8}; pg8::EpiK E{KN, ssq_ckv};
              pg8::gemm_phase<pg8::EpiK, pg8::RunOrder, true, true>(L, g, S, E); }
            { pg8::Gemm g{WUKV + (size_t)2048 * KVL, CKV, 2048, MR, KVL, 0, 0}; pg8::RunOrder S{v0, v1 - v0, 33}; pg8::EpiVT E{VT, ssq_ckv};
              pg8::gemm_phase<pg8::EpiVT, pg8::RunOrder, true, true>(L, g, S, E); }
        }
        for (size_t it = gt; it < (size_t)SEQ * 256; it += NT) {
            const int t = (int)(it >> 8), c8 = (int)(it & 255) * 8; const v4u z = {0u, 0u, 0u, 0u};
            const v4u um = t > 0 ? *(const v4u*)(UCV + (size_t)(t - 1) * 2048 + c8) : z, u0 = *(const v4u*)(UCV + (size_t)t * 2048 + c8), up = t < SEQ - 1 ? *(const v4u*)(UCV + (size_t)(t + 1) * 2048 + c8) : z;
            const v4u gv = *(const v4u*)(GBV + (size_t)t * 2048 + c8); v4u o;
            float w0[8], w1[8], w2[8], wb[8];
#pragma unroll
            for (int q = 0; q < 2; ++q) { const f32x4 a0 = *(const f32x4*)(conv_w + c8 + 4 * q), a1 = *(const f32x4*)(conv_w + 2048 + c8 + 4 * q), a2 = *(const f32x4*)(conv_w + 4096 + c8 + 4 * q), a3 = *(const f32x4*)(conv_b + c8 + 4 * q);
#pragma unroll
                for (int j = 0; j < 4; ++j) { w0[4 * q + j] = a0[j]; w1[4 * q + j] = a1[j]; w2[4 * q + j] = a2[j]; wb[4 * q + j] = a3[j]; } }
#pragma unroll
            for (int j = 0; j < 4; ++j) {
                const float y0 = w0[2 * j] * bflo(um[j]) + w1[2 * j] * bflo(u0[j]) + w2[2 * j] * bflo(up[j]) + wb[2 * j];
                const float y1 = w0[2 * j + 1] * bfhi(um[j]) + w1[2 * j + 1] * bfhi(u0[j]) + w2[2 * j + 1] * bfhi(up[j]) + wb[2 * j + 1];
                o[j] = pk2(bflo(gv[j]) * y0, bfhi(gv[j]) * y1); }
            *(v4u*)(ACAT + (size_t)t * DM + 2048 + c8) = o; }
    }
    GRID_BAR(4);
#ifdef PROBE_CLK
    if (bx == 0 && threadIdx.x == 0) { unsigned long long* ck = (unsigned long long*)(ws + WS_CTL + 524288); ck[0] = __builtin_readcyclecounter(); ck[2] = __builtin_amdgcn_s_memrealtime(); }
#endif

    if (PH_ON(5) && IN(5)) for (int rep_ = 0; rep_ < NREP(5); ++rep_) {
        for (int i = 0;; ++i) { int h, qb;
            if (G == 256) { if (i >= 2) break; h = 2 * (bx & 7) + i; qb = bx >> 3; } else { const int Lu = i * G + bx; if (Lu >= 512) break; h = Lu >> 5; qb = Lu & 31; }
            att::attn_unit<PRB>(Q + (size_t)(qb * 256) * 3072 + h * 192, KN + h * 128, VT + (size_t)(h * 128) * 8448, KR, ACAT + (size_t)(qb * 256) * DM + h * 128, MR, (char*)lds, L, a.probe); }
    }
#ifdef PROBE_CLK
    if (bx == 0 && threadIdx.x == 0) { unsigned long long* ck = (unsigned long long*)(ws + WS_CTL + 524288); ck[1] = __builtin_readcyclecounter(); ck[3] = __builtin_amdgcn_s_memrealtime(); }
#endif
    GRID_BAR(5);

    if (PH_ON(6) && IN(6)) for (int rep_ = 0; rep_ < NREP(6); ++rep_) {
        pg8::Gemm g{ACAT, WO, SEQ, DM, DM, 0, 0}; pg8::StaticOrder S; S.init(SEQ, DM, G, bx); pg8::EpiO E{modf + 2 * DM, DLT};
        pg8::gemm_phase<pg8::EpiO, pg8::StaticOrder, true, true>(L, g, S, E);
    }
    GRID_BAR(6);

    if (PH_ON(7) && IN(7)) for (int rep_ = 0; rep_ < NREP(7); ++rep_) {
        PH_IDS();
        for (int row = gw; row < SEQ; row += NGW) {
            f32x4 v[16]; float ssq[4] = {0.f, 0.f, 0.f, 0.f};
#pragma unroll
            for (int j = 0; j < 16; ++j) { const int idx = 4 * (lane + 64 * j); const unsigned long long d8 = *(const unsigned long long*)(DLT + (size_t)row * DM + idx); const f32x4 xv = *(const f32x4*)(x + (size_t)row * DM + idx);
                v[j][0] = xv[0] + bflo((unsigned)d8); v[j][1] = xv[1] + bfhi((unsigned)d8); v[j][2] = xv[2] + bflo((unsigned)(d8 >> 32)); v[j][3] = xv[3] + bfhi((unsigned)(d8 >> 32));
#pragma unroll
                for (int c = 0; c < 4; ++c) ssq[c] = fmaf(v[j][c], v[j][c], ssq[c]); }
            const float rstd = 1.f / sqrtf(wave_sum((ssq[0] + ssq[1]) + (ssq[2] + ssq[3])) * (1.f / DM) + EPS);
#pragma unroll
            for (int j = 0; j < 16; ++j) { const int idx = 4 * (lane + 64 * j);
                const f32x4 g = *(const f32x4*)(norm2_g + idx), sh = *(const f32x4*)(modf + 3 * DM + idx), sc = *(const f32x4*)(modf + 4 * DM + idx);
                const f32x4 hh = (v[j] * rstd * g) * (sc + 1.f) + sh;
                *(unsigned long long*)(H2 + (size_t)row * DM + idx) = (unsigned long long)pk2(hh[0], hh[1]) | ((unsigned long long)pk2(hh[2], hh[3]) << 32); }
        }
    }
    GRID_BAR(7);

    if (PH_ON(8) && IN(8)) for (int rep_ = 0; rep_ < NREP(8); ++rep_) {
        pg8::Gemm g{H2, KBD, SEQ, 2048, DM, 0, 0}; pg8::StaticOrder S; S.init(SEQ, 2048, G, bx); pg8::EpiF32 E{SC, 2048};
        pg8::gemm_phase<pg8::EpiF32, pg8::StaticOrder, true, true>(L, g, S, E);
    }
    GRID_BAR(8);

    if (PH_ON(9) && IN(9)) for (int rep_ = 0; rep_ < NREP(9); ++rep_) {
        int lane0_ = threadIdx.x; asm volatile("" : "+v"(lane0_)); lane0_ &= 63;
        LAS unsigned* wl = (LAS unsigned*)(L + wave * 8192);
        LAS unsigned* sV1 = wl, *sI1 = wl + 16, *sV2 = wl + 32, *sI2 = wl + 48, *sVc = wl + 64, *sEc = wl + 80;
        LAS unsigned* eL = wl + 128; LAS float* gL = (LAS float*)(wl + 128 + 512);
        const float* gate2 = modf + 5 * DM; const int emask_ = a.probe ? 63 : 0xffff; float* outp_ = a.probe ? (float*)(ws + WS_HX) : a.out;
        for (int tb = gw * 4; tb < SEQ; tb += NGW * 4) {
            for (int ti = 0; ti < 4; ++ti) { const int t = tb + ti; int lane = lane0_; asm volatile("" : "+v"(lane));
                for (int h = 0; h < 8; ++h) { const float* sp = SC + (size_t)t * 2048 + h * 256;
                    { const float s0 = sp[lane], s1 = sp[64 + lane]; const unsigned k[2] = {fkey(s0), fkey(s1)}, vb[2] = {__builtin_bit_cast(unsigned, s0), __builtin_bit_cast(unsigned, s1)}, pl[2] = {(unsigned)lane, (unsigned)(64 + lane)};
                      const unsigned T = kth16<2>(k); compact16<2>(k, vb, pl, T, sV1, sI1, lane); }
                    { const float s0 = sp[128 + lane], s1 = sp[192 + lane]; const unsigned k[2] = {fkey(s0), fkey(s1)}, vb[2] = {__builtin_bit_cast(unsigned, s0), __builtin_bit_cast(unsigned, s1)}, pl[2] = {(unsigned)lane, (unsigned)(64 + lane)};
                      const unsigned T = kth16<2>(k); compact16<2>(k, vb, pl, T, sV2, sI2, lane); }
                    LDS_WAIT();
                    { const float s2b = __builtin_bit_cast(float, sV2[lane & 15]); const unsigned i2b = sI2[lane & 15]; unsigned k[4], vb[4], pl[4];
#pragma unroll
                      for (int r = 0; r < 4; ++r) { const int aa = (lane >> 4) + 4 * r; const float cv = __builtin_bit_cast(float, sV1[aa]) + s2b; k[r] = fkey(cv); vb[r] = __builtin_bit_cast(unsigned, cv); pl[r] = sI1[aa] * 128u + i2b; }
                      const unsigned T = kth16<4>(k); compact16<4>(k, vb, pl, T, sVc, sEc, lane); }
                    LDS_WAIT();
                    { const float tv = __builtin_bit_cast(float, sVc[lane & 15]); const float mx = row16_max(tv);
                      const float ex = expf(tv - mx); const float sm = row16_sum(ex);
                      if (lane < 16) { eL[ti * 128 + h * 16 + lane] = sEc[lane]; gL[ti * 128 + h * 16 + lane] = ex / sm; } }
                    LDS_WAIT();
                }
                { const unsigned e0 = eL[ti * 128 + lane], e1 = eL[ti * 128 + 64 + lane]; const float g0 = gL[ti * 128 + lane], g1 = gL[ti * 128 + 64 + lane];
                  const unsigned k0 = (e0 << 7) | (unsigned)lane, k1 = (e1 << 7) | (unsigned)(64 + lane); int r0 = 0, r1 = 0;
#pragma unroll 8
                  for (int m = 0; m < 128; ++m) { const unsigned km = (eL[ti * 128 + m] << 7) | (unsigned)m; r0 += km < k0 ? 1 : 0; r1 += km < k1 ? 1 : 0; }
                  LDS_WAIT();
                  eL[ti * 128 + r0] = e0; gL[ti * 128 + r0] = g0; eL[ti * 128 + r1] = e1; gL[ti * 128 + r1] = g1;
                  LDS_WAIT(); }
                h16x2 hh[2][16];
#pragma unroll
                for (int b = 0; b < 2; ++b)
#pragma unroll
                    for (int q = 0; q < 8; ++q) { const unsigned long long a0 = *(const unsigned long long*)(H2 + (size_t)t * DM + b * 2048 + q * 256 + lane * 4);
                        hh[b][2 * q] = (h16x2){(_Float16)bflo((unsigned)a0), (_Float16)bfhi((unsigned)a0)}; hh[b][2 * q + 1] = (h16x2){(_Float16)bflo((unsigned)(a0 >> 32)), (_Float16)bfhi((unsigned)(a0 >> 32))}; }
                v4u rr[6][3]; float rs[6];
#define LDROW(j, TAB, e, SOFF) do { const unsigned char* rp_ = (TAB) + (size_t)(e) * ROWB + lane * 16; _Pragma("unroll") for (int p = 0; p < 3; ++p) rr[j][p] = *(const v4u*)(rp_ + p * 1024); rs[j] = SUV[(SOFF) + (e)]; } while (0)
#define EIDX(k) (__builtin_amdgcn_readfirstlane((int)eL[ti * 128 + (k)]) & emask_)
#define UNPKH(j, b) __builtin_amdgcn_cvt_scalef32_pk32_f16_fp6((b) == 0 ? (u32x6v){rr[j][0][0], rr[j][0][1], rr[j][0][2], rr[j][0][3], rr[j][1][0], rr[j][1][1]} : (u32x6v){rr[j][1][2], rr[j][1][3], rr[j][2][0], rr[j][2][1], rr[j][2][2], rr[j][2][3]}, 1.0f)
#define DOTROW(out, j) do { float a0 = 0.f, a1 = 0.f, a2 = 0.f, a3 = 0.f; _Pragma("unroll") for (int b = 0; b < 2; ++b) { const h16x32 x_ = UNPKH(j, b); \
                    _Pragma("unroll") for (int i = 0; i < 16; i += 4) { a0 = __builtin_amdgcn_fdot2((h16x2){x_[2 * i], x_[2 * i + 1]}, hh[b][i], a0, false); a1 = __builtin_amdgcn_fdot2((h16x2){x_[2 * i + 2], x_[2 * i + 3]}, hh[b][i + 1], a1, false); \
                        a2 = __builtin_amdgcn_fdot2((h16x2){x_[2 * i + 4], x_[2 * i + 5]}, hh[b][i + 2], a2, false); a3 = __builtin_amdgcn_fdot2((h16x2){x_[2 * i + 6], x_[2 * i + 7]}, hh[b][i + 3], a3, false); } } \
                    out = (a0 + a1) + (a2 + a3); } while (0)
                int ei[6];
#pragma unroll
                for (int j = 0; j < 6; ++j) { ei[j] = EIDX(j); LDROW(j, UB, ei[j], 0); }
                for (int k0 = 0; k0 < 126; k0 += 6) {
                    float dsum[6];
#pragma unroll
                    for (int j = 0; j < 6; ++j) { float part; DOTROW(part, j); const float sc_ = rs[j];
                        if (k0 + 6 + j < 128) { ei[j] = EIDX(k0 + 6 + j); LDROW(j, UB, ei[j], 0); }
                        dsum[j] = wave_sum(part) * sc_; }
                    if (lane < 6) { float d = dsum[0];
#pragma unroll
                        for (int j = 1; j < 6; ++j) d = lane == j ? dsum[j] : d;
                        gL[ti * 128 + k0 + lane] = gL[ti * 128 + k0 + lane] * gelu_erf(d); }
                }
                { float dsum[2];
#pragma unroll
                  for (int j = 0; j < 2; ++j) { float part; DOTROW(part, j); dsum[j] = wave_sum(part) * rs[j]; }
                  if (lane < 2) { const float d = lane == 0 ? dsum[0] : dsum[1]; gL[ti * 128 + 126 + lane] = gL[ti * 128 + 126 + lane] * gelu_erf(d); } }
                LDS_WAIT();
            }
            for (int ti = 0; ti < 4; ++ti) { const int t = tb + ti; int lane = lane0_; asm volatile("" : "+v"(lane));
                h16x2 ah[2][16];
#pragma unroll
                for (int b = 0; b < 2; ++b)
#pragma unroll
                    for (int i = 0; i < 16; ++i) ah[b][i] = (h16x2){(_Float16)0.f, (_Float16)0.f};
                v4u rr[6][3]; float rs[6];
#define FMAROW(j, WW) do { const _Float16 wh_ = (_Float16)(WW); const h16x2 w2_ = {wh_, wh_}; _Pragma("unroll") for (int b = 0; b < 2; ++b) { const h16x32 x_ = UNPKH(j, b); \
                    _Pragma("unroll") for (int i = 0; i < 16; ++i) ah[b][i] = __builtin_elementwise_fma(w2_, (h16x2){x_[2 * i], x_[2 * i + 1]}, ah[b][i]); } } while (0)
                int ei[6];
#pragma unroll
                for (int j = 0; j < 6; ++j) { ei[j] = EIDX(j); LDROW(j, VB, ei[j], NEXP); }
                for (int k0 = 0; k0 < 126; k0 += 6) {
#pragma unroll
                    for (int j = 0; j < 6; ++j) { FMAROW(j, gL[ti * 128 + k0 + j] * rs[j]);
                        if (k0 + 6 + j < 128) { ei[j] = EIDX(k0 + 6 + j); LDROW(j, VB, ei[j], NEXP); } }
                }
#pragma unroll
                for (int j = 0; j < 2; ++j) FMAROW(j, gL[ti * 128 + 126 + j] * rs[j]);
                float acc[2][32];
#pragma unroll
                for (int b = 0; b < 2; ++b)
#pragma unroll
                    for (int i = 0; i < 16; ++i) { acc[b][2 * i] = (float)ah[b][i][0]; acc[b][2 * i + 1] = (float)ah[b][i][1]; }
                float ssp[4] = {0.f, 0.f, 0.f, 0.f}; int lane_f = lane; asm volatile("" : "+v"(lane_f));
#pragma unroll
                for (int b = 0; b < 2; ++b)
#pragma unroll
                    for (int q = 0; q < 8; ++q) { unsigned o = (unsigned)(b * 2048 + q * 256 + lane_f * 4); asm volatile("" : "+v"(o)); const unsigned long long d8 = *(const unsigned long long*)(DLT + (size_t)t * DM + o); f32x4 xa = *(const f32x4*)(x + (size_t)t * DM + o); const f32x4 ga = *(const f32x4*)(gate2 + o);
                        xa[0] += bflo((unsigned)d8); xa[1] += bfhi((unsigned)d8); xa[2] += bflo((unsigned)(d8 >> 32)); xa[3] += bfhi((unsigned)(d8 >> 32));
#pragma unroll
                        for (int j = 0; j < 4; ++j) { acc[b][4 * q + j] = fmaf(ga[j], acc[b][4 * q + j], xa[j]); ssp[j] = fmaf(acc[b][4 * q + j], acc[b][4 * q + j], ssp[j]); }
                        if ((q & 1) == 1) asm volatile("" ::: "memory"); }
                const float ss = wave_sum((ssp[0] + ssp[1]) + (ssp[2] + ssp[3])); const float rstd = 1.f / sqrtf(ss * (1.f / DM) + EPS);
#pragma unroll
                for (int b = 0; b < 2; ++b)
#pragma unroll
                    for (int q = 0; q < 8; ++q) { unsigned o = (unsigned)(b * 2048 + q * 256 + lane_f * 4); asm volatile("" : "+v"(o)); const f32x4 fa = *(const f32x4*)(final_g + o); f32x4 oa;
#pragma unroll
                        for (int j = 0; j < 4; ++j) oa[j] = acc[b][4 * q + j] * rstd * fa[j];
                        *(f32x4*)(outp_ + (size_t)t * DM + o) = oa; if ((q & 1) == 1) asm volatile("" ::: "memory"); }
            }
            LDS_WAIT();
#undef LDROW
#undef EIDX
#undef DOTROW
#undef FMAROW
#undef UNPKH
        }
    }
#undef IN
#undef GRID_BAR
}

__global__ void __launch_bounds__(NTHR, 2) fwd(Args a) { fwd_body<0, false>(a); }
#ifdef PROBE_PHASES
#ifndef PROBE_MODE
#define PROBE_MODE 0
#endif
__global__ void __launch_bounds__(NTHR, 2) fwd_p(Args a) { fwd_body<PROBE_MODE, true>(a); }
#endif

#ifdef PROBE_MX
typedef int v8i_t __attribute__((ext_vector_type(8)));
typedef float v16f_t __attribute__((ext_vector_type(16)));
__device__ __forceinline__ unsigned char f8enc(int v) {
    if (v == 0) return 0; int e = 0; int m = v; while (m >= 2) { m >>= 1; ++e; } const int frac = (v << 3 >> e) & 7; return (unsigned char)(((e + 7) << 3) | frac); }
__global__ void probe_mx(float* out) {
    const int l = threadIdx.x, r = l & 31, h = l >> 5;
    float code = 0.f;
    for (int hyp = 0; hyp < 2; ++hyp) {
        unsigned char ab[32], bb[32];
        for (int j = 0; j < 32; ++j) { const int k = hyp == 0 ? 32 * h + j : (j < 16 ? 16 * h + j : 32 + 16 * h + (j - 16));
            ab[j] = f8enc(k == (7 * r + 3) % 64 ? 1 : 0); bb[j] = f8enc(1 + ((k + 3 * r) % 13)); }
        v8i_t A, B;
        for (int d = 0; d < 8; ++d) { A[d] = ab[4 * d] | (ab[4 * d + 1] << 8) | (ab[4 * d + 2] << 16) | (ab[4 * d + 3] << 24); B[d] = bb[4 * d] | (bb[4 * d + 1] << 8) | (bb[4 * d + 2] << 16) | (bb[4 * d + 3] << 24); }
        v16f_t c = {};
        c = __builtin_amdgcn_mfma_scale_f32_32x32x64_f8f6f4(A, B, c, 0, 0, 0, 0x7F7F7F7F, 0, 0x7F7F7F7F);
        bool ok = true;
        for (int g = 0; g < 16; ++g) { const int row = (g & 3) + 8 * (g >> 2) + 4 * h, col = r; const int kk = (7 * row + 3) % 64; const float expect = (float)(1 + ((kk + 3 * col) % 13)); ok = ok && (c[g] == expect); }
        const bool all_ok = __all(ok);
        if (all_ok) code += (hyp == 0 ? 1.f : 2.f);
    }
    if (l == 0) out[0] = 1000.f * (1.f + code);
}
#endif

#ifdef PROBE_STAMP
__global__ void probe_stamp_k(float* out) { if (threadIdx.x == 0) { const double v = (double)att::g_stamp[PROBE_STAMP / 10][PROBE_STAMP % 10] / 262.0; out[0] = 200.f * (float)(int)(v / 200.0 + 0.5); for (int w = 0; w < 8; ++w) for (int k = 0; k < 6; ++k) att::g_stamp[w][k] = 0ull; } }
#endif
#ifdef PROBE_CLK
__global__ void probe_clk_k(const unsigned long long* c, float* out) { if (threadIdx.x == 0) { const double cyc = (double)(c[1] - c[0]), tk = (double)(c[3] - c[2]); out[0] = PROBE_CLK == 1 ? 300.f * (float)(int)(cyc / 264.0 / 300.0 + 0.5) : 4000.f * (float)(int)(cyc / tk / 4.0 + 0.5); } }
#endif
extern "C" void kernel_launch(void* const* d_in, const int* in_sizes, int n_in, void* d_out, int out_size, void* d_ws, size_t ws_size, hipStream_t stream) {
    static int grid = 0;
    if (grid == 0) {
        if (n_in != 21 || in_sizes[0] != SEQ * DM || out_size != SEQ * DM || ws_size < WS_END) {
            fprintf(stderr, "kernel_launch: built for 21 inputs, x/out of %d floats, >= %zu bytes of workspace; got n_in %d, in0 %d, out %d, ws %zu; nothing launched\n", SEQ * DM, (size_t)WS_END, n_in, n_in > 0 ? in_sizes[0] : -1, out_size, ws_size); grid = -1; return; }
        int dev = 0, cus = 0, per_cu = 0;
        if (hipGetDevice(&dev) != hipSuccess || hipDeviceGetAttribute(&cus, hipDeviceAttributeMultiprocessorCount, dev) != hipSuccess) { fprintf(stderr, "kernel_launch: device query failed\n"); grid = -1; return; }
        if (hipFuncSetAttribute((const void*)fwd, hipFuncAttributeMaxDynamicSharedMemorySize, LDS_BYTES) != hipSuccess) { fprintf(stderr, "kernel_launch: hipFuncSetAttribute failed\n"); grid = -1; return; }
        if (hipOccupancyMaxActiveBlocksPerMultiprocessor(&per_cu, (const void*)fwd, NTHR, LDS_BYTES) != hipSuccess || per_cu < 1) fprintf(stderr, "kernel_launch: note: occupancy query reports %d workgroups per CU\n", per_cu);
        (void)hipGetLastError();
        grid = cus;
    }
    if (grid < 0) return;
    if (hipMemsetAsync((char*)d_ws + WS_CTL, 0, CTL_ZERO_BYTES, stream) != hipSuccess) { fprintf(stderr, "kernel_launch: memset failed\n"); return; }
    Args a{};
    for (int i = 0; i < 21; ++i) a.in[i] = (const float*)d_in[i];
    a.out = (float*)d_out; a.ws = (unsigned char*)d_ws;
#if MK_ONE_LAUNCH
    a.ph_lo = 0; a.ph_hi = NPHASE;
    hipLaunchKernelGGL(fwd, dim3(grid), dim3(NTHR), LDS_BYTES, stream, a);
#ifndef PROBE_MODE
#define PROBE_MODE 0
#endif
#ifdef PROBE_PHASES
    for (int p = 0; p < NPHASE; ++p) if ((PROBE_PHASES >> p) & 1) { a.ph_lo = p; a.ph_hi = p + 1; a.probe = PROBE_MODE; hipFuncSetAttribute((const void*)fwd_p, hipFuncAttributeMaxDynamicSharedMemorySize, LDS_BYTES); hipLaunchKernelGGL(fwd_p, dim3(grid), dim3(NTHR), LDS_BYTES, stream, a); }
#endif
#else
    for (int p = 0; p < NPHASE; ++p) { a.ph_lo = p; a.ph_hi = p + 1; hipLaunchKernelGGL(fwd, dim3(grid), dim3(NTHR), LDS_BYTES, stream, a); }
#endif
#ifdef PROBE_STAMP
    hipLaunchKernelGGL(probe_stamp_k, dim3(1), dim3(64), 0, stream, (float*)d_out);
#endif
#ifdef PROBE_UB
    hipFuncSetAttribute((const void*)probe_ub, hipFuncAttributeMaxDynamicSharedMemorySize, LDS_BYTES);
    hipLaunchKernelGGL(probe_ub, dim3(256), dim3(512), LDS_BYTES, stream, (float*)((char*)d_ws + WS_CTL + 600000), 400);
#endif
#ifdef PROBE_CLK
    hipLaunchKernelGGL(probe_clk_k, dim3(1), dim3(64), 0, stream, (const unsigned long long*)((char*)d_ws + WS_CTL + 524288), (float*)d_out);
#endif
#ifdef PROBE_MX
    hipLaunchKernelGGL(probe_mx, dim3(1), dim3(64), 0, stream, (float*)d_out);
#endif
    const hipError_t le = hipPeekAtLastError();
    if (le != hipSuccess) fprintf(stderr, "kernel_launch: launch failed: %s\n", hipGetErrorName(le));
}
```

```cpp
#include <hip/hip_runtime.h>
#include <cstdio>
#include <cstdint>
#include <cmath>
namespace pg8 {
#define PG8_LAS __attribute__((address_space(3)))
typedef unsigned short bf16_t;
typedef short bf16x8 __attribute__((ext_vector_type(8)));
typedef float f32x4 __attribute__((ext_vector_type(4)));
typedef unsigned u32x4 __attribute__((ext_vector_type(4)));
constexpr int BM = 256, BK = 64, HALF = 128, HTB = HALF * BK * 2  , STAGE_BYTES = 8 * HTB, NXCD = 8, WGM = 8;

__host__ __device__ __forceinline__ int lds_byte(int r, int c) { const int st = (r >> 4) * 2 + (c >> 5), rr = r & 15, cc = c & 31, ob = rr * 64 + cc * 2; return st * 1024 + (ob ^ (((ob >> 9) & 1) << 5)); }
__host__ __device__ __forceinline__ void stage_rc(int b, int& R, int& C) { const int st = b / 1024, sb = b % 1024, swz = sb ^ (((sb >> 9) & 1) << 5); R = (st >> 1) * 16 + swz / 64; C = (st & 1) * 32 + (swz % 64) / 2; }
__host__ __device__ __forceinline__ int perm32(int rho) { const int n = rho >> 4, i = rho & 15; return 8 * (i >> 2) + 4 * n + (i & 3); }

struct Unit { int pm, pn; };
struct Gemm { const bf16_t* A; const bf16_t* Bt; int M, N, K; size_t a_pn; size_t b_pm; };

struct StaticOrder {
    int nM, nN, nwg, G, c;
    __host__ __device__ void init(int M, int N, int G_, int c_) { nM = M / BM; nN = N / BM; nwg = nM * nN; G = G_; c = c_; }
    __host__ __device__ bool next(int i, Unit& u) const {
        const long L = (long)i * G + c; if (L >= nwg) return false;
        int wgid = (int)L; { const int q = nwg / NXCD, r = nwg % NXCD, xcd = wgid % NXCD, off = wgid / NXCD; wgid = (xcd < r ? xcd * (q + 1) : r * (q + 1) + (xcd - r) * q) + off; }
        const int nig = WGM * nN, gid = wgid / nig, fm = gid * WGM, gsz = (nM - fm) < WGM ? (nM - fm) : WGM;
        u.pm = fm + ((wgid % nig) % gsz); u.pn = (wgid % nig) / gsz; return true;
    }
    __device__ __forceinline__ void a_ready(const Unit&) const {}
    __device__ __forceinline__ void done(const Unit&) const {}
};

__device__ __forceinline__ unsigned cvt_pk_bf16(float lo, float hi) { unsigned r; asm volatile("v_cvt_pk_bf16_f32 %0, %1, %2" : "=v"(r) : "v"(lo), "v"(hi)); return r; }
typedef float f32x2 __attribute__((ext_vector_type(2)));
__device__ __forceinline__ f32x2 gelu_pk(f32x2 v) {
    const f32x2 av = __builtin_elementwise_abs(v), d = av * 0.2316418882f + 1.0f;
    f32x2 t; t.x = __builtin_amdgcn_rcpf(d.x); t.y = __builtin_amdgcn_rcpf(d.y);
    f32x2 q = t * 0.5307027145f + (-0.7265760135f); q = q * t + 0.7107068705f; q = q * t + (-0.142248368f); q = q * t + 0.127414796f; q = q * t;
    const f32x2 s = (v * v) * (-0.72134752044f);
    f32x2 e; e.x = __builtin_amdgcn_exp2f(s.x); e.y = __builtin_amdgcn_exp2f(s.y);
    const f32x2 m = v * (q * e), r = v - m;
    f32x2 o; o.x = v.x < 0.f ? m.x : r.x; o.y = v.y < 0.f ? m.y : r.y; return o;
}


__device__ __forceinline__ u32x4 pack8(f32x4 v0, f32x4 v1) { u32x4 w; w.x = cvt_pk_bf16(v0[0], v0[1]); w.y = cvt_pk_bf16(v0[2], v0[3]); w.z = cvt_pk_bf16(v1[0], v1[1]); w.w = cvt_pk_bf16(v1[2], v1[3]); return w; }
__device__ __forceinline__ unsigned long long pack8_fp8(f32x4 v0, f32x4 v1) { int lo = __builtin_amdgcn_cvt_pk_fp8_f32(v0[0], v0[1], 0, false); lo = __builtin_amdgcn_cvt_pk_fp8_f32(v0[2], v0[3], lo, true);
    int hi = __builtin_amdgcn_cvt_pk_fp8_f32(v1[0], v1[1], 0, false); hi = __builtin_amdgcn_cvt_pk_fp8_f32(v1[2], v1[3], hi, true); return (unsigned long long)(unsigned)lo | ((unsigned long long)(unsigned)hi << 32); }
__device__ __forceinline__ float quad_row_sum(float s) { s += __shfl_xor(s, 16); s += __shfl_xor(s, 32); return s; }

__device__ __forceinline__ f32x4 rope4(f32x4 v, const float* tab, int i) {
    const f32x4 cs = *(const f32x4*)(tab + 2 * i);
    f32x4 o; o[0] = v[0] * cs[0] - v[1] * cs[1]; o[1] = v[1] * cs[0] + v[0] * cs[1]; o[2] = v[2] * cs[2] - v[3] * cs[3]; o[3] = v[3] * cs[2] + v[2] * cs[3]; return o;
}

struct EpiIn {
    static constexpr bool PERM = true, AFTER_DRAIN = false;
    bf16_t* cq; bf16_t* ckv; unsigned char* kr; bf16_t* ub; bf16_t* gb; float* ssq_cq; float* ssq_ckv; const float* rope;
    __device__ __forceinline__ void operator()(const f32x4 (&acc)[2][2][4][2], const Unit& u, int wr, int wc, int fr, int fq) const {
        const int pn = u.pn, row0 = u.pm * BM + wr * 64 + fr, cw = wc * 32 + 8 * fq;
        if (pn < 5) {
            bf16_t* dst = pn < 3 ? cq : ckv; const int ld = pn < 3 ? 768 : 512, pl = pn < 3 ? pn : pn - 3, coff = pl * 256 + cw, nsl = pn < 3 ? 12 : 8; float* ssq = pn < 3 ? ssq_cq : ssq_ckv;
#pragma unroll
            for (int ai = 0; ai < 2; ++ai)
#pragma unroll
                for (int m = 0; m < 4; ++m) { const int row = row0 + ai * HALF + m * 16; float s = 0.f;
#pragma unroll
                    for (int bj = 0; bj < 2; ++bj) { const f32x4 v0 = acc[ai][bj][m][0], v1 = acc[ai][bj][m][1];
                        s += (v0[0] * v0[0] + v0[1] * v0[1]) + (v0[2] * v0[2] + v0[3] * v0[3]) + (v1[0] * v1[0] + v1[1] * v1[1]) + (v1[2] * v1[2] + v1[3] * v1[3]);
                        *(u32x4*)(dst + (size_t)row * ld + coff + bj * HALF) = pack8(v0, v1); }
                    s = quad_row_sum(s); if (fq == 0) ssq[(size_t)row * nsl + pl * 4 + wc] = s; }
        } else if (pn == 5) {
            if (wc < 2) {
#pragma unroll
                for (int ai = 0; ai < 2; ++ai)
#pragma unroll
                    for (int m = 0; m < 4; ++m) { const int row = row0 + ai * HALF + m * 16; f32x4 v0 = acc[ai][0][m][0], v1 = acc[ai][0][m][1];
                        if (row < 8192) { const int pos = wc == 0 ? (row >> 6) : 128 + (row & 63); const float* tab = rope + pos * 32; v0 = rope4(v0, tab, 4 * fq); v1 = rope4(v1, tab, 4 * fq + 2); }
                        *(unsigned long long*)(kr + (size_t)row * 64 + cw) = pack8_fp8(v0, v1); }
            }
        } else if (pn < 22) {
            const int j = pn - 6;
#pragma unroll
            for (int ai = 0; ai < 2; ++ai)
#pragma unroll
                for (int m = 0; m < 4; ++m) { const int row = row0 + ai * HALF + m * 16;
                    *(u32x4*)(ub + (size_t)row * 2048 + j * 128 + cw) = pack8(acc[ai][0][m][0] * acc[ai][1][m][0], acc[ai][0][m][1] * acc[ai][1][m][1]); }
        } else {
            const int j = pn - 22;
#pragma unroll
            for (int ai = 0; ai < 2; ++ai)
#pragma unroll
                for (int m = 0; m < 4; ++m) { const int row = row0 + ai * HALF + m * 16;
#pragma unroll
                    for (int bj = 0; bj < 2; ++bj) *(u32x4*)(gb + (size_t)row * 2048 + j * 256 + bj * HALF + cw) = pack8(acc[ai][bj][m][0], acc[ai][bj][m][1]); }
        }
    }
};

struct EpiQ {
    static constexpr bool PERM = true, AFTER_DRAIN = false;
    unsigned char* q; const float* ssq_cq; const float* rope; float c2;
    __device__ __forceinline__ void operator()(const f32x4 (&acc)[2][2][4][2], const Unit& u, int wr, int wc, int fr, int fq) const {
        const int row0 = u.pm * BM + wr * 64 + fr, cw = wc * 32 + 8 * fq;
#pragma unroll
        for (int ai = 0; ai < 2; ++ai)
#pragma unroll
            for (int m = 0; m < 4; ++m) { const int row = row0 + ai * HALF + m * 16; const f32x4 q0 = *(const f32x4*)(ssq_cq + (size_t)row * 12), q1 = *(const f32x4*)(ssq_cq + (size_t)row * 12 + 4), q2 = *(const f32x4*)(ssq_cq + (size_t)row * 12 + 8);
                const float ssum = (((q0[0] + q0[1]) + (q0[2] + q0[3])) + ((q1[0] + q1[1]) + (q1[2] + q1[3]))) + ((q2[0] + q2[1]) + (q2[2] + q2[3])); const float sc = c2 / sqrtf(ssum * (1.f / 768.f) + 1e-6f);
#pragma unroll
                for (int bj = 0; bj < 2; ++bj) { const int col = u.pn * BM + bj * HALF + cw, d = col % 192; f32x4 v0 = acc[ai][bj][m][0] * sc, v1 = acc[ai][bj][m][1] * sc;
                    if (d >= 128) { const int p = d - 128, ax = p >> 5, i = (p & 31) >> 1; const int pos = ax == 0 ? (row >> 6) : 128 + (row & 63); const float* tab = rope + pos * 32;
                        v0 = rope4(v0, tab, i); v1 = rope4(v1, tab, i + 2); }
                    *(unsigned long long*)(q + (size_t)row * 3072 + col) = pack8_fp8(v0, v1); } }
    }
};

struct EpiK {
    static constexpr bool PERM = true, AFTER_DRAIN = false;
    unsigned char* kn; const float* ssq_ckv;
    __device__ __forceinline__ void operator()(const f32x4 (&acc)[2][2][4][2], const Unit& u, int wr, int wc, int fr, int fq) const {
        const int row0 = u.pm * BM + wr * 64 + fr, cw = u.pn * BM + wc * 32 + 8 * fq;
#pragma unroll
        for (int ai = 0; ai < 2; ++ai)
#pragma unroll
            for (int m = 0; m < 4; ++m) { const int row = row0 + ai * HALF + m * 16; const f32x4 q0 = *(const f32x4*)(ssq_ckv + (size_t)row * 8), q1 = *(const f32x4*)(ssq_ckv + (size_t)row * 8 + 4);
                const float ssum = ((q0[0] + q0[1]) + (q0[2] + q0[3])) + ((q1[0] + q1[1]) + (q1[2] + q1[3])); const float sc = 1.f / sqrtf(ssum * (1.f / 512.f) + 1e-6f);
#pragma unroll
                for (int bj = 0; bj < 2; ++bj) *(unsigned long long*)(kn + (size_t)row * 2048 + cw + bj * HALF) = pack8_fp8(acc[ai][bj][m][0] * sc, acc[ai][bj][m][1] * sc); }
    }
};

struct EpiVT {
    static constexpr bool PERM = true, AFTER_DRAIN = false;
    unsigned char* vt; const float* ssq_ckv;
    __device__ __forceinline__ void operator()(const f32x4 (&acc)[2][2][4][2], const Unit& u, int wr, int wc, int fr, int fq) const {
        const int row0 = u.pm * BM + wr * 64 + fr, key0 = u.pn * BM + wc * 32 + 8 * fq;
        f32x4 rs[2][2];
#pragma unroll
        for (int bj = 0; bj < 2; ++bj)
#pragma unroll
            for (int n = 0; n < 2; ++n)
#pragma unroll
                for (int j = 0; j < 4; ++j) { const int key = key0 + bj * HALF + 4 * n + j; const f32x4 q0 = *(const f32x4*)(ssq_ckv + (size_t)key * 8), q1 = *(const f32x4*)(ssq_ckv + (size_t)key * 8 + 4);
                    const float ssum = ((q0[0] + q0[1]) + (q0[2] + q0[3])) + ((q1[0] + q1[1]) + (q1[2] + q1[3])); rs[bj][n][j] = 1.f / sqrtf(ssum * (1.f / 512.f) + 1e-6f); }
#pragma unroll
        for (int ai = 0; ai < 2; ++ai)
#pragma unroll
            for (int m = 0; m < 4; ++m) { const int row = row0 + ai * HALF + m * 16;
#pragma unroll
                for (int bj = 0; bj < 2; ++bj) { const int key8 = key0 + bj * HALF, g = (key8 & 63) >> 3; unsigned char* dst = vt + (size_t)row * 8448 + (key8 & ~63) + 16 * (g >> 2) + 4 * (g & 3);
                    const f32x4 v0 = acc[ai][bj][m][0] * rs[bj][0], v1 = acc[ai][bj][m][1] * rs[bj][1];
                    int w0 = __builtin_amdgcn_cvt_pk_fp8_f32(v0[0], v0[1], 0, false); w0 = __builtin_amdgcn_cvt_pk_fp8_f32(v0[2], v0[3], w0, true);
                    int w1 = __builtin_amdgcn_cvt_pk_fp8_f32(v1[0], v1[1], 0, false); w1 = __builtin_amdgcn_cvt_pk_fp8_f32(v1[2], v1[3], w1, true);
                    *(int*)dst = w0; *(int*)(dst + 32) = w1; } }
    }
};

struct EpiO {
    static constexpr bool PERM = true, AFTER_DRAIN = false;
    const float* gate; bf16_t* dlt;
    __device__ __forceinline__ void operator()(const f32x4 (&acc)[2][2][4][2], const Unit& u, int wr, int wc, int fr, int fq) const {
        const int row0 = u.pm * BM + wr * 64 + fr, c0 = u.pn * BM + wc * 32 + 8 * fq;
        f32x4 g[2][2];
#pragma unroll
        for (int bj = 0; bj < 2; ++bj)
#pragma unroll
            for (int n = 0; n < 2; ++n) g[bj][n] = *(const f32x4*)(gate + c0 + bj * HALF + 4 * n);
#pragma unroll
        for (int ai = 0; ai < 2; ++ai)
#pragma unroll
            for (int m = 0; m < 4; ++m) { const int row = row0 + ai * HALF + m * 16;
#pragma unroll
                for (int bj = 0; bj < 2; ++bj) *(u32x4*)(dlt + (size_t)row * 4096 + c0 + bj * HALF) = pack8(g[bj][0] * acc[ai][bj][m][0], g[bj][1] * acc[ai][bj][m][1]); }
    }
};

struct EpiPQ {
    static constexpr bool PERM = true, AFTER_DRAIN = false;
    bf16_t* qp;
    __device__ __forceinline__ void operator()(const f32x4 (&acc)[2][2][4][2], const Unit& u, int wr, int wc, int fr, int fq) const {
        const int row0 = u.pm * BM + wr * 64 + fr, cw = wc * 32 + 8 * fq; bf16_t* base = qp + (size_t)u.pn * 8192 * 256;
#pragma unroll
        for (int ai = 0; ai < 2; ++ai)
#pragma unroll
            for (int m = 0; m < 4; ++m) { const int row = row0 + ai * HALF + m * 16;
#pragma unroll
                for (int bj = 0; bj < 2; ++bj) *(u32x4*)(base + (size_t)row * 256 + bj * HALF + cw) = pack8(acc[ai][bj][m][0], acc[ai][bj][m][1]); }
    }
};

struct EpiB16 {
    static constexpr bool PERM = true, AFTER_DRAIN = false;
    bf16_t* o; int ldc;
    __device__ __forceinline__ void operator()(const f32x4 (&acc)[2][2][4][2], const Unit& u, int wr, int wc, int fr, int fq) const {
        const int row0 = u.pm * BM + wr * 64 + fr, c0 = u.pn * BM + wc * 32 + 8 * fq;
#pragma unroll
        for (int ai = 0; ai < 2; ++ai)
#pragma unroll
            for (int m = 0; m < 4; ++m) { const int row = row0 + ai * HALF + m * 16;
#pragma unroll
                for (int bj = 0; bj < 2; ++bj) *(u32x4*)(o + (size_t)row * ldc + c0 + bj * HALF) = pack8(acc[ai][bj][m][0], acc[ai][bj][m][1]); }
    }
};

struct EpiF32 {
    static constexpr bool PERM = true, AFTER_DRAIN = false;
    float* o; int ldc;
    __device__ __forceinline__ void operator()(const f32x4 (&acc)[2][2][4][2], const Unit& u, int wr, int wc, int fr, int fq) const {
        const int row0 = u.pm * BM + wr * 64 + fr, c0 = u.pn * BM + wc * 32 + 8 * fq;
#pragma unroll
        for (int ai = 0; ai < 2; ++ai)
#pragma unroll
            for (int m = 0; m < 4; ++m) { const int row = row0 + ai * HALF + m * 16;
#pragma unroll
                for (int bj = 0; bj < 2; ++bj)
#pragma unroll
                    for (int n = 0; n < 2; ++n) *(f32x4*)(o + (size_t)row * ldc + c0 + bj * HALF + 4 * n) = acc[ai][bj][m][n]; }
    }
};

struct OrderIn : StaticOrder {
    __device__ bool next(int i, Unit& u) const {
        const long L = (long)i * G + c;
        if (L < nwg) return StaticOrder::next(i, u);
        if (L < nwg + 3) { u.pm = 32; u.pn = 3 + (int)(L - nwg); return true; }
        return false;
    }
};

struct RunOrder {
    int base, cnt, nN;
    __device__ bool next(int i, Unit& u) const { if (i >= cnt) return false; const int idx = base + i; u.pm = idx / nN; u.pn = idx % nN; return true; }
    __device__ __forceinline__ void a_ready(const Unit&) const {}
    __device__ __forceinline__ void done(const Unit&) const {}
};
template <class Epi, class Sched, bool ALIGN_EPI = false, bool SP2 = false>
__device__ __forceinline__ void gemm_phase(PG8_LAS unsigned char* lds, const Gemm g, const Sched& S, const Epi& E) {
    int tid_o_ = threadIdx.x; asm volatile("" : "+v"(tid_o_));
    const int tid = tid_o_, wid = __builtin_amdgcn_readfirstlane(tid >> 6), lane = tid & 63, wr = wid >> 2, wc = wid & 3, fr = lane & 15, fq = lane >> 4;
    const int K = g.K, nt = K / BK;
    unsigned voffA[2], voffB[2];
#pragma unroll
    for (int i = 0; i < 2; ++i) { int R, C; stage_rc(tid * 16 + i * 8192, R, C); const int Rb = Epi::PERM ? ((R & ~31) + perm32(R & 31)) : R;
        voffA[i] = (unsigned)(R * K + C) * 2u; voffB[i] = (unsigned)(Rb * K + C) * 2u; }
    const size_t kstep = (size_t)(BK * 2);
    const size_t hstep = (size_t)HALF * K * 2;
    const size_t tstep = 2 * hstep;
    const unsigned ldsw = (unsigned)wid * 1024u;
    const int aoff = lds_byte(wr * 64 + fr, fq * 8), boff = lds_byte(wc * 32 + fr, fq * 8);
#define PG8_SA(b, h) (((b) * 2 + (h)) * HTB)
#define PG8_SB(b, h) ((4 + (b) * 2 + (h)) * HTB)
#define PG8_STAGE(bufoff, gbase, voff) do { _Pragma("unroll") for (int _i = 0; _i < 2; ++_i) \
        __builtin_amdgcn_global_load_lds((const unsigned*)((const char*)(gbase) + (voff)[_i]), (PG8_LAS unsigned*)(lds + (bufoff) + ldsw + _i * 8192), 16, 0, 0); } while (0)
#define PG8_LDA(dst, b, h) do { _Pragma("unroll") for (int m = 0; m < 4; ++m) _Pragma("unroll") for (int k = 0; k < 2; ++k) dst[m][k] = *(const PG8_LAS bf16x8*)(lds + PG8_SA(b, h) + aoff + m * 2048 + k * 1024); } while (0)
#define PG8_LDB(dst, b, h) do { _Pragma("unroll") for (int n = 0; n < 2; ++n) _Pragma("unroll") for (int k = 0; k < 2; ++k) dst[n][k] = *(const PG8_LAS bf16x8*)(lds + PG8_SB(b, h) + boff + n * 2048 + k * 1024); } while (0)
#define PG8_MMA(ai, bj, At, Bt) do { __builtin_amdgcn_s_setprio(1); _Pragma("unroll") for (int m = 0; m < 4; ++m) _Pragma("unroll") for (int n = 0; n < 2; ++n) _Pragma("unroll") for (int k = 0; k < 2; ++k) \
        acc[ai][bj][m][n] = __builtin_amdgcn_mfma_f32_16x16x32_bf16(Bt[n][k], At[m][k], acc[ai][bj][m][n], 0, 0, 0); __builtin_amdgcn_s_setprio(0); } while (0)
#define PG8_WAIT_V(n) asm volatile("s_waitcnt vmcnt(" #n ")" ::: "memory")
#define PG8_WAIT_L(n) asm volatile("s_waitcnt lgkmcnt(" #n ")" ::: "memory")
#define PG8_BAR __builtin_amdgcn_s_barrier()
#define PG8_SCHED __builtin_amdgcn_sched_barrier(0)
    Unit cur, nxt; int ui = 0;
    if (!S.next(0, cur)) return;
    f32x4 acc[2][2][4][2];
#pragma unroll
    for (int a = 0; a < 2; ++a)
#pragma unroll
        for (int b = 0; b < 2; ++b)
#pragma unroll
            for (int m = 0; m < 4; ++m)
#pragma unroll
                for (int n = 0; n < 2; ++n) acc[a][b][m][n] = (f32x4){0.f, 0.f, 0.f, 0.f};
    bf16x8 At[4][2], B0[2][2], B1[2][2];
    const char* cA = (const char*)g.A + (size_t)cur.pm * tstep + (size_t)cur.pn * g.a_pn; const char* cB = (const char*)g.Bt + (size_t)cur.pn * tstep + (size_t)cur.pm * g.b_pm;
    S.a_ready(cur);
    if constexpr (SP2) {
        PG8_STAGE(PG8_SB(0, 0), cB, voffB); PG8_STAGE(PG8_SB(0, 1), cB + hstep, voffB); PG8_STAGE(PG8_SA(0, 0), cA, voffA); PG8_STAGE(PG8_SA(0, 1), cA + hstep, voffA);
        if (wr == 1) PG8_BAR;
        PG8_WAIT_V(2); PG8_BAR;
        PG8_STAGE(PG8_SB(1, 0), cB + kstep, voffB); PG8_STAGE(PG8_SA(1, 0), cA + kstep, voffA); PG8_STAGE(PG8_SB(1, 1), cB + hstep + kstep, voffB);
        PG8_WAIT_V(6); PG8_BAR;
    } else {
        PG8_STAGE(PG8_SB(0, 0), cB, voffB); PG8_STAGE(PG8_SA(0, 0), cA, voffA); PG8_STAGE(PG8_SB(0, 1), cB + hstep, voffB); PG8_STAGE(PG8_SA(0, 1), cA + hstep, voffA);
        if (wr == 1) PG8_BAR;
        PG8_WAIT_V(4); PG8_BAR;
        PG8_STAGE(PG8_SB(1, 0), cB + kstep, voffB); PG8_STAGE(PG8_SA(1, 0), cA + kstep, voffA); PG8_STAGE(PG8_SB(1, 1), cB + hstep + kstep, voffB);
        PG8_WAIT_V(6); PG8_BAR;
    }
    for (;;) {
        const bool has_next = S.next(ui + 1, nxt);
        const char* nA = has_next ? (const char*)g.A + (size_t)nxt.pm * tstep + (size_t)nxt.pn * g.a_pn : cA; const char* nB = has_next ? (const char*)g.Bt + (size_t)nxt.pn * tstep + (size_t)nxt.pm * g.b_pm : cB;
        for (int t = 0; t < nt; t += 2) {
            const bool last = (t == nt - 2);
            const char* a1 = cA + (size_t)(t + 1) * kstep;
            const char* a2 = last ? nA : cA + (size_t)(t + 2) * kstep; const char* b2 = last ? nB : cB + (size_t)(t + 2) * kstep;
            const char* a3 = a2 + kstep; const char* b3 = b2 + kstep;
            if (last && has_next) S.a_ready(nxt);
            if constexpr (SP2) {
            PG8_LDB(B0, 0, 0); PG8_LDB(B1, 0, 1); PG8_SCHED; PG8_LDA(At, 0, 0); PG8_STAGE(PG8_SA(1, 1), a1 + hstep, voffA);
            PG8_WAIT_V(8); PG8_WAIT_L(0); PG8_BAR; PG8_MMA(0, 0, At, B0); PG8_MMA(0, 1, At, B1); PG8_BAR; PG8_SCHED;
            PG8_LDA(At, 0, 1); PG8_STAGE(PG8_SB(0, 0), b2, voffB); PG8_STAGE(PG8_SB(0, 1), b2 + hstep, voffB); PG8_STAGE(PG8_SA(0, 0), a2, voffA);
            PG8_WAIT_V(8); PG8_WAIT_L(0); PG8_BAR; PG8_MMA(1, 0, At, B0); PG8_MMA(1, 1, At, B1); PG8_BAR; PG8_SCHED;
            PG8_LDB(B0, 1, 0); PG8_LDB(B1, 1, 1); PG8_SCHED; PG8_LDA(At, 1, 0); PG8_STAGE(PG8_SA(0, 1), a2 + hstep, voffA);
            PG8_WAIT_V(8); PG8_WAIT_L(0); PG8_BAR; PG8_MMA(0, 0, At, B0); PG8_MMA(0, 1, At, B1); PG8_BAR; PG8_SCHED;
            PG8_LDA(At, 1, 1); PG8_STAGE(PG8_SB(1, 0), b3, voffB); PG8_STAGE(PG8_SB(1, 1), b3 + hstep, voffB); PG8_STAGE(PG8_SA(1, 0), a3, voffA);
            PG8_WAIT_V(8); PG8_WAIT_L(0); PG8_BAR; PG8_MMA(1, 0, At, B0); PG8_MMA(1, 1, At, B1); PG8_BAR; PG8_SCHED;
            } else {
            PG8_LDB(B0, 0, 0); PG8_SCHED; PG8_LDA(At, 0, 0); PG8_STAGE(PG8_SA(1, 1), a1 + hstep, voffA);
            PG8_WAIT_L(8); PG8_BAR; PG8_WAIT_L(0); PG8_MMA(0, 0, At, B0); PG8_BAR; PG8_SCHED;
            PG8_LDB(B1, 0, 1); PG8_STAGE(PG8_SB(0, 0), b2, voffB);
            PG8_BAR; PG8_WAIT_L(0); PG8_MMA(0, 1, At, B1); PG8_BAR;
            PG8_LDA(At, 0, 1); PG8_STAGE(PG8_SA(0, 0), a2, voffA);
            PG8_BAR; PG8_WAIT_L(0); PG8_MMA(1, 0, At, B0); PG8_BAR; PG8_SCHED;
            PG8_STAGE(PG8_SB(0, 1), b2 + hstep, voffB);
            PG8_WAIT_V(6); PG8_BAR; PG8_MMA(1, 1, At, B1); PG8_BAR;
            PG8_LDB(B0, 1, 0); PG8_SCHED; PG8_LDA(At, 1, 0); PG8_STAGE(PG8_SA(0, 1), a2 + hstep, voffA);
            PG8_WAIT_L(8); PG8_BAR; PG8_WAIT_L(0); PG8_MMA(0, 0, At, B0); PG8_BAR; PG8_SCHED;
            PG8_LDB(B1, 1, 1); PG8_STAGE(PG8_SB(1, 0), b3, voffB);
            PG8_BAR; PG8_WAIT_L(0); PG8_MMA(0, 1, At, B1); PG8_BAR;
            PG8_LDA(At, 1, 1); PG8_STAGE(PG8_SA(1, 0), a3, voffA);
            PG8_BAR; PG8_WAIT_L(0); PG8_MMA(1, 0, At, B0); PG8_BAR; PG8_SCHED;
            PG8_STAGE(PG8_SB(1, 1), b3 + hstep, voffB);
            PG8_WAIT_V(6); PG8_BAR; PG8_MMA(1, 1, At, B1); PG8_BAR;
            }
        }
        if constexpr (ALIGN_EPI) { if (wr == 0) PG8_BAR; }
        if constexpr (!Epi::AFTER_DRAIN) { E(acc, cur, wr, wc, fr, fq); S.done(cur); }
        if (!has_next) break;
#pragma unroll
        for (int a = 0; a < 2; ++a)
#pragma unroll
            for (int b = 0; b < 2; ++b)
#pragma unroll
                for (int m = 0; m < 4; ++m)
#pragma unroll
                    for (int n = 0; n < 2; ++n) acc[a][b][m][n] = (f32x4){0.f, 0.f, 0.f, 0.f};
        cur = nxt; cA = nA; cB = nB; ++ui;
        if constexpr (ALIGN_EPI) { if (wr == 1) PG8_BAR; }
    }
    PG8_WAIT_V(0);
    if constexpr (!ALIGN_EPI) { if (wr == 0) PG8_BAR; }
    PG8_BAR;
    if constexpr (Epi::AFTER_DRAIN) { E.fused(acc, cur, wr, wc, fr, fq, lds, wid, lane); S.done(cur); }
#undef PG8_SA
#undef PG8_SB
#undef PG8_STAGE
#undef PG8_LDA
#undef PG8_LDB
#undef PG8_MMA
#undef PG8_WAIT_V
#undef PG8_WAIT_L
#undef PG8_BAR
#undef PG8_SCHED
}
}

namespace att {
using bf16x8 = __attribute__((ext_vector_type(8))) short;
using s16x4  = __attribute__((ext_vector_type(4))) short;
using f32x16 = __attribute__((ext_vector_type(16))) float;
using u32x4  = __attribute__((ext_vector_type(4))) unsigned;
typedef unsigned short bf16;
constexpr int NW = 8, QBLK = 32, KVBLK = 64;
#ifndef ATT_SDEPTH
#define ATT_SDEPTH 1
#endif
constexpr int SDEPTH = ATT_SDEPTH;
#ifndef QKT_GRP
#define QKT_GRP 4
#endif
constexpr int LDQ = 3072, LDKV = 2048, LDKR = 64, LDO = 4096, LDVT = 8448;
constexpr int SHM_V = 8192, SHM_KN = 8192, SHM_KR = 4096;
constexpr float QSC = 64.f, QSI = 1.f / 64.f;
constexpr int NSLOT = 3, OFF_V = 0, OFF_KN = NSLOT * SHM_V, OFF_KR = OFF_KN + NSLOT * SHM_KN, OFF_WS = OFF_KR + NSLOT * SHM_KR, SHM_ATTN = OFF_WS + NW * 64 * 4;
#define ALDS __attribute__((address_space(3)))
constexpr float THRL = 2.5f * 1.4426950408889634f * 64.f;
constexpr float PSH = 5.f;
#define KSWZ(row, colB) ((row) * 256 + ((colB) ^ (((row) & 15) << 4)))
#define RSWZ(row, colB) ((row) * 128 + ((colB) ^ ((((row) >> 1) & 7) << 4)))
#define SBAR() __builtin_amdgcn_sched_barrier(0)
__device__ __forceinline__ int crow(int r, int hi) { return (r & 3) + 8 * (r >> 2) + 4 * hi; }
__device__ __forceinline__ unsigned cvtpk(float lo, float hi) { unsigned r; asm volatile("v_cvt_pk_bf16_f32 %0, %1, %2" : "=v"(r) : "v"(lo), "v"(hi)); return r; }

typedef int v8i32_t __attribute__((ext_vector_type(8)));
typedef float f32x2_t __attribute__((ext_vector_type(2)));
#define SM_MAX3(D, A, B, C) asm("v_max3_f32 %0, %1, %2, %3" : "=v"(D) : "v"(A), "v"(B), "v"(C))
__device__ __forceinline__ float sm_max(const f32x16& p0, const f32x16& p1) {
  float pmax = p0[0];
#pragma unroll
  for (int r = 1; r < 16; ++r) pmax = fmaxf(pmax, p0[r]);
#pragma unroll
  for (int r = 0; r < 16; ++r) pmax = fmaxf(pmax, p1[r]);
  return pmax;
}
__device__ __forceinline__ float sm_decide(float pmax, float& m_reg, float& alpha) {
  { auto rr = __builtin_amdgcn_permlane32_swap(__float_as_uint(pmax), __float_as_uint(pmax), false, false);
    pmax = fmaxf(__uint_as_float(rr[0]), __uint_as_float(rr[1])); }
  float mn;
  if (__builtin_expect(__all(pmax - m_reg <= THRL), 1)) { mn = m_reg; alpha = 1.f; }
  else { mn = fmaxf(m_reg, pmax); alpha = __builtin_amdgcn_exp2f((m_reg - mn) * QSI); m_reg = mn; }
  return fmaf(-mn, QSI, PSH);
}
__device__ __forceinline__ void sm_affine(f32x16& p, float mnq) {
#pragma unroll
  for (int r = 0; r < 16; ++r) p[r] = fmaf(p[r], QSI, mnq);
}
__device__ __forceinline__ void sm_finish(f32x16& p0, f32x16& p1, float alpha, float& l_reg, v8i32_t& pa8, const int prb) {
  if (!(prb & 1)) {
#pragma unroll
    for (int r = 0; r < 16; ++r) p0[r] = __builtin_amdgcn_exp2f(p0[r]);
#pragma unroll
    for (int r = 0; r < 16; ++r) p1[r] = __builtin_amdgcn_exp2f(p1[r]); }
  float ps = 0;
#pragma unroll
  for (int r = 0; r < 16; ++r) ps += p0[r];
#pragma unroll
  for (int r = 0; r < 16; ++r) ps += p1[r];
  { auto rr = __builtin_amdgcn_permlane32_swap(__float_as_uint(ps), __float_as_uint(ps), false, false);
    ps = __uint_as_float(rr[0]) + __uint_as_float(rr[1]); }
  l_reg = l_reg * alpha + ps;
#pragma unroll
  for (int i = 0; i < 4; ++i) { int w = __builtin_amdgcn_cvt_pk_fp8_f32(p0[4 * i], p0[4 * i + 1], 0, false); w = __builtin_amdgcn_cvt_pk_fp8_f32(p0[4 * i + 2], p0[4 * i + 3], w, true); pa8[i] = w;
    int w2 = __builtin_amdgcn_cvt_pk_fp8_f32(p1[4 * i], p1[4 * i + 1], 0, false); w2 = __builtin_amdgcn_cvt_pk_fp8_f32(p1[4 * i + 2], p1[4 * i + 3], w2, true); pa8[4 + i] = w2; }
}
#ifndef QKT_PF
#define QKT_PF 0
#endif
#if QKT_PF == 0
__device__ __forceinline__ void qkt(f32x16& p0, f32x16& p1, const char* Kn, const char* Kr, const bf16x8* qr, const char* Qr, int r32, int hi) {
  p0 = f32x16{}; p1 = f32x16{};
#pragma unroll
  for (int d0 = 0; d0 < 8; ++d0) { const int cb = (d0 * 16 + hi * 8) * 2;
    bf16x8 b0 = *reinterpret_cast<const bf16x8*>(Kn + KSWZ(r32, cb));
    bf16x8 b1 = *reinterpret_cast<const bf16x8*>(Kn + KSWZ(32 + r32, cb));
    p0 = __builtin_amdgcn_mfma_f32_32x32x16_bf16(b0, qr[d0], p0, 0, 0, 0);
    p1 = __builtin_amdgcn_mfma_f32_32x32x16_bf16(b1, qr[d0], p1, 0, 0, 0);
    if ((d0 & (QKT_GRP - 1)) == QKT_GRP - 1) SBAR(); }
#pragma unroll
  for (int d0 = 0; d0 < 4; ++d0) { const int cb = (d0 * 16 + hi * 8) * 2;
    bf16x8 b0 = *reinterpret_cast<const bf16x8*>(Kr + RSWZ(r32, cb));
    bf16x8 b1 = *reinterpret_cast<const bf16x8*>(Kr + RSWZ(32 + r32, cb));
    const bf16x8 qf = qr[8 + d0];
    p0 = __builtin_amdgcn_mfma_f32_32x32x16_bf16(b0, qf, p0, 0, 0, 0);
    p1 = __builtin_amdgcn_mfma_f32_32x32x16_bf16(b1, qf, p1, 0, 0, 0);
    if ((d0 & (QKT_GRP - 1)) == QKT_GRP - 1) SBAR(); }
}
#else
__device__ __forceinline__ void qkt(f32x16& p0, f32x16& p1, const char* Kn, const char* Kr, const bf16x8* qr, const char* Qr, int r32, int hi) {
  p0 = f32x16{}; p1 = f32x16{};
  constexpr int NB = QKT_PF + 1;
  bf16x8 kb0[NB], kb1[NB], qf[NB];
#define KLD(S) do { constexpr int s_ = (S), i_ = s_ % NB; if constexpr (s_ < 8) { const int cb = (s_ * 16 + hi * 8) * 2; kb0[i_] = *reinterpret_cast<const bf16x8*>(Kn + KSWZ(r32, cb)); kb1[i_] = *reinterpret_cast<const bf16x8*>(Kn + KSWZ(32 + r32, cb)); } \
    else { const int cb = ((s_ - 8) * 16 + hi * 8) * 2; kb0[i_] = *reinterpret_cast<const bf16x8*>(Kr + RSWZ(r32, cb)); kb1[i_] = *reinterpret_cast<const bf16x8*>(Kr + RSWZ(32 + r32, cb)); qf[i_] = *reinterpret_cast<const bf16x8*>(Qr + (s_ - 8) * 1024); } } while (0)
#define KSTEP(S) do { constexpr int s_ = (S), i_ = s_ % NB; if constexpr (s_ + QKT_PF < 12) KLD(S + QKT_PF); const bf16x8 q_ = s_ < 8 ? qr[s_ < 8 ? s_ : 0] : qf[i_]; \
    p0 = __builtin_amdgcn_mfma_f32_32x32x16_bf16(kb0[i_], q_, p0, 0, 0, 0); p1 = __builtin_amdgcn_mfma_f32_32x32x16_bf16(kb1[i_], q_, p1, 0, 0, 0); } while (0)
  KLD(0); if constexpr (QKT_PF >= 2) KLD(1);
  KSTEP(0); KSTEP(1); KSTEP(2); KSTEP(3); KSTEP(4); KSTEP(5); KSTEP(6); KSTEP(7); KSTEP(8); KSTEP(9); KSTEP(10); KSTEP(11);
#undef KLD
#undef KSTEP
}
#endif
__device__ __forceinline__ int v_st(int k, int c) { const int kk = (k & ~0xC) | ((k & 4) << 1) | ((k & 8) >> 1); return ((kk >> 3) * 4 + (c >> 5)) * 512 + ((kk & 7) * 32 + (c & 31)) * 2; }
__device__ __forceinline__ int v_rd_base(int lane) { return ((lane & 3) << 3) | (((lane >> 2) & 3) << 6) | (((lane >> 4) & 1) << 5) | (((lane >> 5) & 1) << 8); }
constexpr int v_rd_off(int d0, int ks, int half) { return d0 * 512 + ks * 4096 + half * 2048; }
template <int OFF> __device__ __forceinline__ s16x4 tr_read(int vb) {
  s16x4 r; asm volatile("ds_read_b64_tr_b16 %0, %1 offset:%2" : "=&v"(r) : "v"(vb), "i"(OFF) : "memory"); return r;
}
template <int D0> __device__ __forceinline__ void pv_one(f32x16& od, int vb, bf16x8 pa0, bf16x8 pa1, bf16x8 pa2, bf16x8 pa3) {
  const s16x4 l0 = tr_read<v_rd_off(D0, 0, 0)>(vb), h0 = tr_read<v_rd_off(D0, 0, 1)>(vb), l1 = tr_read<v_rd_off(D0, 1, 0)>(vb), h1 = tr_read<v_rd_off(D0, 1, 1)>(vb);
  const s16x4 l2 = tr_read<v_rd_off(D0, 2, 0)>(vb), h2 = tr_read<v_rd_off(D0, 2, 1)>(vb), l3 = tr_read<v_rd_off(D0, 3, 0)>(vb), h3 = tr_read<v_rd_off(D0, 3, 1)>(vb);
  asm volatile("s_waitcnt lgkmcnt(0)" ::: "memory"); SBAR();
#define PK(L, H) (bf16x8){L[0], L[1], L[2], L[3], H[0], H[1], H[2], H[3]}
  od = __builtin_amdgcn_mfma_f32_32x32x16_bf16(pa0, PK(l0, h0), od, 0, 0, 0);
  od = __builtin_amdgcn_mfma_f32_32x32x16_bf16(pa1, PK(l1, h1), od, 0, 0, 0);
  od = __builtin_amdgcn_mfma_f32_32x32x16_bf16(pa2, PK(l2, h2), od, 0, 0, 0);
  od = __builtin_amdgcn_mfma_f32_32x32x16_bf16(pa3, PK(l3, h3), od, 0, 0, 0);
#undef PK
}
__device__ __forceinline__ void pv_d0(f32x16* o, int vb, bf16x8 pa0, bf16x8 pa1, bf16x8 pa2, bf16x8 pa3) {
  pv_one<0>(o[0], vb, pa0, pa1, pa2, pa3); pv_one<1>(o[1], vb, pa0, pa1, pa2, pa3); pv_one<2>(o[2], vb, pa0, pa1, pa2, pa3); pv_one<3>(o[3], vb, pa0, pa1, pa2, pa3);
}

#define LDSR128(dst, base, OFF) asm volatile("ds_read_b128 %0, %1 offset:%2" : "=v"(dst) : "v"((unsigned)(uintptr_t)(base)), "i"(OFF) : "memory")
#define WAITK4(N, A, B, C, D) asm volatile("s_waitcnt lgkmcnt(" #N ")" : "+v"(A), "+v"(B), "+v"(C), "+v"(D) :: "memory")
#ifndef PADN
#define PADN 7
#endif
#define PAD_STR2(x) #x
#define PAD_STR(x) PAD_STR2(x)
#define MFMA_PAD1() asm volatile("s_nop " PAD_STR(PADN))
#define PINACC2(A, B) asm volatile("" : "+v"(A), "+v"(B))
#define PINACC1(A) asm volatile("" : "+v"(A))
#define PINF(A) asm volatile("" : "+v"(A))
#define WAITV2(N, A, B) asm volatile("s_waitcnt lgkmcnt(" #N ")" : "+v"(A), "+v"(B) :: "memory")
#define V8OF(F) (v8i32_t){(int)F[0][0], (int)F[0][1], (int)F[0][2], (int)F[0][3], (int)F[1][0], (int)F[1][1], (int)F[1][2], (int)F[1][3]}
#define MXMFMA(KF, QF, ACC) __builtin_amdgcn_mfma_scale_f32_32x32x64_f8f6f4(V8OF(KF), QF, ACC, 0, 0, 0, 0x7F7F7F7F, 0, 0x7F7F7F7F)
#define MXMFMA2(PA, VF, ACC) __builtin_amdgcn_mfma_scale_f32_32x32x64_f8f6f4(PA, V8OF(VF), ACC, 0, 0, 0, 0x7F7F7F7F, 0, 0x7F7F7F7F)
template <bool DO_QK, bool DO_PV, class IssueF>
__device__ __forceinline__ void mat_segment(const IssueF& issue, f32x16& p0, f32x16& p1, f32x16* o, const ALDS char* Kn, const ALDS char* Kr, const ALDS char* Vb, const v8i32_t* qf, v8i32_t pa8, int r32, int hi, float& m_reg, float& alpha, const int prb) {
  u32x4 ka[3][2], kb[3][2], vf[4][2];
  const int nbase = r32 * 128, nsw = ((r32 >> 1) & 7) << 4, rbase = r32 * 64, rsw = ((r32 >> 2) & 3) << 4, hb = hi * 32;
  asm volatile("s_waitcnt lgkmcnt(0)" ::: "memory");
#if 1
  asm volatile("s_setprio 1");
#endif
  if constexpr (DO_QK && DO_PV) {
  p0 = f32x16{}; p1 = f32x16{};
  if (!(prb & 4))   { const int a_ = nbase + (((0 * 64) + hb) ^ nsw); LDSR128(ka[0][0], Kn + a_, 0); LDSR128(ka[0][1], Kn + (a_ ^ 16), 0); LDSR128(kb[0][0], Kn + a_, 4096); LDSR128(kb[0][1], Kn + (a_ ^ 16), 4096); }
  if (!(prb & 4))   { const int a_ = nbase + (((1 * 64) + hb) ^ nsw); LDSR128(ka[1][0], Kn + a_, 0); LDSR128(ka[1][1], Kn + (a_ ^ 16), 0); LDSR128(kb[1][0], Kn + a_, 4096); LDSR128(kb[1][1], Kn + (a_ ^ 16), 4096); }
  if (!(prb & 4))   { const int a_ = rbase + (hb ^ rsw); LDSR128(ka[2][0], Kr + a_, 0); LDSR128(ka[2][1], Kr + (a_ ^ 16), 0); LDSR128(kb[2][0], Kr + a_, 2048); LDSR128(kb[2][1], Kr + (a_ ^ 16), 2048); }
  if (!(prb & 4))   { const int a_ = rbase + (hb ^ rsw); LDSR128(vf[0][0], Vb + a_, 0); LDSR128(vf[0][1], Vb + (a_ ^ 16), 0); }
  if (!(prb & 4))   { const int a_ = rbase + (hb ^ rsw); LDSR128(vf[1][0], Vb + a_, 2048); LDSR128(vf[1][1], Vb + (a_ ^ 16), 2048); }
  if (!(prb & 4))   { const int a_ = rbase + (hb ^ rsw); LDSR128(vf[2][0], Vb + a_, 4096); LDSR128(vf[2][1], Vb + (a_ ^ 16), 4096); }
  if (!(prb & 4))   { const int a_ = rbase + (hb ^ rsw); LDSR128(vf[3][0], Vb + a_, 6144); LDSR128(vf[3][1], Vb + (a_ ^ 16), 6144); }
  WAITK4(15, ka[0][0], ka[0][1], kb[0][0], kb[0][1]);
  if (!(prb & 2)) { p0 = MXMFMA(ka[0], qf[0], p0); PINACC1(p0); MFMA_PAD1(); p1 = MXMFMA(kb[0], qf[0], p1); PINACC1(p1); MFMA_PAD1(); }
  issue(0); issue(1);
  WAITK4(12, ka[1][0], ka[1][1], kb[1][0], kb[1][1]);
  if (!(prb & 2)) { p0 = MXMFMA(ka[1], qf[1], p0); PINACC1(p0); MFMA_PAD1(); p1 = MXMFMA(kb[1], qf[1], p1); PINACC1(p1); MFMA_PAD1(); }
  issue(2);
  WAITK4(8, ka[2][0], ka[2][1], kb[2][0], kb[2][1]);
  if (!(prb & 2)) { p0 = MXMFMA(ka[2], qf[2], p0); PINACC1(p0); MFMA_PAD1(); p1 = MXMFMA(kb[2], qf[2], p1); PINACC1(p1); MFMA_PAD1(); }
  WAITV2(6, vf[0][0], vf[0][1]);
  if (!(prb & 2)) { o[0] = MXMFMA2(pa8, vf[0], o[0]); PINACC1(o[0]); }
  float pmax_ = 0.f, mnq_ = 0.f; if (!(prb & 16)) { pmax_ = sm_max(p0, p1); PINF(pmax_); }
  WAITV2(4, vf[1][0], vf[1][1]);
  if (!(prb & 2)) { o[1] = MXMFMA2(pa8, vf[1], o[1]); PINACC1(o[1]); }
  if (!(prb & 16)) { mnq_ = sm_decide(pmax_, m_reg, alpha); PINF(mnq_); }
  WAITV2(2, vf[2][0], vf[2][1]);
  if (!(prb & 2)) { o[2] = MXMFMA2(pa8, vf[2], o[2]); PINACC1(o[2]); }
  if (!(prb & 16)) { sm_affine(p0, mnq_); PINACC1(p0); }
  WAITV2(0, vf[3][0], vf[3][1]);
  if (!(prb & 2)) { o[3] = MXMFMA2(pa8, vf[3], o[3]); PINACC1(o[3]); }
  if (!(prb & 16)) { sm_affine(p1, mnq_); PINACC1(p1); }
  } else if constexpr (DO_QK) {
  p0 = f32x16{}; p1 = f32x16{};
  if (!(prb & 4))   { const int a_ = nbase + (((0 * 64) + hb) ^ nsw); LDSR128(ka[0][0], Kn + a_, 0); LDSR128(ka[0][1], Kn + (a_ ^ 16), 0); LDSR128(kb[0][0], Kn + a_, 4096); LDSR128(kb[0][1], Kn + (a_ ^ 16), 4096); }
  if (!(prb & 4))   { const int a_ = nbase + (((1 * 64) + hb) ^ nsw); LDSR128(ka[1][0], Kn + a_, 0); LDSR128(ka[1][1], Kn + (a_ ^ 16), 0); LDSR128(kb[1][0], Kn + a_, 4096); LDSR128(kb[1][1], Kn + (a_ ^ 16), 4096); }
  if (!(prb & 4))   { const int a_ = rbase + (hb ^ rsw); LDSR128(ka[2][0], Kr + a_, 0); LDSR128(ka[2][1], Kr + (a_ ^ 16), 0); LDSR128(kb[2][0], Kr + a_, 2048); LDSR128(kb[2][1], Kr + (a_ ^ 16), 2048); }
  WAITK4(8, ka[0][0], ka[0][1], kb[0][0], kb[0][1]);
  if (!(prb & 2)) { p0 = MXMFMA(ka[0], qf[0], p0); PINACC1(p0); MFMA_PAD1(); p1 = MXMFMA(kb[0], qf[0], p1); PINACC1(p1); MFMA_PAD1(); }
  issue(0); issue(1);
  WAITK4(4, ka[1][0], ka[1][1], kb[1][0], kb[1][1]);
  if (!(prb & 2)) { p0 = MXMFMA(ka[1], qf[1], p0); PINACC1(p0); MFMA_PAD1(); p1 = MXMFMA(kb[1], qf[1], p1); PINACC1(p1); MFMA_PAD1(); }
  issue(2);
  WAITK4(0, ka[2][0], ka[2][1], kb[2][0], kb[2][1]);
  if (!(prb & 2)) { p0 = MXMFMA(ka[2], qf[2], p0); PINACC1(p0); MFMA_PAD1(); p1 = MXMFMA(kb[2], qf[2], p1); PINACC1(p1); MFMA_PAD1(); }
  if (!(prb & 16)) { const float mnq_ = sm_decide(sm_max(p0, p1), m_reg, alpha); sm_affine(p0, mnq_); sm_affine(p1, mnq_); }
  } else {
  if (!(prb & 4))   { const int a_ = rbase + (hb ^ rsw); LDSR128(vf[0][0], Vb + a_, 0); LDSR128(vf[0][1], Vb + (a_ ^ 16), 0); }
  if (!(prb & 4))   { const int a_ = rbase + (hb ^ rsw); LDSR128(vf[1][0], Vb + a_, 2048); LDSR128(vf[1][1], Vb + (a_ ^ 16), 2048); }
  if (!(prb & 4))   { const int a_ = rbase + (hb ^ rsw); LDSR128(vf[2][0], Vb + a_, 4096); LDSR128(vf[2][1], Vb + (a_ ^ 16), 4096); }
  if (!(prb & 4))   { const int a_ = rbase + (hb ^ rsw); LDSR128(vf[3][0], Vb + a_, 6144); LDSR128(vf[3][1], Vb + (a_ ^ 16), 6144); }
  WAITV2(6, vf[0][0], vf[0][1]);
  if (!(prb & 2)) { o[0] = MXMFMA2(pa8, vf[0], o[0]); PINACC1(o[0]); MFMA_PAD1(); }
  WAITV2(4, vf[1][0], vf[1][1]);
  if (!(prb & 2)) { o[1] = MXMFMA2(pa8, vf[1], o[1]); PINACC1(o[1]); MFMA_PAD1(); }
  WAITV2(2, vf[2][0], vf[2][1]);
  if (!(prb & 2)) { o[2] = MXMFMA2(pa8, vf[2], o[2]); PINACC1(o[2]); MFMA_PAD1(); }
  WAITV2(0, vf[3][0], vf[3][1]);
  if (!(prb & 2)) { o[3] = MXMFMA2(pa8, vf[3], o[3]); PINACC1(o[3]); MFMA_PAD1(); }
  }
#if 1
  asm volatile("s_setprio 0");
#endif
}

#define ATT_BAR() do { asm volatile("" ::: "memory"); __builtin_amdgcn_s_barrier(); asm volatile("" ::: "memory"); } while (0)
#define ATT_VM(N) asm volatile("s_waitcnt vmcnt(" #N ")" ::: "memory")
__device__ __forceinline__ void glds16(const bf16* g, ALDS unsigned char* l) { __builtin_amdgcn_global_load_lds((const unsigned*)g, (ALDS unsigned*)l, 16, 0, 0); }
__device__ __forceinline__ void glds8(const unsigned char* g, ALDS unsigned char* l) { __builtin_amdgcn_global_load_lds((const unsigned*)g, (ALDS unsigned*)l, 16, 0, 0); }
#ifdef PROBE_STAMP
__device__ unsigned long long g_stamp[8][6];
#define STAMP(k) do { const unsigned long long t_ = __builtin_readcyclecounter(); acc_[k] += t_ - tl_; tl_ = t_; } while (0)
#else
#define STAMP(k) do { } while (0)
#endif
template <int PRB> __device__ __forceinline__ void attn_unit(const unsigned char* __restrict__ Qb, const unsigned char* __restrict__ Knh, const unsigned char* __restrict__ Vth, const unsigned char* __restrict__ Krb,
                                          bf16* __restrict__ Ob, int seq, char* lds, ALDS unsigned char* L, const int probe) {
  int tid_ = threadIdx.x; asm volatile("" : "+v"(tid_));
  const int tid = tid_, wid = __builtin_amdgcn_readfirstlane(tid >> 6), lane = tid & 63, r32 = lane & 31, hi = lane >> 5;
  constexpr int prb = PRB; (void)probe;
  const bool trail = wid >= 4;
  float* ws = (float*)(lds + OFF_WS) + wid * 64; float* li_l = ws; float* al_l = ws + 32;
  float m_reg = -1e30f, l_reg = 0; f32x16 o[4] = {}; v8i32_t qf[3];
  const unsigned char* Qw = Qb + (long)(wid * QBLK + r32) * LDQ + hi * 32;
#pragma unroll
  for (int s_ = 0; s_ < 3; ++s_) { const u32x4 a0 = *reinterpret_cast<const u32x4*>(Qw + s_ * 64), a1 = *reinterpret_cast<const u32x4*>(Qw + s_ * 64 + 16);
    qf[s_] = (v8i32_t){(int)a0[0], (int)a0[1], (int)a0[2], (int)a0[3], (int)a1[0], (int)a1[1], (int)a1[2], (int)a1[3]}; }
#define VOFF() ([&]() { const int row = wid * 16 + (lane >> 2), colB = ((lane & 3) * 16) ^ (((row >> 2) & 3) << 4); return row * LDVT + colB; }())
#define KOFF() ([&]() { const int row = wid * 8 + (lane >> 3), colB = ((lane & 7) * 16) ^ (((row >> 1) & 7) << 4); return row * LDKV + colB; }())
#define ROFF() ([&]() { const int row = wid * 16 + (lane >> 2), colB = ((lane & 3) * 16) ^ (((row >> 2) & 3) << 4); return row * LDKR + colB; }())
  const ALDS char* KL = (const ALDS char*)L + OFF_KN; const ALDS char* RL = (const ALDS char*)L + OFF_KR; const ALDS char* VL = (const ALDS char*)L + OFF_V;
#define ISSUE_K(t, s) do { const long kb_ = (long)(t) * KVBLK; const int s_ = (s); \
    glds8(Knh + kb_ * LDKV + KOFF(), L + OFF_KN + s_ * SHM_KN + wid * 1024); if (wid < 4) glds8(Krb + kb_ * LDKR + ROFF(), L + OFF_KR + s_ * SHM_KR + wid * 1024); } while (0)
#define ISSUE_V(t, s) do { const long kb_ = (long)(t) * KVBLK; const int s_ = (s); glds8(Vth + kb_ + VOFF(), L + OFF_V + s_ * SHM_V + wid * 1024); } while (0)
#define ISSUE_NEXT(j) do { if ((j) + 2 < NT) ISSUE_K((j) + 2, sp); if ((j) + 1 < NT) ISSUE_V((j) + 1, sn); } while (0)
#define ROT() do { const int t_ = sc; sc = sn; sn = sp; sp = t_; } while (0)
#define RESC(a) do { if (__any((a) < 1.f)) { if (hi == 0) al_l[r32] = (a); asm volatile("s_waitcnt lgkmcnt(0)" ::: "memory"); \
    _Pragma("unroll") for (int d = 0; d < 4; ++d) _Pragma("unroll") for (int r = 0; r < 16; ++r) o[d][r] *= al_l[crow(r, hi)]; } } while (0)
  f32x16 p0, p1; float mn, al; v8i32_t pa8 = {}; const int NT = (prb & 64) ? 2 : seq / KVBLK;
  int sc = 0, sn = 1, sp = 2;
  ISSUE_K(0, 0); ISSUE_K(1, 1); ISSUE_V(0, 0);
  if (trail) ATT_VM(2); else ATT_VM(3);
  ATT_BAR();
  int jj = 0;
  const auto issue = [&](int step) { if (prb & 8) return;
    const long kb2 = (long)(jj + 2) * KVBLK, kb1 = (long)(jj + 1) * KVBLK;
    if (jj + 2 < NT) { if (step == 0) glds8(Knh + kb2 * LDKV + KOFF(), L + OFF_KN + sp * SHM_KN + wid * 1024); if (step == 1 && wid < 4) glds8(Krb + kb2 * LDKR + ROFF(), L + OFF_KR + sp * SHM_KR + wid * 1024); }
    if (jj + 1 < NT) { if (step == 2) glds8(Vth + kb1 + VOFF(), L + OFF_V + sn * SHM_V + wid * 1024); } };
  const auto noissue = [](int) {};
  mat_segment<true, false>(issue, p0, p1, o, KL, RL, VL, qf, pa8, r32, hi, m_reg, al, prb);
  if (trail) { ATT_VM(2); ATT_BAR(); }
  if (!(prb & 16)) { sm_finish(p0, p1, al, l_reg, pa8, prb); }
  ROT();
#ifdef PROBE_STAMP
  unsigned long long acc_[6] = {0, 0, 0, 0, 0, 0}, tl_ = __builtin_readcyclecounter();
#endif
  for (int j = 1; j < NT; ++j) {
    if (!trail) { if (j + 1 < NT) ATT_VM(3); else ATT_VM(0); STAMP(4); ATT_BAR(); }
    STAMP(0);
    jj = j;
    mat_segment<true, true>(issue, p0, p1, o, KL + sc * SHM_KN, RL + sc * SHM_KR, VL + sp * SHM_V, qf, pa8, r32, hi, m_reg, al, prb);
    STAMP(1);
    if (trail) { if (j + 2 < NT) ATT_VM(2); else ATT_VM(0); STAMP(5); ATT_BAR(); }
    STAMP(2);
    if (!(prb & 16)) { RESC(al); sm_finish(p0, p1, al, l_reg, pa8, prb); }
    ROT();
    STAMP(3);
  }
#ifdef PROBE_STAMP
  if (blockIdx.x == 0 && lane == 0) { for (int k = 0; k < 6; ++k) g_stamp[wid][k] += acc_[k]; }
#endif
  if (!trail) { ATT_VM(0); ATT_BAR(); }
  mat_segment<false, true>(noissue, p0, p1, o, KL, RL, VL + sp * SHM_V, qf, pa8, r32, hi, m_reg, al, prb);
  if (hi == 0) li_l[r32] = l_reg; asm volatile("s_waitcnt lgkmcnt(0)" ::: "memory");
  float rli[16];
#pragma unroll
  for (int r = 0; r < 16; ++r) rli[r] = __builtin_amdgcn_rcpf(li_l[crow(r, hi)]);
  int lane_e = lane; asm volatile("" : "+v"(lane_e));
  bf16* Ow = Ob + (long)(wid * QBLK + 4 * (lane_e >> 5)) * LDO + (lane_e & 31);
#pragma unroll
  for (int r = 0; r < 16; ++r) { const int orow = (r & 3) + 8 * (r >> 2);
#pragma unroll
    for (int d0 = 0; d0 < 4; ++d0) { const float val = o[d0][r] * rli[r]; if (!(prb & 32)) Ow[orow * LDO + d0 * 32] = (bf16)(cvtpk(val, val) & 0xffffu); } }
  ATT_VM(0);
  ATT_BAR();
#undef VOFF
#undef KOFF
#undef ROFF
#undef ISSUE_K
#undef ISSUE_V
#undef ISSUE_NEXT
#undef ROT
#undef RESC
}
#undef KSWZ
#undef RSWZ
}

constexpr int DM = 4096, SEQ = 8192, CTXL = 256, MR = SEQ + CTXL;
constexpr int NH = 16, QL = 768, KVL = 512, NIN = 7680, NMODC = 6 * DM;
constexpr int NEXP = 16384;
constexpr float EPS = 1e-6f;
constexpr float C2 = 0.072168783648703220f * 1.4426950408889634f;

#ifndef MK_ONE_LAUNCH
#define MK_ONE_LAUNCH 1
#endif
constexpr int NPHASE = 10;
constexpr int NWAVES = 8, NTHR = NWAVES * 64;

constexpr size_t MiB = 1u << 20;
constexpr size_t a256(size_t x) { return (x + 255) & ~(size_t)255; }
constexpr size_t WS_CTL = 0, CTL_ZERO_BYTES = 1 * MiB;
constexpr int CW_BAR = 4096;
constexpr int CW_END = CW_BAR + 3456;
static_assert((size_t)CW_END * 4 <= CTL_ZERO_BYTES, "CTL words inside the memset region");
constexpr size_t WS_MODF = 1 * MiB;
constexpr size_t WS_ROPE = WS_MODF + a256((size_t)(NMODC + 2 * DM) * 4);
constexpr size_t WS_WIN  = 2 * MiB;
constexpr size_t WS_WUQ  = WS_WIN + (size_t)NIN * DM * 2;
constexpr size_t WS_WUKV = WS_WUQ + (size_t)3072 * 768 * 2;
constexpr size_t WS_WO   = WS_WUKV + (size_t)4096 * 512 * 2;
constexpr size_t WS_WPQ  = WS_WO + (size_t)DM * DM * 2;
constexpr size_t WS_KBD  = WS_WPQ + (size_t)2048 * DM * 2;
constexpr int ROWB = 3072;
constexpr size_t WS_KB2  = WS_KBD + (size_t)2048 * DM * 2;
constexpr size_t WS_UB   = WS_KB2 + (size_t)8 * 256 * 256 * 2;
constexpr size_t WS_VB   = WS_UB + (size_t)NEXP * ROWB;
constexpr size_t WS_SU   = WS_VB + (size_t)NEXP * ROWB;
constexpr size_t WS_HX   = WS_SU + (size_t)2 * NEXP * 4;
constexpr size_t WS_CQ   = WS_HX + (size_t)MR * DM * 2;
constexpr size_t WS_CKV  = WS_CQ + (size_t)SEQ * QL * 2;
constexpr size_t WS_KR   = WS_CKV + (size_t)MR * KVL * 2;
constexpr size_t WS_U    = WS_KR + (size_t)MR * 64 * 2;
constexpr size_t WS_GB   = WS_U + (size_t)SEQ * 2048 * 2;
constexpr size_t WS_Q    = WS_GB + (size_t)SEQ * 2048 * 2;
constexpr size_t WS_KN   = WS_Q + (size_t)SEQ * 3072 * 2;
constexpr size_t WS_V    = WS_KN + (size_t)MR * 2048 * 2;
constexpr size_t WS_ACAT = WS_V + (size_t)MR * 2048 * 2;
constexpr size_t WS_X1   = WS_ACAT + (size_t)SEQ * DM * 2;
constexpr size_t WS_H2   = WS_X1 + (size_t)SEQ * DM * 4;
constexpr size_t WS_QP   = WS_H2 + (size_t)SEQ * DM * 2;
constexpr size_t WS_SC   = WS_QP + (size_t)SEQ * 2048 * 2;
constexpr size_t WS_MODP = WS_SC + (size_t)SEQ * 2048 * 4;
constexpr size_t WS_SQ1  = WS_MODP + (size_t)64 * 32768 * 4;
constexpr size_t WS_SQ2  = WS_SQ1 + (size_t)SEQ * 12 * 4;
constexpr size_t WS_SQ3  = WS_SQ2 + (size_t)MR * 8 * 4;
constexpr size_t WS_END  = WS_SQ3 + (size_t)SEQ * 64 * 4;
static_assert(WS_ROPE + 192 * 32 * 4 <= WS_WIN, "rope table below the weights");

constexpr int RING_BYTES = 158720;
constexpr int MISC_OFF = RING_BYTES + 320;
constexpr int LDS_BYTES = 163840;
static_assert(att::SHM_ATTN <= RING_BYTES && MISC_OFF + 128 <= LDS_BYTES, "LDS map");

#define GAS __attribute__((address_space(1)))
#define LAS __attribute__((address_space(3)))
typedef unsigned short bf16;
typedef unsigned v4u __attribute__((ext_vector_type(4)));
typedef float f32x4 __attribute__((ext_vector_type(4)));
typedef __bf16 bf16x2_t __attribute__((ext_vector_type(2)));
typedef float f32x2 __attribute__((ext_vector_type(2)));
typedef float f32x16v __attribute__((ext_vector_type(16)));
typedef float f32x32v __attribute__((ext_vector_type(32)));
typedef unsigned u32x6v __attribute__((ext_vector_type(6)));
typedef _Float16 h16x2 __attribute__((ext_vector_type(2)));
typedef _Float16 h16x32 __attribute__((ext_vector_type(32)));
#ifndef FP6_INTERLEAVED
#define FP6_INTERLEAVED 1
#endif
#define LDS_WAIT() asm volatile("s_waitcnt lgkmcnt(0)" ::: "memory")
__device__ __forceinline__ unsigned f2bf(float f) { unsigned u = __builtin_bit_cast(unsigned, f); return (u + 0x7fffu + ((u >> 16) & 1u)) >> 16; }
__device__ __forceinline__ unsigned pk2(float lo, float hi) { return f2bf(lo) | (f2bf(hi) << 16); }
__device__ __forceinline__ float bflo(unsigned w) { return __builtin_bit_cast(float, w << 16); }
__device__ __forceinline__ float bfhi(unsigned w) { return __builtin_bit_cast(float, w & 0xffff0000u); }
__device__ __forceinline__ float dot2bf(unsigned a, unsigned b, float c) { return __builtin_amdgcn_fdot2_f32_bf16(__builtin_bit_cast(bf16x2_t, a), __builtin_bit_cast(bf16x2_t, b), c, false); }
#define DPP_F(v, CTRL) __builtin_bit_cast(float, __builtin_amdgcn_update_dpp(0, __builtin_bit_cast(int, (v)), (CTRL), 0xf, 0xf, true))
__device__ __forceinline__ float row16_sum(float v) { v += DPP_F(v, 0xB1); v += DPP_F(v, 0x4E); v += DPP_F(v, 0x141); v += DPP_F(v, 0x140); return v; }
__device__ __forceinline__ float row16_max(float v) { v = fmaxf(v, DPP_F(v, 0xB1)); v = fmaxf(v, DPP_F(v, 0x4E)); v = fmaxf(v, DPP_F(v, 0x141)); v = fmaxf(v, DPP_F(v, 0x140)); return v; }
__device__ __forceinline__ float rl_f(float v, int l) { return __builtin_bit_cast(float, __builtin_amdgcn_readlane(__builtin_bit_cast(int, v), l)); }
__device__ __forceinline__ float wave_sum(float v) { v = row16_sum(v); return (rl_f(v, 0) + rl_f(v, 16)) + (rl_f(v, 32) + rl_f(v, 48)); }
__device__ __forceinline__ float wave_max(float v) { v = row16_max(v); return fmaxf(fmaxf(rl_f(v, 0), rl_f(v, 16)), fmaxf(rl_f(v, 32), rl_f(v, 48))); }

#define XB_TMO      128
#define XB_XCNT(j)  (256  + 64 * (j))
#define XB_XSUB(j)  (1280 + 64 * (j))
#define XB_XGEN(j)  (2304 + 64 * (j))
#define XB_TOP      3328
#define XB_TOPGEN   3392
#define XCD_BAR_WORDS 3456
#define XB_SPIN_CAP (1u << 18)
__device__ __forceinline__ unsigned xb_ld(unsigned* p)              { return __hip_atomic_load(p, __ATOMIC_RELAXED, __HIP_MEMORY_SCOPE_AGENT); }
__device__ __forceinline__ unsigned xb_add(unsigned* p, unsigned v) { return __hip_atomic_fetch_add(p, v, __ATOMIC_RELAXED, __HIP_MEMORY_SCOPE_AGENT); }
__device__ __forceinline__ unsigned xb_xcc_id() { return (unsigned)__builtin_amdgcn_s_getreg((3 << 11) | 20) & 0xFu; }
#define XB_SPIN(cond, bar) do { unsigned _sp = 0; while (cond) { __builtin_amdgcn_s_sleep(1); \
    if ((++_sp & 255u) == 0u) { if (xb_ld(&(bar)[XB_TMO])) break; if (_sp > XB_SPIN_CAP) { atomicAdd(&(bar)[XB_TMO], 1u); break; } } } } while (0)
struct XcdBarrier { unsigned* bar; unsigned x; volatile LAS unsigned* st; };
__device__ __forceinline__ XcdBarrier xcd_barrier_post(unsigned* bar, volatile LAS unsigned* st) {
    XcdBarrier b; b.bar = bar; b.x = xb_xcc_id(); b.st = st;
    if (threadIdx.x == 0) (void)xb_add(&bar[XB_XCNT(b.x)], 1u);
    return b;
}
__device__ __forceinline__ void xcd_barrier_complete(unsigned* bar, unsigned x, unsigned& nloc, unsigned& nx) {
    const unsigned G = gridDim.x * gridDim.y * gridDim.z;
    unsigned sum, cnt, mine, sp = 0u;
    for (;;) {
        sum = 0u; cnt = 0u; mine = 0u;
#pragma unroll
        for (unsigned j = 0; j < 16; ++j) { const unsigned c = xb_ld(&bar[XB_XCNT(j)]); sum += c; cnt += (c > 0u) ? 1u : 0u; mine = (j == x) ? c : mine; }
        if (sum == G) break;
        __builtin_amdgcn_s_sleep(1);
        if ((++sp & 255u) == 0u) { if (xb_ld(&bar[XB_TMO])) break; if (sp > XB_SPIN_CAP) { atomicAdd(&bar[XB_TMO], 1u); break; } }
    }
    nloc = mine > 0u ? mine : 1u; nx = cnt > 0u ? cnt : 1u;
}
__device__ __forceinline__ void xcd_barrier(const XcdBarrier& b) {
    asm volatile("s_waitcnt vmcnt(0)" ::: "memory");
    __syncthreads();
    if (threadIdx.x == 0) {
        unsigned* bar = b.bar;
        __builtin_amdgcn_s_waitcnt(0);
        unsigned nloc = b.st[0], nx = b.st[1];
        if (nloc == 0u) { xcd_barrier_complete(bar, b.x, nloc, nx); b.st[0] = nloc; b.st[1] = nx; }
        const unsigned old = xb_add(&bar[XB_XSUB(b.x)], 1u);
        const unsigned gen = old / nloc;
        if (old + 1u == (gen + 1u) * nloc) {
            __builtin_amdgcn_fence(__ATOMIC_RELEASE, "agent");
            asm volatile("s_waitcnt vmcnt(0)" ::: "memory");
            const unsigned og = xb_add(&bar[XB_TOP], 1u);
            const unsigned tg = og / nx;
            if (og + 1u == (tg + 1u) * nx) xb_add(&bar[XB_TOPGEN], 1u);
            else XB_SPIN(xb_ld(&bar[XB_TOPGEN]) == tg, bar);
            __builtin_amdgcn_fence(__ATOMIC_ACQUIRE, "agent");
            xb_add(&bar[XB_XGEN(b.x)], 1u);
            asm volatile("s_waitcnt vmcnt(0)" ::: "memory");
        } else {
            XB_SPIN(xb_ld(&bar[XB_XGEN(b.x)]) == gen, bar);
            __builtin_amdgcn_fence(__ATOMIC_ACQUIRE, "agent");
            asm volatile("s_waitcnt vmcnt(0)" ::: "memory");
        }
    }
    __syncthreads();
}

__device__ __forceinline__ int pi32(int o) { return 2 * (o & 15) + (o >> 4); }
__device__ __forceinline__ void tr_item(const float* __restrict__ W, int N, int k0, int n0, bf16* __restrict__ WT, int ldk, int drow0, bool perm, const float* __restrict__ gsc, LAS float* scr, int lane) {
    f32x4 w[8]; const int c4 = (lane & 7) * 4, rsub = lane >> 3;
#pragma unroll
    for (int i = 0; i < 8; ++i) w[i] = *(const f32x4*)(W + (size_t)(k0 + 8 * i + rsub) * N + n0 + c4);
#pragma unroll
    for (int i = 0; i < 8; ++i) { const int kk = 8 * i + rsub; const float g = gsc ? gsc[k0 + kk] : 1.f;
        scr[kk * 33 + c4] = w[i][0] * g; scr[kk * 33 + c4 + 1] = w[i][1] * g; scr[kk * 33 + c4 + 2] = w[i][2] * g; scr[kk * 33 + c4 + 3] = w[i][3] * g; }
    LDS_WAIT(); asm volatile("" ::: "memory");
    const int c = lane & 7;
#pragma unroll
    for (int j = 0; j < 4; ++j) { const int n = (lane >> 3) + 8 * j; const LAS float* s = scr + (8 * c) * 33 + n;
        v4u o; o.x = pk2(s[0 * 33], s[1 * 33]); o.y = pk2(s[2 * 33], s[3 * 33]); o.z = pk2(s[4 * 33], s[5 * 33]); o.w = pk2(s[6 * 33], s[7 * 33]);
        const int dn = perm ? pi32(n) : n;
        *(v4u*)(WT + (size_t)(drow0 + dn) * ldk + k0 + 8 * c) = o; }
    LDS_WAIT(); asm volatile("" ::: "memory");
}
__device__ __forceinline__ float silu_f(float v) { return v / (1.f + expf(-v)); }
__device__ __forceinline__ float gelu_erf(float v) { return 0.5f * v * (1.f + erff(v * 0.70710678118654752f)); }
__device__ __forceinline__ unsigned fkey(float f) { const unsigned u = __builtin_bit_cast(unsigned, f); return (u & 0x80000000u) ? ~u : (u | 0x80000000u); }

template <int NV> __device__ __forceinline__ unsigned kth16(const unsigned (&k)[NV]) {
    unsigned T = 0u;
    for (int bit = 31; bit >= 0; --bit) { const unsigned c = T | (1u << bit); int cnt = 0;
#pragma unroll
        for (int v = 0; v < NV; ++v) cnt += __popcll(__ballot(k[v] >= c));
        if (cnt >= 16) T = c; }
    return T;
}
template <int NV> __device__ __forceinline__ void compact16(const unsigned (&k)[NV], const unsigned (&val)[NV], const unsigned (&pay)[NV], unsigned T, LAS unsigned* oval, LAS unsigned* opay, int lane) {
    const unsigned long long lt = (1ull << lane) - 1ull; int pos = 0;
#pragma unroll
    for (int v = 0; v < NV; ++v) { const bool s = k[v] > T; const unsigned long long m = __ballot(s); const int slot = pos + __popcll(m & lt); if (s) { oval[slot] = val[v]; opay[slot] = pay[v]; } pos += __popcll(m); }
#pragma unroll
    for (int v = 0; v < NV; ++v) { const bool s = k[v] == T; const unsigned long long m = __ballot(s); const int slot = pos + __popcll(m & lt); if (s && slot < 16) { oval[slot] = val[v]; opay[slot] = pay[v]; } pos += __popcll(m); }
}

struct Args { const float* in[21]; float* out; unsigned char* ws; int ph_lo, ph_hi, probe, pad; };
static_assert(sizeof(Args) == 23 * 8 + 16, "Args has no padding");

template <int PRB, bool PK> __device__ __forceinline__ void fwd_body(const Args& a) {
    extern __shared__ __attribute__((aligned(16))) unsigned char lds[];
    LAS unsigned char* L = (LAS unsigned char*)lds;
    const int wave = __builtin_amdgcn_readfirstlane((int)threadIdx.x >> 6);
    const int G = gridDim.x, bx = blockIdx.x;
    const int gw = bx * NWAVES + wave, NGW = G * NWAVES;
    const size_t NT = (size_t)G * NTHR;
#define PH_IDS() int tid_ph_ = threadIdx.x; asm volatile("" : "+v"(tid_ph_)); const int tid = tid_ph_, lane = tid & 63; const size_t gt = (size_t)bx * NTHR + tid; (void)lane; (void)gt
    unsigned char* ws = a.ws;
    float* ctlf = (float*)(ws + WS_CTL);
    const float* x = a.in[0]; const float* cvec = a.in[1]; const float* ctx = a.in[2]; const float* cctx = a.in[3]; const float* w_ada = a.in[4]; const float* b_ada = a.in[5];
    const float* norm1_g = a.in[6]; const float* w_in = a.in[7]; const float* q_norm_g = a.in[8]; const float* w_uq = a.in[9]; const float* kv_norm_g = a.in[10]; const float* w_ukv = a.in[11];
    const float* conv_w = a.in[12]; const float* conv_b = a.in[13]; const float* w_o = a.in[14]; const float* norm2_g = a.in[15]; const float* peer_wq = a.in[16]; const float* peer_keys = a.in[17];
    const float* peer_u = a.in[18]; const float* peer_v = a.in[19]; const float* final_g = a.in[20];
    float* modp = (float*)(ws + WS_MODP); float* ssq_cq = (float*)(ws + WS_SQ1); float* ssq_ckv = (float*)(ws + WS_SQ2); float* ssq_x1 = (float*)(ws + WS_SQ3);
    float* modf = (float*)(ws + WS_MODF); float* rope = (float*)(ws + WS_ROPE);
    bf16* WIN = (bf16*)(ws + WS_WIN); bf16* WUQ = (bf16*)(ws + WS_WUQ); bf16* WUKV = (bf16*)(ws + WS_WUKV); bf16* WO = (bf16*)(ws + WS_WO); bf16* WPQ = (bf16*)(ws + WS_WPQ); bf16* KBD = (bf16*)(ws + WS_KBD); bf16* KB2 = (bf16*)(ws + WS_KB2);
    unsigned char* UB = ws + WS_UB; unsigned char* VB = ws + WS_VB; float* SUV = (float*)(ws + WS_SU); bf16* HX = (bf16*)(ws + WS_HX); bf16* CQ = (bf16*)(ws + WS_CQ); bf16* CKV = (bf16*)(ws + WS_CKV); unsigned char* KR = ws + WS_KR;
    bf16* UCV = (bf16*)(ws + WS_U); bf16* GBV = (bf16*)(ws + WS_GB); unsigned char* Q = ws + WS_Q; unsigned char* KN = ws + WS_KN; unsigned char* VT = ws + WS_V; bf16* ACAT = (bf16*)(ws + WS_ACAT);
    bf16* DLT = (bf16*)(ws + WS_X1); bf16* H2 = (bf16*)(ws + WS_H2); float* SC = (float*)(ws + WS_SC);

    for (int u = threadIdx.x; u < (LDS_BYTES - RING_BYTES) / 4; u += NTHR) ((LAS unsigned*)(L + RING_BYTES))[u] = 0u;
    __syncthreads();
    const int lo = a.ph_lo, hi = a.ph_hi;
    XcdBarrier bar; bar.bar = (unsigned*)ctlf + CW_BAR; bar.x = 0; bar.st = (volatile LAS unsigned*)(L + MISC_OFF);
    if (hi - lo > 1) bar = xcd_barrier_post((unsigned*)ctlf + CW_BAR, (volatile LAS unsigned*)(L + MISC_OFF));
#define IN(k) (lo <= (k) && (k) < hi)
#ifndef PHASE_MASK
#define PHASE_MASK 0x3ff
#endif
#ifndef PROBE_PHASES
#define PROBE_PHASES_ 0
#else
#define PROBE_PHASES_ PROBE_PHASES
#endif
#define PH_ON(k) ((((PK) ? (PROBE_PHASES_) : (PHASE_MASK)) >> (k)) & 1)
#ifndef REPEAT_MASK
#define REPEAT_MASK 0
#endif
#define NREP(k) (1 + (((REPEAT_MASK) >> (k)) & 1))
#define GRID_BAR(k) do { if (IN(k) && IN((k) + 1)) xcd_barrier(bar); } while (0)

    if (PH_ON(0) && IN(0)) for (int rep_ = 0; rep_ < NREP(0); ++rep_) {
        PH_IDS();
        const int psel = a.probe ? a.probe : 7;
        if (psel & 1)
        for (int it = gw; it < 64 * 96; it += NGW) {
            const int kb = it / 96, cb = it % 96, col = cb * 256 + lane * 4;
            const float* wp = w_ada + (size_t)(kb * 64) * NMODC + col;
            f32x4 ax = {0.f, 0.f, 0.f, 0.f}, ac = {0.f, 0.f, 0.f, 0.f}; const bool cc = cb < 32;
            const float sxv = silu_f(cvec[kb * 64 + lane]), scv = silu_f(cctx[kb * 64 + lane]);
#pragma unroll 16
            for (int i = 0; i < 64; ++i) { const f32x4 w = __builtin_nontemporal_load((const f32x4*)(wp + (size_t)i * NMODC));
                ax += w * rl_f(sxv, i); ac += w * (cc ? rl_f(scv, i) : 0.f); }
            *(f32x4*)(modp + (size_t)kb * 32768 + col) = ax; if (cc) *(f32x4*)(modp + (size_t)kb * 32768 + NMODC + col) = ac;
        }
        if (psel & 2) {
            LAS float* scr = (LAS float*)(L + wave * 8448);
            constexpr int I_IN = 64 * 234, I_UQ = 12 * 96, I_UKV = 8 * 128, I_O = 64 * 128, NIT = I_IN + I_UQ + I_UKV + I_O;
            for (int it = gw; it < NIT; it += NGW) { int r = it;
                if (r < I_IN) { const int kb = r / 234, n0 = (r % 234) * 32; int drow0; bool perm = false;
                    if (n0 < 1280) drow0 = n0; else if (n0 < 1344) { drow0 = n0; perm = true; }
                    else { const int c0 = n0 - 1344; if (c0 < 2048) drow0 = 1536 + (c0 >> 7) * 256 + (c0 & 127); else if (c0 < 4096) drow0 = 5632 + (c0 - 2048); else { const int c1 = c0 - 4096; drow0 = 1536 + (c1 >> 7) * 256 + 128 + (c1 & 127); } }
                    tr_item(w_in, 7488, kb * 64, n0, WIN, 4096, drow0, perm, nullptr, scr, lane); continue; } r -= I_IN;
                if (r < I_UQ) { const int kb = r / 96, n0 = (r % 96) * 32; tr_item(w_uq, 3072, kb * 64, n0, WUQ, 768, n0, (n0 % 192) >= 128, q_norm_g, scr, lane); continue; } r -= I_UQ;
                if (r < I_UKV) { const int kb = r / 128, n0 = (r % 128) * 32; tr_item(w_ukv, 4096, kb * 64, n0, WUKV, 512, ((n0 & 255) < 128 ? 0 : 2048) + (n0 >> 8) * 128 + (n0 & 127), false, kv_norm_g, scr, lane); continue; } r -= I_UKV;
                { const int kb = r / 128, n0 = (r % 128) * 32; tr_item(w_o, 4096, kb * 64, n0, WO, 4096, n0, false, nullptr, scr, lane); }
            }
        }
        for (size_t i = gt; i < (size_t)192 * 512; i += NT) { const v4u z = {0u, 0u, 0u, 0u}; *(v4u*)(WIN + (size_t)1344 * 4096 + i * 8) = z; }
        for (size_t i = gt; i < (size_t)DM * 2048 / 8; i += NT) {
            const int d = (int)(i >> 8), c8 = (int)(i & 255) * 8, h = c8 >> 8, j = c8 & 255; const float* sp_ = peer_wq + (size_t)d * 2048 + c8; const f32x4 a0 = *(const f32x4*)sp_, a1 = *(const f32x4*)(sp_ + 4);
            v4u o; o.x = pk2(a0[0], a0[1]); o.y = pk2(a0[2], a0[3]); o.z = pk2(a1[0], a1[1]); o.w = pk2(a1[2], a1[3]); *(v4u*)(WPQ + ((size_t)h * DM + d) * 256 + j) = o; }
        for (size_t i = gt; i < (size_t)8 * 256 * 32; i += NT) {
            const int d8 = (int)(i & 31) * 8, rr = (int)(i >> 5) & 255, h = (int)(i >> 13), p = rr >> 7, k = rr & 127; v4u o = {0u, 0u, 0u, 0u};
            if ((d8 >> 7) == p) { const float* s_ = peer_keys + ((size_t)((h * 2 + p) * 128 + k)) * 128 + (d8 & 127); const f32x4 a0 = *(const f32x4*)s_, a1 = *(const f32x4*)(s_ + 4);
                o.x = pk2(a0[0], a0[1]); o.y = pk2(a0[2], a0[3]); o.z = pk2(a1[0], a1[1]); o.w = pk2(a1[2], a1[3]); }
            *(v4u*)(KB2 + i * 8) = o; }
        for (size_t i = gt; i < (size_t)192 * 16; i += NT) {
            const int pi = (int)(i >> 4), fi = (int)(i & 15); const int pos = pi < 128 ? pi : pi - 128;
            const float fr = __builtin_amdgcn_exp2f(-(float)fi * 0.83048202372184059f);
            const float turns = (float)pos * fr * 0.15915494309189535f, fx = turns - floorf(turns);
            rope[pi * 32 + 2 * fi] = __builtin_amdgcn_cosf(fx); rope[pi * 32 + 2 * fi + 1] = __builtin_amdgcn_sinf(fx); }
        if (psel & 4)
        for (int r = gw; r < 2 * NEXP; r += NGW) { const bool isv = r >= NEXP; const int e = isv ? r - NEXP : r; const float* src = (isv ? peer_v : peer_u) + (size_t)e * DM + lane * 4;
            f32x4 v[2][8]; float am = 0.f;
#pragma unroll
            for (int b = 0; b < 2; ++b)
#pragma unroll
                for (int q = 0; q < 8; ++q) { v[b][q] = __builtin_nontemporal_load((const f32x4*)(src + b * 2048 + q * 256)); am = fmaxf(am, fmaxf(fmaxf(fabsf(v[b][q][0]), fabsf(v[b][q][1])), fmaxf(fabsf(v[b][q][2]), fabsf(v[b][q][3])))); }
            am = wave_max(am);
            const float sc = am > 0.f ? exp2f(floorf(log2f(7.5f / am))) : 1.f;
            unsigned d[12];
#pragma unroll
            for (int b = 0; b < 2; ++b) { f32x16v s0, s1;
#pragma unroll
                for (int i = 0; i < 16; ++i) { const int i0 = FP6_INTERLEAVED ? 2 * i : i, i1 = FP6_INTERLEAVED ? 2 * i + 1 : 16 + i; s0[i] = v[b][i0 >> 2][i0 & 3] * sc; s1[i] = v[b][i1 >> 2][i1 & 3] * sc; }
                const u32x6v w = __builtin_amdgcn_cvt_scalef32_2xpk16_fp6_f32(s0, s1, 1.0f);
#pragma unroll
                for (int i = 0; i < 6; ++i) d[6 * b + i] = w[i]; }
            unsigned char* dst = (isv ? VB : UB) + (size_t)e * ROWB + lane * 16;
#pragma unroll
            for (int p = 0; p < 3; ++p) { const v4u o = {d[4 * p], d[4 * p + 1], d[4 * p + 2], d[4 * p + 3]}; *(v4u*)(dst + p * 1024) = o; }
            if (lane == 0) SUV[r] = 1.f / sc;
        }
    }
    GRID_BAR(0);

    if (PH_ON(1) && IN(1)) for (int rep_ = 0; rep_ < NREP(1); ++rep_) {
        PH_IDS();
        for (size_t j = gt; j < (size_t)(NMODC + 2 * DM); j += NT) { float sacc = 0.f;
#pragma unroll 8
            for (int kb = 0; kb < 64; ++kb) sacc += modp[(size_t)kb * 32768 + j];
            modf[j] = sacc + b_ada[j < (size_t)NMODC ? j : j - NMODC]; }
        { pg8::Gemm g{KB2, WPQ, 2048, DM, 256, 0, (size_t)DM * 256 * 2}; pg8::StaticOrder S; S.init(2048, DM, G, bx); pg8::EpiB16 E{KBD, DM};
          pg8::gemm_phase<pg8::EpiB16, pg8::StaticOrder, true, true>(L, g, S, E); }
    }
    GRID_BAR(1);

    if (PH_ON(2) && IN(2)) for (int rep_ = 0; rep_ < NREP(2); ++rep_) {
        PH_IDS();
        for (int row = gw; row < MR; row += NGW) {
            const bool lat = row < SEQ; const float* xr = lat ? x + (size_t)row * DM : ctx + (size_t)(row - SEQ) * DM; const float* md = lat ? modf : modf + NMODC;
            f32x4 v[16]; float ss = 0.f;
#pragma unroll
            for (int j = 0; j < 16; ++j) { v[j] = *(const f32x4*)(xr + 4 * (lane + 64 * j)); ss += (v[j][0] * v[j][0] + v[j][1] * v[j][1]) + (v[j][2] * v[j][2] + v[j][3] * v[j][3]); }
            ss = wave_sum(ss); const float rstd = 1.f / sqrtf(ss * (1.f / DM) + EPS);
#pragma unroll
            for (int j = 0; j < 16; ++j) { const int idx = 4 * (lane + 64 * j);
                const f32x4 g = *(const f32x4*)(norm1_g + idx), sh = *(const f32x4*)(md + idx), sc = *(const f32x4*)(md + DM + idx);
                const f32x4 hh = (v[j] * rstd * g) * (sc + 1.f) + sh;
                *(unsigned long long*)(HX + (size_t)row * DM + idx) = (unsigned long long)pk2(hh[0], hh[1]) | ((unsigned long long)pk2(hh[2], hh[3]) << 32); }
        }
    }
    GRID_BAR(2);

    if (PH_ON(3) && IN(3)) for (int rep_ = 0; rep_ < NREP(3); ++rep_) {
        pg8::Gemm g{HX, WIN, MR, NIN, DM, 0, 0}; pg8::OrderIn S; S.init(SEQ, NIN, G, bx);
        pg8::EpiIn E{CQ, CKV, KR, UCV, GBV, ssq_cq, ssq_ckv, rope};
        pg8::gemm_phase<pg8::EpiIn, pg8::OrderIn, true, true>(L, g, S, E);
    }
    GRID_BAR(3);

    if (PH_ON(4) && IN(4)) for (int rep_ = 0; rep_ < NREP(4); ++rep_) {
        PH_IDS();
        {
            int nq, qb0, nkv, kb0;
            if (G == 256) { nq = bx < 144 ? 1 : bx < 240 ? 2 : 3; qb0 = bx < 144 ? bx : bx < 240 ? 144 + 2 * (bx - 144) : 336 + 3 * (bx - 240); nkv = bx < 144 ? 3 : bx < 240 ? 1 : 0; kb0 = bx < 144 ? 3 * bx : 432 + (bx - 144); }
            else { qb0 = (int)(((long)384 * bx) / G); nq = (int)(((long)384 * (bx + 1)) / G) - qb0; kb0 = (int)(((long)528 * bx) / G); nkv = (int)(((long)528 * (bx + 1)) / G) - kb0; }
            const int k0 = kb0 < 264 ? kb0 : 264, k1 = kb0 + nkv < 264 ? kb0 + nkv : 264;
            const int v0 = (kb0 > 264 ? kb0 : 264) - 264, v1 = (kb0 + nkv > 264 ? kb0 + nkv : 264) - 264;
            { pg8::Gemm g{CQ, WUQ, SEQ, 3072, QL, 0, 0}; pg8::RunOrder S{qb0, nq, 12}; pg8::EpiQ E{Q, ssq_cq, rope, C2 * att::QSC};
              pg8::gemm_phase<pg8::EpiQ, pg8::RunOrder, true, true>(L, g, S, E); }
            { pg8::Gemm g{CKV, WUKV, MR, 2048, KVL, 0, 0}; pg8::RunOrder S{k0, k1 - k0, 8}; pg8::EpiK E{KN, ssq_ckv};
              pg8::gemm_phase<pg8::EpiK, pg8::RunOrder, true, true>(L, g, S, E); }
            { pg8::Gemm g{WUKV + (size_t)2048 * KVL, CKV, 2048, MR, KVL, 0, 0}; pg8::RunOrder S{v0, v1 - v0, 33}; pg8::EpiVT E{VT, ssq_ckv};
              pg8::gemm_phase<pg8::EpiVT, pg8::RunOrder, true, true>(L, g, S, E); }
        }
        for (size_t it = gt; it < (size_t)SEQ * 256; it += NT) {
            const int t = (int)(it >> 8), c8 = (int)(it & 255) * 8; const v4u z = {0u, 0u, 0u, 0u};
            const v4u um = t > 0 ? *(const v4u*)(UCV + (size_t)(t - 1) * 2048 + c8) : z, u0 = *(const v4u*)(UCV + (size_t)t * 2048 + c8), up = t < SEQ - 1 ? *(const v4u*)(UCV + (size_t)(t + 1) * 2048 + c8) : z;
            const v4u gv = *(const v4u*)(GBV + (size_t)t * 2048 + c8); v4u o;
            float w0[8], w1[8], w2[8], wb[8];
#pragma unroll
            for (int q = 0; q < 2; ++q) { const f32x4 a0 = *(const f32x4*)(conv_w + c8 + 4 * q), a1 = *(const f32x4*)(conv_w + 2048 + c8 + 4 * q), a2 = *(const f32x4*)(conv_w + 4096 + c8 + 4 * q), a3 = *(const f32x4*)(conv_b + c8 + 4 * q);
#pragma unroll
                for (int j = 0; j < 4; ++j) { w0[4 * q + j] = a0[j]; w1[4 * q + j] = a1[j]; w2[4 * q + j] = a2[j]; wb[4 * q + j] = a3[j]; } }
#pragma unroll
            for (int j = 0; j < 4; ++j) {
                const float y0 = w0[2 * j] * bflo(um[j]) + w1[2 * j] * bflo(u0[j]) + w2[2 * j] * bflo(up[j]) + wb[2 * j];
                const float y1 = w0[2 * j + 1] * bfhi(um[j]) + w1[2 * j + 1] * bfhi(u0[j]) + w2[2 * j + 1] * bfhi(up[j]) + wb[2 * j + 1];
                o[j] = pk2(bflo(gv[j]) * y0, bfhi(gv[j]) * y1); }
            *(v4u*)(ACAT + (size_t)t * DM + 2048 + c8) = o; }
    }
    GRID_BAR(4);
#ifdef PROBE_CLK
    if (bx == 0 && threadIdx.x == 0) { unsigned long long* ck = (unsigned long long*)(ws + WS_CTL + 524288); ck[0] = __builtin_readcyclecounter(); ck[2] = __builtin_amdgcn_s_memrealtime(); }
#endif

    if (PH_ON(5) && IN(5)) for (int rep_ = 0; rep_ < NREP(5); ++rep_) {
        for (int i = 0;; ++i) { int h, qb;
            if (G == 256) { if (i >= 2) break; h = 2 * (bx & 7) + i; qb = bx >> 3; } else { const int Lu = i * G + bx; if (Lu >= 512) break; h = Lu >> 5; qb = Lu & 31; }
            att::attn_unit<PRB>(Q + (size_t)(qb * 256) * 3072 + h * 192, KN + h * 128, VT + (size_t)(h * 128) * 8448, KR, ACAT + (size_t)(qb * 256) * DM + h * 128, MR, (char*)lds, L, a.probe); }
    }
#ifdef PROBE_CLK
    if (bx == 0 && threadIdx.x == 0) { unsigned long long* ck = (unsigned long long*)(ws + WS_CTL + 524288); ck[1] = __builtin_readcyclecounter(); ck[3] = __builtin_amdgcn_s_memrealtime(); }
#endif
    GRID_BAR(5);

    if (PH_ON(6) && IN(6)) for (int rep_ = 0; rep_ < NREP(6); ++rep_) {
        pg8::Gemm g{ACAT, WO, SEQ, DM, DM, 0, 0}; pg8::StaticOrder S; S.init(SEQ, DM, G, bx); pg8::EpiO E{modf + 2 * DM, DLT};
        pg8::gemm_phase<pg8::EpiO, pg8::StaticOrder, true, true>(L, g, S, E);
    }
    GRID_BAR(6);

    if (PH_ON(7) && IN(7)) for (int rep_ = 0; rep_ < NREP(7); ++rep_) {
        PH_IDS();
        for (int row = gw; row < SEQ; row += NGW) {
            f32x4 v[16]; float ssq[4] = {0.f, 0.f, 0.f, 0.f};
#pragma unroll
            for (int j = 0; j < 16; ++j) { const int idx = 4 * (lane + 64 * j); const unsigned long long d8 = *(const unsigned long long*)(DLT + (size_t)row * DM + idx); const f32x4 xv = *(const f32x4*)(x + (size_t)row * DM + idx);
                v[j][0] = xv[0] + bflo((unsigned)d8); v[j][1] = xv[1] + bfhi((unsigned)d8); v[j][2] = xv[2] + bflo((unsigned)(d8 >> 32)); v[j][3] = xv[3] + bfhi((unsigned)(d8 >> 32));
#pragma unroll
                for (int c = 0; c < 4; ++c) ssq[c] = fmaf(v[j][c], v[j][c], ssq[c]); }
            const float rstd = 1.f / sqrtf(wave_sum((ssq[0] + ssq[1]) + (ssq[2] + ssq[3])) * (1.f / DM) + EPS);
#pragma unroll
            for (int j = 0; j < 16; ++j) { const int idx = 4 * (lane + 64 * j);
                const f32x4 g = *(const f32x4*)(norm2_g + idx), sh = *(const f32x4*)(modf + 3 * DM + idx), sc = *(const f32x4*)(modf + 4 * DM + idx);
                const f32x4 hh = (v[j] * rstd * g) * (sc + 1.f) + sh;
                *(unsigned long long*)(H2 + (size_t)row * DM + idx) = (unsigned long long)pk2(hh[0], hh[1]) | ((unsigned long long)pk2(hh[2], hh[3]) << 32); }
        }
    }
    GRID_BAR(7);

    if (PH_ON(8) && IN(8)) for (int rep_ = 0; rep_ < NREP(8); ++rep_) {
        pg8::Gemm g{H2, KBD, SEQ, 2048, DM, 0, 0}; pg8::StaticOrder S; S.init(SEQ, 2048, G, bx); pg8::EpiF32 E{SC, 2048};
        pg8::gemm_phase<pg8::EpiF32, pg8::StaticOrder, true, true>(L, g, S, E);
    }
    GRID_BAR(8);

    if (PH_ON(9) && IN(9)) for (int rep_ = 0; rep_ < NREP(9); ++rep_) {
        int lane0_ = threadIdx.x; asm volatile("" : "+v"(lane0_)); lane0_ &= 63;
        LAS unsigned* wl = (LAS unsigned*)(L + wave * 8192);
        LAS unsigned* sV1 = wl, *sI1 = wl + 16, *sV2 = wl + 32, *sI2 = wl + 48, *sVc = wl + 64, *sEc = wl + 80;
        LAS unsigned* eL = wl + 128; LAS float* gL = (LAS float*)(wl + 128 + 512);
        const float* gate2 = modf + 5 * DM; const int emask_ = a.probe ? 63 : 0xffff; float* outp_ = a.probe ? (float*)(ws + WS_HX) : a.out;
        for (int tb = gw * 4; tb < SEQ; tb += NGW * 4) {
            for (int ti = 0; ti < 4; ++ti) { const int t = tb + ti; int lane = lane0_; asm volatile("" : "+v"(lane));
                for (int h = 0; h < 8; ++h) { const float* sp = SC + (size_t)t * 2048 + h * 256;
                    { const float s0 = sp[lane], s1 = sp[64 + lane]; const unsigned k[2] = {fkey(s0), fkey(s1)}, vb[2] = {__builtin_bit_cast(unsigned, s0), __builtin_bit_cast(unsigned, s1)}, pl[2] = {(unsigned)lane, (unsigned)(64 + lane)};
                      const unsigned T = kth16<2>(k); compact16<2>(k, vb, pl, T, sV1, sI1, lane); }
                    { const float s0 = sp[128 + lane], s1 = sp[192 + lane]; const unsigned k[2] = {fkey(s0), fkey(s1)}, vb[2] = {__builtin_bit_cast(unsigned, s0), __builtin_bit_cast(unsigned, s1)}, pl[2] = {(unsigned)lane, (unsigned)(64 + lane)};
                      const unsigned T = kth16<2>(k); compact16<2>(k, vb, pl, T, sV2, sI2, lane); }
                    LDS_WAIT();
                    { const float s2b = __builtin_bit_cast(float, sV2[lane & 15]); const unsigned i2b = sI2[lane & 15]; unsigned k[4], vb[4], pl[4];
#pragma unroll
                      for (int r = 0; r < 4; ++r) { const int aa = (lane >> 4) + 4 * r; const float cv = __builtin_bit_cast(float, sV1[aa]) + s2b; k[r] = fkey(cv); vb[r] = __builtin_bit_cast(unsigned, cv); pl[r] = sI1[aa] * 128u + i2b; }
                      const unsigned T = kth16<4>(k); compact16<4>(k, vb, pl, T, sVc, sEc, lane); }
                    LDS_WAIT();
                    { const float tv = __builtin_bit_cast(float, sVc[lane & 15]); const float mx = row16_max(tv);
                      const float ex = expf(tv - mx); const float sm = row16_sum(ex);
                      if (lane < 16) { eL[ti * 128 + h * 16 + lane] = sEc[lane]; gL[ti * 128 + h * 16 + lane] = ex / sm; } }
                    LDS_WAIT();
                }
                { const unsigned e0 = eL[ti * 128 + lane], e1 = eL[ti * 128 + 64 + lane]; const float g0 = gL[ti * 128 + lane], g1 = gL[ti * 128 + 64 + lane];
                  const unsigned k0 = (e0 << 7) | (unsigned)lane, k1 = (e1 << 7) | (unsigned)(64 + lane); int r0 = 0, r1 = 0;
#pragma unroll 8
                  for (int m = 0; m < 128; ++m) { const unsigned km = (eL[ti * 128 + m] << 7) | (unsigned)m; r0 += km < k0 ? 1 : 0; r1 += km < k1 ? 1 : 0; }
                  LDS_WAIT();
                  eL[ti * 128 + r0] = e0; gL[ti * 128 + r0] = g0; eL[ti * 128 + r1] = e1; gL[ti * 128 + r1] = g1;
                  LDS_WAIT(); }
                h16x2 hh[2][16];
#pragma unroll
                for (int b = 0; b < 2; ++b)
#pragma unroll
                    for (int q = 0; q < 8; ++q) { const unsigned long long a0 = *(const unsigned long long*)(H2 + (size_t)t * DM + b * 2048 + q * 256 + lane * 4);
                        hh[b][2 * q] = (h16x2){(_Float16)bflo((unsigned)a0), (_Float16)bfhi((unsigned)a0)}; hh[b][2 * q + 1] = (h16x2){(_Float16)bflo((unsigned)(a0 >> 32)), (_Float16)bfhi((unsigned)(a0 >> 32))}; }
                v4u rr[6][3]; float rs[6];
#define LDROW(j, TAB, e, SOFF) do { const unsigned char* rp_ = (TAB) + (size_t)(e) * ROWB + lane * 16; _Pragma("unroll") for (int p = 0; p < 3; ++p) rr[j][p] = *(const v4u*)(rp_ + p * 1024); rs[j] = SUV[(SOFF) + (e)]; } while (0)
#define EIDX(k) (__builtin_amdgcn_readfirstlane((int)eL[ti * 128 + (k)]) & emask_)
#define UNPKH(j, b) __builtin_amdgcn_cvt_scalef32_pk32_f16_fp6((b) == 0 ? (u32x6v){rr[j][0][0], rr[j][0][1], rr[j][0][2], rr[j][0][3], rr[j][1][0], rr[j][1][1]} : (u32x6v){rr[j][1][2], rr[j][1][3], rr[j][2][0], rr[j][2][1], rr[j][2][2], rr[j][2][3]}, 1.0f)
#define DOTROW(out, j) do { float a0 = 0.f, a1 = 0.f, a2 = 0.f, a3 = 0.f; _Pragma("unroll") for (int b = 0; b < 2; ++b) { const h16x32 x_ = UNPKH(j, b); \
                    _Pragma("unroll") for (int i = 0; i < 16; i += 4) { a0 = __builtin_amdgcn_fdot2((h16x2){x_[2 * i], x_[2 * i + 1]}, hh[b][i], a0, false); a1 = __builtin_amdgcn_fdot2((h16x2){x_[2 * i + 2], x_[2 * i + 3]}, hh[b][i + 1], a1, false); \
                        a2 = __builtin_amdgcn_fdot2((h16x2){x_[2 * i + 4], x_[2 * i + 5]}, hh[b][i + 2], a2, false); a3 = __builtin_amdgcn_fdot2((h16x2){x_[2 * i + 6], x_[2 * i + 7]}, hh[b][i + 3], a3, false); } } \
                    out = (a0 + a1) + (a2 + a3); } while (0)
                int ei[6];
#pragma unroll
                for (int j = 0; j < 6; ++j) { ei[j] = EIDX(j); LDROW(j, UB, ei[j], 0); }
                for (int k0 = 0; k0 < 126; k0 += 6) {
                    float dsum[6];
#pragma unroll
                    for (int j = 0; j < 6; ++j) { float part; DOTROW(part, j); const float sc_ = rs[j];
                        if (k0 + 6 + j < 128) { ei[j] = EIDX(k0 + 6 + j); LDROW(j, UB, ei[j], 0); }
                        dsum[j] = wave_sum(part) * sc_; }
                    if (lane < 6) { float d = dsum[0];
#pragma unroll
                        for (int j = 1; j < 6; ++j) d = lane == j ? dsum[j] : d;
                        gL[ti * 128 + k0 + lane] = gL[ti * 128 + k0 + lane] * gelu_erf(d); }
                }
                { float dsum[2];
#pragma unroll
                  for (int j = 0; j < 2; ++j) { float part; DOTROW(part, j); dsum[j] = wave_sum(part) * rs[j]; }
                  if (lane < 2) { const float d = lane == 0 ? dsum[0] : dsum[1]; gL[ti * 128 + 126 + lane] = gL[ti * 128 + 126 + lane] * gelu_erf(d); } }
                LDS_WAIT();
            }
            for (int ti = 0; ti < 4; ++ti) { const int t = tb + ti; int lane = lane0_; asm volatile("" : "+v"(lane));
                h16x2 ah[2][16];
#pragma unroll
                for (int b = 0; b < 2; ++b)
#pragma unroll
                    for (int i = 0; i < 16; ++i) ah[b][i] = (h16x2){(_Float16)0.f, (_Float16)0.f};
                v4u rr[6][3]; float rs[6];
#define FMAROW(j, WW) do { const _Float16 wh_ = (_Float16)(WW); const h16x2 w2_ = {wh_, wh_}; _Pragma("unroll") for (int b = 0; b < 2; ++b) { const h16x32 x_ = UNPKH(j, b); \
                    _Pragma("unroll") for (int i = 0; i < 16; ++i) ah[b][i] = __builtin_elementwise_fma(w2_, (h16x2){x_[2 * i], x_[2 * i + 1]}, ah[b][i]); } } while (0)
                int ei[6];
#pragma unroll
                for (int j = 0; j < 6; ++j) { ei[j] = EIDX(j); LDROW(j, VB, ei[j], NEXP); }
                for (int k0 = 0; k0 < 126; k0 += 6) {
#pragma unroll
                    for (int j = 0; j < 6; ++j) { FMAROW(j, gL[ti * 128 + k0 + j] * rs[j]);
                        if (k0 + 6 + j < 128) { ei[j] = EIDX(k0 + 6 + j); LDROW(j, VB, ei[j], NEXP); } }
                }
#pragma unroll
                for (int j = 0; j < 2; ++j) FMAROW(j, gL[ti * 128 + 126 + j] * rs[j]);
                float acc[2][32];
#pragma unroll
                for (int b = 0; b < 2; ++b)
#pragma unroll
                    for (int i = 0; i < 16; ++i) { acc[b][2 * i] = (float)ah[b][i][0]; acc[b][2 * i + 1] = (float)ah[b][i][1]; }
                float ssp[4] = {0.f, 0.f, 0.f, 0.f}; int lane_f = lane; asm volatile("" : "+v"(lane_f));
#pragma unroll
                for (int b = 0; b < 2; ++b)
#pragma unroll
                    for (int q = 0; q < 8; ++q) { unsigned o = (unsigned)(b * 2048 + q * 256 + lane_f * 4); asm volatile("" : "+v"(o)); const unsigned long long d8 = *(const unsigned long long*)(DLT + (size_t)t * DM + o); f32x4 xa = *(const f32x4*)(x + (size_t)t * DM + o); const f32x4 ga = *(const f32x4*)(gate2 + o);
                        xa[0] += bflo((unsigned)d8); xa[1] += bfhi((unsigned)d8); xa[2] += bflo((unsigned)(d8 >> 32)); xa[3] += bfhi((unsigned)(d8 >> 32));
#pragma unroll
                        for (int j = 0; j < 4; ++j) { acc[b][4 * q + j] = fmaf(ga[j], acc[b][4 * q + j], xa[j]); ssp[j] = fmaf(acc[b][4 * q + j], acc[b][4 * q + j], ssp[j]); }
                        if ((q & 1) == 1) asm volatile("" ::: "memory"); }
                const float ss = wave_sum((ssp[0] + ssp[1]) + (ssp[2] + ssp[3])); const float rstd = 1.f / sqrtf(ss * (1.f / DM) + EPS);
#pragma unroll
                for (int b = 0; b < 2; ++b)
#pragma unroll
                    for (int q = 0; q < 8; ++q) { unsigned o = (unsigned)(b * 2048 + q * 256 + lane_f * 4); asm volatile("" : "+v"(o)); const f32x4 fa = *(const f32x4*)(final_g + o); f32x4 oa;
#pragma unroll
                        for (int j = 0; j < 4; ++j) oa[j] = acc[b][4 * q + j] * rstd * fa[j];
                        *(f32x4*)(outp_ + (size_t)t * DM + o) = oa; if ((q & 1) == 1) asm volatile("" ::: "memory"); }
            }
            LDS_WAIT();
#undef LDROW
#undef EIDX
#undef DOTROW
#undef FMAROW
#undef UNPKH
        }
    }
#undef IN
#undef GRID_BAR
}

__global__ void __launch_bounds__(NTHR, 2) fwd(Args a) { fwd_body<0, false>(a); }
#ifdef PROBE_PHASES
#ifndef PROBE_MODE
#define PROBE_MODE 0
#endif
__global__ void __launch_bounds__(NTHR, 2) fwd_p(Args a) { fwd_body<PROBE_MODE, true>(a); }
#endif

#ifdef PROBE_MX
typedef int v8i_t __attribute__((ext_vector_type(8)));
typedef float v16f_t __attribute__((ext_vector_type(16)));
__device__ __forceinline__ unsigned char f8enc(int v) {
    if (v == 0) return 0; int e = 0; int m = v; while (m >= 2) { m >>= 1; ++e; } const int frac = (v << 3 >> e) & 7; return (unsigned char)(((e + 7) << 3) | frac); }
__global__ void probe_mx(float* out) {
    const int l = threadIdx.x, r = l & 31, h = l >> 5;
    float code = 0.f;
    for (int hyp = 0; hyp < 2; ++hyp) {
        unsigned char ab[32], bb[32];
        for (int j = 0; j < 32; ++j) { const int k = hyp == 0 ? 32 * h + j : (j < 16 ? 16 * h + j : 32 + 16 * h + (j - 16));
            ab[j] = f8enc(k == (7 * r + 3) % 64 ? 1 : 0); bb[j] = f8enc(1 + ((k + 3 * r) % 13)); }
        v8i_t A, B;
        for (int d = 0; d < 8; ++d) { A[d] = ab[4 * d] | (ab[4 * d + 1] << 8) | (ab[4 * d + 2] << 16) | (ab[4 * d + 3] << 24); B[d] = bb[4 * d] | (bb[4 * d + 1] << 8) | (bb[4 * d + 2] << 16) | (bb[4 * d + 3] << 24); }
        v16f_t c = {};
        c = __builtin_amdgcn_mfma_scale_f32_32x32x64_f8f6f4(A, B, c, 0, 0, 0, 0x7F7F7F7F, 0, 0x7F7F7F7F);
        bool ok = true;
        for (int g = 0; g < 16; ++g) { const int row = (g & 3) + 8 * (g >> 2) + 4 * h, col = r; const int kk = (7 * row + 3) % 64; const float expect = (float)(1 + ((kk + 3 * col) % 13)); ok = ok && (c[g] == expect); }
        const bool all_ok = __all(ok);
        if (all_ok) code += (hyp == 0 ? 1.f : 2.f);
    }
    if (l == 0) out[0] = 1000.f * (1.f + code);
}
#endif

#ifdef PROBE_STAMP
__global__ void probe_stamp_k(float* out) { if (threadIdx.x == 0) { const double v = (double)att::g_stamp[PROBE_STAMP / 10][PROBE_STAMP % 10] / 262.0; out[0] = 200.f * (float)(int)(v / 200.0 + 0.5); for (int w = 0; w < 8; ++w) for (int k = 0; k < 6; ++k) att::g_stamp[w][k] = 0ull; } }
#endif
#ifdef PROBE_CLK
__global__ void probe_clk_k(const unsigned long long* c, float* out) { if (threadIdx.x == 0) { const double cyc = (double)(c[1] - c[0]), tk = (double)(c[3] - c[2]); out[0] = PROBE_CLK == 1 ? 300.f * (float)(int)(cyc / 264.0 / 300.0 + 0.5) : 4000.f * (float)(int)(cyc / tk / 4.0 + 0.5); } }
#endif
extern "C" void kernel_launch(void* const* d_in, const int* in_sizes, int n_in, void* d_out, int out_size, void* d_ws, size_t ws_size, hipStream_t stream) {
    static int grid = 0;
    if (grid == 0) {
        if (n_in != 21 || in_sizes[0] != SEQ * DM || out_size != SEQ * DM || ws_size < WS_END) {
            fprintf(stderr, "kernel_launch: built for 21 inputs, x/out of %d floats, >= %zu bytes of workspace; got n_in %d, in0 %d, out %d, ws %zu; nothing launched\n", SEQ * DM, (size_t)WS_END, n_in, n_in > 0 ? in_sizes[0] : -1, out_size, ws_size); grid = -1; return; }
        int dev = 0, cus = 0, per_cu = 0;
        if (hipGetDevice(&dev) != hipSuccess || hipDeviceGetAttribute(&cus, hipDeviceAttributeMultiprocessorCount, dev) != hipSuccess) { fprintf(stderr, "kernel_launch: device query failed\n"); grid = -1; return; }
        if (hipFuncSetAttribute((const void*)fwd, hipFuncAttributeMaxDynamicSharedMemorySize, LDS_BYTES) != hipSuccess) { fprintf(stderr, "kernel_launch: hipFuncSetAttribute failed\n"); grid = -1; return; }
        if (hipOccupancyMaxActiveBlocksPerMultiprocessor(&per_cu, (const void*)fwd, NTHR, LDS_BYTES) != hipSuccess || per_cu < 1) fprintf(stderr, "kernel_launch: note: occupancy query reports %d workgroups per CU\n", per_cu);
        (void)hipGetLastError();
        grid = cus;
    }
    if (grid < 0) return;
    if (hipMemsetAsync((char*)d_ws + WS_CTL, 0, CTL_ZERO_BYTES, stream) != hipSuccess) { fprintf(stderr, "kernel_launch: memset failed\n"); return; }
    Args a{};
    for (int i = 0; i < 21; ++i) a.in[i] = (const float*)d_in[i];
    a.out = (float*)d_out; a.ws = (unsigned char*)d_ws;
#if MK_ONE_LAUNCH
    a.ph_lo = 0; a.ph_hi = NPHASE;
    hipLaunchKernelGGL(fwd, dim3(grid), dim3(NTHR), LDS_BYTES, stream, a);
#ifndef PROBE_MODE
#define PROBE_MODE 0
#endif
#ifdef PROBE_PHASES
    for (int p = 0; p < NPHASE; ++p) if ((PROBE_PHASES >> p) & 1) { a.ph_lo = p; a.ph_hi = p + 1; a.probe = PROBE_MODE; hipFuncSetAttribute((const void*)fwd_p, hipFuncAttributeMaxDynamicSharedMemorySize, LDS_BYTES); hipLaunchKernelGGL(fwd_p, dim3(grid), dim3(NTHR), LDS_BYTES, stream, a); }
#endif
#else
    for (int p = 0; p < NPHASE; ++p) { a.ph_lo = p; a.ph_hi = p + 1; hipLaunchKernelGGL(fwd, dim3(grid), dim3(NTHR), LDS_BYTES, stream, a); }
#endif
#ifdef PROBE_STAMP
    hipLaunchKernelGGL(probe_stamp_k, dim3(1), dim3(64), 0, stream, (float*)d_out);
#endif
#ifdef PROBE_UB
    hipFuncSetAttribute((const void*)probe_ub, hipFuncAttributeMaxDynamicSharedMemorySize, LDS_BYTES);
    hipLaunchKernelGGL(probe_ub, dim3(256), dim3(512), LDS_BYTES, stream, (float*)((char*)d_ws + WS_CTL + 600000), 400);
#endif
#ifdef PROBE_CLK
    hipLaunchKernelGGL(probe_clk_k, dim3(1), dim3(64), 0, stream, (const unsigned long long*)((char*)d_ws + WS_CTL + 524288), (float*)d_out);
#endif
#ifdef PROBE_MX
    hipLaunchKernelGGL(probe_mx, dim3(1), dim3(64), 0, stream, (float*)d_out);
#endif
    const hipError_t le = hipPeekAtLastError();
    if (le != hipSuccess) fprintf(stderr, "kernel_launch: launch failed: %s\n", hipGetErrorName(le));
}
```

```cpp
#include <hip/hip_runtime.h>
#include <cstdio>
#include <cstdint>
#include <cmath>
namespace pg8 {
#define PG8_LAS __attribute__((address_space(3)))
typedef unsigned short bf16_t;
typedef short bf16x8 __attribute__((ext_vector_type(8)));
typedef float f32x4 __attribute__((ext_vector_type(4)));
typedef unsigned u32x4 __attribute__((ext_vector_type(4)));
constexpr int BM = 256, BK = 64, HALF = 128, HTB = HALF * BK * 2  , STAGE_BYTES = 8 * HTB, NXCD = 8, WGM = 8;

__host__ __device__ __forceinline__ int lds_byte(int r, int c) { const int st = (r >> 4) * 2 + (c >> 5), rr = r & 15, cc = c & 31, ob = rr * 64 + cc * 2; return st * 1024 + (ob ^ (((ob >> 9) & 1) << 5)); }
__host__ __device__ __forceinline__ void stage_rc(int b, int& R, int& C) { const int st = b / 1024, sb = b % 1024, swz = sb ^ (((sb >> 9) & 1) << 5); R = (st >> 1) * 16 + swz / 64; C = (st & 1) * 32 + (swz % 64) / 2; }
__host__ __device__ __forceinline__ int perm32(int rho) { const int n = rho >> 4, i = rho & 15; return 8 * (i >> 2) + 4 * n + (i & 3); }

struct Unit { int pm, pn; };
struct Gemm { const bf16_t* A; const bf16_t* Bt; int M, N, K; size_t a_pn; size_t b_pm; };

struct StaticOrder {
    int nM, nN, nwg, G, c;
    __host__ __device__ void init(int M, int N, int G_, int c_) { nM = M / BM; nN = N / BM; nwg = nM * nN; G = G_; c = c_; }
    __host__ __device__ bool next(int i, Unit& u) const {
        const long L = (long)i * G + c; if (L >= nwg) return false;
        int wgid = (int)L; { const int q = nwg / NXCD, r = nwg % NXCD, xcd = wgid % NXCD, off = wgid / NXCD; wgid = (xcd < r ? xcd * (q + 1) : r * (q + 1) + (xcd - r) * q) + off; }
        const int nig = WGM * nN, gid = wgid / nig, fm = gid * WGM, gsz = (nM - fm) < WGM ? (nM - fm) : WGM;
        u.pm = fm + ((wgid % nig) % gsz); u.pn = (wgid % nig) / gsz; return true;
    }
    __device__ __forceinline__ void a_ready(const Unit&) const {}
    __device__ __forceinline__ void done(const Unit&) const {}
};

__device__ __forceinline__ unsigned cvt_pk_bf16(float lo, float hi) { unsigned r; asm volatile("v_cvt_pk_bf16_f32 %0, %1, %2" : "=v"(r) : "v"(lo), "v"(hi)); return r; }
typedef float f32x2 __attribute__((ext_vector_type(2)));
__device__ __forceinline__ f32x2 gelu_pk(f32x2 v) {
    const f32x2 av = __builtin_elementwise_abs(v), d = av * 0.2316418882f + 1.0f;
    f32x2 t; t.x = __builtin_amdgcn_rcpf(d.x); t.y = __builtin_amdgcn_rcpf(d.y);
    f32x2 q = t * 0.5307027145f + (-0.7265760135f); q = q * t + 0.7107068705f; q = q * t + (-0.142248368f); q = q * t + 0.127414796f; q = q * t;
    const f32x2 s = (v * v) * (-0.72134752044f);
    f32x2 e; e.x = __builtin_amdgcn_exp2f(s.x); e.y = __builtin_amdgcn_exp2f(s.y);
    const f32x2 m = v * (q * e), r = v - m;
    f32x2 o; o.x = v.x < 0.f ? m.x : r.x; o.y = v.y < 0.f ? m.y : r.y; return o;
}


__device__ __forceinline__ u32x4 pack8(f32x4 v0, f32x4 v1) { u32x4 w; w.x = cvt_pk_bf16(v0[0], v0[1]); w.y = cvt_pk_bf16(v0[2], v0[3]); w.z = cvt_pk_bf16(v1[0], v1[1]); w.w = cvt_pk_bf16(v1[2], v1[3]); return w; }
__device__ __forceinline__ unsigned long long pack8_fp8(f32x4 v0, f32x4 v1) { int lo = __builtin_amdgcn_cvt_pk_fp8_f32(v0[0], v0[1], 0, false); lo = __builtin_amdgcn_cvt_pk_fp8_f32(v0[2], v0[3], lo, true);
    int hi = __builtin_amdgcn_cvt_pk_fp8_f32(v1[0], v1[1], 0, false); hi = __builtin_amdgcn_cvt_pk_fp8_f32(v1[2], v1[3], hi, true); return (unsigned long long)(unsigned)lo | ((unsigned long long)(unsigned)hi << 32); }
__device__ __forceinline__ float quad_row_sum(float s) { s += __shfl_xor(s, 16); s += __shfl_xor(s, 32); return s; }

__device__ __forceinline__ f32x4 rope4(f32x4 v, const float* tab, int i) {
    const f32x4 cs = *(const f32x4*)(tab + 2 * i);
    f32x4 o; o[0] = v[0] * cs[0] - v[1] * cs[1]; o[1] = v[1] * cs[0] + v[0] * cs[1]; o[2] = v[2] * cs[2] - v[3] * cs[3]; o[3] = v[3] * cs[2] + v[2] * cs[3]; return o;
}

struct EpiIn {
    static constexpr bool PERM = true, AFTER_DRAIN = false;
    bf16_t* cq; bf16_t* ckv; unsigned char* kr; bf16_t* ub; bf16_t* gb; float* ssq_cq; float* ssq_ckv; const float* rope;
    __device__ __forceinline__ void operator()(const f32x4 (&acc)[2][2][4][2], const Unit& u, int wr, int wc, int fr, int fq) const {
        const int pn = u.pn, row0 = u.pm * BM + wr * 64 + fr, cw = wc * 32 + 8 * fq;
        if (pn < 5) {
            bf16_t* dst = pn < 3 ? cq : ckv; const int ld = pn < 3 ? 768 : 512, pl = pn < 3 ? pn : pn - 3, coff = pl * 256 + cw, nsl = pn < 3 ? 12 : 8; float* ssq = pn < 3 ? ssq_cq : ssq_ckv;
#pragma unroll
            for (int ai = 0; ai < 2; ++ai)
#pragma unroll
                for (int m = 0; m < 4; ++m) { const int row = row0 + ai * HALF + m * 16; float s = 0.f;
#pragma unroll
                    for (int bj = 0; bj < 2; ++bj) { const f32x4 v0 = acc[ai][bj][m][0], v1 = acc[ai][bj][m][1];
                        s += (v0[0] * v0[0] + v0[1] * v0[1]) + (v0[2] * v0[2] + v0[3] * v0[3]) + (v1[0] * v1[0] + v1[1] * v1[1]) + (v1[2] * v1[2] + v1[3] * v1[3]);
                        *(u32x4*)(dst + (size_t)row * ld + coff + bj * HALF) = pack8(v0, v1); }
                    s = quad_row_sum(s); if (fq == 0) ssq[(size_t)row * nsl + pl * 4 + wc] = s; }
        } else if (pn == 5) {
            if (wc < 2) {
#pragma unroll
                for (int ai = 0; ai < 2; ++ai)
#pragma unroll
                    for (int m = 0; m < 4; ++m) { const int row = row0 + ai * HALF + m * 16; f32x4 v0 = acc[ai][0][m][0], v1 = acc[ai][0][m][1];
                        if (row < 8192) { const int pos = wc == 0 ? (row >> 6) : 128 + (row & 63); const float* tab = rope + pos * 32; v0 = rope4(v0, tab, 4 * fq); v1 = rope4(v1, tab, 4 * fq + 2); }
                        *(unsigned long long*)(kr + (size_t)row * 64 + cw) = pack8_fp8(v0, v1); }
            }
        } else if (pn < 22) {
            const int j = pn - 6;
#pragma unroll
            for (int ai = 0; ai < 2; ++ai)
#pragma unroll
                for (int m = 0; m < 4; ++m) { const int row = row0 + ai * HALF + m * 16;
                    *(u32x4*)(ub + (size_t)row * 2048 + j * 128 + cw) = pack8(acc[ai][0][m][0] * acc[ai][1][m][0], acc[ai][0][m][1] * acc[ai][1][m][1]); }
        } else {
            const int j = pn - 22;
#pragma unroll
            for (int ai = 0; ai < 2; ++ai)
#pragma unroll
                for (int m = 0; m < 4; ++m) { const int row = row0 + ai * HALF + m * 16;
#pragma unroll
                    for (int bj = 0; bj < 2; ++bj) *(u32x4*)(gb + (size_t)row * 2048 + j * 256 + bj * HALF + cw) = pack8(acc[ai][bj][m][0], acc[ai][bj][m][1]); }
        }
    }
};

struct EpiQ {
    static constexpr bool PERM = true, AFTER_DRAIN = false;
    unsigned char* q; const float* ssq_cq; const float* rope; float c2;
    __device__ __forceinline__ void operator()(const f32x4 (&acc)[2][2][4][2], const Unit& u, int wr, int wc, int fr, int fq) const {
        const int row0 = u.pm * BM + wr * 64 + fr, cw = wc * 32 + 8 * fq;
#pragma unroll
        for (int ai = 0; ai < 2; ++ai)
#pragma unroll
            for (int m = 0; m < 4; ++m) { const int row = row0 + ai * HALF + m * 16; const f32x4 q0 = *(const f32x4*)(ssq_cq + (size_t)row * 12), q1 = *(const f32x4*)(ssq_cq + (size_t)row * 12 + 4), q2 = *(const f32x4*)(ssq_cq + (size_t)row * 12 + 8);
                const float ssum = (((q0[0] + q0[1]) + (q0[2] + q0[3])) + ((q1[0] + q1[1]) + (q1[2] + q1[3]))) + ((q2[0] + q2[1]) + (q2[2] + q2[3])); const float sc = c2 / sqrtf(ssum * (1.f / 768.f) + 1e-6f);
#pragma unroll
                for (int bj = 0; bj < 2; ++bj) { const int col = u.pn * BM + bj * HALF + cw, d = col % 192; f32x4 v0 = acc[ai][bj][m][0] * sc, v1 = acc[ai][bj][m][1] * sc;
                    if (d >= 128) { const int p = d - 128, ax = p >> 5, i = (p & 31) >> 1; const int pos = ax == 0 ? (row >> 6) : 128 + (row & 63); const float* tab = rope + pos * 32;
                        v0 = rope4(v0, tab, i); v1 = rope4(v1, tab, i + 2); }
                    *(unsigned long long*)(q + (size_t)row * 3072 + col) = pack8_fp8(v0, v1); } }
    }
};

struct EpiK {
    static constexpr bool PERM = true, AFTER_DRAIN = false;
    unsigned char* kn; const float* ssq_ckv;
    __device__ __forceinline__ void operator()(const f32x4 (&acc)[2][2][4][2], const Unit& u, int wr, int wc, int fr, int fq) const {
        const int row0 = u.pm * BM + wr * 64 + fr, cw = u.pn * BM + wc * 32 + 8 * fq;
#pragma unroll
        for (int ai = 0; ai < 2; ++ai)
#pragma unroll
            for (int m = 0; m < 4; ++m) { const int row = row0 + ai * HALF + m * 16; const f32x4 q0 = *(const f32x4*)(ssq_ckv + (size_t)row * 8), q1 = *(const f32x4*)(ssq_ckv + (size_t)row * 8 + 4);
                const float ssum = ((q0[0] + q0[1]) + (q0[2] + q0[3])) + ((q1[0] + q1[1]) + (q1[2] + q1[3])); const float sc = 1.f / sqrtf(ssum * (1.f / 512.f) + 1e-6f);
#pragma unroll
                for (int bj = 0; bj < 2; ++bj) *(unsigned long long*)(kn + (size_t)row * 2048 + cw + bj * HALF) = pack8_fp8(acc[ai][bj][m][0] * sc, acc[ai][bj][m][1] * sc); }
    }
};

struct EpiVT {
    static constexpr bool PERM = true, AFTER_DRAIN = false;
    unsigned char* vt; const float* ssq_ckv;
    __device__ __forceinline__ void operator()(const f32x4 (&acc)[2][2][4][2], const Unit& u, int wr, int wc, int fr, int fq) const {
        const int row0 = u.pm * BM + wr * 64 + fr, key0 = u.pn * BM + wc * 32 + 8 * fq;
        f32x4 rs[2][2];
#pragma unroll
        for (int bj = 0; bj < 2; ++bj)
#pragma unroll
            for (int n = 0; n < 2; ++n)
#pragma unroll
                for (int j = 0; j < 4; ++j) { const int key = key0 + bj * HALF + 4 * n + j; const f32x4 q0 = *(const f32x4*)(ssq_ckv + (size_t)key * 8), q1 = *(const f32x4*)(ssq_ckv + (size_t)key * 8 + 4);
                    const float ssum = ((q0[0] + q0[1]) + (q0[2] + q0[3])) + ((q1[0] + q1[1]) + (q1[2] + q1[3])); rs[bj][n][j] = 1.f / sqrtf(ssum * (1.f / 512.f) + 1e-6f); }
#pragma unroll
        for (int ai = 0; ai < 2; ++ai)
#pragma unroll
            for (int m = 0; m < 4; ++m) { const int row = row0 + ai * HALF + m * 16;
#pragma unroll
                for (int bj = 0; bj < 2; ++bj) { const int key8 = key0 + bj * HALF, g = (key8 & 63) >> 3; unsigned char* dst = vt + (size_t)row * 8448 + (key8 & ~63) + 16 * (g >> 2) + 4 * (g & 3);
                    const f32x4 v0 = acc[ai][bj][m][0] * rs[bj][0], v1 = acc[ai][bj][m][1] * rs[bj][1];
                    int w0 = __builtin_amdgcn_cvt_pk_fp8_f32(v0[0], v0[1], 0, false); w0 = __builtin_amdgcn_cvt_pk_fp8_f32(v0[2], v0[3], w0, true);
                    int w1 = __builtin_amdgcn_cvt_pk_fp8_f32(v1[0], v1[1], 0, false); w1 = __builtin_amdgcn_cvt_pk_fp8_f32(v1[2], v1[3], w1, true);
                    *(int*)dst = w0; *(int*)(dst + 32) = w1; } }
    }
};

struct EpiO {
    static constexpr bool PERM = true, AFTER_DRAIN = false;
    const float* gate; bf16_t* dlt;
    __device__ __forceinline__ void operator()(const f32x4 (&acc)[2][2][4][2], const Unit& u, int wr, int wc, int fr, int fq) const {
        const int row0 = u.pm * BM + wr * 64 + fr, c0 = u.pn * BM + wc * 32 + 8 * fq;
        f32x4 g[2][2];
#pragma unroll
        for (int bj = 0; bj < 2; ++bj)
#pragma unroll
            for (int n = 0; n < 2; ++n) g[bj][n] = *(const f32x4*)(gate + c0 + bj * HALF + 4 * n);
#pragma unroll
        for (int ai = 0; ai < 2; ++ai)
#pragma unroll
            for (int m = 0; m < 4; ++m) { const int row = row0 + ai * HALF + m * 16;
#pragma unroll
                for (int bj = 0; bj < 2; ++bj) *(u32x4*)(dlt + (size_t)row * 4096 + c0 + bj * HALF) = pack8(g[bj][0] * acc[ai][bj][m][0], g[bj][1] * acc[ai][bj][m][1]); }
    }
};

struct EpiPQ {
    static constexpr bool PERM = true, AFTER_DRAIN = false;
    bf16_t* qp;
    __device__ __forceinline__ void operator()(const f32x4 (&acc)[2][2][4][2], const Unit& u, int wr, int wc, int fr, int fq) const {
        const int row0 = u.pm * BM + wr * 64 + fr, cw = wc * 32 + 8 * fq; bf16_t* base = qp + (size_t)u.pn * 8192 * 256;
#pragma unroll
        for (int ai = 0; ai < 2; ++ai)
#pragma unroll
            for (int m = 0; m < 4; ++m) { const int row = row0 + ai * HALF + m * 16;
#pragma unroll
                for (int bj = 0; bj < 2; ++bj) *(u32x4*)(base + (size_t)row * 256 + bj * HALF + cw) = pack8(acc[ai][bj][m][0], acc[ai][bj][m][1]); }
    }
};

struct EpiB16 {
    static constexpr bool PERM = true, AFTER_DRAIN = false;
    bf16_t* o; int ldc;
    __device__ __forceinline__ void operator()(const f32x4 (&acc)[2][2][4][2], const Unit& u, int wr, int wc, int fr, int fq) const {
        const int row0 = u.pm * BM + wr * 64 + fr, c0 = u.pn * BM + wc * 32 + 8 * fq;
#pragma unroll
        for (int ai = 0; ai < 2; ++ai)
#pragma unroll
            for (int m = 0; m < 4; ++m) { const int row = row0 + ai * HALF + m * 16;
#pragma unroll
                for (int bj = 0; bj < 2; ++bj) *(u32x4*)(o + (size_t)row * ldc + c0 + bj * HALF) = pack8(acc[ai][bj][m][0], acc[ai][bj][m][1]); }
    }
};

struct EpiF32 {
    static constexpr bool PERM = true, AFTER_DRAIN = false;
    float* o; int ldc;
    __device__ __forceinline__ void operator()(const f32x4 (&acc)[2][2][4][2], const Unit& u, int wr, int wc, int fr, int fq) const {
        const int row0 = u.pm * BM + wr * 64 + fr, c0 = u.pn * BM + wc * 32 + 8 * fq;
#pragma unroll
        for (int ai = 0; ai < 2; ++ai)
#pragma unroll
            for (int m = 0; m < 4; ++m) { const int row = row0 + ai * HALF + m * 16;
#pragma unroll
                for (int bj = 0; bj < 2; ++bj)
#pragma unroll
                    for (int n = 0; n < 2; ++n) *(f32x4*)(o + (size_t)row * ldc + c0 + bj * HALF + 4 * n) = acc[ai][bj][m][n]; }
    }
};

struct OrderIn : StaticOrder {
    __device__ bool next(int i, Unit& u) const {
        const long L = (long)i * G + c;
        if (L < nwg) return StaticOrder::next(i, u);
        if (L < nwg + 3) { u.pm = 32; u.pn = 3 + (int)(L - nwg); return true; }
        return false;
    }
};

struct RunOrder {
    int base, cnt, nN;
    __device__ bool next(int i, Unit& u) const { if (i >= cnt) return false; const int idx = base + i; u.pm = idx / nN; u.pn = idx % nN; return true; }
    __device__ __forceinline__ void a_ready(const Unit&) const {}
    __device__ __forceinline__ void done(const Unit&) const {}
};
template <class Epi, class Sched, bool ALIGN_EPI = false, bool SP2 = false>
__device__ __forceinline__ void gemm_phase(PG8_LAS unsigned char* lds, const Gemm g, const Sched& S, const Epi& E) {
    int tid_o_ = threadIdx.x; asm volatile("" : "+v"(tid_o_));
    const int tid = tid_o_, wid = __builtin_amdgcn_readfirstlane(tid >> 6), lane = tid & 63, wr = wid >> 2, wc = wid & 3, fr = lane & 15, fq = lane >> 4;
    const int K = g.K, nt = K / BK;
    unsigned voffA[2], voffB[2];
#pragma unroll
    for (int i = 0; i < 2; ++i) { int R, C; stage_rc(tid * 16 + i * 8192, R, C); const int Rb = Epi::PERM ? ((R & ~31) + perm32(R & 31)) : R;
        voffA[i] = (unsigned)(R * K + C) * 2u; voffB[i] = (unsigned)(Rb * K + C) * 2u; }
    const size_t kstep = (size_t)(BK * 2);
    const size_t hstep = (size_t)HALF * K * 2;
    const size_t tstep = 2 * hstep;
    const unsigned ldsw = (unsigned)wid * 1024u;
    const int aoff = lds_byte(wr * 64 + fr, fq * 8), boff = lds_byte(wc * 32 + fr, fq * 8);
#define PG8_SA(b, h) (((b) * 2 + (h)) * HTB)
#define PG8_SB(b, h) ((4 + (b) * 2 + (h)) * HTB)
#define PG8_STAGE(bufoff, gbase, voff) do { _Pragma("unroll") for (int _i = 0; _i < 2; ++_i) \
        __builtin_amdgcn_global_load_lds((const unsigned*)((const char*)(gbase) + (voff)[_i]), (PG8_LAS unsigned*)(lds + (bufoff) + ldsw + _i * 8192), 16, 0, 0); } while (0)
#define PG8_LDA(dst, b, h) do { _Pragma("unroll") for (int m = 0; m < 4; ++m) _Pragma("unroll") for (int k = 0; k < 2; ++k) dst[m][k] = *(const PG8_LAS bf16x8*)(lds + PG8_SA(b, h) + aoff + m * 2048 + k * 1024); } while (0)
#define PG8_LDB(dst, b, h) do { _Pragma("unroll") for (int n = 0; n < 2; ++n) _Pragma("unroll") for (int k = 0; k < 2; ++k) dst[n][k] = *(const PG8_LAS bf16x8*)(lds + PG8_SB(b, h) + boff + n * 2048 + k * 1024); } while (0)
#define PG8_MMA(ai, bj, At, Bt) do { __builtin_amdgcn_s_setprio(1); _Pragma("unroll") for (int m = 0; m < 4; ++m) _Pragma("unroll") for (int n = 0; n < 2; ++n) _Pragma("unroll") for (int k = 0; k < 2; ++k) \
        acc[ai][bj][m][n] = __builtin_amdgcn_mfma_f32_16x16x32_bf16(Bt[n][k], At[m][k], acc[ai][bj][m][n], 0, 0, 0); __builtin_amdgcn_s_setprio(0); } while (0)
#define PG8_WAIT_V(n) asm volatile("s_waitcnt vmcnt(" #n ")" ::: "memory")
#define PG8_WAIT_L(n) asm volatile("s_waitcnt lgkmcnt(" #n ")" ::: "memory")
#define PG8_BAR __builtin_amdgcn_s_barrier()
#define PG8_SCHED __builtin_amdgcn_sched_barrier(0)
    Unit cur, nxt; int ui = 0;
    if (!S.next(0, cur)) return;
    f32x4 acc[2][2][4][2];
#pragma unroll
    for (int a = 0; a < 2; ++a)
#pragma unroll
        for (int b = 0; b < 2; ++b)
#pragma unroll
            for (int m = 0; m < 4; ++m)
#pragma unroll
                for (int n = 0; n < 2; ++n) acc[a][b][m][n] = (f32x4){0.f, 0.f, 0.f, 0.f};
    bf16x8 At[4][2], B0[2][2], B1[2][2];
    const char* cA = (const char*)g.A + (size_t)cur.pm * tstep + (size_t)cur.pn * g.a_pn; const char* cB = (const char*)g.Bt + (size_t)cur.pn * tstep + (size_t)cur.pm * g.b_pm;
    S.a_ready(cur);
    if constexpr (SP2) {
        PG8_STAGE(PG8_SB(0, 0), cB, voffB); PG8_STAGE(PG8_SB(0, 1), cB + hstep, voffB); PG8_STAGE(PG8_SA(0, 0), cA, voffA); PG8_STAGE(PG8_SA(0, 1), cA + hstep, voffA);
        if (wr == 1) PG8_BAR;
        PG8_WAIT_V(2); PG8_BAR;
        PG8_STAGE(PG8_SB(1, 0), cB + kstep, voffB); PG8_STAGE(PG8_SA(1, 0), cA + kstep, voffA); PG8_STAGE(PG8_SB(1, 1), cB + hstep + kstep, voffB);
        PG8_WAIT_V(6); PG8_BAR;
    } else {
        PG8_STAGE(PG8_SB(0, 0), cB, voffB); PG8_STAGE(PG8_SA(0, 0), cA, voffA); PG8_STAGE(PG8_SB(0, 1), cB + hstep, voffB); PG8_STAGE(PG8_SA(0, 1), cA + hstep, voffA);
        if (wr == 1) PG8_BAR;
        PG8_WAIT_V(4); PG8_BAR;
        PG8_STAGE(PG8_SB(1, 0), cB + kstep, voffB); PG8_STAGE(PG8_SA(1, 0), cA + kstep, voffA); PG8_STAGE(PG8_SB(1, 1), cB + hstep + kstep, voffB);
        PG8_WAIT_V(6); PG8_BAR;
    }
    for (;;) {
        const bool has_next = S.next(ui + 1, nxt);
        const char* nA = has_next ? (const char*)g.A + (size_t)nxt.pm * tstep + (size_t)nxt.pn * g.a_pn : cA; const char* nB = has_next ? (const char*)g.Bt + (size_t)nxt.pn * tstep + (size_t)nxt.pm * g.b_pm : cB;
        for (int t = 0; t < nt; t += 2) {
            const bool last = (t == nt - 2);
            const char* a1 = cA + (size_t)(t + 1) * kstep;
            const char* a2 = last ? nA : cA + (size_t)(t + 2) * kstep; const char* b2 = last ? nB : cB + (size_t)(t + 2) * kstep;
            const char* a3 = a2 + kstep; const char* b3 = b2 + kstep;
            if (last && has_next) S.a_ready(nxt);
            if constexpr (SP2) {
            PG8_LDB(B0, 0, 0); PG8_LDB(B1, 0, 1); PG8_SCHED; PG8_LDA(At, 0, 0); PG8_STAGE(PG8_SA(1, 1), a1 + hstep, voffA);
            PG8_WAIT_V(8); PG8_WAIT_L(0); PG8_BAR; PG8_MMA(0, 0, At, B0); PG8_MMA(0, 1, At, B1); PG8_BAR; PG8_SCHED;
            PG8_LDA(At, 0, 1); PG8_STAGE(PG8_SB(0, 0), b2, voffB); PG8_STAGE(PG8_SB(0, 1), b2 + hstep, voffB); PG8_STAGE(PG8_SA(0, 0), a2, voffA);
            PG8_WAIT_V(8); PG8_WAIT_L(0); PG8_BAR; PG8_MMA(1, 0, At, B0); PG8_MMA(1, 1, At, B1); PG8_BAR; PG8_SCHED;
            PG8_LDB(B0, 1, 0); PG8_LDB(B1, 1, 1); PG8_SCHED; PG8_LDA(At, 1, 0); PG8_STAGE(PG8_SA(0, 1), a2 + hstep, voffA);
            PG8_WAIT_V(8); PG8_WAIT_L(0); PG8_BAR; PG8_MMA(0, 0, At, B0); PG8_MMA(0, 1, At, B1); PG8_BAR; PG8_SCHED;
            PG8_LDA(At, 1, 1); PG8_STAGE(PG8_SB(1, 0), b3, voffB); PG8_STAGE(PG8_SB(1, 1), b3 + hstep, voffB); PG8_STAGE(PG8_SA(1, 0), a3, voffA);
            PG8_WAIT_V(8); PG8_WAIT_L(0); PG8_BAR; PG8_MMA(1, 0, At, B0); PG8_MMA(1, 1, At, B1); PG8_BAR; PG8_SCHED;
            } else {
            PG8_LDB(B0, 0, 0); PG8_SCHED; PG8_LDA(At, 0, 0); PG8_STAGE(PG8_SA(1, 1), a1 + hstep, voffA);
            PG8_WAIT_L(8); PG8_BAR; PG8_WAIT_L(0); PG8_MMA(0, 0, At, B0); PG8_BAR; PG8_SCHED;
            PG8_LDB(B1, 0, 1); PG8_STAGE(PG8_SB(0, 0), b2, voffB);
            PG8_BAR; PG8_WAIT_L(0); PG8_MMA(0, 1, At, B1); PG8_BAR;
            PG8_LDA(At, 0, 1); PG8_STAGE(PG8_SA(0, 0), a2, voffA);
            PG8_BAR; PG8_WAIT_L(0); PG8_MMA(1, 0, At, B0); PG8_BAR; PG8_SCHED;
            PG8_STAGE(PG8_SB(0, 1), b2 + hstep, voffB);
            PG8_WAIT_V(6); PG8_BAR; PG8_MMA(1, 1, At, B1); PG8_BAR;
            PG8_LDB(B0, 1, 0); PG8_SCHED; PG8_LDA(At, 1, 0); PG8_STAGE(PG8_SA(0, 1), a2 + hstep, voffA);
            PG8_WAIT_L(8); PG8_BAR; PG8_WAIT_L(0); PG8_MMA(0, 0, At, B0); PG8_BAR; PG8_SCHED;
            PG8_LDB(B1, 1, 1); PG8_STAGE(PG8_SB(1, 0), b3, voffB);
            PG8_BAR; PG8_WAIT_L(0); PG8_MMA(0, 1, At, B1); PG8_BAR;
            PG8_LDA(At, 1, 1); PG8_STAGE(PG8_SA(1, 0), a3, voffA);
            PG8_BAR; PG8_WAIT_L(0); PG8_MMA(1, 0, At, B0); PG8_BAR; PG8_SCHED;
            PG8_STAGE(PG8_SB(1, 1), b3 + hstep, voffB);
            PG8_WAIT_V(6); PG8_BAR; PG8_MMA(1, 1, At, B1); PG8_BAR;
            }
        }
        if constexpr (ALIGN_EPI) { if (wr == 0) PG8_BAR; }
        if constexpr (!Epi::AFTER_DRAIN) { int te_ = tid; asm volatile("" : "+v"(te_)); const int le_ = te_ & 63;
            E(acc, cur, wr, wc, le_ & 15, le_ >> 4); S.done(cur); }
        if (!has_next) break;
#pragma unroll
        for (int a = 0; a < 2; ++a)
#pragma unroll
            for (int b = 0; b < 2; ++b)
#pragma unroll
                for (int m = 0; m < 4; ++m)
#pragma unroll
                    for (int n = 0; n < 2; ++n) acc[a][b][m][n] = (f32x4){0.f, 0.f, 0.f, 0.f};
        cur = nxt; cA = nA; cB = nB; ++ui;
        if constexpr (ALIGN_EPI) { if (wr == 1) PG8_BAR; }
    }
    PG8_WAIT_V(0);
    if constexpr (!ALIGN_EPI) { if (wr == 0) PG8_BAR; }
    PG8_BAR;
    if constexpr (Epi::AFTER_DRAIN) { E.fused(acc, cur, wr, wc, fr, fq, lds, wid, lane); S.done(cur); }
#undef PG8_SA
#undef PG8_SB
#undef PG8_STAGE
#undef PG8_LDA
#undef PG8_LDB
#undef PG8_MMA
#undef PG8_WAIT_V
#undef PG8_WAIT_L
#undef PG8_BAR
#undef PG8_SCHED
}
}

namespace att {
using bf16x8 = __attribute__((ext_vector_type(8))) short;
using s16x4  = __attribute__((ext_vector_type(4))) short;
using f32x16 = __attribute__((ext_vector_type(16))) float;
using u32x4  = __attribute__((ext_vector_type(4))) unsigned;
typedef unsigned short bf16;
constexpr int NW = 8, QBLK = 32, KVBLK = 64;
#ifndef ATT_SDEPTH
#define ATT_SDEPTH 1
#endif
constexpr int SDEPTH = ATT_SDEPTH;
#ifndef QKT_GRP
#define QKT_GRP 4
#endif
constexpr int LDQ = 3072, LDKV = 2048, LDKR = 64, LDO = 4096, LDVT = 8448;
constexpr int SHM_V = 8192, SHM_KN = 8192, SHM_KR = 4096;
constexpr float QSC = 64.f, QSI = 1.f / 64.f;
constexpr int NSLOT = 3, OFF_V = 0, OFF_KN = NSLOT * SHM_V, OFF_KR = OFF_KN + NSLOT * SHM_KN, OFF_WS = OFF_KR + NSLOT * SHM_KR, SHM_ATTN = OFF_WS + NW * 64 * 4;
#define ALDS __attribute__((address_space(3)))
#ifndef SUM4
#define SUM4 0
#endif
#ifndef PV_FILL
#define PV_FILL 0
#endif
#ifndef ACC_OFS
#define ACC_OFS 1
#endif
constexpr float THRL = 2.5f * 1.4426950408889634f * 64.f;
constexpr float PSH = 5.f;
#define KSWZ(row, colB) ((row) * 256 + ((colB) ^ (((row) & 15) << 4)))
#define RSWZ(row, colB) ((row) * 128 + ((colB) ^ ((((row) >> 1) & 7) << 4)))
#define SBAR() __builtin_amdgcn_sched_barrier(0)
__device__ __forceinline__ int crow(int r, int hi) { return (r & 3) + 8 * (r >> 2) + 4 * hi; }
__device__ __forceinline__ unsigned cvtpk(float lo, float hi) { unsigned r; asm volatile("v_cvt_pk_bf16_f32 %0, %1, %2" : "=v"(r) : "v"(lo), "v"(hi)); return r; }

typedef int v8i32_t __attribute__((ext_vector_type(8)));
#ifndef ISSUE_LATE
#define ISSUE_LATE 0
#endif
#ifndef S1_IN_P
#define S1_IN_P 4
#endif
#define EXP_IN_P 0
typedef float f32x2_t __attribute__((ext_vector_type(2)));
#define SM_MAX3(D, A, B, C) asm("v_max3_f32 %0, %1, %2, %3" : "=v"(D) : "v"(A), "v"(B), "v"(C))
__device__ __forceinline__ float sm_max(const f32x16& p0, const f32x16& p1) {
  float pmax = p0[0];
#pragma unroll
  for (int r = 1; r < 16; ++r) pmax = fmaxf(pmax, p0[r]);
#pragma unroll
  for (int r = 0; r < 16; ++r) pmax = fmaxf(pmax, p1[r]);
  return pmax;
}
__device__ __forceinline__ float sm_decide(float pmax, float& m_reg, float& alpha) {
  { auto rr = __builtin_amdgcn_permlane32_swap(__float_as_uint(pmax), __float_as_uint(pmax), false, false);
    pmax = fmaxf(__uint_as_float(rr[0]), __uint_as_float(rr[1])); }
  float mn;
  if (__builtin_expect(__all(pmax - m_reg <= THRL), 1)) { mn = m_reg; alpha = 1.f; }
  else { mn = fmaxf(m_reg, pmax); alpha = __builtin_amdgcn_exp2f((m_reg - mn) * QSI); m_reg = mn; }
  return fmaf(-mn, QSI, PSH);
}
#if ACC_OFS
__device__ __forceinline__ float sm_decide_ofs(float pmax, float& alpha, f32x16& mtup, const bool first) {
  { auto rr = __builtin_amdgcn_permlane32_swap(__float_as_uint(pmax), __float_as_uint(pmax), false, false);
    pmax = fmaxf(__uint_as_float(rr[0]), __uint_as_float(rr[1])); }
  const float ex = pmax - PSH; float d = 0.f; alpha = 1.f;
  if (__builtin_expect(first || !__all(ex <= THRL * QSI), 0)) { d = first ? ex : fmaxf(ex, 0.f); alpha = first ? 1.f : __builtin_amdgcn_exp2f(-d);
#pragma unroll
    for (int r = 0; r < 16; ++r) mtup[r] -= d; }
  return d;
}
__device__ __forceinline__ void sm_rebase(f32x16& p, float d) {
  if (__builtin_expect(__any(d != 0.f), 0)) {
#pragma unroll
    for (int r = 0; r < 16; ++r) p[r] -= d; }
}
#endif
__device__ __forceinline__ void sm_affine(f32x16& p, float mnq) {
#pragma unroll
  for (int r = 0; r < 16; ++r) p[r] = fmaf(p[r], QSI, mnq);
}
__device__ __forceinline__ void sm_finish(f32x16& p0, f32x16& p1, float alpha, float& l_reg, v8i32_t& pa8, const int prb, const bool p0_done = false) {
  if (!(prb & 1)) {
    if (!p0_done) {
#pragma unroll
    for (int r = 0; r < 16; ++r) p0[r] = __builtin_amdgcn_exp2f(p0[r]); }
#if EXP_IN_P < 2
#pragma unroll
    for (int r = 0; r < 16; ++r) p1[r] = __builtin_amdgcn_exp2f(p1[r]);
#endif
  }
#if SUM4
  float ps0 = p0[0], ps1 = p0[1], ps2 = p0[2], ps3 = p0[3];
#pragma unroll
  for (int r = 4; r < 16; r += 4) { ps0 += p0[r]; ps1 += p0[r + 1]; ps2 += p0[r + 2]; ps3 += p0[r + 3]; }
#pragma unroll
  for (int r = 0; r < 16; r += 4) { ps0 += p1[r]; ps1 += p1[r + 1]; ps2 += p1[r + 2]; ps3 += p1[r + 3]; }
  float ps = (ps0 + ps1) + (ps2 + ps3);
#else
  float ps = 0;
#pragma unroll
  for (int r = 0; r < 16; ++r) ps += p0[r];
#pragma unroll
  for (int r = 0; r < 16; ++r) ps += p1[r];
#endif
  { auto rr = __builtin_amdgcn_permlane32_swap(__float_as_uint(ps), __float_as_uint(ps), false, false);
    ps = __uint_as_float(rr[0]) + __uint_as_float(rr[1]); }
  l_reg = l_reg * alpha + ps;
#pragma unroll
  for (int i = 0; i < 4; ++i) { int w = __builtin_amdgcn_cvt_pk_fp8_f32(p0[4 * i], p0[4 * i + 1], 0, false); w = __builtin_amdgcn_cvt_pk_fp8_f32(p0[4 * i + 2], p0[4 * i + 3], w, true); pa8[i] = w;
    int w2 = __builtin_amdgcn_cvt_pk_fp8_f32(p1[4 * i], p1[4 * i + 1], 0, false); w2 = __builtin_amdgcn_cvt_pk_fp8_f32(p1[4 * i + 2], p1[4 * i + 3], w2, true); pa8[4 + i] = w2; }
}
#ifndef QKT_PF
#define QKT_PF 0
#endif
#if QKT_PF == 0
__device__ __forceinline__ void qkt(f32x16& p0, f32x16& p1, const char* Kn, const char* Kr, const bf16x8* qr, const char* Qr, int r32, int hi) {
#if !ACC_OFS
  p0 = f32x16{}; p1 = f32x16{};
#endif
#pragma unroll
  for (int d0 = 0; d0 < 8; ++d0) { const int cb = (d0 * 16 + hi * 8) * 2;
    bf16x8 b0 = *reinterpret_cast<const bf16x8*>(Kn + KSWZ(r32, cb));
    bf16x8 b1 = *reinterpret_cast<const bf16x8*>(Kn + KSWZ(32 + r32, cb));
    p0 = __builtin_amdgcn_mfma_f32_32x32x16_bf16(b0, qr[d0], p0, 0, 0, 0);
    p1 = __builtin_amdgcn_mfma_f32_32x32x16_bf16(b1, qr[d0], p1, 0, 0, 0);
    if ((d0 & (QKT_GRP - 1)) == QKT_GRP - 1) SBAR(); }
#pragma unroll
  for (int d0 = 0; d0 < 4; ++d0) { const int cb = (d0 * 16 + hi * 8) * 2;
    bf16x8 b0 = *reinterpret_cast<const bf16x8*>(Kr + RSWZ(r32, cb));
    bf16x8 b1 = *reinterpret_cast<const bf16x8*>(Kr + RSWZ(32 + r32, cb));
    const bf16x8 qf = qr[8 + d0];
    p0 = __builtin_amdgcn_mfma_f32_32x32x16_bf16(b0, qf, p0, 0, 0, 0);
    p1 = __builtin_amdgcn_mfma_f32_32x32x16_bf16(b1, qf, p1, 0, 0, 0);
    if ((d0 & (QKT_GRP - 1)) == QKT_GRP - 1) SBAR(); }
}
#else
__device__ __forceinline__ void qkt(f32x16& p0, f32x16& p1, const char* Kn, const char* Kr, const bf16x8* qr, const char* Qr, int r32, int hi) {
#if !ACC_OFS
  p0 = f32x16{}; p1 = f32x16{};
#endif
  constexpr int NB = QKT_PF + 1;
  bf16x8 kb0[NB], kb1[NB], qf[NB];
#define KLD(S) do { constexpr int s_ = (S), i_ = s_ % NB; if constexpr (s_ < 8) { const int cb = (s_ * 16 + hi * 8) * 2; kb0[i_] = *reinterpret_cast<const bf16x8*>(Kn + KSWZ(r32, cb)); kb1[i_] = *reinterpret_cast<const bf16x8*>(Kn + KSWZ(32 + r32, cb)); } \
    else { const int cb = ((s_ - 8) * 16 + hi * 8) * 2; kb0[i_] = *reinterpret_cast<const bf16x8*>(Kr + RSWZ(r32, cb)); kb1[i_] = *reinterpret_cast<const bf16x8*>(Kr + RSWZ(32 + r32, cb)); qf[i_] = *reinterpret_cast<const bf16x8*>(Qr + (s_ - 8) * 1024); } } while (0)
#define KSTEP(S) do { constexpr int s_ = (S), i_ = s_ % NB; if constexpr (s_ + QKT_PF < 12) KLD(S + QKT_PF); const bf16x8 q_ = s_ < 8 ? qr[s_ < 8 ? s_ : 0] : qf[i_]; \
    p0 = __builtin_amdgcn_mfma_f32_32x32x16_bf16(kb0[i_], q_, p0, 0, 0, 0); p1 = __builtin_amdgcn_mfma_f32_32x32x16_bf16(kb1[i_], q_, p1, 0, 0, 0); } while (0)
  KLD(0); if constexpr (QKT_PF >= 2) KLD(1);
  KSTEP(0); KSTEP(1); KSTEP(2); KSTEP(3); KSTEP(4); KSTEP(5); KSTEP(6); KSTEP(7); KSTEP(8); KSTEP(9); KSTEP(10); KSTEP(11);
#undef KLD
#undef KSTEP
}
#endif
__device__ __forceinline__ int v_st(int k, int c) { const int kk = (k & ~0xC) | ((k & 4) << 1) | ((k & 8) >> 1); return ((kk >> 3) * 4 + (c >> 5)) * 512 + ((kk & 7) * 32 + (c & 31)) * 2; }
__device__ __forceinline__ int v_rd_base(int lane) { return ((lane & 3) << 3) | (((lane >> 2) & 3) << 6) | (((lane >> 4) & 1) << 5) | (((lane >> 5) & 1) << 8); }
constexpr int v_rd_off(int d0, int ks, int half) { return d0 * 512 + ks * 4096 + half * 2048; }
template <int OFF> __device__ __forceinline__ s16x4 tr_read(int vb) {
  s16x4 r; asm volatile("ds_read_b64_tr_b16 %0, %1 offset:%2" : "=&v"(r) : "v"(vb), "i"(OFF) : "memory"); return r;
}
template <int D0> __device__ __forceinline__ void pv_one(f32x16& od, int vb, bf16x8 pa0, bf16x8 pa1, bf16x8 pa2, bf16x8 pa3) {
  const s16x4 l0 = tr_read<v_rd_off(D0, 0, 0)>(vb), h0 = tr_read<v_rd_off(D0, 0, 1)>(vb), l1 = tr_read<v_rd_off(D0, 1, 0)>(vb), h1 = tr_read<v_rd_off(D0, 1, 1)>(vb);
  const s16x4 l2 = tr_read<v_rd_off(D0, 2, 0)>(vb), h2 = tr_read<v_rd_off(D0, 2, 1)>(vb), l3 = tr_read<v_rd_off(D0, 3, 0)>(vb), h3 = tr_read<v_rd_off(D0, 3, 1)>(vb);
  asm volatile("s_waitcnt lgkmcnt(0)" ::: "memory"); SBAR();
#define PK(L, H) (bf16x8){L[0], L[1], L[2], L[3], H[0], H[1], H[2], H[3]}
  od = __builtin_amdgcn_mfma_f32_32x32x16_bf16(pa0, PK(l0, h0), od, 0, 0, 0);
  od = __builtin_amdgcn_mfma_f32_32x32x16_bf16(pa1, PK(l1, h1), od, 0, 0, 0);
  od = __builtin_amdgcn_mfma_f32_32x32x16_bf16(pa2, PK(l2, h2), od, 0, 0, 0);
  od = __builtin_amdgcn_mfma_f32_32x32x16_bf16(pa3, PK(l3, h3), od, 0, 0, 0);
#undef PK
}
__device__ __forceinline__ void pv_d0(f32x16* o, int vb, bf16x8 pa0, bf16x8 pa1, bf16x8 pa2, bf16x8 pa3) {
  pv_one<0>(o[0], vb, pa0, pa1, pa2, pa3); pv_one<1>(o[1], vb, pa0, pa1, pa2, pa3); pv_one<2>(o[2], vb, pa0, pa1, pa2, pa3); pv_one<3>(o[3], vb, pa0, pa1, pa2, pa3);
}

#define LDSR128(dst, base, OFF) asm volatile("ds_read_b128 %0, %1 offset:%2" : "=v"(dst) : "v"((unsigned)(uintptr_t)(base)), "i"(OFF) : "memory")
#define WAITK4(N, A, B, C, D) asm volatile("s_waitcnt lgkmcnt(" #N ")" : "+v"(A), "+v"(B), "+v"(C), "+v"(D) :: "memory")
#ifndef PADN
#define PADN 7
#endif
#define PAD_STR2(x) #x
#define PAD_STR(x) PAD_STR2(x)
#define MFMA_PAD1() asm volatile("s_nop " PAD_STR(PADN))
#ifndef PRIO_T
#define PRIO_T 0
#endif
#ifndef QKPAD
#define QKPAD 0
#endif
#if QKPAD == 0
#define MFMA_PADA() MFMA_PAD1()
#else
#define MFMA_PADA() do { } while (0)
#endif
#define PINACC2(A, B) asm volatile("" : "+v"(A), "+v"(B))
#define PINACC1(A) asm volatile("" : "+v"(A))
#define PINF(A) asm volatile("" : "+v"(A))
#define WAITV2(N, A, B) asm volatile("s_waitcnt lgkmcnt(" #N ")" : "+v"(A), "+v"(B) :: "memory")
#define V8OF(F) (v8i32_t){(int)F[0][0], (int)F[0][1], (int)F[0][2], (int)F[0][3], (int)F[1][0], (int)F[1][1], (int)F[1][2], (int)F[1][3]}
#define MXMFMA(KF, QF, ACC) __builtin_amdgcn_mfma_scale_f32_32x32x64_f8f6f4(V8OF(KF), QF, ACC, 0, 0, 0, 0x7F7F7F7F, 0, 0x7F7F7F7F)
#if ACC_OFS
#undef MXMFMA
#define MXMFMA(KF, QF, ACC) __builtin_amdgcn_mfma_scale_f32_32x32x64_f8f6f4(V8OF(KF), QF, ACC, 0, 0, 0, 0x7F7F7F7F, 0, 0x79797979)
#endif
#define MXMFMA2(PA, VF, ACC) __builtin_amdgcn_mfma_scale_f32_32x32x64_f8f6f4(PA, V8OF(VF), ACC, 0, 0, 0, 0x7F7F7F7F, 0, 0x7F7F7F7F)
template <bool DO_QK, bool DO_PV, class IssueF>
__device__ __forceinline__ void mat_segment(const IssueF& issue, f32x16& p0, f32x16& p1, f32x16* o, const ALDS char* Kn, const ALDS char* Kr, const ALDS char* Vb, const v8i32_t* qf, v8i32_t pa8, int r32, int hi, float& m_reg, float& alpha, float& pmax_, float& mnq_, f32x16& mtup, const bool hp, const int prb) {
  u32x4 ka[3][2], kb[3][2], vf[4][2];
  const int nbase = r32 * 128, nsw = ((r32 >> 1) & 7) << 4, rbase = r32 * 64, rsw = ((r32 >> 2) & 3) << 4, hb = hi * 32;
  asm volatile("s_waitcnt lgkmcnt(0)" ::: "memory");
#if PRIO_T
  if (hp) asm volatile("s_setprio 2"); else asm volatile("s_setprio 1");
#else
  asm volatile("s_setprio 1");
#endif
  if constexpr (DO_QK && DO_PV) {
#if !ACC_OFS
  p0 = f32x16{}; p1 = f32x16{};
#endif
  if (!(prb & 4))   { const int a_ = nbase + (((0 * 64) + hb) ^ nsw); LDSR128(ka[0][0], Kn + a_, 0); LDSR128(ka[0][1], Kn + (a_ ^ 16), 0); LDSR128(kb[0][0], Kn + a_, 4096); LDSR128(kb[0][1], Kn + (a_ ^ 16), 4096); }
  if (!(prb & 4))   { const int a_ = nbase + (((1 * 64) + hb) ^ nsw); LDSR128(ka[1][0], Kn + a_, 0); LDSR128(ka[1][1], Kn + (a_ ^ 16), 0); LDSR128(kb[1][0], Kn + a_, 4096); LDSR128(kb[1][1], Kn + (a_ ^ 16), 4096); }
  if (!(prb & 4))   { const int a_ = rbase + (hb ^ rsw); LDSR128(ka[2][0], Kr + a_, 0); LDSR128(ka[2][1], Kr + (a_ ^ 16), 0); LDSR128(kb[2][0], Kr + a_, 2048); LDSR128(kb[2][1], Kr + (a_ ^ 16), 2048); }
  if (!(prb & 4))   { const int a_ = rbase + (hb ^ rsw); LDSR128(vf[0][0], Vb + a_, 0); LDSR128(vf[0][1], Vb + (a_ ^ 16), 0); }
  if (!(prb & 4))   { const int a_ = rbase + (hb ^ rsw); LDSR128(vf[1][0], Vb + a_, 2048); LDSR128(vf[1][1], Vb + (a_ ^ 16), 2048); }
  if (!(prb & 4))   { const int a_ = rbase + (hb ^ rsw); LDSR128(vf[2][0], Vb + a_, 4096); LDSR128(vf[2][1], Vb + (a_ ^ 16), 4096); }
  if (!(prb & 4))   { const int a_ = rbase + (hb ^ rsw); LDSR128(vf[3][0], Vb + a_, 6144); LDSR128(vf[3][1], Vb + (a_ ^ 16), 6144); }
  WAITK4(15, ka[0][0], ka[0][1], kb[0][0], kb[0][1]);
#if ACC_OFS
  if (!(prb & 2)) { p0 = MXMFMA(ka[0], qf[0], mtup); PINACC1(p0); MFMA_PADA(); p1 = MXMFMA(kb[0], qf[0], mtup); PINACC1(p1); MFMA_PAD1(); }
#else
  if (!(prb & 2)) { p0 = MXMFMA(ka[0], qf[0], p0); PINACC1(p0); MFMA_PADA(); p1 = MXMFMA(kb[0], qf[0], p1); PINACC1(p1); MFMA_PAD1(); }
#endif
#if !ISSUE_LATE
  issue(0); issue(1);
#endif
  WAITK4(12, ka[1][0], ka[1][1], kb[1][0], kb[1][1]);
  if (!(prb & 2)) { p0 = MXMFMA(ka[1], qf[1], p0); PINACC1(p0); MFMA_PADA(); p1 = MXMFMA(kb[1], qf[1], p1); PINACC1(p1); MFMA_PAD1(); }
#if !ISSUE_LATE
  issue(2);
#endif
  WAITK4(8, ka[2][0], ka[2][1], kb[2][0], kb[2][1]);
  if (!(prb & 2)) { p0 = MXMFMA(ka[2], qf[2], p0); PINACC1(p0); MFMA_PADA(); p1 = MXMFMA(kb[2], qf[2], p1); PINACC1(p1); MFMA_PAD1(); }
  WAITV2(6, vf[0][0], vf[0][1]);
  if (!(prb & 2)) { o[0] = MXMFMA2(pa8, vf[0], o[0]); PINACC1(o[0]); if (S1_IN_P <= 0) MFMA_PAD1(); }
#if ISSUE_LATE
  issue(0); issue(1); issue(2);
#endif
  if (S1_IN_P >= 1 && !(prb & 16)) { pmax_ = sm_max(p0, p1); PINF(pmax_); }
  WAITV2(4, vf[1][0], vf[1][1]);
  if (!(prb & 2)) { o[1] = MXMFMA2(pa8, vf[1], o[1]); PINACC1(o[1]); if (S1_IN_P <= 1) MFMA_PAD1(); }
#if ACC_OFS
  if (!(prb & 16)) { mnq_ = sm_decide_ofs(pmax_, alpha, mtup, false); PINF(mnq_); }
#else
  if (S1_IN_P >= 2 && !(prb & 16)) { mnq_ = sm_decide(pmax_, m_reg, alpha); PINF(mnq_); }
#endif
  WAITV2(2, vf[2][0], vf[2][1]);
  if (!(prb & 2)) { o[2] = MXMFMA2(pa8, vf[2], o[2]); PINACC1(o[2]); if (S1_IN_P <= 2) MFMA_PAD1(); }
#if ACC_OFS
  if (!(prb & 16)) { sm_rebase(p0, mnq_); PINACC1(p0); }
#if PV_FILL == 1
  MFMA_PAD1();
#elif PV_FILL == 2
  if (!(prb & 16)) { _Pragma("unroll") for (int r = 0; r < 8; ++r) p0[r] = __builtin_amdgcn_exp2f(p0[r]); PINACC1(p0); }
#endif
#else
  if (S1_IN_P >= 3 && !(prb & 16)) { sm_affine(p0, mnq_); PINACC1(p0); }
#endif
  WAITV2(0, vf[3][0], vf[3][1]);
  if (!(prb & 2)) { o[3] = MXMFMA2(pa8, vf[3], o[3]); PINACC1(o[3]); if (S1_IN_P <= 3) MFMA_PAD1(); }
#if ACC_OFS
  if (!(prb & 16)) { sm_rebase(p1, mnq_); PINACC1(p1); }
#if PV_FILL == 1
  MFMA_PAD1();
#elif PV_FILL == 2
  if (!(prb & 16)) { _Pragma("unroll") for (int r = 8; r < 16; ++r) p0[r] = __builtin_amdgcn_exp2f(p0[r]); PINACC1(p0); }
#endif
#else
  if (S1_IN_P >= 4 && !(prb & 16)) { sm_affine(p1, mnq_); PINACC1(p1); }
#endif
#if EXP_IN_P >= 1
  if (!(prb & 16)) { _Pragma("unroll") for (int r = 0; r < 16; ++r) p0[r] = __builtin_amdgcn_exp2f(p0[r]); PINACC1(p0); }
#endif
#if EXP_IN_P >= 2
  if (!(prb & 16)) { _Pragma("unroll") for (int r = 0; r < 16; ++r) p1[r] = __builtin_amdgcn_exp2f(p1[r]); PINACC1(p1); }
#endif
  } else if constexpr (DO_QK) {
#if !ACC_OFS
  p0 = f32x16{}; p1 = f32x16{};
#endif
  if (!(prb & 4))   { const int a_ = nbase + (((0 * 64) + hb) ^ nsw); LDSR128(ka[0][0], Kn + a_, 0); LDSR128(ka[0][1], Kn + (a_ ^ 16), 0); LDSR128(kb[0][0], Kn + a_, 4096); LDSR128(kb[0][1], Kn + (a_ ^ 16), 4096); }
  if (!(prb & 4))   { const int a_ = nbase + (((1 * 64) + hb) ^ nsw); LDSR128(ka[1][0], Kn + a_, 0); LDSR128(ka[1][1], Kn + (a_ ^ 16), 0); LDSR128(kb[1][0], Kn + a_, 4096); LDSR128(kb[1][1], Kn + (a_ ^ 16), 4096); }
  if (!(prb & 4))   { const int a_ = rbase + (hb ^ rsw); LDSR128(ka[2][0], Kr + a_, 0); LDSR128(ka[2][1], Kr + (a_ ^ 16), 0); LDSR128(kb[2][0], Kr + a_, 2048); LDSR128(kb[2][1], Kr + (a_ ^ 16), 2048); }
  WAITK4(8, ka[0][0], ka[0][1], kb[0][0], kb[0][1]);
#if ACC_OFS
  if (!(prb & 2)) { p0 = MXMFMA(ka[0], qf[0], mtup); PINACC1(p0); MFMA_PADA(); p1 = MXMFMA(kb[0], qf[0], mtup); PINACC1(p1); MFMA_PAD1(); }
#else
  if (!(prb & 2)) { p0 = MXMFMA(ka[0], qf[0], p0); PINACC1(p0); MFMA_PADA(); p1 = MXMFMA(kb[0], qf[0], p1); PINACC1(p1); MFMA_PAD1(); }
#endif
  issue(0); issue(1);
  WAITK4(4, ka[1][0], ka[1][1], kb[1][0], kb[1][1]);
  if (!(prb & 2)) { p0 = MXMFMA(ka[1], qf[1], p0); PINACC1(p0); MFMA_PADA(); p1 = MXMFMA(kb[1], qf[1], p1); PINACC1(p1); MFMA_PAD1(); }
  issue(2);
  WAITK4(0, ka[2][0], ka[2][1], kb[2][0], kb[2][1]);
  if (!(prb & 2)) { p0 = MXMFMA(ka[2], qf[2], p0); PINACC1(p0); MFMA_PADA(); p1 = MXMFMA(kb[2], qf[2], p1); PINACC1(p1); MFMA_PAD1(); }
  } else {
  if (!(prb & 4))   { const int a_ = rbase + (hb ^ rsw); LDSR128(vf[0][0], Vb + a_, 0); LDSR128(vf[0][1], Vb + (a_ ^ 16), 0); }
  if (!(prb & 4))   { const int a_ = rbase + (hb ^ rsw); LDSR128(vf[1][0], Vb + a_, 2048); LDSR128(vf[1][1], Vb + (a_ ^ 16), 2048); }
  if (!(prb & 4))   { const int a_ = rbase + (hb ^ rsw); LDSR128(vf[2][0], Vb + a_, 4096); LDSR128(vf[2][1], Vb + (a_ ^ 16), 4096); }
  if (!(prb & 4))   { const int a_ = rbase + (hb ^ rsw); LDSR128(vf[3][0], Vb + a_, 6144); LDSR128(vf[3][1], Vb + (a_ ^ 16), 6144); }
  WAITV2(6, vf[0][0], vf[0][1]);
  if (!(prb & 2)) { o[0] = MXMFMA2(pa8, vf[0], o[0]); PINACC1(o[0]); MFMA_PAD1(); }
  WAITV2(4, vf[1][0], vf[1][1]);
  if (!(prb & 2)) { o[1] = MXMFMA2(pa8, vf[1], o[1]); PINACC1(o[1]); MFMA_PAD1(); }
  WAITV2(2, vf[2][0], vf[2][1]);
  if (!(prb & 2)) { o[2] = MXMFMA2(pa8, vf[2], o[2]); PINACC1(o[2]); MFMA_PAD1(); }
  WAITV2(0, vf[3][0], vf[3][1]);
  if (!(prb & 2)) { o[3] = MXMFMA2(pa8, vf[3], o[3]); PINACC1(o[3]); MFMA_PAD1(); }
  }
  if (prb & 2) { PINACC1(p0); PINACC1(p1); }
#if PRIO_T
  if (hp) asm volatile("s_setprio 1"); else asm volatile("s_setprio 0");
#else
  asm volatile("s_setprio 0");
#endif
}

#define ATT_BAR() do { asm volatile("" ::: "memory"); __builtin_amdgcn_s_barrier(); asm volatile("" ::: "memory"); } while (0)
#define ATT_VM(N) asm volatile("s_waitcnt vmcnt(" #N ")" ::: "memory")
__device__ __forceinline__ void glds16(const bf16* g, ALDS unsigned char* l) { __builtin_amdgcn_global_load_lds((const unsigned*)g, (ALDS unsigned*)l, 16, 0, 0); }
__device__ __forceinline__ void glds8(const unsigned char* g, ALDS unsigned char* l) { __builtin_amdgcn_global_load_lds((const unsigned*)g, (ALDS unsigned*)l, 16, 0, 0); }
#ifdef PROBE_STAMP
__device__ unsigned long long g_stamp[8][6];
#define STAMP(k) do { const unsigned long long t_ = __builtin_readcyclecounter(); acc_[k] += t_ - tl_; tl_ = t_; } while (0)
#else
#define STAMP(k) do { } while (0)
#endif
template <int PRB> __device__ __forceinline__ void attn_unit(const unsigned char* __restrict__ Qb, const unsigned char* __restrict__ Knh, const unsigned char* __restrict__ Vth, const unsigned char* __restrict__ Krb,
                                          bf16* __restrict__ Ob, int seq, char* lds, ALDS unsigned char* L, const int probe) {
  int tid_ = threadIdx.x; asm volatile("" : "+v"(tid_));
  const int tid = tid_, wid = __builtin_amdgcn_readfirstlane(tid >> 6), lane = tid & 63, r32 = lane & 31, hi = lane >> 5;
  constexpr int prb = PRB; (void)probe;
  const bool trail = wid >= 4;
  float* ws = (float*)(lds + OFF_WS) + wid * 64; float* li_l = ws; float* al_l = ws + 32;
  float m_reg = -1e30f, l_reg = 0; f32x16 o[4] = {}; v8i32_t qf[3];
  f32x16 mtup;
#pragma unroll
  for (int r = 0; r < 16; ++r) mtup[r] = PSH;
  asm volatile("" : "+v"(mtup));
  const unsigned char* Qw = Qb + (long)(wid * QBLK + r32) * LDQ + hi * 32;
#pragma unroll
  for (int s_ = 0; s_ < 3; ++s_) { const u32x4 a0 = *reinterpret_cast<const u32x4*>(Qw + s_ * 64), a1 = *reinterpret_cast<const u32x4*>(Qw + s_ * 64 + 16);
    qf[s_] = (v8i32_t){(int)a0[0], (int)a0[1], (int)a0[2], (int)a0[3], (int)a1[0], (int)a1[1], (int)a1[2], (int)a1[3]}; }
#define VOFF() ([&]() { const int row = wid * 16 + (lane >> 2), colB = ((lane & 3) * 16) ^ (((row >> 2) & 3) << 4); return row * LDVT + colB; }())
#define KOFF() ([&]() { const int row = wid * 8 + (lane >> 3), colB = ((lane & 7) * 16) ^ (((row >> 1) & 7) << 4); return row * LDKV + colB; }())
#define ROFF() ([&]() { const int row = wid * 16 + (lane >> 2), colB = ((lane & 3) * 16) ^ (((row >> 2) & 3) << 4); return row * LDKR + colB; }())
  const ALDS char* KL = (const ALDS char*)L + OFF_KN; const ALDS char* RL = (const ALDS char*)L + OFF_KR; const ALDS char* VL = (const ALDS char*)L + OFF_V;
#define ISSUE_K(t, s) do { const long kb_ = (long)(t) * KVBLK; const int s_ = (s); \
    glds8(Knh + kb_ * LDKV + KOFF(), L + OFF_KN + s_ * SHM_KN + wid * 1024); if (wid < 4) glds8(Krb + kb_ * LDKR + ROFF(), L + OFF_KR + s_ * SHM_KR + wid * 1024); } while (0)
#define ISSUE_V(t, s) do { const long kb_ = (long)(t) * KVBLK; const int s_ = (s); glds8(Vth + kb_ + VOFF(), L + OFF_V + s_ * SHM_V + wid * 1024); } while (0)
#define ISSUE_NEXT(j) do { if ((j) + 2 < NT) ISSUE_K((j) + 2, sp); if ((j) + 1 < NT) ISSUE_V((j) + 1, sn); } while (0)
#define ROT() do { const int t_ = sc; sc = sn; sn = sp; sp = t_; } while (0)
#define RESC(a) do { if (__any((a) < 1.f)) { if (hi == 0) al_l[r32] = (a); asm volatile("s_waitcnt lgkmcnt(0)" ::: "memory"); \
    _Pragma("unroll") for (int d = 0; d < 4; ++d) _Pragma("unroll") for (int r = 0; r < 16; ++r) o[d][r] *= al_l[crow(r, hi)]; } } while (0)
  f32x16 p0, p1; float mn, al, pmx = 0.f, mnq = 0.f; v8i32_t pa8 = {}; const int NT = (prb & 64) ? 2 : seq / KVBLK;
  int sc = 0, sn = 1, sp = 2;
  ISSUE_K(0, 0); ISSUE_K(1, 1); ISSUE_V(0, 0);
  if (trail) ATT_VM(2); else ATT_VM(3);
  ATT_BAR();
  int jj = 0;
  const auto issue = [&](int step) { if (prb & 8) return;
    const long kb2 = (long)(jj + 2) * KVBLK, kb1 = (long)(jj + 1) * KVBLK;
    if (jj + 2 < NT) { if (step == 0) glds8(Knh + kb2 * LDKV + KOFF(), L + OFF_KN + sp * SHM_KN + wid * 1024); if (step == 1 && wid < 4) glds8(Krb + kb2 * LDKR + ROFF(), L + OFF_KR + sp * SHM_KR + wid * 1024); }
    if (jj + 1 < NT) { if (step == 2) glds8(Vth + kb1 + VOFF(), L + OFF_V + sn * SHM_V + wid * 1024); } };
  const auto noissue = [](int) {};
  mat_segment<true, false>(issue, p0, p1, o, KL, RL, VL, qf, pa8, r32, hi, m_reg, al, pmx, mnq, mtup, trail, prb);
  if (trail) { ATT_VM(2); ATT_BAR(); }
#if ACC_OFS
  if (!(prb & 16)) { mnq = sm_decide_ofs(sm_max(p0, p1), al, mtup, true); sm_rebase(p0, mnq); sm_rebase(p1, mnq); sm_finish(p0, p1, al, l_reg, pa8, prb); }
#else
  if (!(prb & 16)) { mnq = sm_decide(sm_max(p0, p1), m_reg, al); sm_affine(p0, mnq); sm_affine(p1, mnq); sm_finish(p0, p1, al, l_reg, pa8, prb); }
#endif
  ROT();
#ifdef PROBE_STAMP
  unsigned long long acc_[6] = {0, 0, 0, 0, 0, 0}, tl_ = __builtin_readcyclecounter();
#endif
  for (int j = 1; j < NT; ++j) {
    if (!trail) { if (j + 1 < NT) ATT_VM(3); else ATT_VM(0); STAMP(4); ATT_BAR(); }
    STAMP(0);
    jj = j;
    mat_segment<true, true>(issue, p0, p1, o, KL + sc * SHM_KN, RL + sc * SHM_KR, VL + sp * SHM_V, qf, pa8, r32, hi, m_reg, al, pmx, mnq, mtup, trail, prb);
    STAMP(1);
    if (trail) { if (j + 2 < NT) ATT_VM(2); else ATT_VM(0); STAMP(5); ATT_BAR(); }
    STAMP(2);
    if (!(prb & 16)) {
#if !ACC_OFS
      if (S1_IN_P < 1) pmx = sm_max(p0, p1); if (S1_IN_P < 2) mnq = sm_decide(pmx, m_reg, al); if (S1_IN_P < 3) sm_affine(p0, mnq); if (S1_IN_P < 4) sm_affine(p1, mnq);
#endif
      RESC(al); sm_finish(p0, p1, al, l_reg, pa8, prb, ACC_OFS && PV_FILL == 2); }
    ROT();
    STAMP(3);
  }
#ifdef PROBE_STAMP
  if (blockIdx.x == 0 && lane == 0) { for (int k = 0; k < 6; ++k) g_stamp[wid][k] += acc_[k]; }
#endif
  if (!trail) { ATT_VM(0); ATT_BAR(); }
  mat_segment<false, true>(noissue, p0, p1, o, KL, RL, VL + sp * SHM_V, qf, pa8, r32, hi, m_reg, al, pmx, mnq, mtup, trail, prb);
  if (hi == 0) li_l[r32] = l_reg; asm volatile("s_waitcnt lgkmcnt(0)" ::: "memory");
  float rli[16];
#pragma unroll
  for (int r = 0; r < 16; ++r) rli[r] = __builtin_amdgcn_rcpf(li_l[crow(r, hi)]);
  int lane_e = lane; asm volatile("" : "+v"(lane_e));
  bf16* Ow = Ob + (long)(wid * QBLK + 4 * (lane_e >> 5)) * LDO + (lane_e & 31);
#pragma unroll
  for (int r = 0; r < 16; ++r) { const int orow = (r & 3) + 8 * (r >> 2);
#pragma unroll
    for (int d0 = 0; d0 < 4; ++d0) { const float val = o[d0][r] * rli[r]; if (!(prb & 32)) Ow[orow * LDO + d0 * 32] = (bf16)(cvtpk(val, val) & 0xffffu); } }
  ATT_VM(0);
  ATT_BAR();
#undef VOFF
#undef KOFF
#undef ROFF
#undef ISSUE_K
#undef ISSUE_V
#undef ISSUE_NEXT
#undef ROT
#undef RESC
}
#undef KSWZ
#undef RSWZ
}

constexpr int DM = 4096, SEQ = 8192, CTXL = 256, MR = SEQ + CTXL;
constexpr int NH = 16, QL = 768, KVL = 512, NIN = 7680, NMODC = 6 * DM;
constexpr int NEXP = 16384;
constexpr float EPS = 1e-6f;
constexpr float C2 = 0.072168783648703220f * 1.4426950408889634f;

#ifndef MK_ONE_LAUNCH
#define MK_ONE_LAUNCH 1
#endif
constexpr int NPHASE = 10;
constexpr int NWAVES = 8, NTHR = NWAVES * 64;

constexpr size_t MiB = 1u << 20;
constexpr size_t a256(size_t x) { return (x + 255) & ~(size_t)255; }
constexpr size_t WS_CTL = 0, CTL_ZERO_BYTES = 1 * MiB;
constexpr int CW_BAR = 4096;
constexpr int CW_END = CW_BAR + 3456;
static_assert((size_t)CW_END * 4 <= CTL_ZERO_BYTES, "CTL words inside the memset region");
constexpr size_t WS_MODF = 1 * MiB;
constexpr size_t WS_ROPE = WS_MODF + a256((size_t)(NMODC + 2 * DM) * 4);
constexpr size_t WS_WIN  = 2 * MiB;
constexpr size_t WS_WUQ  = WS_WIN + (size_t)NIN * DM * 2;
constexpr size_t WS_WUKV = WS_WUQ + (size_t)3072 * 768 * 2;
constexpr size_t WS_WO   = WS_WUKV + (size_t)4096 * 512 * 2;
constexpr size_t WS_WPQ  = WS_WO + (size_t)DM * DM * 2;
constexpr size_t WS_KBD  = WS_WPQ + (size_t)2048 * DM * 2;
constexpr int ROWB = 3072;
constexpr size_t WS_KB2  = WS_KBD + (size_t)2048 * DM * 2;
constexpr size_t WS_UB   = WS_KB2 + (size_t)8 * 256 * 256 * 2;
constexpr size_t WS_VB   = WS_UB + (size_t)NEXP * ROWB;
constexpr size_t WS_SU   = WS_VB + (size_t)NEXP * ROWB;
constexpr size_t WS_HX   = WS_SU + (size_t)2 * NEXP * 4;
constexpr size_t WS_CQ   = WS_HX + (size_t)MR * DM * 2;
constexpr size_t WS_CKV  = WS_CQ + (size_t)SEQ * QL * 2;
constexpr size_t WS_KR   = WS_CKV + (size_t)MR * KVL * 2;
constexpr size_t WS_U    = WS_KR + (size_t)MR * 64 * 2;
constexpr size_t WS_GB   = WS_U + (size_t)SEQ * 2048 * 2;
constexpr size_t WS_Q    = WS_GB + (size_t)SEQ * 2048 * 2;
constexpr size_t WS_KN   = WS_Q + (size_t)SEQ * 3072 * 2;
constexpr size_t WS_V    = WS_KN + (size_t)MR * 2048 * 2;
constexpr size_t WS_ACAT = WS_V + (size_t)MR * 2048 * 2;
constexpr size_t WS_X1   = WS_ACAT + (size_t)SEQ * DM * 2;
constexpr size_t WS_H2   = WS_X1 + (size_t)SEQ * DM * 4;
constexpr size_t WS_QP   = WS_H2 + (size_t)SEQ * DM * 2;
constexpr size_t WS_SC   = WS_QP + (size_t)SEQ * 2048 * 2;
constexpr size_t WS_MODP = WS_SC + (size_t)SEQ * 2048 * 4;
constexpr size_t WS_SQ1  = WS_MODP + (size_t)64 * 32768 * 4;
constexpr size_t WS_SQ2  = WS_SQ1 + (size_t)SEQ * 12 * 4;
constexpr size_t WS_SQ3  = WS_SQ2 + (size_t)MR * 8 * 4;
constexpr size_t WS_END  = WS_SQ3 + (size_t)SEQ * 64 * 4;
static_assert(WS_ROPE + 192 * 32 * 4 <= WS_WIN, "rope table below the weights");

constexpr int RING_BYTES = 158720;
constexpr int MISC_OFF = RING_BYTES + 320;
constexpr int LDS_BYTES = 163840;
static_assert(att::SHM_ATTN <= RING_BYTES && MISC_OFF + 128 <= LDS_BYTES, "LDS map");

#define GAS __attribute__((address_space(1)))
#define LAS __attribute__((address_space(3)))
typedef unsigned short bf16;
typedef unsigned v4u __attribute__((ext_vector_type(4)));
typedef float f32x4 __attribute__((ext_vector_type(4)));
typedef __bf16 bf16x2_t __attribute__((ext_vector_type(2)));
typedef float f32x2 __attribute__((ext_vector_type(2)));
typedef float f32x16v __attribute__((ext_vector_type(16)));
typedef float f32x32v __attribute__((ext_vector_type(32)));
typedef unsigned u32x6v __attribute__((ext_vector_type(6)));
typedef _Float16 h16x2 __attribute__((ext_vector_type(2)));
typedef _Float16 h16x32 __attribute__((ext_vector_type(32)));
#ifndef FP6_INTERLEAVED
#define FP6_INTERLEAVED 1
#endif
#define LDS_WAIT() asm volatile("s_waitcnt lgkmcnt(0)" ::: "memory")
__device__ __forceinline__ unsigned f2bf(float f) { unsigned u = __builtin_bit_cast(unsigned, f); return (u + 0x7fffu + ((u >> 16) & 1u)) >> 16; }
__device__ __forceinline__ unsigned pk2(float lo, float hi) { return f2bf(lo) | (f2bf(hi) << 16); }
__device__ __forceinline__ float bflo(unsigned w) { return __builtin_bit_cast(float, w << 16); }
__device__ __forceinline__ float bfhi(unsigned w) { return __builtin_bit_cast(float, w & 0xffff0000u); }
__device__ __forceinline__ float dot2bf(unsigned a, unsigned b, float c) { return __builtin_amdgcn_fdot2_f32_bf16(__builtin_bit_cast(bf16x2_t, a), __builtin_bit_cast(bf16x2_t, b), c, false); }
#define DPP_F(v, CTRL) __builtin_bit_cast(float, __builtin_amdgcn_update_dpp(0, __builtin_bit_cast(int, (v)), (CTRL), 0xf, 0xf, true))
__device__ __forceinline__ float row16_sum(float v) { v += DPP_F(v, 0xB1); v += DPP_F(v, 0x4E); v += DPP_F(v, 0x141); v += DPP_F(v, 0x140); return v; }
__device__ __forceinline__ float row16_max(float v) { v = fmaxf(v, DPP_F(v, 0xB1)); v = fmaxf(v, DPP_F(v, 0x4E)); v = fmaxf(v, DPP_F(v, 0x141)); v = fmaxf(v, DPP_F(v, 0x140)); return v; }
__device__ __forceinline__ float rl_f(float v, int l) { return __builtin_bit_cast(float, __builtin_amdgcn_readlane(__builtin_bit_cast(int, v), l)); }
__device__ __forceinline__ float wave_sum(float v) { v = row16_sum(v); return (rl_f(v, 0) + rl_f(v, 16)) + (rl_f(v, 32) + rl_f(v, 48)); }
__device__ __forceinline__ float wave_max(float v) { v = row16_max(v); return fmaxf(fmaxf(rl_f(v, 0), rl_f(v, 16)), fmaxf(rl_f(v, 32), rl_f(v, 48))); }

#define XB_TMO      128
#define XB_XCNT(j)  (256  + 64 * (j))
#define XB_XSUB(j)  (1280 + 64 * (j))
#define XB_XGEN(j)  (2304 + 64 * (j))
#define XB_TOP      3328
#define XB_TOPGEN   3392
#define XCD_BAR_WORDS 3456
#define XB_SPIN_CAP (1u << 18)
__device__ __forceinline__ unsigned xb_ld(unsigned* p)              { return __hip_atomic_load(p, __ATOMIC_RELAXED, __HIP_MEMORY_SCOPE_AGENT); }
__device__ __forceinline__ unsigned xb_add(unsigned* p, unsigned v) { return __hip_atomic_fetch_add(p, v, __ATOMIC_RELAXED, __HIP_MEMORY_SCOPE_AGENT); }
__device__ __forceinline__ unsigned xb_xcc_id() { return (unsigned)__builtin_amdgcn_s_getreg((3 << 11) | 20) & 0xFu; }
#define XB_SPIN(cond, bar) do { unsigned _sp = 0; while (cond) { __builtin_amdgcn_s_sleep(1); \
    if ((++_sp & 255u) == 0u) { if (xb_ld(&(bar)[XB_TMO])) break; if (_sp > XB_SPIN_CAP) { atomicAdd(&(bar)[XB_TMO], 1u); break; } } } } while (0)
struct XcdBarrier { unsigned* bar; unsigned x; volatile LAS unsigned* st; };
__device__ __forceinline__ XcdBarrier xcd_barrier_post(unsigned* bar, volatile LAS unsigned* st) {
    XcdBarrier b; b.bar = bar; b.x = xb_xcc_id(); b.st = st;
    if (threadIdx.x == 0) (void)xb_add(&bar[XB_XCNT(b.x)], 1u);
    return b;
}
__device__ __forceinline__ void xcd_barrier_complete(unsigned* bar, unsigned x, unsigned& nloc, unsigned& nx) {
    const unsigned G = gridDim.x * gridDim.y * gridDim.z;
    unsigned sum, cnt, mine, sp = 0u;
    for (;;) {
        sum = 0u; cnt = 0u; mine = 0u;
#pragma unroll
        for (unsigned j = 0; j < 16; ++j) { const unsigned c = xb_ld(&bar[XB_XCNT(j)]); sum += c; cnt += (c > 0u) ? 1u : 0u; mine = (j == x) ? c : mine; }
        if (sum == G) break;
        __builtin_amdgcn_s_sleep(1);
        if ((++sp & 255u) == 0u) { if (xb_ld(&bar[XB_TMO])) break; if (sp > XB_SPIN_CAP) { atomicAdd(&bar[XB_TMO], 1u); break; } }
    }
    nloc = mine > 0u ? mine : 1u; nx = cnt > 0u ? cnt : 1u;
}
__device__ __forceinline__ void xcd_barrier(const XcdBarrier& b) {
    asm volatile("s_waitcnt vmcnt(0)" ::: "memory");
    __syncthreads();
    if (threadIdx.x == 0) {
        unsigned* bar = b.bar;
        __builtin_amdgcn_s_waitcnt(0);
        unsigned nloc = b.st[0], nx = b.st[1];
        if (nloc == 0u) { xcd_barrier_complete(bar, b.x, nloc, nx); b.st[0] = nloc; b.st[1] = nx; }
        const unsigned old = xb_add(&bar[XB_XSUB(b.x)], 1u);
        const unsigned gen = old / nloc;
        if (old + 1u == (gen + 1u) * nloc) {
            __builtin_amdgcn_fence(__ATOMIC_RELEASE, "agent");
            asm volatile("s_waitcnt vmcnt(0)" ::: "memory");
            const unsigned og = xb_add(&bar[XB_TOP], 1u);
            const unsigned tg = og / nx;
            if (og + 1u == (tg + 1u) * nx) xb_add(&bar[XB_TOPGEN], 1u);
            else XB_SPIN(xb_ld(&bar[XB_TOPGEN]) == tg, bar);
            __builtin_amdgcn_fence(__ATOMIC_ACQUIRE, "agent");
            xb_add(&bar[XB_XGEN(b.x)], 1u);
            asm volatile("s_waitcnt vmcnt(0)" ::: "memory");
        } else {
            XB_SPIN(xb_ld(&bar[XB_XGEN(b.x)]) == gen, bar);
            __builtin_amdgcn_fence(__ATOMIC_ACQUIRE, "agent");
            asm volatile("s_waitcnt vmcnt(0)" ::: "memory");
        }
    }
    __syncthreads();
}

__device__ __forceinline__ int pi32(int o) { return 2 * (o & 15) + (o >> 4); }
__device__ __forceinline__ void tr_item(const float* __restrict__ W, int N, int k0, int n0, bf16* __restrict__ WT, int ldk, int drow0, bool perm, const float* __restrict__ gsc, LAS float* scr, int lane) {
    f32x4 w[8]; const int c4 = (lane & 7) * 4, rsub = lane >> 3;
#pragma unroll
    for (int i = 0; i < 8; ++i) w[i] = *(const f32x4*)(W + (size_t)(k0 + 8 * i + rsub) * N + n0 + c4);
#pragma unroll
    for (int i = 0; i < 8; ++i) { const int kk = 8 * i + rsub; const float g = gsc ? gsc[k0 + kk] : 1.f;
        scr[kk * 33 + c4] = w[i][0] * g; scr[kk * 33 + c4 + 1] = w[i][1] * g; scr[kk * 33 + c4 + 2] = w[i][2] * g; scr[kk * 33 + c4 + 3] = w[i][3] * g; }
    LDS_WAIT(); asm volatile("" ::: "memory");
    const int c = lane & 7;
#pragma unroll
    for (int j = 0; j < 4; ++j) { const int n = (lane >> 3) + 8 * j; const LAS float* s = scr + (8 * c) * 33 + n;
        v4u o; o.x = pk2(s[0 * 33], s[1 * 33]); o.y = pk2(s[2 * 33], s[3 * 33]); o.z = pk2(s[4 * 33], s[5 * 33]); o.w = pk2(s[6 * 33], s[7 * 33]);
        const int dn = perm ? pi32(n) : n;
        *(v4u*)(WT + (size_t)(drow0 + dn) * ldk + k0 + 8 * c) = o; }
    LDS_WAIT(); asm volatile("" ::: "memory");
}
__device__ __forceinline__ float silu_f(float v) { return v / (1.f + expf(-v)); }
__device__ __forceinline__ float gelu_erf(float v) { return 0.5f * v * (1.f + erff(v * 0.70710678118654752f)); }
__device__ __forceinline__ unsigned fkey(float f) { const unsigned u = __builtin_bit_cast(unsigned, f); return (u & 0x80000000u) ? ~u : (u | 0x80000000u); }

template <int NV> __device__ __forceinline__ unsigned kth16(const unsigned (&k)[NV]) {
    unsigned T = 0u;
    for (int bit = 31; bit >= 0; --bit) { const unsigned c = T | (1u << bit); int cnt = 0;
#pragma unroll
        for (int v = 0; v < NV; ++v) cnt += __popcll(__ballot(k[v] >= c));
        if (cnt >= 16) T = c; }
    return T;
}
template <int NV> __device__ __forceinline__ void compact16(const unsigned (&k)[NV], const unsigned (&val)[NV], const unsigned (&pay)[NV], unsigned T, LAS unsigned* oval, LAS unsigned* opay, int lane) {
    const unsigned long long lt = (1ull << lane) - 1ull; int pos = 0;
#pragma unroll
    for (int v = 0; v < NV; ++v) { const bool s = k[v] > T; const unsigned long long m = __ballot(s); const int slot = pos + __popcll(m & lt); if (s) { oval[slot] = val[v]; opay[slot] = pay[v]; } pos += __popcll(m); }
#pragma unroll
    for (int v = 0; v < NV; ++v) { const bool s = k[v] == T; const unsigned long long m = __ballot(s); const int slot = pos + __popcll(m & lt); if (s && slot < 16) { oval[slot] = val[v]; opay[slot] = pay[v]; } pos += __popcll(m); }
}

struct Args { const float* in[21]; float* out; unsigned char* ws; int ph_lo, ph_hi, probe, pad; };
static_assert(sizeof(Args) == 23 * 8 + 16, "Args has no padding");

template <int PRB, bool PK> __device__ __forceinline__ void fwd_body(const Args& a) {
    extern __shared__ __attribute__((aligned(16))) unsigned char lds[];
    LAS unsigned char* L = (LAS unsigned char*)lds;
    const int wave = __builtin_amdgcn_readfirstlane((int)threadIdx.x >> 6);
    const int G = gridDim.x, bx = blockIdx.x;
    const int gw = bx * NWAVES + wave, NGW = G * NWAVES;
    const size_t NT = (size_t)G * NTHR;
#define PH_IDS() int tid_ph_ = threadIdx.x; asm volatile("" : "+v"(tid_ph_)); const int tid = tid_ph_, lane = tid & 63; const size_t gt = (size_t)bx * NTHR + tid; (void)lane; (void)gt
    unsigned char* ws = a.ws;
    float* ctlf = (float*)(ws + WS_CTL);
    const float* x = a.in[0]; const float* cvec = a.in[1]; const float* ctx = a.in[2]; const float* cctx = a.in[3]; const float* w_ada = a.in[4]; const float* b_ada = a.in[5];
    const float* norm1_g = a.in[6]; const float* w_in = a.in[7]; const float* q_norm_g = a.in[8]; const float* w_uq = a.in[9]; const float* kv_norm_g = a.in[10]; const float* w_ukv = a.in[11];
    const float* conv_w = a.in[12]; const float* conv_b = a.in[13]; const float* w_o = a.in[14]; const float* norm2_g = a.in[15]; const float* peer_wq = a.in[16]; const float* peer_keys = a.in[17];
    const float* peer_u = a.in[18]; const float* peer_v = a.in[19]; const float* final_g = a.in[20];
    float* modp = (float*)(ws + WS_MODP); float* ssq_cq = (float*)(ws + WS_SQ1); float* ssq_ckv = (float*)(ws + WS_SQ2); float* ssq_x1 = (float*)(ws + WS_SQ3);
    float* modf = (float*)(ws + WS_MODF); float* rope = (float*)(ws + WS_ROPE);
    bf16* WIN = (bf16*)(ws + WS_WIN); bf16* WUQ = (bf16*)(ws + WS_WUQ); bf16* WUKV = (bf16*)(ws + WS_WUKV); bf16* WO = (bf16*)(ws + WS_WO); bf16* WPQ = (bf16*)(ws + WS_WPQ); bf16* KBD = (bf16*)(ws + WS_KBD); bf16* KB2 = (bf16*)(ws + WS_KB2);
    unsigned char* UB = ws + WS_UB; unsigned char* VB = ws + WS_VB; float* SUV = (float*)(ws + WS_SU); bf16* HX = (bf16*)(ws + WS_HX); bf16* CQ = (bf16*)(ws + WS_CQ); bf16* CKV = (bf16*)(ws + WS_CKV); unsigned char* KR = ws + WS_KR;
    bf16* UCV = (bf16*)(ws + WS_U); bf16* GBV = (bf16*)(ws + WS_GB); unsigned char* Q = ws + WS_Q; unsigned char* KN = ws + WS_KN; unsigned char* VT = ws + WS_V; bf16* ACAT = (bf16*)(ws + WS_ACAT);
    bf16* DLT = (bf16*)(ws + WS_X1); bf16* H2 = (bf16*)(ws + WS_H2); float* SC = (float*)(ws + WS_SC);

    for (int u = threadIdx.x; u < (LDS_BYTES - RING_BYTES) / 4; u += NTHR) ((LAS unsigned*)(L + RING_BYTES))[u] = 0u;
    __syncthreads();
    const int lo = a.ph_lo, hi = a.ph_hi;
    XcdBarrier bar; bar.bar = (unsigned*)ctlf + CW_BAR; bar.x = 0; bar.st = (volatile LAS unsigned*)(L + MISC_OFF);
    if (hi - lo > 1) bar = xcd_barrier_post((unsigned*)ctlf + CW_BAR, (volatile LAS unsigned*)(L + MISC_OFF));
#define IN(k) (lo <= (k) && (k) < hi)
#ifndef PHASE_MASK
#define PHASE_MASK 0x3ff
#endif
#ifndef PROBE_PHASES
#define PROBE_PHASES_ 0
#else
#define PROBE_PHASES_ PROBE_PHASES
#endif
#define PH_ON(k) ((((PK) ? (PROBE_PHASES_) : (PHASE_MASK)) >> (k)) & 1)
#ifndef REPEAT_MASK
#define REPEAT_MASK 0
#endif
#define NREP(k) (1 + (((REPEAT_MASK) >> (k)) & 1))
#define GRID_BAR(k) do { if (IN(k) && IN((k) + 1)) xcd_barrier(bar); } while (0)

#ifndef XTAIL
#define XTAIL 0
#endif
#ifndef TAIL_ROWS
#define TAIL_ROWS 24
#endif
    const auto conv_load = [&](const int r, const int lane, f32x4 (&v)[2][8]) { const bool isv = r >= NEXP; const int e = isv ? r - NEXP : r; const float* src = (isv ? peer_v : peer_u) + (size_t)e * DM + lane * 4;
#pragma unroll
            for (int b = 0; b < 2; ++b)
#pragma unroll
                for (int q = 0; q < 8; ++q) v[b][q] = __builtin_nontemporal_load((const f32x4*)(src + b * 2048 + q * 256));
    };
    const auto conv_finish = [&](const int r, const int lane, const f32x4 (&v)[2][8]) { const bool isv = r >= NEXP; const int e = isv ? r - NEXP : r; float am = 0.f;
#pragma unroll
            for (int b = 0; b < 2; ++b)
#pragma unroll
                for (int q = 0; q < 8; ++q) am = fmaxf(am, fmaxf(fmaxf(fabsf(v[b][q][0]), fabsf(v[b][q][1])), fmaxf(fabsf(v[b][q][2]), fabsf(v[b][q][3]))));
            am = wave_max(am);
            const float sc = am > 0.f ? exp2f(floorf(log2f(7.5f / am))) : 1.f;
            unsigned d[12];
#pragma unroll
            for (int b = 0; b < 2; ++b) { f32x16v s0, s1;
#pragma unroll
                for (int i = 0; i < 16; ++i) { const int i0 = FP6_INTERLEAVED ? 2 * i : i, i1 = FP6_INTERLEAVED ? 2 * i + 1 : 16 + i; s0[i] = v[b][i0 >> 2][i0 & 3] * sc; s1[i] = v[b][i1 >> 2][i1 & 3] * sc; }
                const u32x6v w = __builtin_amdgcn_cvt_scalef32_2xpk16_fp6_f32(s0, s1, 1.0f);
#pragma unroll
                for (int i = 0; i < 6; ++i) d[6 * b + i] = w[i]; }
            unsigned char* dst = (isv ? VB : UB) + (size_t)e * ROWB + lane * 16;
#pragma unroll
            for (int p = 0; p < 3; ++p) { const v4u o = {d[4 * p], d[4 * p + 1], d[4 * p + 2], d[4 * p + 3]}; *(v4u*)(dst + p * 1024) = o; }
            if (lane == 0) SUV[r] = 1.f / sc;
    };
    const auto conv_row = [&](const int r, const int lane) { f32x4 v[2][8]; conv_load(r, lane, v); conv_finish(r, lane, v); };

    if (PH_ON(0) && IN(0)) for (int rep_ = 0; rep_ < NREP(0); ++rep_) {
        PH_IDS();
        const int psel = a.probe ? a.probe : 7;
        if (psel & 1)
        for (int it = gw; it < 64 * 96; it += NGW) {
            const int kb = it / 96, cb = it % 96, col = cb * 256 + lane * 4;
            const float* wp = w_ada + (size_t)(kb * 64) * NMODC + col;
            f32x4 ax = {0.f, 0.f, 0.f, 0.f}, ac = {0.f, 0.f, 0.f, 0.f}; const bool cc = cb < 32;
            const float sxv = silu_f(cvec[kb * 64 + lane]), scv = silu_f(cctx[kb * 64 + lane]);
#pragma unroll 16
            for (int i = 0; i < 64; ++i) { const f32x4 w = __builtin_nontemporal_load((const f32x4*)(wp + (size_t)i * NMODC));
                ax += w * rl_f(sxv, i); ac += w * (cc ? rl_f(scv, i) : 0.f); }
            *(f32x4*)(modp + (size_t)kb * 32768 + col) = ax; if (cc) *(f32x4*)(modp + (size_t)kb * 32768 + NMODC + col) = ac;
        }
        if (psel & 2) {
            LAS float* scr = (LAS float*)(L + wave * 8448);
            constexpr int I_IN = 64 * 234, I_UQ = 12 * 96, I_UKV = 8 * 128, I_O = 64 * 128, NIT = I_IN + I_UQ + I_UKV + I_O;
            for (int it = gw; it < NIT; it += NGW) { int r = it;
                if (r < I_IN) { const int kb = r / 234, n0 = (r % 234) * 32; int drow0; bool perm = false;
                    if (n0 < 1280) drow0 = n0; else if (n0 < 1344) { drow0 = n0; perm = true; }
                    else { const int c0 = n0 - 1344; if (c0 < 2048) drow0 = 1536 + (c0 >> 7) * 256 + (c0 & 127); else if (c0 < 4096) drow0 = 5632 + (c0 - 2048); else { const int c1 = c0 - 4096; drow0 = 1536 + (c1 >> 7) * 256 + 128 + (c1 & 127); } }
                    tr_item(w_in, 7488, kb * 64, n0, WIN, 4096, drow0, perm, nullptr, scr, lane); continue; } r -= I_IN;
                if (r < I_UQ) { const int kb = r / 96, n0 = (r % 96) * 32; tr_item(w_uq, 3072, kb * 64, n0, WUQ, 768, n0, (n0 % 192) >= 128, q_norm_g, scr, lane); continue; } r -= I_UQ;
                if (r < I_UKV) { const int kb = r / 128, n0 = (r % 128) * 32; tr_item(w_ukv, 4096, kb * 64, n0, WUKV, 512, ((n0 & 255) < 128 ? 0 : 2048) + (n0 >> 8) * 128 + (n0 & 127), false, kv_norm_g, scr, lane); continue; } r -= I_UKV;
                { const int kb = r / 128, n0 = (r % 128) * 32; tr_item(w_o, 4096, kb * 64, n0, WO, 4096, n0, false, nullptr, scr, lane); }
            }
        }
        for (size_t i = gt; i < (size_t)192 * 512; i += NT) { const v4u z = {0u, 0u, 0u, 0u}; *(v4u*)(WIN + (size_t)1344 * 4096 + i * 8) = z; }
        for (size_t i = gt; i < (size_t)DM * 2048 / 8; i += NT) {
            const int d = (int)(i >> 8), c8 = (int)(i & 255) * 8, h = c8 >> 8, j = c8 & 255; const float* sp_ = peer_wq + (size_t)d * 2048 + c8; const f32x4 a0 = *(const f32x4*)sp_, a1 = *(const f32x4*)(sp_ + 4);
            v4u o; o.x = pk2(a0[0], a0[1]); o.y = pk2(a0[2], a0[3]); o.z = pk2(a1[0], a1[1]); o.w = pk2(a1[2], a1[3]); *(v4u*)(WPQ + ((size_t)h * DM + d) * 256 + j) = o; }
        for (size_t i = gt; i < (size_t)8 * 256 * 32; i += NT) {
            const int d8 = (int)(i & 31) * 8, rr = (int)(i >> 5) & 255, h = (int)(i >> 13), p = rr >> 7, k = rr & 127; v4u o = {0u, 0u, 0u, 0u};
            if ((d8 >> 7) == p) { const float* s_ = peer_keys + ((size_t)((h * 2 + p) * 128 + k)) * 128 + (d8 & 127); const f32x4 a0 = *(const f32x4*)s_, a1 = *(const f32x4*)(s_ + 4);
                o.x = pk2(a0[0], a0[1]); o.y = pk2(a0[2], a0[3]); o.z = pk2(a1[0], a1[1]); o.w = pk2(a1[2], a1[3]); }
            *(v4u*)(KB2 + i * 8) = o; }
        for (size_t i = gt; i < (size_t)192 * 16; i += NT) {
            const int pi = (int)(i >> 4), fi = (int)(i & 15); const int pos = pi < 128 ? pi : pi - 128;
            const float fr = __builtin_amdgcn_exp2f(-(float)fi * 0.83048202372184059f);
            const float turns = (float)pos * fr * 0.15915494309189535f, fx = turns - floorf(turns);
            rope[pi * 32 + 2 * fi] = __builtin_amdgcn_cosf(fx); rope[pi * 32 + 2 * fi + 1] = __builtin_amdgcn_sinf(fx); }
    }
    GRID_BAR(0);

    if (PH_ON(1) && IN(1)) for (int rep_ = 0; rep_ < NREP(1); ++rep_) {
        PH_IDS();
        for (size_t j = gt; j < (size_t)(NMODC + 2 * DM); j += NT) { float sacc = 0.f;
#pragma unroll 8
            for (int kb = 0; kb < 64; ++kb) sacc += modp[(size_t)kb * 32768 + j];
            modf[j] = sacc + b_ada[j < (size_t)NMODC ? j : j - NMODC]; }
        { pg8::Gemm g{KB2, WPQ, 2048, DM, 256, 0, (size_t)DM * 256 * 2}; pg8::StaticOrder S; S.init(2048, DM, G, bx); pg8::EpiB16 E{KBD, DM};
          pg8::gemm_phase<pg8::EpiB16, pg8::StaticOrder, true, true>(L, g, S, E); }
        if ((XTAIL & 1) && G == 256 && bx >= 128) { for (int k = 0; k < 2; ++k) conv_row(488 * TAIL_ROWS + (bx - 128) * 8 + wave + 1024 * k, lane); }
    }
    GRID_BAR(1);

    if (PH_ON(2) && IN(2)) for (int rep_ = 0; rep_ < NREP(2); ++rep_) {
        PH_IDS();
        for (int row = gw; row < MR; row += NGW) {
            const bool lat = row < SEQ; const float* xr = lat ? x + (size_t)row * DM : ctx + (size_t)(row - SEQ) * DM; const float* md = lat ? modf : modf + NMODC;
            f32x4 v[16]; float ss = 0.f;
#pragma unroll
            for (int j = 0; j < 16; ++j) { v[j] = *(const f32x4*)(xr + 4 * (lane + 64 * j)); ss += (v[j][0] * v[j][0] + v[j][1] * v[j][1]) + (v[j][2] * v[j][2] + v[j][3] * v[j][3]); }
            ss = wave_sum(ss); const float rstd = 1.f / sqrtf(ss * (1.f / DM) + EPS);
#pragma unroll
            for (int j = 0; j < 16; ++j) { const int idx = 4 * (lane + 64 * j);
                const f32x4 g = *(const f32x4*)(norm1_g + idx), sh = *(const f32x4*)(md + idx), sc = *(const f32x4*)(md + DM + idx);
                const f32x4 hh = (v[j] * rstd * g) * (sc + 1.f) + sh;
                *(unsigned long long*)(HX + (size_t)row * DM + idx) = (unsigned long long)pk2(hh[0], hh[1]) | ((unsigned long long)pk2(hh[2], hh[3]) << 32); }
        }
    }
    GRID_BAR(2);

    if (PH_ON(3) && IN(3)) for (int rep_ = 0; rep_ < NREP(3); ++rep_) {
        pg8::Gemm g{HX, WIN, MR, NIN, DM, 0, 0}; pg8::OrderIn S; S.init(SEQ, NIN, G, bx);
        pg8::EpiIn E{CQ, CKV, KR, UCV, GBV, ssq_cq, ssq_ckv, rope};
        pg8::gemm_phase<pg8::EpiIn, pg8::OrderIn, true, true>(L, g, S, E);
        if (G == 256 && bx >= 195) { PH_IDS();
            const int w0 = (bx - 195) * 8 + wave;
            for (int k = 0; k < TAIL_ROWS; ++k) conv_row(w0 + 488 * k, lane); }
    }
    GRID_BAR(3);

    if (PH_ON(4) && IN(4)) for (int rep_ = 0; rep_ < NREP(4); ++rep_) {
        PH_IDS();
        {
            int nq, qb0, nkv, kb0;
            if (G == 256) { nq = bx < 144 ? 1 : bx < 240 ? 2 : 3; qb0 = bx < 144 ? bx : bx < 240 ? 144 + 2 * (bx - 144) : 336 + 3 * (bx - 240); nkv = bx < 144 ? 3 : bx < 240 ? 1 : 0; kb0 = bx < 144 ? 3 * bx : 432 + (bx - 144); }
            else { qb0 = (int)(((long)384 * bx) / G); nq = (int)(((long)384 * (bx + 1)) / G) - qb0; kb0 = (int)(((long)528 * bx) / G); nkv = (int)(((long)528 * (bx + 1)) / G) - kb0; }
            const int k0 = kb0 < 264 ? kb0 : 264, k1 = kb0 + nkv < 264 ? kb0 + nkv : 264;
            const int v0 = (kb0 > 264 ? kb0 : 264) - 264, v1 = (kb0 + nkv > 264 ? kb0 + nkv : 264) - 264;
            { pg8::Gemm g{CQ, WUQ, SEQ, 3072, QL, 0, 0}; pg8::RunOrder S{qb0, nq, 12}; pg8::EpiQ E{Q, ssq_cq, rope, C2 * att::QSC};
              pg8::gemm_phase<pg8::EpiQ, pg8::RunOrder, true, true>(L, g, S, E); }
            { pg8::Gemm g{CKV, WUKV, MR, 2048, KVL, 0, 0}; pg8::RunOrder S{k0, k1 - k0, 8}; pg8::EpiK E{KN, ssq_ckv};
              pg8::gemm_phase<pg8::EpiK, pg8::RunOrder, true, true>(L, g, S, E); }
            { pg8::Gemm g{WUKV + (size_t)2048 * KVL, CKV, 2048, MR, KVL, 0, 0}; pg8::RunOrder S{v0, v1 - v0, 33}; pg8::EpiVT E{VT, ssq_ckv};
              pg8::gemm_phase<pg8::EpiVT, pg8::RunOrder, true, true>(L, g, S, E); }
        }
        for (size_t it = gt; it < (size_t)SEQ * 256; it += NT) {
            const int t = (int)(it >> 8), c8 = (int)(it & 255) * 8; const v4u z = {0u, 0u, 0u, 0u};
            const v4u um = t > 0 ? *(const v4u*)(UCV + (size_t)(t - 1) * 2048 + c8) : z, u0 = *(const v4u*)(UCV + (size_t)t * 2048 + c8), up = t < SEQ - 1 ? *(const v4u*)(UCV + (size_t)(t + 1) * 2048 + c8) : z;
            const v4u gv = *(const v4u*)(GBV + (size_t)t * 2048 + c8); v4u o;
            float w0[8], w1[8], w2[8], wb[8];
#pragma unroll
            for (int q = 0; q < 2; ++q) { const f32x4 a0 = *(const f32x4*)(conv_w + c8 + 4 * q), a1 = *(const f32x4*)(conv_w + 2048 + c8 + 4 * q), a2 = *(const f32x4*)(conv_w + 4096 + c8 + 4 * q), a3 = *(const f32x4*)(conv_b + c8 + 4 * q);
#pragma unroll
                for (int j = 0; j < 4; ++j) { w0[4 * q + j] = a0[j]; w1[4 * q + j] = a1[j]; w2[4 * q + j] = a2[j]; wb[4 * q + j] = a3[j]; } }
#pragma unroll
            for (int j = 0; j < 4; ++j) {
                const float y0 = w0[2 * j] * bflo(um[j]) + w1[2 * j] * bflo(u0[j]) + w2[2 * j] * bflo(up[j]) + wb[2 * j];
                const float y1 = w0[2 * j + 1] * bfhi(um[j]) + w1[2 * j + 1] * bfhi(u0[j]) + w2[2 * j + 1] * bfhi(up[j]) + wb[2 * j + 1];
                o[j] = pk2(bflo(gv[j]) * y0, bfhi(gv[j]) * y1); }
            *(v4u*)(ACAT + (size_t)t * DM + 2048 + c8) = o; }
        if ((XTAIL & 2) && G == 256 && bx >= 144 && bx < 240) { for (int k = 0; k < 2; ++k) conv_row(488 * TAIL_ROWS + ((XTAIL & 1) ? 2048 : 0) + (bx - 144) * 8 + wave + 768 * k, lane); }
    }
    GRID_BAR(4);
#ifdef PROBE_CLK
    if (bx == 0 && threadIdx.x == 0) { unsigned long long* ck = (unsigned long long*)(ws + WS_CTL + 524288); ck[0] = __builtin_readcyclecounter(); ck[2] = __builtin_amdgcn_s_memrealtime(); }
#endif

    if (PH_ON(5) && IN(5)) for (int rep_ = 0; rep_ < NREP(5); ++rep_) {
        for (int i = 0;; ++i) { int h, qb;
            if (G == 256) { if (i >= 2) break; h = 2 * (bx & 7) + i; qb = bx >> 3; } else { const int Lu = i * G + bx; if (Lu >= 512) break; h = Lu >> 5; qb = Lu & 31; }
#ifdef PROBE_ROLES
            if (PK) { if (wave >= 4) att::attn_unit<PROBE_ROLES / 256>(Q + (size_t)(qb * 256) * 3072 + h * 192, KN + h * 128, VT + (size_t)(h * 128) * 8448, KR, ACAT + (size_t)(qb * 256) * DM + h * 128, MR, (char*)lds, L, a.probe);
                      else att::attn_unit<PROBE_ROLES % 256>(Q + (size_t)(qb * 256) * 3072 + h * 192, KN + h * 128, VT + (size_t)(h * 128) * 8448, KR, ACAT + (size_t)(qb * 256) * DM + h * 128, MR, (char*)lds, L, a.probe); continue; }
#endif
            att::attn_unit<PRB>(Q + (size_t)(qb * 256) * 3072 + h * 192, KN + h * 128, VT + (size_t)(h * 128) * 8448, KR, ACAT + (size_t)(qb * 256) * DM + h * 128, MR, (char*)lds, L, a.probe); }
    }
#ifdef PROBE_CLK
    if (bx == 0 && threadIdx.x == 0) { unsigned long long* ck = (unsigned long long*)(ws + WS_CTL + 524288); ck[1] = __builtin_readcyclecounter(); ck[3] = __builtin_amdgcn_s_memrealtime(); }
#endif
    GRID_BAR(5);

    if (PH_ON(6) && IN(6)) for (int rep_ = 0; rep_ < NREP(6); ++rep_) {
        pg8::Gemm g{ACAT, WO, SEQ, DM, DM, 0, 0}; pg8::StaticOrder S; S.init(SEQ, DM, G, bx); pg8::EpiO E{modf + 2 * DM, DLT};
        pg8::gemm_phase<pg8::EpiO, pg8::StaticOrder, true, true>(L, g, S, E);
    }
    GRID_BAR(6);

    if (PH_ON(7) && IN(7)) for (int rep_ = 0; rep_ < NREP(7); ++rep_) {
        PH_IDS();
        for (int row = gw; row < SEQ; row += NGW) {
            f32x4 v[16]; float ssq[4] = {0.f, 0.f, 0.f, 0.f};
#pragma unroll
            for (int j = 0; j < 16; ++j) { const int idx = 4 * (lane + 64 * j); const unsigned long long d8 = *(const unsigned long long*)(DLT + (size_t)row * DM + idx); const f32x4 xv = *(const f32x4*)(x + (size_t)row * DM + idx);
                v[j][0] = xv[0] + bflo((unsigned)d8); v[j][1] = xv[1] + bfhi((unsigned)d8); v[j][2] = xv[2] + bflo((unsigned)(d8 >> 32)); v[j][3] = xv[3] + bfhi((unsigned)(d8 >> 32));
#pragma unroll
                for (int c = 0; c < 4; ++c) ssq[c] = fmaf(v[j][c], v[j][c], ssq[c]); }
            const float rstd = 1.f / sqrtf(wave_sum((ssq[0] + ssq[1]) + (ssq[2] + ssq[3])) * (1.f / DM) + EPS);
#pragma unroll
            for (int j = 0; j < 16; ++j) { const int idx = 4 * (lane + 64 * j);
                const f32x4 g = *(const f32x4*)(norm2_g + idx), sh = *(const f32x4*)(modf + 3 * DM + idx), sc = *(const f32x4*)(modf + 4 * DM + idx);
                const f32x4 hh = (v[j] * rstd * g) * (sc + 1.f) + sh;
                *(unsigned long long*)(H2 + (size_t)row * DM + idx) = (unsigned long long)pk2(hh[0], hh[1]) | ((unsigned long long)pk2(hh[2], hh[3]) << 32); }
        }
    }
    GRID_BAR(7);

    if (PH_ON(8) && IN(8)) for (int rep_ = 0; rep_ < NREP(8); ++rep_) {
        pg8::Gemm g{H2, KBD, SEQ, 2048, DM, 0, 0}; pg8::StaticOrder S; S.init(SEQ, 2048, G, bx); pg8::EpiF32 E{SC, 2048};
        const bool drain_first = ((bx >> 3) & 1) == 0;
        if (drain_first) { PH_IDS(); for (int r = (G == 256 ? 488 * TAIL_ROWS : 0) + gw; r < 2 * NEXP; r += NGW) conv_row(r, lane); }
        pg8::gemm_phase<pg8::EpiF32, pg8::StaticOrder, true, true>(L, g, S, E);
        if (!drain_first) { PH_IDS(); for (int r = (G == 256 ? 488 * TAIL_ROWS : 0) + gw; r < 2 * NEXP; r += NGW) conv_row(r, lane); }
    }
    GRID_BAR(8);

    if (PH_ON(9) && IN(9)) for (int rep_ = 0; rep_ < NREP(9); ++rep_) {
        int lane0_ = threadIdx.x; asm volatile("" : "+v"(lane0_)); lane0_ &= 63;
        LAS unsigned* wl = (LAS unsigned*)(L + wave * 8192);
        LAS unsigned* sV1 = wl, *sI1 = wl + 16, *sV2 = wl + 32, *sI2 = wl + 48, *sVc = wl + 64, *sEc = wl + 80;
        LAS unsigned* eL = wl + 128; LAS float* gL = (LAS float*)(wl + 128 + 512);
        const float* gate2 = modf + 5 * DM; const int emask_ = a.probe ? 63 : 0xffff; float* outp_ = a.probe ? (float*)(ws + WS_HX) : a.out;
        for (int tb = gw * 4; tb < SEQ; tb += NGW * 4) {
            for (int ti = 0; ti < 4; ++ti) { const int t = tb + ti; int lane = lane0_; asm volatile("" : "+v"(lane));
                for (int h = 0; h < 8; ++h) { const float* sp = SC + (size_t)t * 2048 + h * 256;
                    { const float s0 = sp[lane], s1 = sp[64 + lane]; const unsigned k[2] = {fkey(s0), fkey(s1)}, vb[2] = {__builtin_bit_cast(unsigned, s0), __builtin_bit_cast(unsigned, s1)}, pl[2] = {(unsigned)lane, (unsigned)(64 + lane)};
                      const unsigned T = kth16<2>(k); compact16<2>(k, vb, pl, T, sV1, sI1, lane); }
                    { const float s0 = sp[128 + lane], s1 = sp[192 + lane]; const unsigned k[2] = {fkey(s0), fkey(s1)}, vb[2] = {__builtin_bit_cast(unsigned, s0), __builtin_bit_cast(unsigned, s1)}, pl[2] = {(unsigned)lane, (unsigned)(64 + lane)};
                      const unsigned T = kth16<2>(k); compact16<2>(k, vb, pl, T, sV2, sI2, lane); }
                    LDS_WAIT();
                    { const float s2b = __builtin_bit_cast(float, sV2[lane & 15]); const unsigned i2b = sI2[lane & 15]; unsigned k[4], vb[4], pl[4];
#pragma unroll
                      for (int r = 0; r < 4; ++r) { const int aa = (lane >> 4) + 4 * r; const float cv = __builtin_bit_cast(float, sV1[aa]) + s2b; k[r] = fkey(cv); vb[r] = __builtin_bit_cast(unsigned, cv); pl[r] = sI1[aa] * 128u + i2b; }
                      const unsigned T = kth16<4>(k); compact16<4>(k, vb, pl, T, sVc, sEc, lane); }
                    LDS_WAIT();
                    { const float tv = __builtin_bit_cast(float, sVc[lane & 15]); const float mx = row16_max(tv);
                      const float ex = expf(tv - mx); const float sm = row16_sum(ex);
                      if (lane < 16) { eL[ti * 128 + h * 16 + lane] = sEc[lane]; gL[ti * 128 + h * 16 + lane] = ex / sm; } }
                    LDS_WAIT();
                }
                { const unsigned e0 = eL[ti * 128 + lane], e1 = eL[ti * 128 + 64 + lane]; const float g0 = gL[ti * 128 + lane], g1 = gL[ti * 128 + 64 + lane];
                  const unsigned k0 = (e0 << 7) | (unsigned)lane, k1 = (e1 << 7) | (unsigned)(64 + lane); int r0 = 0, r1 = 0;
#pragma unroll 8
                  for (int m = 0; m < 128; ++m) { const unsigned km = (eL[ti * 128 + m] << 7) | (unsigned)m; r0 += km < k0 ? 1 : 0; r1 += km < k1 ? 1 : 0; }
                  LDS_WAIT();
                  eL[ti * 128 + r0] = e0; gL[ti * 128 + r0] = g0; eL[ti * 128 + r1] = e1; gL[ti * 128 + r1] = g1;
                  LDS_WAIT(); }
                h16x2 hh[2][16];
#pragma unroll
                for (int b = 0; b < 2; ++b)
#pragma unroll
                    for (int q = 0; q < 8; ++q) { const unsigned long long a0 = *(const unsigned long long*)(H2 + (size_t)t * DM + b * 2048 + q * 256 + lane * 4);
                        hh[b][2 * q] = (h16x2){(_Float16)bflo((unsigned)a0), (_Float16)bfhi((unsigned)a0)}; hh[b][2 * q + 1] = (h16x2){(_Float16)bflo((unsigned)(a0 >> 32)), (_Float16)bfhi((unsigned)(a0 >> 32))}; }
                v4u rr[6][3]; float rs[6];
#define LDROW(j, TAB, e, SOFF) do { const unsigned char* rp_ = (TAB) + (size_t)(e) * ROWB + lane * 16; _Pragma("unroll") for (int p = 0; p < 3; ++p) rr[j][p] = *(const v4u*)(rp_ + p * 1024); rs[j] = SUV[(SOFF) + (e)]; } while (0)
#define EIDX(k) (__builtin_amdgcn_readfirstlane((int)eL[ti * 128 + (k)]) & emask_)
#define UNPKH(j, b) __builtin_amdgcn_cvt_scalef32_pk32_f16_fp6((b) == 0 ? (u32x6v){rr[j][0][0], rr[j][0][1], rr[j][0][2], rr[j][0][3], rr[j][1][0], rr[j][1][1]} : (u32x6v){rr[j][1][2], rr[j][1][3], rr[j][2][0], rr[j][2][1], rr[j][2][2], rr[j][2][3]}, 1.0f)
#define DOTROW(out, j) do { float a0 = 0.f, a1 = 0.f, a2 = 0.f, a3 = 0.f; _Pragma("unroll") for (int b = 0; b < 2; ++b) { const h16x32 x_ = UNPKH(j, b); \
                    _Pragma("unroll") for (int i = 0; i < 16; i += 4) { a0 = __builtin_amdgcn_fdot2((h16x2){x_[2 * i], x_[2 * i + 1]}, hh[b][i], a0, false); a1 = __builtin_amdgcn_fdot2((h16x2){x_[2 * i + 2], x_[2 * i + 3]}, hh[b][i + 1], a1, false); \
                        a2 = __builtin_amdgcn_fdot2((h16x2){x_[2 * i + 4], x_[2 * i + 5]}, hh[b][i + 2], a2, false); a3 = __builtin_amdgcn_fdot2((h16x2){x_[2 * i + 6], x_[2 * i + 7]}, hh[b][i + 3], a3, false); } } \
                    out = (a0 + a1) + (a2 + a3); } while (0)
                int ei[6];
#pragma unroll
                for (int j = 0; j < 6; ++j) { ei[j] = EIDX(j); LDROW(j, UB, ei[j], 0); }
                for (int k0 = 0; k0 < 126; k0 += 6) {
                    float dsum[6];
#pragma unroll
                    for (int j = 0; j < 6; ++j) { float part; DOTROW(part, j); const float sc_ = rs[j];
                        if (k0 + 6 + j < 128) { ei[j] = EIDX(k0 + 6 + j); LDROW(j, UB, ei[j], 0); }
                        dsum[j] = wave_sum(part) * sc_; }
                    if (lane < 6) { float d = dsum[0];
#pragma unroll
                        for (int j = 1; j < 6; ++j) d = lane == j ? dsum[j] : d;
                        gL[ti * 128 + k0 + lane] = gL[ti * 128 + k0 + lane] * gelu_erf(d); }
                }
                { float dsum[2];
#pragma unroll
                  for (int j = 0; j < 2; ++j) { float part; DOTROW(part, j); dsum[j] = wave_sum(part) * rs[j]; }
                  if (lane < 2) { const float d = lane == 0 ? dsum[0] : dsum[1]; gL[ti * 128 + 126 + lane] = gL[ti * 128 + 126 + lane] * gelu_erf(d); } }
                LDS_WAIT();
            }
            for (int ti = 0; ti < 4; ++ti) { const int t = tb + ti; int lane = lane0_; asm volatile("" : "+v"(lane));
                h16x2 ah[2][16];
#pragma unroll
                for (int b = 0; b < 2; ++b)
#pragma unroll
                    for (int i = 0; i < 16; ++i) ah[b][i] = (h16x2){(_Float16)0.f, (_Float16)0.f};
                v4u rr[6][3]; float rs[6];
#define FMAROW(j, WW) do { const _Float16 wh_ = (_Float16)(WW); const h16x2 w2_ = {wh_, wh_}; _Pragma("unroll") for (int b = 0; b < 2; ++b) { const h16x32 x_ = UNPKH(j, b); \
                    _Pragma("unroll") for (int i = 0; i < 16; ++i) ah[b][i] = __builtin_elementwise_fma(w2_, (h16x2){x_[2 * i], x_[2 * i + 1]}, ah[b][i]); } } while (0)
                int ei[6];
#pragma unroll
                for (int j = 0; j < 6; ++j) { ei[j] = EIDX(j); LDROW(j, VB, ei[j], NEXP); }
                for (int k0 = 0; k0 < 126; k0 += 6) {
#pragma unroll
                    for (int j = 0; j < 6; ++j) { FMAROW(j, gL[ti * 128 + k0 + j] * rs[j]);
                        if (k0 + 6 + j < 128) { ei[j] = EIDX(k0 + 6 + j); LDROW(j, VB, ei[j], NEXP); } }
                }
#pragma unroll
                for (int j = 0; j < 2; ++j) FMAROW(j, gL[ti * 128 + 126 + j] * rs[j]);
                float acc[2][32];
#pragma unroll
                for (int b = 0; b < 2; ++b)
#pragma unroll
                    for (int i = 0; i < 16; ++i) { acc[b][2 * i] = (float)ah[b][i][0]; acc[b][2 * i + 1] = (float)ah[b][i][1]; }
                float ssp[4] = {0.f, 0.f, 0.f, 0.f}; int lane_f = lane; asm volatile("" : "+v"(lane_f));
#pragma unroll
                for (int b = 0; b < 2; ++b)
#pragma unroll
                    for (int q = 0; q < 8; ++q) { unsigned o = (unsigned)(b * 2048 + q * 256 + lane_f * 4); asm volatile("" : "+v"(o)); const unsigned long long d8 = *(const unsigned long long*)(DLT + (size_t)t * DM + o); f32x4 xa = *(const f32x4*)(x + (size_t)t * DM + o); const f32x4 ga = *(const f32x4*)(gate2 + o);
                        xa[0] += bflo((unsigned)d8); xa[1] += bfhi((unsigned)d8); xa[2] += bflo((unsigned)(d8 >> 32)); xa[3] += bfhi((unsigned)(d8 >> 32));
#pragma unroll
                        for (int j = 0; j < 4; ++j) { acc[b][4 * q + j] = fmaf(ga[j], acc[b][4 * q + j], xa[j]); ssp[j] = fmaf(acc[b][4 * q + j], acc[b][4 * q + j], ssp[j]); }
                        if ((q & 1) == 1) asm volatile("" ::: "memory"); }
                const float ss = wave_sum((ssp[0] + ssp[1]) + (ssp[2] + ssp[3])); const float rstd = 1.f / sqrtf(ss * (1.f / DM) + EPS);
#pragma unroll
                for (int b = 0; b < 2; ++b)
#pragma unroll
                    for (int q = 0; q < 8; ++q) { unsigned o = (unsigned)(b * 2048 + q * 256 + lane_f * 4); asm volatile("" : "+v"(o)); const f32x4 fa = *(const f32x4*)(final_g + o); f32x4 oa;
#pragma unroll
                        for (int j = 0; j < 4; ++j) oa[j] = acc[b][4 * q + j] * rstd * fa[j];
                        *(f32x4*)(outp_ + (size_t)t * DM + o) = oa; if ((q & 1) == 1) asm volatile("" ::: "memory"); }
            }
            LDS_WAIT();
#undef LDROW
#undef EIDX
#undef DOTROW
#undef FMAROW
#undef UNPKH
        }
    }
#undef IN
#undef GRID_BAR
}

__global__ void __launch_bounds__(NTHR, 2) fwd(Args a) { fwd_body<0, false>(a); }
#ifdef PROBE_PHASES
#ifndef PROBE_MODE
#define PROBE_MODE 0
#endif
__global__ void __launch_bounds__(NTHR, 2) fwd_p(Args a) { fwd_body<PROBE_MODE, true>(a); }
#endif

#ifdef PROBE_MX
typedef int v8i_t __attribute__((ext_vector_type(8)));
typedef float v16f_t __attribute__((ext_vector_type(16)));
__device__ __forceinline__ unsigned char f8enc(int v) {
    if (v == 0) return 0; int e = 0; int m = v; while (m >= 2) { m >>= 1; ++e; } const int frac = (v << 3 >> e) & 7; return (unsigned char)(((e + 7) << 3) | frac); }
__global__ void probe_mx(float* out) {
    const int l = threadIdx.x, r = l & 31, h = l >> 5;
    float code = 0.f;
    for (int hyp = 0; hyp < 2; ++hyp) {
        unsigned char ab[32], bb[32];
        for (int j = 0; j < 32; ++j) { const int k = hyp == 0 ? 32 * h + j : (j < 16 ? 16 * h + j : 32 + 16 * h + (j - 16));
            ab[j] = f8enc(k == (7 * r + 3) % 64 ? 1 : 0); bb[j] = f8enc(1 + ((k + 3 * r) % 13)); }
        v8i_t A, B;
        for (int d = 0; d < 8; ++d) { A[d] = ab[4 * d] | (ab[4 * d + 1] << 8) | (ab[4 * d + 2] << 16) | (ab[4 * d + 3] << 24); B[d] = bb[4 * d] | (bb[4 * d + 1] << 8) | (bb[4 * d + 2] << 16) | (bb[4 * d + 3] << 24); }
        v16f_t c = {};
        c = __builtin_amdgcn_mfma_scale_f32_32x32x64_f8f6f4(A, B, c, 0, 0, 0, 0x7F7F7F7F, 0, 0x7F7F7F7F);
        bool ok = true;
        for (int g = 0; g < 16; ++g) { const int row = (g & 3) + 8 * (g >> 2) + 4 * h, col = r; const int kk = (7 * row + 3) % 64; const float expect = (float)(1 + ((kk + 3 * col) % 13)); ok = ok && (c[g] == expect); }
        const bool all_ok = __all(ok);
        if (all_ok) code += (hyp == 0 ? 1.f : 2.f);
    }
    if (l == 0) out[0] = 1000.f * (1.f + code);
}
#endif

#ifdef PROBE_STAMP
__global__ void probe_stamp_k(float* out) { if (threadIdx.x == 0) { const double v = (double)att::g_stamp[PROBE_STAMP / 10][PROBE_STAMP % 10] / 262.0; out[0] = 200.f * (float)(int)(v / 200.0 + 0.5); for (int w = 0; w < 8; ++w) for (int k = 0; k < 6; ++k) att::g_stamp[w][k] = 0ull; } }
#endif
#ifdef PROBE_CLK
__global__ void probe_clk_k(const unsigned long long* c, float* out) { if (threadIdx.x == 0) { const double cyc = (double)(c[1] - c[0]), tk = (double)(c[3] - c[2]); out[0] = PROBE_CLK == 1 ? 300.f * (float)(int)(cyc / 264.0 / 300.0 + 0.5) : 4000.f * (float)(int)(cyc / tk / 4.0 + 0.5); } }
#endif
extern "C" void kernel_launch(void* const* d_in, const int* in_sizes, int n_in, void* d_out, int out_size, void* d_ws, size_t ws_size, hipStream_t stream) {
    static int grid = 0;
    if (grid == 0) {
        if (n_in != 21 || in_sizes[0] != SEQ * DM || out_size != SEQ * DM || ws_size < WS_END) {
            fprintf(stderr, "kernel_launch: built for 21 inputs, x/out of %d floats, >= %zu bytes of workspace; got n_in %d, in0 %d, out %d, ws %zu; nothing launched\n", SEQ * DM, (size_t)WS_END, n_in, n_in > 0 ? in_sizes[0] : -1, out_size, ws_size); grid = -1; return; }
        int dev = 0, cus = 0, per_cu = 0;
        if (hipGetDevice(&dev) != hipSuccess || hipDeviceGetAttribute(&cus, hipDeviceAttributeMultiprocessorCount, dev) != hipSuccess) { fprintf(stderr, "kernel_launch: device query failed\n"); grid = -1; return; }
        if (hipFuncSetAttribute((const void*)fwd, hipFuncAttributeMaxDynamicSharedMemorySize, LDS_BYTES) != hipSuccess) { fprintf(stderr, "kernel_launch: hipFuncSetAttribute failed\n"); grid = -1; return; }
        if (hipOccupancyMaxActiveBlocksPerMultiprocessor(&per_cu, (const void*)fwd, NTHR, LDS_BYTES) != hipSuccess || per_cu < 1) fprintf(stderr, "kernel_launch: note: occupancy query reports %d workgroups per CU\n", per_cu);
        (void)hipGetLastError();
        grid = cus;
    }
    if (grid < 0) return;
    if (hipMemsetAsync((char*)d_ws + WS_CTL, 0, CTL_ZERO_BYTES, stream) != hipSuccess) { fprintf(stderr, "kernel_launch: memset failed\n"); return; }
    Args a{};
    for (int i = 0; i < 21; ++i) a.in[i] = (const float*)d_in[i];
    a.out = (float*)d_out; a.ws = (unsigned char*)d_ws;
#if MK_ONE_LAUNCH
    a.ph_lo = 0; a.ph_hi = NPHASE;
    hipLaunchKernelGGL(fwd, dim3(grid), dim3(NTHR), LDS_BYTES, stream, a);
#ifndef PROBE_MODE
#define PROBE_MODE 0
#endif
#ifdef PROBE_PHASES
    for (int p = 0; p < NPHASE; ++p) if ((PROBE_PHASES >> p) & 1) { a.ph_lo = p; a.ph_hi = p + 1; a.probe = PROBE_MODE; hipFuncSetAttribute((const void*)fwd_p, hipFuncAttributeMaxDynamicSharedMemorySize, LDS_BYTES); hipLaunchKernelGGL(fwd_p, dim3(grid), dim3(NTHR), LDS_BYTES, stream, a); }
#endif
#else
    for (int p = 0; p < NPHASE; ++p) { a.ph_lo = p; a.ph_hi = p + 1; hipLaunchKernelGGL(fwd, dim3(grid), dim3(NTHR), LDS_BYTES, stream, a); }
#endif
#ifdef PROBE_STAMP
    hipLaunchKernelGGL(probe_stamp_k, dim3(1), dim3(64), 0, stream, (float*)d_out);
#endif
#ifdef PROBE_UB
    hipFuncSetAttribute((const void*)probe_ub, hipFuncAttributeMaxDynamicSharedMemorySize, LDS_BYTES);
    hipLaunchKernelGGL(probe_ub, dim3(256), dim3(512), LDS_BYTES, stream, (float*)((char*)d_ws + WS_CTL + 600000), 400);
#endif
#ifdef PROBE_CLK
    hipLaunchKernelGGL(probe_clk_k, dim3(1), dim3(64), 0, stream, (const unsigned long long*)((char*)d_ws + WS_CTL + 524288), (float*)d_out);
#endif
#ifdef PROBE_MX
    hipLaunchKernelGGL(probe_mx, dim3(1), dim3(64), 0, stream, (float*)d_out);
#endif
    const hipError_t le = hipPeekAtLastError();
    if (le != hipSuccess) fprintf(stderr, "kernel_launch: launch failed: %s\n", hipGetErrorName(le));
}
```
